# Optimizing an MI355X kernel written in HIP

```python
import math
import jax, jax.numpy as jnp
from jax import lax
import numpy as np

D_MODEL = 1024
BATCH = 16
SEQ = 4096
DEPTH = 1

HG_HEADS = 4
HG_DK = 128
HG_DV = 128
HG_WIDTH = HG_HEADS * HG_DK
HG_CHUNK = 64
DF_HEADS = 4
DF_DQK = 64
DF_DV = 2 * DF_DQK
DF_QK_WIDTH = DF_HEADS * DF_DQK
DF_V_WIDTH = DF_HEADS * DF_DV
Q_BLOCK = 128
ROPE_THETA = 500000.0
ROT_DIM = DF_DQK // 4
N_MEM = 256
MEM_HEADS = 4
MEM_DH = 128
MEM_WIDTH = MEM_HEADS * MEM_DH
N_BRANCH = 3
IN_WIDTH = 4 * HG_WIDTH + 4 * DF_QK_WIDTH + DF_V_WIDTH + MEM_WIDTH
IN_SPLITS = (512, 1024, 1536, 2048, 2304, 2560, 2816, 3072, 3584)
N_GROUPS = 4
EXPERTS_PER_GROUP = 8
N_EXPERTS = N_GROUPS * EXPERTS_PER_GROUP
TOP_K = 2
D_EXPERT = 512
MOE_BLOCK = 128
DEEPNORM_ALPHA = (2.0 * DEPTH) ** 0.25
DEEPNORM_BETA = (8.0 * DEPTH) ** -0.25
LN_EPS = 1e-5
RMS_EPS = 1e-6

kernel_name = 'hybrid_hgrn2_diffattn_memxattn_hmoe_deepnorm'


def _layer_norm(x, gain, bias):
    xf = x.astype(jnp.float32)
    mu = jnp.mean(xf, axis=-1, keepdims=True)
    var = jnp.mean(jnp.square(xf - mu), axis=-1, keepdims=True)
    y = (xf - mu) * lax.rsqrt(var + LN_EPS)
    return (y * gain.astype(jnp.float32) + bias.astype(jnp.float32)).astype(x.dtype)


def _rms_norm(x, gain):
    xf = x.astype(jnp.float32)
    y = xf * lax.rsqrt(jnp.mean(jnp.square(xf), axis=-1, keepdims=True) + RMS_EPS)
    return (y * gain.astype(jnp.float32)).astype(x.dtype)


def _rope_tables(positions):
    inv_freq = ROPE_THETA ** (-jnp.arange(0, ROT_DIM, 2, dtype=jnp.float32) / ROT_DIM)
    ang = positions.astype(jnp.float32)[..., None] * inv_freq
    return jnp.cos(ang)[:, :, None, :], jnp.sin(ang)[:, :, None, :]


def _apply_partial_rope(t, cos, sin):
    half = ROT_DIM // 2
    t1, t2, rest = t[..., :half], t[..., half:ROT_DIM], t[..., ROT_DIM:]
    c = cos.astype(t.dtype)
    s = sin.astype(t.dtype)
    return jnp.concatenate([t1 * c - t2 * s, t2 * c + t1 * s, rest], axis=-1)


def _hgrn2(q, f_pre, v_in, g, lb, norm_gain):
    b_sz, s_len, _ = q.shape
    n_chunks = s_len // HG_CHUNK
    f32 = jnp.float32
    forget = lb + (1.0 - lb) * jax.nn.sigmoid(f_pre.astype(f32))
    log_f = jnp.log(forget)
    k = 1.0 - forget
    qf = jax.nn.silu(q.astype(f32))
    v = v_in.astype(f32)

    def to_chunks(t):
        return t.reshape(b_sz, n_chunks, HG_CHUNK, HG_HEADS, -1).transpose(1, 0, 3, 2, 4)

    causal = jnp.tril(jnp.ones((HG_CHUNK, HG_CHUNK), dtype=bool))[:, :, None]

    def chunk_step(state, inp):
        qc, kc, vc, lfc = inp
        cum = jnp.cumsum(lfc, axis=2)
        o_inter = jnp.einsum('bhtk,bhkv->bhtv', qc * jnp.exp(cum), state)
        rel = cum[:, :, :, None, :] - cum[:, :, None, :, :]
        decay = jnp.where(causal, jnp.exp(jnp.where(causal, rel, 0.0)), 0.0)
        scores = jnp.einsum('bhtsk,bhsk->bhts', qc[:, :, :, None, :] * decay, kc)
        o_intra = jnp.einsum('bhts,bhsv->bhtv', scores, vc)
        last = cum[:, :, -1:, :]
        state = jnp.exp(last[:, :, 0, :])[..., None] * state + jnp.einsum(
            'bhsk,bhsv->bhkv', kc * jnp.exp(last - cum), vc)
        return state, o_inter + o_intra

    state0 = jnp.zeros((b_sz, HG_HEADS, HG_DK, HG_DV), f32)
    _, o = lax.scan(chunk_step, state0,
                    (to_chunks(qf), to_chunks(k), to_chunks(v), to_chunks(log_f)))
    o = o.transpose(1, 0, 3, 2, 4).reshape(b_sz, s_len, HG_HEADS, HG_DV)
    o = _rms_norm(o, norm_gain.reshape(HG_HEADS, HG_DV))
    gate = jax.nn.silu(g.astype(f32)).reshape(b_sz, s_len, HG_HEADS, HG_DV)
    return (o * gate).reshape(b_sz, s_len, HG_WIDTH).astype(q.dtype)


def _diff_attention(q1, q2, k1, k2, v, lam, lam_init, subln_gain):
    b_sz, s_len = q1.shape[0], q1.shape[1]
    q = jnp.stack([q1, q2], axis=1).transpose(0, 1, 3, 2, 4)
    k = jnp.stack([k1, k2], axis=1).transpose(0, 1, 3, 2, 4)
    vt = v.transpose(0, 2, 1, 3)
    scale = DF_DQK ** -0.5
    key_pos = jnp.arange(s_len)

    def query_block(i):
        start = i * Q_BLOCK
        qb = lax.dynamic_slice_in_dim(q, start, Q_BLOCK, axis=3)
        s = jnp.einsum('bmhqd,bmhkd->bmhqk', qb, k).astype(jnp.float32) * scale
        mask = (start + jnp.arange(Q_BLOCK))[:, None] >= key_pos[None, :]
        p = jax.nn.softmax(jnp.where(mask, s, -jnp.inf), axis=-1)
        w = p[:, 0] - lam * p[:, 1]
        return jnp.einsum('bhqk,bhkd->bhqd', w.astype(vt.dtype), vt)

    o = lax.map(query_block, jnp.arange(s_len // Q_BLOCK))
    o = o.transpose(1, 0, 3, 2, 4).reshape(b_sz, s_len, DF_HEADS, DF_DV)
    o = _rms_norm(o, subln_gain) * (1.0 - lam_init)
    return o.reshape(b_sz, s_len, DF_V_WIDTH)


def _memory_attention(q, k, v):
    s = jnp.einsum('bshd,bnhd->bhsn', q, k).astype(jnp.float32) * (MEM_DH ** -0.5)
    p = jax.nn.softmax(s, axis=-1)
    o = jnp.einsum('bhsn,bnhd->bshd', p.astype(v.dtype), v)
    return o.reshape(o.shape[0], o.shape[1], MEM_WIDTH)


def _token_mixer(x, cos, sin, mem, w_in, w_gates, lb, hg_gain, lam_q1, lam_k1, lam_q2, lam_k2,
                 lam_init, df_gain, w_mem_kv, wb_hg, wb_df, wb_mem, w_out):
    b_sz, s_len, _ = x.shape
    f32 = jnp.float32
    proj = x @ w_in
    hq, hf, hi, hg, dq1, dq2, dk1, dk2, dv, mq = jnp.split(proj, IN_SPLITS, axis=-1)

    y_hg = _hgrn2(hq, hf, hi, hg, lb, hg_gain)

    def heads(t, h):
        return t.reshape(t.shape[0], t.shape[1], h, -1)

    def rope(t):
        return _apply_partial_rope(heads(t, DF_HEADS), cos, sin)

    lam = (jnp.exp(jnp.sum(lam_q1.astype(f32) * lam_k1.astype(f32)))
           - jnp.exp(jnp.sum(lam_q2.astype(f32) * lam_k2.astype(f32))) + lam_init)
    y_df = _diff_attention(rope(dq1), rope(dq2), rope(dk1), rope(dk2), heads(dv, DF_HEADS),
                           lam, lam_init, df_gain)

    mk, mv = jnp.split(mem @ w_mem_kv, 2, axis=-1)
    y_mem = _memory_attention(heads(mq, MEM_HEADS), heads(mk, MEM_HEADS), heads(mv, MEM_HEADS))

    gates = jax.nn.sigmoid((x @ w_gates).astype(f32)).astype(x.dtype)
    gates = gates.reshape(b_sz, s_len, N_BRANCH, D_MODEL)
    merged = (gates[:, :, 0] * (y_hg @ wb_hg) + gates[:, :, 1] * (y_df @ wb_df)
              + gates[:, :, 2] * (y_mem @ wb_mem))
    return merged @ w_out


def _hier_moe(h, w_group_router, w_expert_router, w_gate, w_up, w_down):
    b_sz, s_len, d = h.shape
    n_tok = b_sz * s_len
    hf = h.reshape(n_tok, d)
    f32 = jnp.float32
    group_p = jax.nn.softmax((hf @ w_group_router).astype(f32), axis=-1)
    group_idx = jnp.argmax(group_p, axis=-1).astype(jnp.int32)
    group_w = jnp.max(group_p, axis=-1)
    exp_logits = (hf @ w_expert_router).astype(f32).reshape(n_tok, N_GROUPS, EXPERTS_PER_GROUP)
    in_group = jnp.take_along_axis(exp_logits, group_idx[:, None, None], axis=1)[:, 0]
    top_logit, top_local = lax.top_k(in_group, TOP_K)
    top_w = jax.nn.softmax(top_logit, axis=-1) * group_w[:, None]
    expert_id = (group_idx[:, None] * EXPERTS_PER_GROUP + top_local.astype(jnp.int32)).reshape(-1)

    n_assign = n_tok * TOP_K
    token_id = jnp.repeat(jnp.arange(n_tok, dtype=jnp.int32), TOP_K)
    order = jnp.argsort(expert_id)
    sorted_e = expert_id[order]
    counts = jnp.bincount(expert_id, length=N_EXPERTS).astype(jnp.int32)
    padded = (counts + MOE_BLOCK - 1) // MOE_BLOCK * MOE_BLOCK
    padded_end = jnp.cumsum(padded)
    padded_start = padded_end - padded
    seg_start = jnp.cumsum(counts) - counts
    dest = padded_start[sorted_e] + jnp.arange(n_assign, dtype=jnp.int32) - seg_start[sorted_e]
    n_slots = n_assign + N_EXPERTS * MOE_BLOCK
    n_blocks = n_slots // MOE_BLOCK
    slot_tok = jnp.zeros((n_slots,), jnp.int32).at[dest].set(token_id[order])
    slot_w = jnp.zeros((n_slots,), h.dtype).at[dest].set(top_w.reshape(-1)[order].astype(h.dtype))
    block_start = jnp.arange(n_blocks, dtype=jnp.int32) * MOE_BLOCK
    block_expert = jnp.minimum(jnp.searchsorted(padded_end, block_start, side='right'),
                               N_EXPERTS - 1).astype(jnp.int32)

    def expert_block(args):
        tok, w, e = args
        xb = hf[tok]
        act = jax.nn.silu(xb @ w_gate[e]) * (xb @ w_up[e])
        return (act @ w_down[e]) * w[:, None]

    y = lax.map(expert_block, (slot_tok.reshape(n_blocks, MOE_BLOCK),
                               slot_w.reshape(n_blocks, MOE_BLOCK), block_expert))
    out = jnp.zeros_like(hf).at[slot_tok].add(y.reshape(n_slots, d))
    return out.reshape(b_sz, s_len, d)


def _normal(k, shape, scale):
    return jax.random.normal(k, shape, jnp.float32) * scale


def setup_inputs(seed: int = 0) -> dict:
    key = jax.random.key(seed)
    ks = jax.random.split(key, 32)
    L = DEPTH
    beta = DEEPNORM_BETA
    d_inv = D_MODEL ** -0.5
    offset = jax.random.randint(ks[2], (BATCH, 1), 0, 1024, dtype=jnp.int32)
    positions = (offset + jnp.arange(SEQ, dtype=jnp.int32)[None, :]).astype(jnp.int32)
    return {
        'x': _normal(ks[0], (BATCH, SEQ, D_MODEL), 1.0),
        'mem': _normal(ks[1], (BATCH, N_MEM, D_MODEL), 1.0),
        'positions': positions,
        'w_in': _normal(ks[3], (L, D_MODEL, IN_WIDTH), d_inv),
        'w_gates': _normal(ks[4], (L, D_MODEL, N_BRANCH * D_MODEL), d_inv),
        'hgrn_lower_bounds': _normal(ks[5], (L + 1, HG_WIDTH), 0.1),
        'hgrn_norm_gain': 1.0 + _normal(ks[6], (L, HG_WIDTH), 0.02),
        'diff_lambda_q1': _normal(ks[7], (L, DF_DQK), 0.1),
        'diff_lambda_k1': _normal(ks[8], (L, DF_DQK), 0.1),
        'diff_lambda_q2': _normal(ks[9], (L, DF_DQK), 0.1),
        'diff_lambda_k2': _normal(ks[10], (L, DF_DQK), 0.1),
        'diff_subln_gain': 1.0 + _normal(ks[11], (L, DF_DV), 0.02),
        'w_mem_kv': _normal(ks[12], (L, D_MODEL, 2 * MEM_WIDTH), d_inv),
        'w_branch_hgrn': _normal(ks[13], (L, HG_WIDTH, D_MODEL), beta * HG_WIDTH ** -0.5),
        'w_branch_diff': _normal(ks[14], (L, DF_V_WIDTH, D_MODEL), beta * DF_V_WIDTH ** -0.5),
        'w_branch_mem': _normal(ks[15], (L, MEM_WIDTH, D_MODEL), beta * MEM_WIDTH ** -0.5),
        'w_out': _normal(ks[16], (L, D_MODEL, D_MODEL), beta * d_inv),
        'ln1_gain': 1.0 + _normal(ks[17], (L, D_MODEL), 0.02),
        'ln1_bias': _normal(ks[18], (L, D_MODEL), 0.02),
        'w_group_router': _normal(ks[19], (L, D_MODEL, N_GROUPS), d_inv),
        'w_expert_router': _normal(ks[20], (L, D_MODEL, N_EXPERTS), d_inv),
        'w_expert_gate': _normal(ks[21], (L, N_EXPERTS, D_MODEL, D_EXPERT), d_inv),
        'w_expert_up': _normal(ks[22], (L, N_EXPERTS, D_MODEL, D_EXPERT), d_inv),
        'w_expert_down': _normal(ks[23], (L, N_EXPERTS, D_EXPERT, D_MODEL), beta * D_EXPERT ** -0.5),
        'ln2_gain': 1.0 + _normal(ks[24], (L, D_MODEL), 0.02),
        'ln2_bias': _normal(ks[25], (L, D_MODEL), 0.02),
    }


def reference(x, mem, positions, w_in, w_gates, hgrn_lower_bounds, hgrn_norm_gain,
              diff_lambda_q1, diff_lambda_k1, diff_lambda_q2, diff_lambda_k2, diff_subln_gain,
              w_mem_kv, w_branch_hgrn, w_branch_diff, w_branch_mem, w_out, ln1_gain, ln1_bias,
              w_group_router, w_expert_router, w_expert_gate, w_expert_up, w_expert_down,
              ln2_gain, ln2_bias):
    lower = jnp.cumsum(jax.nn.softmax(hgrn_lower_bounds.astype(jnp.float32), axis=0), axis=0)
    cos, sin = _rope_tables(positions)
    for l in range(DEPTH):
        lam_init = 0.8 - 0.6 * math.exp(-0.3 * l)
        mix = _token_mixer(x, cos, sin, mem, w_in[l], w_gates[l], lower[l], hgrn_norm_gain[l],
                           diff_lambda_q1[l], diff_lambda_k1[l], diff_lambda_q2[l], diff_lambda_k2[l],
                           lam_init, diff_subln_gain[l], w_mem_kv[l], w_branch_hgrn[l],
                           w_branch_diff[l], w_branch_mem[l], w_out[l])
        x = _layer_norm(DEEPNORM_ALPHA * x + mix, ln1_gain[l], ln1_bias[l])
        ffn = _hier_moe(x, w_group_router[l], w_expert_router[l], w_expert_gate[l],
                        w_expert_up[l], w_expert_down[l])
        x = _layer_norm(DEEPNORM_ALPHA * x + ffn, ln2_gain[l], ln2_bias[l])
    return x
```

```cpp
#include <hip/hip_runtime.h>
#include <hip/hip_cooperative_groups.h>
#include <cstdio>
#include <cstdint>
namespace cg = cooperative_groups;

#ifndef PHASE_MASK
#define PHASE_MASK 0xffff
#endif
#ifndef MK_ONE_LAUNCH
#define MK_ONE_LAUNCH 0
#endif

typedef unsigned short bf16_t;
typedef short bf16x8 __attribute__((ext_vector_type(8)));
typedef float f32x4 __attribute__((ext_vector_type(4)));
typedef unsigned u32x4 __attribute__((ext_vector_type(4)));
typedef unsigned u32x2 __attribute__((ext_vector_type(2)));

constexpr int NTOK = 65536, DM = 1024, SEQ = 4096, NBATCH = 16, NMEM = 256, NEXP = 32;
constexpr int NSLOT = 2 * NTOK + NEXP * 256;
constexpr float ALPHA = 1.189207115002721f;
constexpr float LN_EPS = 1e-5f, RMS_EPS = 1e-6f;
constexpr float LOG2E = 1.4426950408889634f;
constexpr float QSCALE_DF = 0.125f * LOG2E;
constexpr float QSCALE_MEM = 0.08838834764831845f * LOG2E;
constexpr float LAM_INIT = 0.2f;
constexpr int NPHASE = 11;

constexpr size_t MiB = (size_t)1 << 20;
constexpr size_t WS_CTL = 0;
constexpr size_t WS_SCAL = 1 * MiB;
constexpr size_t WS_ROPE = 2 * MiB;
constexpr size_t WS_RECI = 6 * MiB;
constexpr size_t WS_RECW = 7 * MiB;
constexpr size_t WS_WT_IN = 8 * MiB;
constexpr size_t WS_WT_G = 16 * MiB;
constexpr size_t WS_WT_MKV = 22 * MiB;
constexpr size_t WS_WT_B = 24 * MiB;
constexpr size_t WS_WT_OUT = 27 * MiB;
constexpr size_t WS_WT_R = 29 * MiB;
constexpr size_t WS_WT_GU = 30 * MiB;
constexpr size_t WS_WT_DN = 94 * MiB;
constexpr size_t WS_MEMB = 126 * MiB;
constexpr size_t WS_MKV = 134 * MiB;
constexpr size_t WS_DEC = 142 * MiB;
constexpr size_t WS_LOGITS = 144 * MiB;
constexpr size_t WS_HG = 176 * MiB;
constexpr size_t WS_DQK = 432 * MiB;
constexpr size_t WS_DV = 560 * MiB;
constexpr size_t WS_MQ = 624 * MiB;
constexpr size_t WS_XB = 688 * MiB;
constexpr size_t WS_Y = 816 * MiB;
constexpr size_t WS_END = 1008 * MiB;
constexpr size_t WS_MERGED = WS_HG;
constexpr size_t WS_X1B = WS_DV;
constexpr size_t WS_XS = WS_HG;
constexpr size_t WS_H = 448 * MiB;
constexpr size_t WS_YB = 584 * MiB;
constexpr int LDS_BYTES = 147456;

struct Params { const void* in[26]; float* out; unsigned char* ws; int ph_lo, ph_hi; };

__device__ __forceinline__ float bf2f(bf16_t v) { return __uint_as_float(((unsigned)v) << 16); }
__device__ __forceinline__ bf16_t f2bf(float f) { unsigned u = __float_as_uint(f); u += 0x7fffu + ((u >> 16) & 1u); return (bf16_t)(u >> 16); }
__device__ __forceinline__ unsigned pk2(float lo, float hi) { return (unsigned)f2bf(lo) | ((unsigned)f2bf(hi) << 16); }
__device__ __forceinline__ float sigmoidf_(float x) { return __builtin_amdgcn_rcpf(1.f + __expf(-x)); }
__device__ __forceinline__ float siluf_(float x) { return x * __builtin_amdgcn_rcpf(1.f + __expf(-x)); }
__device__ __forceinline__ float wave_sum(float v) {
#pragma unroll
    for (int o = 1; o < 64; o <<= 1) v += __shfl_xor(v, o);
    return v;
}
__device__ __forceinline__ float wave_max(float v) {
#pragma unroll
    for (int o = 1; o < 64; o <<= 1) v = fmaxf(v, __shfl_xor(v, o));
    return v;
}
#define LDS_WAIT() asm volatile("s_waitcnt lgkmcnt(0)" ::: "memory")

__device__ __forceinline__ void tr_item(const float* W, int K, int N, bf16_t* WT, int dst_row0, float* scr, int k0, int n0, int lane) {
#pragma unroll 8
    for (int i = 0; i < 32; ++i) { const int kk = 2 * i + (lane >> 5); scr[kk * 33 + (lane & 31)] = W[(size_t)(k0 + kk) * N + n0 + (lane & 31)]; }
    LDS_WAIT();
    const int c = lane & 7;
#pragma unroll
    for (int j = 0; j < 4; ++j) { const int n = (lane >> 3) + 8 * j; const float* s = scr + (8 * c) * 33 + n;
        u32x4 o; o.x = pk2(s[0 * 33], s[1 * 33]); o.y = pk2(s[2 * 33], s[3 * 33]); o.z = pk2(s[4 * 33], s[5 * 33]); o.w = pk2(s[6 * 33], s[7 * 33]);
        *(u32x4*)(WT + (size_t)(dst_row0 + n) * K + k0 + 8 * c) = o; }
    LDS_WAIT();
}
__device__ __forceinline__ void tr_job(const float* W, int K, int N, int ne, bf16_t* WT, int erow, int blk, int blkstride, int base, float* scr, int gw, int ngw, int lane) {
    const int nkb = K / 64, nnb = N / 32, per = nkb * nnb, total = per * ne;
    for (int it = gw; it < total; it += ngw) {
        const int e = it / per, r = it % per, kb = r / nnb, nb = r % nnb, n0 = nb * 32;
        tr_item(W + (size_t)e * K * N, K, N, WT, base + e * erow + (n0 / blk) * blkstride + (n0 % blk), scr, kb * 64, n0, lane);
    }
}
__device__ __forceinline__ void sincos_acc(float ang, float& c, float& s) {
    const double a = (double)ang;
    const double q = rint(a * 0.63661977236758134308);
    const double r = fma(-q, 1.57079632679489661923, a) - q * 6.12323399573676603587e-17;
    const double r2 = r * r;
    double sp = 1.0 / 6227020800.0; sp = fma(sp, r2, -1.0 / 39916800.0); sp = fma(sp, r2, 1.0 / 362880.0); sp = fma(sp, r2, -1.0 / 5040.0);
    sp = fma(sp, r2, 1.0 / 120.0); sp = fma(sp, r2, -1.0 / 6.0); sp = fma(sp, r2, 1.0); const double sr = sp * r;
    double cp = 1.0 / 479001600.0; cp = fma(cp, r2, -1.0 / 3628800.0); cp = fma(cp, r2, 1.0 / 40320.0); cp = fma(cp, r2, -1.0 / 720.0);
    cp = fma(cp, r2, 1.0 / 24.0); cp = fma(cp, r2, -0.5); const double cr = fma(cp, r2, 1.0);
    const int qi = ((int)q) & 3;
    const double cc = (qi == 0) ? cr : (qi == 1) ? -sr : (qi == 2) ? -cr : sr;
    const double ss = (qi == 0) ? sr : (qi == 1) ? cr : (qi == 2) ? -sr : -cr;
    c = (float)cc; s = (float)ss;
}
__device__ __forceinline__ void phase_prologue(const Params& p, unsigned char* lds) {
    const int tid = threadIdx.x, lane = tid & 63, wave = tid >> 6;
    const int gw = blockIdx.x * 8 + wave, ngw = gridDim.x * 8;
    const size_t gt = (size_t)blockIdx.x * 512 + tid, ngt = (size_t)gridDim.x * 512;
    unsigned char* ws = p.ws;
    float* scr = (float*)lds + wave * (64 * 33);
    tr_job((const float*)p.in[3], 1024, 4096, 1, (bf16_t*)(ws + WS_WT_IN), 0, 4096, 0, 0, scr, gw, ngw, lane);
    tr_job((const float*)p.in[4], 1024, 3072, 1, (bf16_t*)(ws + WS_WT_G), 0, 3072, 0, 0, scr, gw, ngw, lane);
    tr_job((const float*)p.in[12], 1024, 1024, 1, (bf16_t*)(ws + WS_WT_MKV), 0, 1024, 0, 0, scr, gw, ngw, lane);
    tr_job((const float*)p.in[13], 512, 1024, 1, (bf16_t*)(ws + WS_WT_B), 0, 1024, 0, 0, scr, gw, ngw, lane);
    tr_job((const float*)p.in[14], 512, 1024, 1, (bf16_t*)(ws + WS_WT_B), 0, 1024, 0, 1024, scr, gw, ngw, lane);
    tr_job((const float*)p.in[15], 512, 1024, 1, (bf16_t*)(ws + WS_WT_B), 0, 1024, 0, 2048, scr, gw, ngw, lane);
    tr_job((const float*)p.in[16], 1024, 1024, 1, (bf16_t*)(ws + WS_WT_OUT), 0, 1024, 0, 0, scr, gw, ngw, lane);
    tr_job((const float*)p.in[21], 1024, 512, 32, (bf16_t*)(ws + WS_WT_GU), 1024, 128, 256, 0, scr, gw, ngw, lane);
    tr_job((const float*)p.in[22], 1024, 512, 32, (bf16_t*)(ws + WS_WT_GU), 1024, 128, 256, 128, scr, gw, ngw, lane);
    tr_job((const float*)p.in[23], 512, 1024, 32, (bf16_t*)(ws + WS_WT_DN), 1024, 1024, 0, 0, scr, gw, ngw, lane);
    { const float* wg = (const float*)p.in[19]; const float* we = (const float*)p.in[20]; bf16_t* wr = (bf16_t*)(ws + WS_WT_R);
      for (size_t i = gt; i < 256 * 1024; i += ngt) { const int r = (int)(i >> 10), k = (int)(i & 1023);
          const float v = r < 4 ? wg[k * 4 + r] : (r < 36 ? we[k * 32 + (r - 4)] : 0.f); wr[i] = f2bf(v); } }
    { const float* x = (const float*)p.in[0]; bf16_t* xb = (bf16_t*)(ws + WS_XB);
      for (size_t i = gt; i < (size_t)NTOK * DM / 8; i += ngt) { const f32x4 a = *(const f32x4*)(x + i * 8), b = *(const f32x4*)(x + i * 8 + 4);
          u32x4 o; o.x = pk2(a.x, a.y); o.y = pk2(a.z, a.w); o.z = pk2(b.x, b.y); o.w = pk2(b.z, b.w); *(u32x4*)(xb + i * 8) = o; }
      const float* mm = (const float*)p.in[1]; bf16_t* mb = (bf16_t*)(ws + WS_MEMB);
      for (size_t i = gt; i < (size_t)NBATCH * NMEM * DM / 8; i += ngt) { const f32x4 a = *(const f32x4*)(mm + i * 8), b = *(const f32x4*)(mm + i * 8 + 4);
          u32x4 o; o.x = pk2(a.x, a.y); o.y = pk2(a.z, a.w); o.z = pk2(b.x, b.y); o.w = pk2(b.z, b.w); *(u32x4*)(mb + i * 8) = o; } }
    { const int* pos = (const int*)p.in[2]; float* rope = (float*)(ws + WS_ROPE);
      for (size_t i = gt; i < (size_t)NTOK * 8; i += ngt) { const int tk = (int)(i >> 3), fi = (int)(i & 7);
          const float invf = fi == 0 ? 1.0f : fi == 1 ? 0.1939227432012558f : fi == 2 ? 0.03760603070259094f : fi == 3 ? 0.007292664609849453f : fi == 4 ? 0.0014142135623842478f
                           : fi == 5 ? 0.00027424818836152554f : fi == 6 ? 5.3182957344688475e-05f : 1.0313385246263351e-05f;
          const float ang = (float)pos[tk] * invf; float c, s; sincos_acc(ang, c, s); rope[i * 2] = c; rope[i * 2 + 1] = s; } }
    if (blockIdx.x == 0) {
        float* sc = (float*)(ws + WS_SCAL); const float* lbs = (const float*)p.in[5];
        { const float a = lbs[tid], b = lbs[512 + tid]; sc[tid] = 1.f / (1.f + expf(b - a)); }
        if (wave == 0) {
            const float* q1 = (const float*)p.in[7]; const float* k1 = (const float*)p.in[8]; const float* q2 = (const float*)p.in[9]; const float* k2 = (const float*)p.in[10];
            const float s1 = wave_sum(q1[lane] * k1[lane]), s2 = wave_sum(q2[lane] * k2[lane]);
            if (lane == 0) sc[512] = expf(s1) - expf(s2) + LAM_INIT;
        }
        if (tid < 64) ((int*)(ws + WS_CTL))[tid] = 0;
    }
}

struct SgCtx { int t, wr, wc, fr, fq; unsigned char* sA; unsigned char* sB; };
__device__ __forceinline__ SgCtx sg_ctx(unsigned char* lds) {
    SgCtx c; const int tid = threadIdx.x; c.t = tid & 255; const int team = tid >> 8; const int wid = c.t >> 6, lane = c.t & 63;
    c.wr = wid >> 1; c.wc = wid & 1; c.fr = lane & 15; c.fq = lane >> 4; c.sA = lds + team * 16384; c.sB = c.sA + 8192; return c;
}
__device__ __forceinline__ void sg_zero(f32x4 (&acc)[4][2]) {
#pragma unroll
    for (int m = 0; m < 4; ++m)
#pragma unroll
        for (int n = 0; n < 2; ++n) acc[m][n] = (f32x4){0.f, 0.f, 0.f, 0.f};
}
__device__ __forceinline__ void sg_tile(f32x4 (&acc)[4][2], const bf16_t* a0, const bf16_t* a1, const bf16_t* b0, int K, const SgCtx& c) {
    const int bo = c.t * 16;
#pragma unroll 1
    for (int kt = 0; kt < K; kt += 32) {
        const bf16x8 va0 = *(const bf16x8*)(a0 + kt), va1 = *(const bf16x8*)(a1 + kt), vb0 = *(const bf16x8*)(b0 + kt);
        *(bf16x8*)(c.sA + bo) = va0; *(bf16x8*)(c.sA + bo + 4096) = va1; *(bf16x8*)(c.sB + bo) = vb0;
        __syncthreads();
        bf16x8 At[4], Bt[2];
#pragma unroll
        for (int m = 0; m < 4; ++m) At[m] = *(const bf16x8*)(c.sA + (c.wr * 64 + m * 16 + c.fr) * 64 + c.fq * 16);
#pragma unroll
        for (int n = 0; n < 2; ++n) Bt[n] = *(const bf16x8*)(c.sB + (c.wc * 32 + n * 16 + c.fr) * 64 + c.fq * 16);
#pragma unroll
        for (int m = 0; m < 4; ++m)
#pragma unroll
            for (int n = 0; n < 2; ++n) acc[m][n] = __builtin_amdgcn_mfma_f32_16x16x32_bf16(At[m], Bt[n], acc[m][n], 0, 0, 0);
        __syncthreads();
    }
}
#define SG_R0(c) ((c).t >> 2)
#define SG_C0(c) (((c).t & 3) * 8)
template <class F> __device__ __forceinline__ void sg_store_bf16(const f32x4 (&acc)[4][2], bf16_t* dst, size_t ld, const SgCtx& c, F f) {
    bf16_t* base = dst + (size_t)(c.wr * 64 + c.fq * 4) * ld + c.wc * 32 + c.fr;
#pragma unroll
    for (int m = 0; m < 4; ++m)
#pragma unroll
        for (int j = 0; j < 4; ++j) { bf16_t* pr = base + (size_t)(m * 16 + j) * ld;
#pragma unroll
            for (int n = 0; n < 2; ++n) pr[n * 16] = f2bf(f(acc[m][n][j], c.wc * 32 + n * 16));
            asm volatile("" ::: "memory"); }
}
struct FIdent { __device__ __forceinline__ float operator()(float v, int) const { return v; } };
struct FSilu { __device__ __forceinline__ float operator()(float v, int) const { return siluf_(v); } };
struct FQScale { __device__ __forceinline__ float operator()(float v, int d0) const { return d0 >= 16 ? v * QSCALE_DF : v; } };

__device__ __forceinline__ void phase_proj(const Params& p, unsigned char* lds) {
    const SgCtx c = sg_ctx(lds); const int team = threadIdx.x >> 8; unsigned char* ws = p.ws;
    const bf16_t* XB = (const bf16_t*)(ws + WS_XB); const bf16_t* WT = (const bf16_t*)(ws + WS_WT_IN);
    bf16_t* HG = (bf16_t*)(ws + WS_HG); bf16_t* DQK = (bf16_t*)(ws + WS_DQK); bf16_t* DV = (bf16_t*)(ws + WS_DV); bf16_t* MQ = (bf16_t*)(ws + WS_MQ);
    const int r0 = SG_R0(c), c0 = SG_C0(c);
    { const int ntiles = 512 * 64;
      for (int tb = 2 * blockIdx.x; tb < ntiles; tb += 2 * gridDim.x) {
        const int tile = tb + team; const int tm = tile >> 6, tn = tile & 63;
        f32x4 acc[4][2]; sg_zero(acc);
        sg_tile(acc, XB + (size_t)(tm * 128 + r0) * 1024 + c0, XB + (size_t)(tm * 128 + r0 + 64) * 1024 + c0, WT + (size_t)(tn * 64 + r0) * 1024 + c0, 1024, c);
        const size_t mrow = (size_t)tm * 128; const int n0 = tn * 64;
        if (n0 < 2048) { const int g = n0 >> 9; bf16_t* d = HG + mrow * 2048 + n0; if (g == 0 || g == 3) sg_store_bf16(acc, d, 2048, c, FSilu()); else sg_store_bf16(acc, d, 2048, c, FIdent()); }
        else if (n0 < 3072) { bf16_t* d = DQK + mrow * 1024 + (n0 - 2048); if (n0 < 2560) sg_store_bf16(acc, d, 1024, c, FQScale()); else sg_store_bf16(acc, d, 1024, c, FIdent()); }
        else if (n0 < 3584) sg_store_bf16(acc, DV + mrow * 512 + (n0 - 3072), 512, c, FIdent());
        else sg_store_bf16(acc, MQ + mrow * 512 + (n0 - 3584), 512, c, FIdent());
      } }
    { const bf16_t* MB = (const bf16_t*)(ws + WS_MEMB); const bf16_t* WK = (const bf16_t*)(ws + WS_WT_MKV); bf16_t* MKV = (bf16_t*)(ws + WS_MKV);
      const int ntiles = 32 * 16;
      for (int tb = 2 * blockIdx.x; tb < ntiles; tb += 2 * gridDim.x) {
        const int tile = tb + team; const int tm = tile >> 4, tn = tile & 15;
        f32x4 acc[4][2]; sg_zero(acc);
        sg_tile(acc, MB + (size_t)(tm * 128 + r0) * 1024 + c0, MB + (size_t)(tm * 128 + r0 + 64) * 1024 + c0, WK + (size_t)(tn * 64 + r0) * 1024 + c0, 1024, c);
        sg_store_bf16(acc, MKV + (size_t)tm * 128 * 1024 + tn * 64, 1024, c, FIdent());
      } }
}
__device__ __forceinline__ void phase_rope(const Params& p, unsigned char* lds) {
    unsigned char* ws = p.ws; bf16_t* DQK = (bf16_t*)(ws + WS_DQK); const float* rope = (const float*)(ws + WS_ROPE);
    const size_t gt = (size_t)blockIdx.x * 512 + threadIdx.x, ngt = (size_t)gridDim.x * 512;
    for (size_t i = gt; i < (size_t)NTOK * 128; i += ngt) {
        const size_t m = i >> 7; const int rem = (int)(i & 127), gh = rem >> 3, fi = rem & 7;
        bf16_t* q = DQK + m * 1024 + gh * 64;
        const float t1 = bf2f(q[fi]), t2 = bf2f(q[8 + fi]); const float cs = rope[(m * 8 + fi) * 2], sn = rope[(m * 8 + fi) * 2 + 1];
        float o1 = t1 * cs - t2 * sn, o2 = t2 * cs + t1 * sn;
        if (gh < 8) { o1 *= QSCALE_DF; o2 *= QSCALE_DF; }
        q[fi] = f2bf(o1); q[8 + fi] = f2bf(o2);
    }
}
__device__ __forceinline__ void phase_hgrn_naive(const Params& p, unsigned char* lds) {
    unsigned char* ws = p.ws; const bf16_t* HG = (const bf16_t*)(ws + WS_HG); bf16_t* Y = (bf16_t*)(ws + WS_Y);
    const float* lower0 = (const float*)(ws + WS_SCAL); const float* gain = (const float*)p.in[6];
    float* fs = (float*)lds; float* ks = fs + 128; float* qs = ks + 128; float* part = qs + 128; float* red = part + 512;
    const int tid = threadIdx.x, v = tid & 127, kq = tid >> 7, lane = tid & 63, wave = tid >> 6;
    for (int bh = blockIdx.x; bh < 64; bh += gridDim.x) {
        const int b = bh >> 2, h = bh & 3;
        float S[32];
#pragma unroll
        for (int i = 0; i < 32; ++i) S[i] = 0.f;
        const float lbv = lower0[h * 128 + v], gn = gain[h * 128 + v];
        for (int t = 0; t < SEQ; ++t) {
            const size_t m = (size_t)b * SEQ + t; const bf16_t* row = HG + m * 2048 + h * 128;
            if (tid < 128) { const float fp = bf2f(row[512 + v]); const float f = lbv + (1.f - lbv) * sigmoidf_(fp); fs[v] = f; ks[v] = 1.f - f; qs[v] = bf2f(row[v]); }
            const float vv = bf2f(row[1024 + v]);
            __syncthreads();
            float o = 0.f;
#pragma unroll
            for (int i = 0; i < 32; ++i) { const int k = kq * 32 + i; S[i] = fs[k] * S[i] + ks[k] * vv; o += qs[k] * S[i]; }
            part[kq * 128 + v] = o;
            __syncthreads();
            float ot = 0.f;
            if (tid < 128) { ot = part[v] + part[128 + v] + part[256 + v] + part[384 + v]; const float sq = wave_sum(ot * ot); if (lane == 0) red[wave] = sq; }
            __syncthreads();
            if (tid < 128) { const float ms = (red[0] + red[1]) * (1.f / 128.f); const float y = ot * rsqrtf(ms + RMS_EPS) * gn * bf2f(row[1536 + v]); Y[m * 1536 + h * 128 + v] = f2bf(y); }
        }
        __syncthreads();
    }
}
template <bool DIFF>
__device__ __forceinline__ void phase_attn_naive(const Params& p, unsigned char* lds) {
    constexpr int DQ = DIFF ? 64 : 128, NMAP = DIFF ? 2 : 1;
    unsigned char* ws = p.ws; const int tid = threadIdx.x, lane = tid & 63, wave = tid >> 6;
    float* wbuf = (float*)lds + wave * 4096; float* qbuf = (float*)(lds + 131072) + wave * 128;
    const bf16_t* DQK = (const bf16_t*)(ws + WS_DQK); const bf16_t* DV = (const bf16_t*)(ws + WS_DV); const bf16_t* MQ = (const bf16_t*)(ws + WS_MQ); const bf16_t* MKV = (const bf16_t*)(ws + WS_MKV);
    bf16_t* Y = (bf16_t*)(ws + WS_Y); const float lam = ((const float*)(ws + WS_SCAL))[512]; const float* sub_gain = (const float*)p.in[11];
    const int gw = blockIdx.x * 8 + wave, ngw = gridDim.x * 8; const int nrows = NTOK * 4;
    for (int r = gw; r < nrows; r += ngw) {
        int b, h, nk; size_t m; const bf16_t *Q, *K, *V; int kp, vp;
        if (DIFF) { const int bh = r >> 12, i = r & 4095; b = bh >> 2; h = bh & 3; m = (size_t)b * SEQ + i; nk = i + 1;
            Q = DQK + m * 1024 + h * 64; K = DQK + (size_t)b * SEQ * 1024 + 512 + h * 64; kp = 1024; V = DV + (size_t)b * SEQ * 512 + h * 128; vp = 512; }
        else { m = (size_t)(r >> 2); h = r & 3; b = (int)(m >> 12); nk = NMEM;
            Q = MQ + m * 512 + h * 128; K = MKV + (size_t)b * NMEM * 1024 + h * 128; kp = 1024; V = MKV + (size_t)b * NMEM * 1024 + 512 + h * 128; vp = 1024; }
        if (DIFF) { qbuf[lane] = bf2f(Q[lane]); qbuf[64 + lane] = bf2f(Q[256 + lane]); }
        else { qbuf[lane] = bf2f(Q[lane]) * QSCALE_MEM; qbuf[64 + lane] = bf2f(Q[64 + lane]) * QSCALE_MEM; }
        LDS_WAIT();
        float mx[NMAP], ls[NMAP];
#pragma unroll
        for (int a = 0; a < NMAP; ++a) { mx[a] = -1e30f; ls[a] = 0.f; }
        for (int j = lane; j < nk; j += 64) {
#pragma unroll
            for (int a = 0; a < NMAP; ++a) {
                const bf16_t* kr = K + (size_t)j * kp + a * 256; float s = 0.f;
#pragma unroll 2
                for (int cc = 0; cc < DQ / 8; ++cc) { const bf16x8 kv = *(const bf16x8*)(kr + cc * 8);
#pragma unroll
                    for (int e = 0; e < 8; ++e) s += qbuf[a * 64 + cc * 8 + e] * bf2f((bf16_t)kv[e]); }
                if (s > mx[a]) { ls[a] = ls[a] * exp2f(mx[a] - s) + 1.f; mx[a] = s; } else ls[a] += exp2f(s - mx[a]);
            }
        }
        float M[NMAP], Linv[NMAP];
#pragma unroll
        for (int a = 0; a < NMAP; ++a) { M[a] = wave_max(mx[a]); const float l = wave_sum(ls[a] * exp2f(mx[a] - M[a])); Linv[a] = 1.f / l; }
        for (int j = lane; j < nk; j += 64) {
            float w = 0.f;
#pragma unroll
            for (int a = 0; a < NMAP; ++a) {
                const bf16_t* kr = K + (size_t)j * kp + a * 256; float s = 0.f;
#pragma unroll 2
                for (int cc = 0; cc < DQ / 8; ++cc) { const bf16x8 kv = *(const bf16x8*)(kr + cc * 8);
#pragma unroll
                    for (int e = 0; e < 8; ++e) s += qbuf[a * 64 + cc * 8 + e] * bf2f((bf16_t)kv[e]); }
                const float pj = exp2f(s - M[a]) * Linv[a]; w = (a == 0) ? pj : w - lam * pj;
            }
            wbuf[j] = w;
        }
        LDS_WAIT();
        float a0 = 0.f, a1 = 0.f; const bf16_t* vb = V + 2 * lane;
        for (int j = 0; j < nk; ++j) { const float w = wbuf[j]; const unsigned u = *(const unsigned*)(vb + (size_t)j * vp); a0 += w * __uint_as_float(u << 16); a1 += w * __uint_as_float(u & 0xffff0000u); }
        if (DIFF) { const float ms = wave_sum(a0 * a0 + a1 * a1) * (1.f / 128.f); const float rs = rsqrtf(ms + RMS_EPS) * (1.f - LAM_INIT);
            *(unsigned*)(Y + m * 1536 + 512 + h * 128 + 2 * lane) = pk2(a0 * rs * sub_gain[2 * lane], a1 * rs * sub_gain[2 * lane + 1]); }
        else *(unsigned*)(Y + m * 1536 + 1024 + h * 128 + 2 * lane) = pk2(a0, a1);
        LDS_WAIT();
    }
}
__device__ __forceinline__ void phase_merge(const Params& p, unsigned char* lds) {
    const SgCtx c = sg_ctx(lds); const int team = threadIdx.x >> 8; unsigned char* ws = p.ws;
    const bf16_t* XB = (const bf16_t*)(ws + WS_XB); const bf16_t* WG = (const bf16_t*)(ws + WS_WT_G); const bf16_t* Y = (const bf16_t*)(ws + WS_Y); const bf16_t* WB = (const bf16_t*)(ws + WS_WT_B);
    bf16_t* MG = (bf16_t*)(ws + WS_MERGED); const int r0 = SG_R0(c), c0 = SG_C0(c);
    const int ntiles = 512 * 16;
    for (int tb = 2 * blockIdx.x; tb < ntiles; tb += 2 * gridDim.x) {
        const int tile = tb + team; const int tm = tile >> 4, tn = tile & 15;
        f32x4 sum[4][2]; sg_zero(sum);
#pragma unroll 1
        for (int br = 0; br < 3; ++br) {
            f32x4 ag[4][2]; sg_zero(ag);
            sg_tile(ag, XB + (size_t)(tm * 128 + r0) * 1024 + c0, XB + (size_t)(tm * 128 + r0 + 64) * 1024 + c0, WG + (size_t)(br * 1024 + tn * 64 + r0) * 1024 + c0, 1024, c);
            f32x4 ay[4][2]; sg_zero(ay);
            sg_tile(ay, Y + (size_t)(tm * 128 + r0) * 1536 + br * 512 + c0, Y + (size_t)(tm * 128 + r0 + 64) * 1536 + br * 512 + c0, WB + (size_t)(br * 1024 + tn * 64 + r0) * 512 + c0, 512, c);
#pragma unroll
            for (int m = 0; m < 4; ++m)
#pragma unroll
                for (int n = 0; n < 2; ++n)
#pragma unroll
                    for (int j = 0; j < 4; ++j) sum[m][n][j] += sigmoidf_(ag[m][n][j]) * ay[m][n][j];
        }
        sg_store_bf16(sum, MG + (size_t)tm * 128 * 1024 + tn * 64, 1024, c, FIdent());
    }
}
__device__ __forceinline__ void phase_wout(const Params& p, unsigned char* lds) {
    const SgCtx c = sg_ctx(lds); const int team = threadIdx.x >> 8; unsigned char* ws = p.ws;
    const bf16_t* MG = (const bf16_t*)(ws + WS_MERGED); const bf16_t* WO = (const bf16_t*)(ws + WS_WT_OUT); const float* x = (const float*)p.in[0]; float* pre = p.out;
    const int r0 = SG_R0(c), c0 = SG_C0(c); const int ntiles = 512 * 16;
    for (int tb = 2 * blockIdx.x; tb < ntiles; tb += 2 * gridDim.x) {
        const int tile = tb + team; const int tm = tile >> 4, tn = tile & 15;
        f32x4 acc[4][2]; sg_zero(acc);
        sg_tile(acc, MG + (size_t)(tm * 128 + r0) * 1024 + c0, MG + (size_t)(tm * 128 + r0 + 64) * 1024 + c0, WO + (size_t)(tn * 64 + r0) * 1024 + c0, 1024, c);
        { const size_t off = ((size_t)tm * 128 + c.wr * 64 + c.fq * 4) * 1024 + tn * 64 + c.wc * 32 + c.fr;
#pragma unroll
          for (int m = 0; m < 4; ++m)
#pragma unroll
              for (int j = 0; j < 4; ++j) { const size_t o2 = off + (size_t)(m * 16 + j) * 1024;
#pragma unroll
                  for (int n = 0; n < 2; ++n) pre[o2 + n * 16] = ALPHA * x[o2 + n * 16] + acc[m][n][j];
                  asm volatile("" ::: "memory"); } }
    }
}
__device__ __forceinline__ void phase_ln1_route(const Params& p, unsigned char* lds) {
    unsigned char* ws = p.ws; const int tid = threadIdx.x, lane = tid & 63, wave = tid >> 6;
    float* x1f = p.out; bf16_t* x1b = (bf16_t*)(ws + WS_X1B); const float* g1 = (const float*)p.in[17]; const float* b1 = (const float*)p.in[18];
    const float* wg = (const float*)p.in[19]; const float* we = (const float*)p.in[20];
    int* cnt = (int*)(ws + WS_CTL); int* reci = (int*)(ws + WS_RECI); float* recw = (float*)(ws + WS_RECW);
    const int gw = blockIdx.x * 8 + wave, ngw = gridDim.x * 8;
    for (int t = gw; t < NTOK; t += ngw) {
        float* row = x1f + (size_t)t * 1024; f32x4 v[4]; float s = 0.f;
#pragma unroll
        for (int j = 0; j < 4; ++j) { v[j] = *(const f32x4*)(row + 256 * j + 4 * lane); s += (v[j].x + v[j].y) + (v[j].z + v[j].w); }
        const float mean = wave_sum(s) * (1.f / 1024.f); float s2 = 0.f;
#pragma unroll
        for (int j = 0; j < 4; ++j) { v[j] = v[j] - mean; s2 += (v[j].x * v[j].x + v[j].y * v[j].y) + (v[j].z * v[j].z + v[j].w * v[j].w); }
        const float rstd = rsqrtf(wave_sum(s2) * (1.f / 1024.f) + LN_EPS);
#pragma unroll
        for (int j = 0; j < 4; ++j) { const f32x4 gg = *(const f32x4*)(g1 + 256 * j + 4 * lane), bb = *(const f32x4*)(b1 + 256 * j + 4 * lane);
            v[j] = v[j] * rstd * gg + bb; *(f32x4*)(row + 256 * j + 4 * lane) = v[j];
            u32x2 o; o.x = pk2(v[j].x, v[j].y); o.y = pk2(v[j].z, v[j].w); *(u32x2*)(x1b + (size_t)t * 1024 + 256 * j + 4 * lane) = o; }
        float lg[36];
#pragma unroll
        for (int i = 0; i < 36; ++i) lg[i] = 0.f;
#pragma unroll
        for (int j = 0; j < 4; ++j)
#pragma unroll
            for (int e = 0; e < 4; ++e) { const int k = 256 * j + 4 * lane + e; const float xv = v[j][e];
                const f32x4 g4 = *(const f32x4*)(wg + k * 4);
#pragma unroll
                for (int q = 0; q < 4; ++q) lg[q] += xv * g4[q];
#pragma unroll
                for (int q8 = 0; q8 < 8; ++q8) { const f32x4 e4 = *(const f32x4*)(we + k * 32 + q8 * 4);
#pragma unroll
                    for (int q = 0; q < 4; ++q) lg[4 + q8 * 4 + q] += xv * e4[q]; } }
#pragma unroll
        for (int i = 0; i < 36; ++i) lg[i] = wave_sum(lg[i]);
        int gi = 0; float gm = lg[0];
#pragma unroll
        for (int q = 1; q < 4; ++q) if (lg[q] > gm) { gm = lg[q]; gi = q; }
        float gs = 0.f;
#pragma unroll
        for (int q = 0; q < 4; ++q) gs += expf(lg[q] - gm);
        const float group_w = 1.f / gs;
        float ig[8];
#pragma unroll
        for (int i = 0; i < 8; ++i) ig[i] = gi == 0 ? lg[4 + i] : gi == 1 ? lg[12 + i] : gi == 2 ? lg[20 + i] : lg[28 + i];
        int i1 = 0; float l1 = ig[0];
#pragma unroll
        for (int i = 1; i < 8; ++i) if (ig[i] > l1) { l1 = ig[i]; i1 = i; }
        int i2 = -1; float l2 = -3.0e38f;
#pragma unroll
        for (int i = 0; i < 8; ++i) if (i != i1 && ig[i] > l2) { l2 = ig[i]; i2 = i; }
        const float e2 = expf(l2 - l1); const float w1 = group_w / (1.f + e2), w2 = group_w * e2 / (1.f + e2);
        if (lane == 0) { const int ea = gi * 8 + i1, eb = gi * 8 + i2; const int pa = atomicAdd(cnt + ea, 1), pb = atomicAdd(cnt + eb, 1);
            reci[t * 4 + 0] = ea; reci[t * 4 + 1] = eb; reci[t * 4 + 2] = pa; reci[t * 4 + 3] = pb; recw[t * 2] = w1; recw[t * 2 + 1] = w2; }
    }
}
__device__ __forceinline__ int expert_layout(const int* cnt, int lane, int& tiles, int& endi) {
    tiles = (lane < 32) ? ((cnt[lane] + 255) >> 8) : 0; int x = tiles;
#pragma unroll
    for (int o = 1; o < 32; o <<= 1) { const int y = __shfl_up(x, o); if (lane >= o) x += y; }
    endi = x; return __shfl(x, 31);
}
__device__ __forceinline__ int expert_of_tile(int rt, int lane, int endi) { return __popcll(__ballot(lane < 32 && endi <= rt)); }
__device__ __forceinline__ void phase_dispatch(const Params& p, unsigned char* lds) {
    unsigned char* ws = p.ws; const int tid = threadIdx.x, lane = tid & 63, wave = tid >> 6;
    const int* cnt = (const int*)(ws + WS_CTL); int* reci = (int*)(ws + WS_RECI); const bf16_t* x1b = (const bf16_t*)(ws + WS_X1B); bf16_t* xs = (bf16_t*)(ws + WS_XS);
    int tiles, endi; expert_layout(cnt, lane, tiles, endi); const int base = endi - tiles;
    const int gw = blockIdx.x * 8 + wave, ngw = gridDim.x * 8;
    for (int t = gw; t < NTOK; t += ngw) {
        const int ea = reci[t * 4], eb = reci[t * 4 + 1], pa = reci[t * 4 + 2], pb = reci[t * 4 + 3];
        const int sa = __shfl(base, ea) * 256 + pa, sb = __shfl(base, eb) * 256 + pb;
        const u32x4 a = *(const u32x4*)(x1b + (size_t)t * 1024 + lane * 8), b = *(const u32x4*)(x1b + (size_t)t * 1024 + 512 + lane * 8);
        *(u32x4*)(xs + (size_t)sa * 1024 + lane * 8) = a; *(u32x4*)(xs + (size_t)sa * 1024 + 512 + lane * 8) = b;
        *(u32x4*)(xs + (size_t)sb * 1024 + lane * 8) = a; *(u32x4*)(xs + (size_t)sb * 1024 + 512 + lane * 8) = b;
        if (lane == 0) { reci[t * 4 + 2] = sa; reci[t * 4 + 3] = sb; }
    }
}
__device__ __forceinline__ void phase_exp_gu(const Params& p, unsigned char* lds) {
    const SgCtx c = sg_ctx(lds); const int team = threadIdx.x >> 8, lane = threadIdx.x & 63; unsigned char* ws = p.ws;
    const int* cnt = (const int*)(ws + WS_CTL); const bf16_t* XS = (const bf16_t*)(ws + WS_XS); const bf16_t* WGU = (const bf16_t*)(ws + WS_WT_GU); bf16_t* H = (bf16_t*)(ws + WS_H);
    int tiles, endi; const int nt256 = expert_layout(cnt, lane, tiles, endi);
    const int r0 = SG_R0(c), c0 = SG_C0(c); const int ntiles = nt256 * 2 * 8;
    for (int tb = 2 * blockIdx.x; tb < ntiles; tb += 2 * gridDim.x) {
        int tile = tb + team; const bool valid = tile < ntiles; if (!valid) tile = ntiles - 1;
        const int rt = tile >> 3, tn = tile & 7; const int e = expert_of_tile(rt >> 1, lane, endi);
        const bf16_t* a0 = XS + (size_t)(rt * 128 + r0) * 1024 + c0; const bf16_t* a1 = a0 + (size_t)64 * 1024;
        const bf16_t* bg = WGU + (size_t)(e * 1024 + (tn >> 1) * 256 + (tn & 1) * 64 + r0) * 1024 + c0;
        f32x4 ag[4][2]; sg_zero(ag); sg_tile(ag, a0, a1, bg, 1024, c);
        f32x4 au[4][2]; sg_zero(au); sg_tile(au, a0, a1, bg + (size_t)128 * 1024, 1024, c);
#pragma unroll
        for (int m = 0; m < 4; ++m)
#pragma unroll
            for (int n = 0; n < 2; ++n)
#pragma unroll
                for (int j = 0; j < 4; ++j) ag[m][n][j] = siluf_(ag[m][n][j]) * au[m][n][j];
        if (valid) sg_store_bf16(ag, H + (size_t)rt * 128 * 512 + tn * 64, 512, c, FIdent());
    }
}
__device__ __forceinline__ void phase_exp_dn(const Params& p, unsigned char* lds) {
    const SgCtx c = sg_ctx(lds); const int team = threadIdx.x >> 8, lane = threadIdx.x & 63; unsigned char* ws = p.ws;
    const int* cnt = (const int*)(ws + WS_CTL); const bf16_t* H = (const bf16_t*)(ws + WS_H); const bf16_t* WDN = (const bf16_t*)(ws + WS_WT_DN); bf16_t* YB = (bf16_t*)(ws + WS_YB);
    int tiles, endi; const int nt256 = expert_layout(cnt, lane, tiles, endi);
    const int r0 = SG_R0(c), c0 = SG_C0(c); const int ntiles = nt256 * 2 * 16;
    for (int tb = 2 * blockIdx.x; tb < ntiles; tb += 2 * gridDim.x) {
        int tile = tb + team; const bool valid = tile < ntiles; if (!valid) tile = ntiles - 1;
        const int rt = tile >> 4, tn = tile & 15; const int e = expert_of_tile(rt >> 1, lane, endi);
        const bf16_t* a0 = H + (size_t)(rt * 128 + r0) * 512 + c0; const bf16_t* b0 = WDN + (size_t)(e * 1024 + tn * 64 + r0) * 512 + c0;
        f32x4 acc[4][2]; sg_zero(acc); sg_tile(acc, a0, a0 + (size_t)64 * 512, b0, 512, c);
        if (valid) sg_store_bf16(acc, YB + (size_t)rt * 128 * 1024 + tn * 64, 1024, c, FIdent());
    }
}
__device__ __forceinline__ void phase_final(const Params& p, unsigned char* lds) {
    unsigned char* ws = p.ws; const int tid = threadIdx.x, lane = tid & 63, wave = tid >> 6;
    float* out = p.out; const bf16_t* YB = (const bf16_t*)(ws + WS_YB); const int* reci = (const int*)(ws + WS_RECI); const float* recw = (const float*)(ws + WS_RECW);
    const float* g2 = (const float*)p.in[24]; const float* b2 = (const float*)p.in[25];
    const int gw = blockIdx.x * 8 + wave, ngw = gridDim.x * 8;
    for (int t = gw; t < NTOK; t += ngw) {
        float* row = out + (size_t)t * 1024; const int sa = reci[t * 4 + 2], sb = reci[t * 4 + 3]; const float wa = recw[t * 2], wb = recw[t * 2 + 1];
        f32x4 v[4]; float s = 0.f;
#pragma unroll
        for (int j = 0; j < 4; ++j) { const f32x4 xv = *(const f32x4*)(row + 256 * j + 4 * lane);
            const u32x2 ya = *(const u32x2*)(YB + (size_t)sa * 1024 + 256 * j + 4 * lane), yb = *(const u32x2*)(YB + (size_t)sb * 1024 + 256 * j + 4 * lane);
            f32x4 fa, fb; fa.x = __uint_as_float(ya.x << 16); fa.y = __uint_as_float(ya.x & 0xffff0000u); fa.z = __uint_as_float(ya.y << 16); fa.w = __uint_as_float(ya.y & 0xffff0000u);
            fb.x = __uint_as_float(yb.x << 16); fb.y = __uint_as_float(yb.x & 0xffff0000u); fb.z = __uint_as_float(yb.y << 16); fb.w = __uint_as_float(yb.y & 0xffff0000u);
            v[j] = xv * ALPHA + fa * wa + fb * wb; s += (v[j].x + v[j].y) + (v[j].z + v[j].w); }
        const float mean = wave_sum(s) * (1.f / 1024.f); float s2 = 0.f;
#pragma unroll
        for (int j = 0; j < 4; ++j) { v[j] = v[j] - mean; s2 += (v[j].x * v[j].x + v[j].y * v[j].y) + (v[j].z * v[j].z + v[j].w * v[j].w); }
        const float rstd = rsqrtf(wave_sum(s2) * (1.f / 1024.f) + LN_EPS);
#pragma unroll
        for (int j = 0; j < 4; ++j) { const f32x4 gg = *(const f32x4*)(g2 + 256 * j + 4 * lane), bb = *(const f32x4*)(b2 + 256 * j + 4 * lane);
            *(f32x4*)(row + 256 * j + 4 * lane) = v[j] * rstd * gg + bb; }
    }
}

template <bool COOP>
__global__ void __launch_bounds__(512, 2) k_fwd(Params p) {
    extern __shared__ __attribute__((aligned(16))) unsigned char lds[];
    const int lo = p.ph_lo, hi = p.ph_hi;
#define RUN_PHASE(k, call) do { if (((PHASE_MASK >> (k)) & 1) && lo <= (k) && (k) < hi) { call; if (COOP && (k) + 1 < hi) { cg::this_grid().sync(); } } } while (0)
    RUN_PHASE(0, phase_prologue(p, lds));
    RUN_PHASE(1, phase_proj(p, lds));
    RUN_PHASE(2, phase_rope(p, lds));
    RUN_PHASE(3, (phase_hgrn_naive(p, lds), __syncthreads(), phase_attn_naive<true>(p, lds), __syncthreads(), phase_attn_naive<false>(p, lds)));
    RUN_PHASE(4, phase_merge(p, lds));
    RUN_PHASE(5, phase_wout(p, lds));
    RUN_PHASE(6, phase_ln1_route(p, lds));
    RUN_PHASE(7, phase_dispatch(p, lds));
    RUN_PHASE(8, phase_exp_gu(p, lds));
    RUN_PHASE(9, phase_exp_dn(p, lds));
    RUN_PHASE(10, phase_final(p, lds));
#undef RUN_PHASE
}

extern "C" void kernel_launch(void* const* d_in, const int* in_sizes, int n_in, void* d_out, int out_size, void* d_ws, size_t ws_size, hipStream_t stream) {
    static int grid = 0;
    if (grid == 0) {
        if (n_in != 26 || in_sizes[0] != NTOK * DM || out_size != NTOK * DM || ws_size < WS_END) {
            fprintf(stderr, "kernel_launch: unexpected shapes: n_in %d in0 %d out %d ws %zu (need >= %zu)\n", n_in, n_in > 0 ? in_sizes[0] : -1, out_size, ws_size, (size_t)WS_END); grid = -1; return; }
        int dev = 0, cus = 0, per_cu = 0;
        hipGetDevice(&dev); hipDeviceGetAttribute(&cus, hipDeviceAttributeMultiprocessorCount, dev);
        if (MK_ONE_LAUNCH) {
            hipFuncSetAttribute((const void*)k_fwd<true>, hipFuncAttributeMaxDynamicSharedMemorySize, LDS_BYTES);
            hipOccupancyMaxActiveBlocksPerMultiprocessor(&per_cu, (const void*)k_fwd<true>, 512, LDS_BYTES);
            if (per_cu < 1) { fprintf(stderr, "kernel_launch: occupancy query says %d blocks/CU\n", per_cu); per_cu = 1; }
            grid = cus * 1;
        } else {
            hipFuncSetAttribute((const void*)k_fwd<false>, hipFuncAttributeMaxDynamicSharedMemorySize, LDS_BYTES);
            grid = cus;
        }
        (void)hipGetLastError();
    }
    if (grid < 0) return;
    Params p{};
    for (int i = 0; i < 26; ++i) p.in[i] = d_in[i];
    p.out = (float*)d_out; p.ws = (unsigned char*)d_ws;
    if (MK_ONE_LAUNCH) {
        p.ph_lo = 0; p.ph_hi = NPHASE;
        void* args[] = {&p};
        hipError_t e = hipLaunchCooperativeKernel((const void*)k_fwd<true>, dim3(grid), dim3(512), args, LDS_BYTES, stream);
        if (e != hipSuccess) fprintf(stderr, "cooperative launch failed: %s (grid %d)\n", hipGetErrorString(e), grid);
    } else {
        for (int ph = 0; ph < NPHASE; ++ph) { p.ph_lo = ph; p.ph_hi = ph + 1; hipLaunchKernelGGL(k_fwd<false>, dim3(grid), dim3(512), LDS_BYTES, stream, p); }
    }
}
```

```cpp
#include <hip/hip_runtime.h>
#include <hip/hip_cooperative_groups.h>
#include <cstdio>
#include <cstdint>
namespace cg = cooperative_groups;

#ifndef PHASE_MASK
#define PHASE_MASK 0xffff
#endif
#ifndef MK_ONE_LAUNCH
#define MK_ONE_LAUNCH 1
#endif

typedef unsigned short bf16_t;
typedef short bf16x8 __attribute__((ext_vector_type(8)));
typedef float f32x4 __attribute__((ext_vector_type(4)));
typedef unsigned u32x4 __attribute__((ext_vector_type(4)));
typedef unsigned u32x2 __attribute__((ext_vector_type(2)));

constexpr int NTOK = 65536, DM = 1024, SEQ = 4096, NBATCH = 16, NMEM = 256, NEXP = 32;
constexpr int NSLOT = 2 * NTOK + NEXP * 256;
constexpr float ALPHA = 1.189207115002721f;
constexpr float LN_EPS = 1e-5f, RMS_EPS = 1e-6f;
constexpr float LOG2E = 1.4426950408889634f;
constexpr float QSCALE_DF = 0.125f * LOG2E;
constexpr float QSCALE_MEM = 0.08838834764831845f * LOG2E;
constexpr float LAM_INIT = 0.2f;
constexpr int NPHASE = 11;

constexpr size_t MiB = (size_t)1 << 20;
constexpr size_t WS_CTL = 0;
constexpr size_t WS_SCAL = 1 * MiB;
constexpr size_t WS_ROPE = 2 * MiB;
constexpr size_t WS_RECI = 6 * MiB;
constexpr size_t WS_RECW = 7 * MiB;
constexpr size_t WS_WT_IN = 8 * MiB;
constexpr size_t WS_WT_G = 16 * MiB;
constexpr size_t WS_WT_MKV = 22 * MiB;
constexpr size_t WS_WT_B = 24 * MiB;
constexpr size_t WS_WT_OUT = 27 * MiB;
constexpr size_t WS_WT_R = 29 * MiB;
constexpr size_t WS_WT_GU = 30 * MiB;
constexpr size_t WS_WT_DN = 94 * MiB;
constexpr size_t WS_MEMB = 126 * MiB;
constexpr size_t WS_MKV = 134 * MiB;
constexpr size_t WS_DEC = 142 * MiB;
constexpr size_t WS_LOGITS = 144 * MiB;
constexpr size_t WS_HG = 176 * MiB;
constexpr size_t WS_DQK = 432 * MiB;
constexpr size_t WS_DV = 560 * MiB;
constexpr size_t WS_MQ = 624 * MiB;
constexpr size_t WS_XB = 688 * MiB;
constexpr size_t WS_Y = 816 * MiB;
constexpr size_t WS_END = 1008 * MiB;
constexpr size_t WS_MERGED = WS_HG;
constexpr size_t WS_X1B = WS_DV;
constexpr size_t WS_XS = WS_HG;
constexpr size_t WS_H = 448 * MiB;
constexpr size_t WS_YB = 584 * MiB;
constexpr int LDS_BYTES = 147456;

struct Params { const void* in[26]; float* out; unsigned char* ws; int ph_lo, ph_hi; };

__device__ __forceinline__ float bf2f(bf16_t v) { return __uint_as_float(((unsigned)v) << 16); }
__device__ __forceinline__ bf16_t f2bf(float f) { unsigned u = __float_as_uint(f); u += 0x7fffu + ((u >> 16) & 1u); return (bf16_t)(u >> 16); }
__device__ __forceinline__ unsigned pk2(float lo, float hi) { return (unsigned)f2bf(lo) | ((unsigned)f2bf(hi) << 16); }
__device__ __forceinline__ float sigmoidf_(float x) { return __builtin_amdgcn_rcpf(1.f + __expf(-x)); }
__device__ __forceinline__ float siluf_(float x) { return x * __builtin_amdgcn_rcpf(1.f + __expf(-x)); }
__device__ __forceinline__ float wave_sum(float v) {
#pragma unroll
    for (int o = 1; o < 64; o <<= 1) v += __shfl_xor(v, o);
    return v;
}
__device__ __forceinline__ float wave_max(float v) {
#pragma unroll
    for (int o = 1; o < 64; o <<= 1) v = fmaxf(v, __shfl_xor(v, o));
    return v;
}
#define LDS_WAIT() asm volatile("s_waitcnt lgkmcnt(0)" ::: "memory")

__device__ __forceinline__ void tr_item(const float* W, int K, int N, bf16_t* WT, int dst_row0, float* scr, int k0, int n0, int lane) {
#pragma unroll 8
    for (int i = 0; i < 32; ++i) { const int kk = 2 * i + (lane >> 5); scr[kk * 33 + (lane & 31)] = W[(size_t)(k0 + kk) * N + n0 + (lane & 31)]; }
    LDS_WAIT();
    const int c = lane & 7;
#pragma unroll
    for (int j = 0; j < 4; ++j) { const int n = (lane >> 3) + 8 * j; const float* s = scr + (8 * c) * 33 + n;
        u32x4 o; o.x = pk2(s[0 * 33], s[1 * 33]); o.y = pk2(s[2 * 33], s[3 * 33]); o.z = pk2(s[4 * 33], s[5 * 33]); o.w = pk2(s[6 * 33], s[7 * 33]);
        *(u32x4*)(WT + (size_t)(dst_row0 + n) * K + k0 + 8 * c) = o; }
    LDS_WAIT();
}
__device__ __forceinline__ void tr_job(const float* W, int K, int N, int ne, bf16_t* WT, int erow, int blk, int blkstride, int base, float* scr, int gw, int ngw, int lane) {
    const int nkb = K / 64, nnb = N / 32, per = nkb * nnb, total = per * ne;
    for (int it = gw; it < total; it += ngw) {
        const int e = it / per, r = it % per, kb = r / nnb, nb = r % nnb, n0 = nb * 32;
        tr_item(W + (size_t)e * K * N, K, N, WT, base + e * erow + (n0 / blk) * blkstride + (n0 % blk), scr, kb * 64, n0, lane);
    }
}
__device__ __forceinline__ void sincos_acc(float ang, float& c, float& s) {
    const double a = (double)ang;
    const double q = rint(a * 0.63661977236758134308);
    const double r = fma(-q, 1.57079632679489661923, a) - q * 6.12323399573676603587e-17;
    const double r2 = r * r;
    double sp = 1.0 / 6227020800.0; sp = fma(sp, r2, -1.0 / 39916800.0); sp = fma(sp, r2, 1.0 / 362880.0); sp = fma(sp, r2, -1.0 / 5040.0);
    sp = fma(sp, r2, 1.0 / 120.0); sp = fma(sp, r2, -1.0 / 6.0); sp = fma(sp, r2, 1.0); const double sr = sp * r;
    double cp = 1.0 / 479001600.0; cp = fma(cp, r2, -1.0 / 3628800.0); cp = fma(cp, r2, 1.0 / 40320.0); cp = fma(cp, r2, -1.0 / 720.0);
    cp = fma(cp, r2, 1.0 / 24.0); cp = fma(cp, r2, -0.5); const double cr = fma(cp, r2, 1.0);
    const int qi = ((int)q) & 3;
    const double cc = (qi == 0) ? cr : (qi == 1) ? -sr : (qi == 2) ? -cr : sr;
    const double ss = (qi == 0) ? sr : (qi == 1) ? cr : (qi == 2) ? -sr : -cr;
    c = (float)cc; s = (float)ss;
}
__device__ __forceinline__ void phase_prologue(const Params& p, unsigned char* lds) {
    const int tid = threadIdx.x, lane = tid & 63, wave = tid >> 6;
    const int gw = blockIdx.x * 8 + wave, ngw = gridDim.x * 8;
    const size_t gt = (size_t)blockIdx.x * 512 + tid, ngt = (size_t)gridDim.x * 512;
    unsigned char* ws = p.ws;
    float* scr = (float*)lds + wave * (64 * 33);
    tr_job((const float*)p.in[3], 1024, 4096, 1, (bf16_t*)(ws + WS_WT_IN), 0, 4096, 0, 0, scr, gw, ngw, lane);
    tr_job((const float*)p.in[4], 1024, 3072, 1, (bf16_t*)(ws + WS_WT_G), 0, 3072, 0, 0, scr, gw, ngw, lane);
    tr_job((const float*)p.in[12], 1024, 1024, 1, (bf16_t*)(ws + WS_WT_MKV), 0, 1024, 0, 0, scr, gw, ngw, lane);
    tr_job((const float*)p.in[13], 512, 1024, 1, (bf16_t*)(ws + WS_WT_B), 0, 1024, 0, 0, scr, gw, ngw, lane);
    tr_job((const float*)p.in[14], 512, 1024, 1, (bf16_t*)(ws + WS_WT_B), 0, 1024, 0, 1024, scr, gw, ngw, lane);
    tr_job((const float*)p.in[15], 512, 1024, 1, (bf16_t*)(ws + WS_WT_B), 0, 1024, 0, 2048, scr, gw, ngw, lane);
    tr_job((const float*)p.in[16], 1024, 1024, 1, (bf16_t*)(ws + WS_WT_OUT), 0, 1024, 0, 0, scr, gw, ngw, lane);
    tr_job((const float*)p.in[21], 1024, 512, 32, (bf16_t*)(ws + WS_WT_GU), 1024, 128, 256, 0, scr, gw, ngw, lane);
    tr_job((const float*)p.in[22], 1024, 512, 32, (bf16_t*)(ws + WS_WT_GU), 1024, 128, 256, 128, scr, gw, ngw, lane);
    tr_job((const float*)p.in[23], 512, 1024, 32, (bf16_t*)(ws + WS_WT_DN), 1024, 1024, 0, 0, scr, gw, ngw, lane);
    { const float* wg = (const float*)p.in[19]; const float* we = (const float*)p.in[20]; bf16_t* wr = (bf16_t*)(ws + WS_WT_R);
      for (size_t i = gt; i < 256 * 1024; i += ngt) { const int r = (int)(i >> 10), k = (int)(i & 1023);
          const float v = r < 4 ? wg[k * 4 + r] : (r < 36 ? we[k * 32 + (r - 4)] : 0.f); wr[i] = f2bf(v); } }
    { const float* x = (const float*)p.in[0]; bf16_t* xb = (bf16_t*)(ws + WS_XB);
      for (size_t i = gt; i < (size_t)NTOK * DM / 8; i += ngt) { const f32x4 a = *(const f32x4*)(x + i * 8), b = *(const f32x4*)(x + i * 8 + 4);
          u32x4 o; o.x = pk2(a.x, a.y); o.y = pk2(a.z, a.w); o.z = pk2(b.x, b.y); o.w = pk2(b.z, b.w); *(u32x4*)(xb + i * 8) = o; }
      const float* mm = (const float*)p.in[1]; bf16_t* mb = (bf16_t*)(ws + WS_MEMB);
      for (size_t i = gt; i < (size_t)NBATCH * NMEM * DM / 8; i += ngt) { const f32x4 a = *(const f32x4*)(mm + i * 8), b = *(const f32x4*)(mm + i * 8 + 4);
          u32x4 o; o.x = pk2(a.x, a.y); o.y = pk2(a.z, a.w); o.z = pk2(b.x, b.y); o.w = pk2(b.z, b.w); *(u32x4*)(mb + i * 8) = o; } }
    { const int* pos = (const int*)p.in[2]; float* rope = (float*)(ws + WS_ROPE);
      for (size_t i = gt; i < (size_t)NTOK * 8; i += ngt) { const int tk = (int)(i >> 3), fi = (int)(i & 7);
          const float invf = fi == 0 ? 1.0f : fi == 1 ? 0.1939227432012558f : fi == 2 ? 0.03760603070259094f : fi == 3 ? 0.007292664609849453f : fi == 4 ? 0.0014142135623842478f
                           : fi == 5 ? 0.00027424818836152554f : fi == 6 ? 5.3182957344688475e-05f : 1.0313385246263351e-05f;
          const float ang = (float)pos[tk] * invf; float c, s; sincos_acc(ang, c, s); rope[i * 2] = c; rope[i * 2 + 1] = s; } }
    if (blockIdx.x == 0) {
        float* sc = (float*)(ws + WS_SCAL); const float* lbs = (const float*)p.in[5];
        { const float a = lbs[tid], b = lbs[512 + tid]; sc[tid] = 1.f / (1.f + expf(b - a)); }
        if (wave == 0) {
            const float* q1 = (const float*)p.in[7]; const float* k1 = (const float*)p.in[8]; const float* q2 = (const float*)p.in[9]; const float* k2 = (const float*)p.in[10];
            const float s1 = wave_sum(q1[lane] * k1[lane]), s2 = wave_sum(q2[lane] * k2[lane]);
            if (lane == 0) sc[512] = expf(s1) - expf(s2) + LAM_INIT;
        }
        if (tid < 64) ((int*)(ws + WS_CTL))[tid] = 0;
    }
}

struct SgCtx { int t, wr, wc, fr, fq; unsigned char* sA; unsigned char* sB; };
__device__ __forceinline__ SgCtx sg_ctx(unsigned char* lds) {
    SgCtx c; const int tid = threadIdx.x; c.t = tid & 255; const int team = tid >> 8; const int wid = c.t >> 6, lane = c.t & 63;
    c.wr = wid >> 1; c.wc = wid & 1; c.fr = lane & 15; c.fq = lane >> 4; c.sA = lds + team * 16384; c.sB = c.sA + 8192; return c;
}
__device__ __forceinline__ void sg_zero(f32x4 (&acc)[4][2]) {
#pragma unroll
    for (int m = 0; m < 4; ++m)
#pragma unroll
        for (int n = 0; n < 2; ++n) acc[m][n] = (f32x4){0.f, 0.f, 0.f, 0.f};
}
__device__ __forceinline__ void sg_tile(f32x4 (&acc)[4][2], const bf16_t* a0, const bf16_t* a1, const bf16_t* b0, int K, const SgCtx& c) {
    const int bo = c.t * 16;
#pragma unroll 1
    for (int kt = 0; kt < K; kt += 32) {
        const bf16x8 va0 = *(const bf16x8*)(a0 + kt), va1 = *(const bf16x8*)(a1 + kt), vb0 = *(const bf16x8*)(b0 + kt);
        *(bf16x8*)(c.sA + bo) = va0; *(bf16x8*)(c.sA + bo + 4096) = va1; *(bf16x8*)(c.sB + bo) = vb0;
        __syncthreads();
        bf16x8 At[4], Bt[2];
#pragma unroll
        for (int m = 0; m < 4; ++m) At[m] = *(const bf16x8*)(c.sA + (c.wr * 64 + m * 16 + c.fr) * 64 + c.fq * 16);
#pragma unroll
        for (int n = 0; n < 2; ++n) Bt[n] = *(const bf16x8*)(c.sB + (c.wc * 32 + n * 16 + c.fr) * 64 + c.fq * 16);
#pragma unroll
        for (int m = 0; m < 4; ++m)
#pragma unroll
            for (int n = 0; n < 2; ++n) acc[m][n] = __builtin_amdgcn_mfma_f32_16x16x32_bf16(At[m], Bt[n], acc[m][n], 0, 0, 0);
        __syncthreads();
    }
}
#define SG_R0(c) ((c).t >> 2)
#define SG_C0(c) (((c).t & 3) * 8)
template <class F> __device__ __forceinline__ void sg_store_bf16(const f32x4 (&acc)[4][2], bf16_t* dst, size_t ld, const SgCtx& c, F f) {
    bf16_t* base = dst + (size_t)(c.wr * 64 + c.fq * 4) * ld + c.wc * 32 + c.fr;
#pragma unroll
    for (int m = 0; m < 4; ++m)
#pragma unroll
        for (int j = 0; j < 4; ++j) { bf16_t* pr = base + (size_t)(m * 16 + j) * ld;
#pragma unroll
            for (int n = 0; n < 2; ++n) pr[n * 16] = f2bf(f(acc[m][n][j], c.wc * 32 + n * 16));
            asm volatile("" ::: "memory"); }
}
struct FIdent { __device__ __forceinline__ float operator()(float v, int) const { return v; } };
struct FSilu { __device__ __forceinline__ float operator()(float v, int) const { return siluf_(v); } };
struct FQScale { __device__ __forceinline__ float operator()(float v, int d0) const { return d0 >= 16 ? v * QSCALE_DF : v; } };

__device__ __forceinline__ void phase_proj(const Params& p, unsigned char* lds) {
    const SgCtx c = sg_ctx(lds); const int team = threadIdx.x >> 8; unsigned char* ws = p.ws;
    const bf16_t* XB = (const bf16_t*)(ws + WS_XB); const bf16_t* WT = (const bf16_t*)(ws + WS_WT_IN);
    bf16_t* HG = (bf16_t*)(ws + WS_HG); bf16_t* DQK = (bf16_t*)(ws + WS_DQK); bf16_t* DV = (bf16_t*)(ws + WS_DV); bf16_t* MQ = (bf16_t*)(ws + WS_MQ);
    const int r0 = SG_R0(c), c0 = SG_C0(c);
    { const int ntiles = 512 * 64;
      for (int tb = 2 * blockIdx.x; tb < ntiles; tb += 2 * gridDim.x) {
        const int tile = tb + team; const int tm = tile >> 6, tn = tile & 63;
        f32x4 acc[4][2]; sg_zero(acc);
        sg_tile(acc, XB + (size_t)(tm * 128 + r0) * 1024 + c0, XB + (size_t)(tm * 128 + r0 + 64) * 1024 + c0, WT + (size_t)(tn * 64 + r0) * 1024 + c0, 1024, c);
        const size_t mrow = (size_t)tm * 128; const int n0 = tn * 64;
        if (n0 < 2048) { const int g = n0 >> 9; bf16_t* d = HG + mrow * 2048 + n0; if (g == 0 || g == 3) sg_store_bf16(acc, d, 2048, c, FSilu()); else sg_store_bf16(acc, d, 2048, c, FIdent()); }
        else if (n0 < 3072) { bf16_t* d = DQK + mrow * 1024 + (n0 - 2048); if (n0 < 2560) sg_store_bf16(acc, d, 1024, c, FQScale()); else sg_store_bf16(acc, d, 1024, c, FIdent()); }
        else if (n0 < 3584) sg_store_bf16(acc, DV + mrow * 512 + (n0 - 3072), 512, c, FIdent());
        else sg_store_bf16(acc, MQ + mrow * 512 + (n0 - 3584), 512, c, FIdent());
      } }
    { const bf16_t* MB = (const bf16_t*)(ws + WS_MEMB); const bf16_t* WK = (const bf16_t*)(ws + WS_WT_MKV); bf16_t* MKV = (bf16_t*)(ws + WS_MKV);
      const int ntiles = 32 * 16;
      for (int tb = 2 * blockIdx.x; tb < ntiles; tb += 2 * gridDim.x) {
        const int tile = tb + team; const int tm = tile >> 4, tn = tile & 15;
        f32x4 acc[4][2]; sg_zero(acc);
        sg_tile(acc, MB + (size_t)(tm * 128 + r0) * 1024 + c0, MB + (size_t)(tm * 128 + r0 + 64) * 1024 + c0, WK + (size_t)(tn * 64 + r0) * 1024 + c0, 1024, c);
        sg_store_bf16(acc, MKV + (size_t)tm * 128 * 1024 + tn * 64, 1024, c, FIdent());
      } }
}
__device__ __forceinline__ void phase_rope(const Params& p, unsigned char* lds) {
    unsigned char* ws = p.ws; bf16_t* DQK = (bf16_t*)(ws + WS_DQK); const float* rope = (const float*)(ws + WS_ROPE);
    const size_t gt = (size_t)blockIdx.x * 512 + threadIdx.x, ngt = (size_t)gridDim.x * 512;
    for (size_t i = gt; i < (size_t)NTOK * 128; i += ngt) {
        const size_t m = i >> 7; const int rem = (int)(i & 127), gh = rem >> 3, fi = rem & 7;
        bf16_t* q = DQK + m * 1024 + gh * 64;
        const float t1 = bf2f(q[fi]), t2 = bf2f(q[8 + fi]); const float cs = rope[(m * 8 + fi) * 2], sn = rope[(m * 8 + fi) * 2 + 1];
        float o1 = t1 * cs - t2 * sn, o2 = t2 * cs + t1 * sn;
        if (gh < 8) { o1 *= QSCALE_DF; o2 *= QSCALE_DF; }
        q[fi] = f2bf(o1); q[8 + fi] = f2bf(o2);
    }
}
__device__ __forceinline__ void phase_hgrn_naive(const Params& p, unsigned char* lds) {
    unsigned char* ws = p.ws; const bf16_t* HG = (const bf16_t*)(ws + WS_HG); bf16_t* Y = (bf16_t*)(ws + WS_Y);
    const float* lower0 = (const float*)(ws + WS_SCAL); const float* gain = (const float*)p.in[6];
    float* fs = (float*)lds; float* ks = fs + 128; float* qs = ks + 128; float* part = qs + 128; float* red = part + 512;
    const int tid = threadIdx.x, v = tid & 127, kq = tid >> 7, lane = tid & 63, wave = tid >> 6;
    for (int bh = blockIdx.x; bh < 64; bh += gridDim.x) {
        const int b = bh >> 2, h = bh & 3;
        float S[32];
#pragma unroll
        for (int i = 0; i < 32; ++i) S[i] = 0.f;
        const float lbv = lower0[h * 128 + v], gn = gain[h * 128 + v];
        for (int t = 0; t < SEQ; ++t) {
            const size_t m = (size_t)b * SEQ + t; const bf16_t* row = HG + m * 2048 + h * 128;
            if (tid < 128) { const float fp = bf2f(row[512 + v]); const float f = lbv + (1.f - lbv) * sigmoidf_(fp); fs[v] = f; ks[v] = 1.f - f; qs[v] = bf2f(row[v]); }
            const float vv = bf2f(row[1024 + v]);
            __syncthreads();
            float o = 0.f;
#pragma unroll
            for (int i = 0; i < 32; ++i) { const int k = kq * 32 + i; S[i] = fs[k] * S[i] + ks[k] * vv; o += qs[k] * S[i]; }
            part[kq * 128 + v] = o;
            __syncthreads();
            float ot = 0.f;
            if (tid < 128) { ot = part[v] + part[128 + v] + part[256 + v] + part[384 + v]; const float sq = wave_sum(ot * ot); if (lane == 0) red[wave] = sq; }
            __syncthreads();
            if (tid < 128) { const float ms = (red[0] + red[1]) * (1.f / 128.f); const float y = ot * rsqrtf(ms + RMS_EPS) * gn * bf2f(row[1536 + v]); Y[m * 1536 + h * 128 + v] = f2bf(y); }
        }
        __syncthreads();
    }
}
template <bool DIFF>
__device__ __forceinline__ void phase_attn_naive(const Params& p, unsigned char* lds) {
    constexpr int DQ = DIFF ? 64 : 128, NMAP = DIFF ? 2 : 1;
    unsigned char* ws = p.ws; const int tid = threadIdx.x, lane = tid & 63, wave = tid >> 6;
    float* wbuf = (float*)lds + wave * 4096; float* qbuf = (float*)(lds + 131072) + wave * 128;
    const bf16_t* DQK = (const bf16_t*)(ws + WS_DQK); const bf16_t* DV = (const bf16_t*)(ws + WS_DV); const bf16_t* MQ = (const bf16_t*)(ws + WS_MQ); const bf16_t* MKV = (const bf16_t*)(ws + WS_MKV);
    bf16_t* Y = (bf16_t*)(ws + WS_Y); const float lam = ((const float*)(ws + WS_SCAL))[512]; const float* sub_gain = (const float*)p.in[11];
    const int gw = blockIdx.x * 8 + wave, ngw = gridDim.x * 8; const int nrows = NTOK * 4;
    for (int r = gw; r < nrows; r += ngw) {
        int b, h, nk; size_t m; const bf16_t *Q, *K, *V; int kp, vp;
        if (DIFF) { const int bh = r >> 12, i = r & 4095; b = bh >> 2; h = bh & 3; m = (size_t)b * SEQ + i; nk = i + 1;
            Q = DQK + m * 1024 + h * 64; K = DQK + (size_t)b * SEQ * 1024 + 512 + h * 64; kp = 1024; V = DV + (size_t)b * SEQ * 512 + h * 128; vp = 512; }
        else { m = (size_t)(r >> 2); h = r & 3; b = (int)(m >> 12); nk = NMEM;
            Q = MQ + m * 512 + h * 128; K = MKV + (size_t)b * NMEM * 1024 + h * 128; kp = 1024; V = MKV + (size_t)b * NMEM * 1024 + 512 + h * 128; vp = 1024; }
        if (DIFF) { qbuf[lane] = bf2f(Q[lane]); qbuf[64 + lane] = bf2f(Q[256 + lane]); }
        else { qbuf[lane] = bf2f(Q[lane]) * QSCALE_MEM; qbuf[64 + lane] = bf2f(Q[64 + lane]) * QSCALE_MEM; }
        LDS_WAIT();
        float mx[NMAP], ls[NMAP];
#pragma unroll
        for (int a = 0; a < NMAP; ++a) { mx[a] = -1e30f; ls[a] = 0.f; }
        for (int j = lane; j < nk; j += 64) {
#pragma unroll
            for (int a = 0; a < NMAP; ++a) {
                const bf16_t* kr = K + (size_t)j * kp + a * 256; float s = 0.f;
#pragma unroll 2
                for (int cc = 0; cc < DQ / 8; ++cc) { const bf16x8 kv = *(const bf16x8*)(kr + cc * 8);
#pragma unroll
                    for (int e = 0; e < 8; ++e) s += qbuf[a * 64 + cc * 8 + e] * bf2f((bf16_t)kv[e]); }
                if (s > mx[a]) { ls[a] = ls[a] * exp2f(mx[a] - s) + 1.f; mx[a] = s; } else ls[a] += exp2f(s - mx[a]);
            }
        }
        float M[NMAP], Linv[NMAP];
#pragma unroll
        for (int a = 0; a < NMAP; ++a) { M[a] = wave_max(mx[a]); const float l = wave_sum(ls[a] * exp2f(mx[a] - M[a])); Linv[a] = 1.f / l; }
        for (int j = lane; j < nk; j += 64) {
            float w = 0.f;
#pragma unroll
            for (int a = 0; a < NMAP; ++a) {
                const bf16_t* kr = K + (size_t)j * kp + a * 256; float s = 0.f;
#pragma unroll 2
                for (int cc = 0; cc < DQ / 8; ++cc) { const bf16x8 kv = *(const bf16x8*)(kr + cc * 8);
#pragma unroll
                    for (int e = 0; e < 8; ++e) s += qbuf[a * 64 + cc * 8 + e] * bf2f((bf16_t)kv[e]); }
                const float pj = exp2f(s - M[a]) * Linv[a]; w = (a == 0) ? pj : w - lam * pj;
            }
            wbuf[j] = w;
        }
        LDS_WAIT();
        float a0 = 0.f, a1 = 0.f; const bf16_t* vb = V + 2 * lane;
        for (int j = 0; j < nk; ++j) { const float w = wbuf[j]; const unsigned u = *(const unsigned*)(vb + (size_t)j * vp); a0 += w * __uint_as_float(u << 16); a1 += w * __uint_as_float(u & 0xffff0000u); }
        if (DIFF) { const float ms = wave_sum(a0 * a0 + a1 * a1) * (1.f / 128.f); const float rs = rsqrtf(ms + RMS_EPS) * (1.f - LAM_INIT);
            *(unsigned*)(Y + m * 1536 + 512 + h * 128 + 2 * lane) = pk2(a0 * rs * sub_gain[2 * lane], a1 * rs * sub_gain[2 * lane + 1]); }
        else *(unsigned*)(Y + m * 1536 + 1024 + h * 128 + 2 * lane) = pk2(a0, a1);
        LDS_WAIT();
    }
}
__device__ __forceinline__ void phase_merge(const Params& p, unsigned char* lds) {
    const SgCtx c = sg_ctx(lds); const int team = threadIdx.x >> 8; unsigned char* ws = p.ws;
    const bf16_t* XB = (const bf16_t*)(ws + WS_XB); const bf16_t* WG = (const bf16_t*)(ws + WS_WT_G); const bf16_t* Y = (const bf16_t*)(ws + WS_Y); const bf16_t* WB = (const bf16_t*)(ws + WS_WT_B);
    bf16_t* MG = (bf16_t*)(ws + WS_MERGED); const int r0 = SG_R0(c), c0 = SG_C0(c);
    const int ntiles = 512 * 16;
    for (int tb = 2 * blockIdx.x; tb < ntiles; tb += 2 * gridDim.x) {
        const int tile = tb + team; const int tm = tile >> 4, tn = tile & 15;
        f32x4 sum[4][2]; sg_zero(sum);
#pragma unroll 1
        for (int br = 0; br < 3; ++br) {
            f32x4 ag[4][2]; sg_zero(ag);
            sg_tile(ag, XB + (size_t)(tm * 128 + r0) * 1024 + c0, XB + (size_t)(tm * 128 + r0 + 64) * 1024 + c0, WG + (size_t)(br * 1024 + tn * 64 + r0) * 1024 + c0, 1024, c);
            f32x4 ay[4][2]; sg_zero(ay);
            sg_tile(ay, Y + (size_t)(tm * 128 + r0) * 1536 + br * 512 + c0, Y + (size_t)(tm * 128 + r0 + 64) * 1536 + br * 512 + c0, WB + (size_t)(br * 1024 + tn * 64 + r0) * 512 + c0, 512, c);
#pragma unroll
            for (int m = 0; m < 4; ++m)
#pragma unroll
                for (int n = 0; n < 2; ++n)
#pragma unroll
                    for (int j = 0; j < 4; ++j) sum[m][n][j] += sigmoidf_(ag[m][n][j]) * ay[m][n][j];
        }
        sg_store_bf16(sum, MG + (size_t)tm * 128 * 1024 + tn * 64, 1024, c, FIdent());
    }
}
__device__ __forceinline__ void phase_wout(const Params& p, unsigned char* lds) {
    const SgCtx c = sg_ctx(lds); const int team = threadIdx.x >> 8; unsigned char* ws = p.ws;
    const bf16_t* MG = (const bf16_t*)(ws + WS_MERGED); const bf16_t* WO = (const bf16_t*)(ws + WS_WT_OUT); const float* x = (const float*)p.in[0]; float* pre = p.out;
    const int r0 = SG_R0(c), c0 = SG_C0(c); const int ntiles = 512 * 16;
    for (int tb = 2 * blockIdx.x; tb < ntiles; tb += 2 * gridDim.x) {
        const int tile = tb + team; const int tm = tile >> 4, tn = tile & 15;
        f32x4 acc[4][2]; sg_zero(acc);
        sg_tile(acc, MG + (size_t)(tm * 128 + r0) * 1024 + c0, MG + (size_t)(tm * 128 + r0 + 64) * 1024 + c0, WO + (size_t)(tn * 64 + r0) * 1024 + c0, 1024, c);
        { const size_t off = ((size_t)tm * 128 + c.wr * 64 + c.fq * 4) * 1024 + tn * 64 + c.wc * 32 + c.fr;
#pragma unroll
          for (int m = 0; m < 4; ++m)
#pragma unroll
              for (int j = 0; j < 4; ++j) { const size_t o2 = off + (size_t)(m * 16 + j) * 1024;
#pragma unroll
                  for (int n = 0; n < 2; ++n) pre[o2 + n * 16] = ALPHA * x[o2 + n * 16] + acc[m][n][j];
                  asm volatile("" ::: "memory"); } }
    }
}
__device__ __forceinline__ void phase_ln1_route(const Params& p, unsigned char* lds) {
    unsigned char* ws = p.ws; const int tid = threadIdx.x, lane = tid & 63, wave = tid >> 6;
    float* x1f = p.out; bf16_t* x1b = (bf16_t*)(ws + WS_X1B); const float* g1 = (const float*)p.in[17]; const float* b1 = (const float*)p.in[18];
    const float* wg = (const float*)p.in[19]; const float* we = (const float*)p.in[20];
    int* cnt = (int*)(ws + WS_CTL); int* reci = (int*)(ws + WS_RECI); float* recw = (float*)(ws + WS_RECW);
    const int gw = blockIdx.x * 8 + wave, ngw = gridDim.x * 8;
    for (int t = gw; t < NTOK; t += ngw) {
        float* row = x1f + (size_t)t * 1024; f32x4 v[4]; float s = 0.f;
#pragma unroll
        for (int j = 0; j < 4; ++j) { v[j] = *(const f32x4*)(row + 256 * j + 4 * lane); s += (v[j].x + v[j].y) + (v[j].z + v[j].w); }
        const float mean = wave_sum(s) * (1.f / 1024.f); float s2 = 0.f;
#pragma unroll
        for (int j = 0; j < 4; ++j) { v[j] = v[j] - mean; s2 += (v[j].x * v[j].x + v[j].y * v[j].y) + (v[j].z * v[j].z + v[j].w * v[j].w); }
        const float rstd = rsqrtf(wave_sum(s2) * (1.f / 1024.f) + LN_EPS);
#pragma unroll
        for (int j = 0; j < 4; ++j) { const f32x4 gg = *(const f32x4*)(g1 + 256 * j + 4 * lane), bb = *(const f32x4*)(b1 + 256 * j + 4 * lane);
            v[j] = v[j] * rstd * gg + bb; *(f32x4*)(row + 256 * j + 4 * lane) = v[j];
            u32x2 o; o.x = pk2(v[j].x, v[j].y); o.y = pk2(v[j].z, v[j].w); *(u32x2*)(x1b + (size_t)t * 1024 + 256 * j + 4 * lane) = o; }
        float lg[36];
#pragma unroll
        for (int i = 0; i < 36; ++i) lg[i] = 0.f;
#pragma unroll
        for (int j = 0; j < 4; ++j)
#pragma unroll
            for (int e = 0; e < 4; ++e) { const int k = 256 * j + 4 * lane + e; const float xv = v[j][e];
                const f32x4 g4 = *(const f32x4*)(wg + k * 4);
#pragma unroll
                for (int q = 0; q < 4; ++q) lg[q] += xv * g4[q];
#pragma unroll
                for (int q8 = 0; q8 < 8; ++q8) { const f32x4 e4 = *(const f32x4*)(we + k * 32 + q8 * 4);
#pragma unroll
                    for (int q = 0; q < 4; ++q) lg[4 + q8 * 4 + q] += xv * e4[q]; } }
#pragma unroll
        for (int i = 0; i < 36; ++i) lg[i] = wave_sum(lg[i]);
        int gi = 0; float gm = lg[0];
#pragma unroll
        for (int q = 1; q < 4; ++q) if (lg[q] > gm) { gm = lg[q]; gi = q; }
        float gs = 0.f;
#pragma unroll
        for (int q = 0; q < 4; ++q) gs += expf(lg[q] - gm);
        const float group_w = 1.f / gs;
        float ig[8];
#pragma unroll
        for (int i = 0; i < 8; ++i) ig[i] = gi == 0 ? lg[4 + i] : gi == 1 ? lg[12 + i] : gi == 2 ? lg[20 + i] : lg[28 + i];
        int i1 = 0; float l1 = ig[0];
#pragma unroll
        for (int i = 1; i < 8; ++i) if (ig[i] > l1) { l1 = ig[i]; i1 = i; }
        int i2 = -1; float l2 = -3.0e38f;
#pragma unroll
        for (int i = 0; i < 8; ++i) if (i != i1 && ig[i] > l2) { l2 = ig[i]; i2 = i; }
        const float e2 = expf(l2 - l1); const float w1 = group_w / (1.f + e2), w2 = group_w * e2 / (1.f + e2);
        if (lane == 0) { const int ea = gi * 8 + i1, eb = gi * 8 + i2; const int pa = atomicAdd(cnt + ea, 1), pb = atomicAdd(cnt + eb, 1);
            reci[t * 4 + 0] = ea; reci[t * 4 + 1] = eb; reci[t * 4 + 2] = pa; reci[t * 4 + 3] = pb; recw[t * 2] = w1; recw[t * 2 + 1] = w2; }
    }
}
__device__ __forceinline__ int expert_layout(const int* cnt, int lane, int& tiles, int& endi) {
    tiles = (lane < 32) ? ((cnt[lane] + 255) >> 8) : 0; int x = tiles;
#pragma unroll
    for (int o = 1; o < 32; o <<= 1) { const int y = __shfl_up(x, o); if (lane >= o) x += y; }
    endi = x; return __shfl(x, 31);
}
__device__ __forceinline__ int expert_of_tile(int rt, int lane, int endi) { return __popcll(__ballot(lane < 32 && endi <= rt)); }
__device__ __forceinline__ void phase_dispatch(const Params& p, unsigned char* lds) {
    unsigned char* ws = p.ws; const int tid = threadIdx.x, lane = tid & 63, wave = tid >> 6;
    const int* cnt = (const int*)(ws + WS_CTL); int* reci = (int*)(ws + WS_RECI); const bf16_t* x1b = (const bf16_t*)(ws + WS_X1B); bf16_t* xs = (bf16_t*)(ws + WS_XS);
    int tiles, endi; expert_layout(cnt, lane, tiles, endi); const int base = endi - tiles;
    const int gw = blockIdx.x * 8 + wave, ngw = gridDim.x * 8;
    for (int t = gw; t < NTOK; t += ngw) {
        const int ea = reci[t * 4], eb = reci[t * 4 + 1], pa = reci[t * 4 + 2], pb = reci[t * 4 + 3];
        const int sa = __shfl(base, ea) * 256 + pa, sb = __shfl(base, eb) * 256 + pb;
        const u32x4 a = *(const u32x4*)(x1b + (size_t)t * 1024 + lane * 8), b = *(const u32x4*)(x1b + (size_t)t * 1024 + 512 + lane * 8);
        *(u32x4*)(xs + (size_t)sa * 1024 + lane * 8) = a; *(u32x4*)(xs + (size_t)sa * 1024 + 512 + lane * 8) = b;
        *(u32x4*)(xs + (size_t)sb * 1024 + lane * 8) = a; *(u32x4*)(xs + (size_t)sb * 1024 + 512 + lane * 8) = b;
        if (lane == 0) { reci[t * 4 + 2] = sa; reci[t * 4 + 3] = sb; }
    }
}
__device__ __forceinline__ void phase_exp_gu(const Params& p, unsigned char* lds) {
    const SgCtx c = sg_ctx(lds); const int team = threadIdx.x >> 8, lane = threadIdx.x & 63; unsigned char* ws = p.ws;
    const int* cnt = (const int*)(ws + WS_CTL); const bf16_t* XS = (const bf16_t*)(ws + WS_XS); const bf16_t* WGU = (const bf16_t*)(ws + WS_WT_GU); bf16_t* H = (bf16_t*)(ws + WS_H);
    int tiles, endi; const int nt256 = expert_layout(cnt, lane, tiles, endi);
    const int r0 = SG_R0(c), c0 = SG_C0(c); const int ntiles = nt256 * 2 * 8;
    for (int tb = 2 * blockIdx.x; tb < ntiles; tb += 2 * gridDim.x) {
        int tile = tb + team; const bool valid = tile < ntiles; if (!valid) tile = ntiles - 1;
        const int rt = tile >> 3, tn = tile & 7; const int e = expert_of_tile(rt >> 1, lane, endi);
        const bf16_t* a0 = XS + (size_t)(rt * 128 + r0) * 1024 + c0; const bf16_t* a1 = a0 + (size_t)64 * 1024;
        const bf16_t* bg = WGU + (size_t)(e * 1024 + (tn >> 1) * 256 + (tn & 1) * 64 + r0) * 1024 + c0;
        f32x4 ag[4][2]; sg_zero(ag); sg_tile(ag, a0, a1, bg, 1024, c);
        f32x4 au[4][2]; sg_zero(au); sg_tile(au, a0, a1, bg + (size_t)128 * 1024, 1024, c);
#pragma unroll
        for (int m = 0; m < 4; ++m)
#pragma unroll
            for (int n = 0; n < 2; ++n)
#pragma unroll
                for (int j = 0; j < 4; ++j) ag[m][n][j] = siluf_(ag[m][n][j]) * au[m][n][j];
        if (valid) sg_store_bf16(ag, H + (size_t)rt * 128 * 512 + tn * 64, 512, c, FIdent());
    }
}
__device__ __forceinline__ void phase_exp_dn(const Params& p, unsigned char* lds) {
    const SgCtx c = sg_ctx(lds); const int team = threadIdx.x >> 8, lane = threadIdx.x & 63; unsigned char* ws = p.ws;
    const int* cnt = (const int*)(ws + WS_CTL); const bf16_t* H = (const bf16_t*)(ws + WS_H); const bf16_t* WDN = (const bf16_t*)(ws + WS_WT_DN); bf16_t* YB = (bf16_t*)(ws + WS_YB);
    int tiles, endi; const int nt256 = expert_layout(cnt, lane, tiles, endi);
    const int r0 = SG_R0(c), c0 = SG_C0(c); const int ntiles = nt256 * 2 * 16;
    for (int tb = 2 * blockIdx.x; tb < ntiles; tb += 2 * gridDim.x) {
        int tile = tb + team; const bool valid = tile < ntiles; if (!valid) tile = ntiles - 1;
        const int rt = tile >> 4, tn = tile & 15; const int e = expert_of_tile(rt >> 1, lane, endi);
        const bf16_t* a0 = H + (size_t)(rt * 128 + r0) * 512 + c0; const bf16_t* b0 = WDN + (size_t)(e * 1024 + tn * 64 + r0) * 512 + c0;
        f32x4 acc[4][2]; sg_zero(acc); sg_tile(acc, a0, a0 + (size_t)64 * 512, b0, 512, c);
        if (valid) sg_store_bf16(acc, YB + (size_t)rt * 128 * 1024 + tn * 64, 1024, c, FIdent());
    }
}
__device__ __forceinline__ void phase_final(const Params& p, unsigned char* lds) {
    unsigned char* ws = p.ws; const int tid = threadIdx.x, lane = tid & 63, wave = tid >> 6;
    float* out = p.out; const bf16_t* YB = (const bf16_t*)(ws + WS_YB); const int* reci = (const int*)(ws + WS_RECI); const float* recw = (const float*)(ws + WS_RECW);
    const float* g2 = (const float*)p.in[24]; const float* b2 = (const float*)p.in[25];
    const int gw = blockIdx.x * 8 + wave, ngw = gridDim.x * 8;
    for (int t = gw; t < NTOK; t += ngw) {
        float* row = out + (size_t)t * 1024; const int sa = reci[t * 4 + 2], sb = reci[t * 4 + 3]; const float wa = recw[t * 2], wb = recw[t * 2 + 1];
        f32x4 v[4]; float s = 0.f;
#pragma unroll
        for (int j = 0; j < 4; ++j) { const f32x4 xv = *(const f32x4*)(row + 256 * j + 4 * lane);
            const u32x2 ya = *(const u32x2*)(YB + (size_t)sa * 1024 + 256 * j + 4 * lane), yb = *(const u32x2*)(YB + (size_t)sb * 1024 + 256 * j + 4 * lane);
            f32x4 fa, fb; fa.x = __uint_as_float(ya.x << 16); fa.y = __uint_as_float(ya.x & 0xffff0000u); fa.z = __uint_as_float(ya.y << 16); fa.w = __uint_as_float(ya.y & 0xffff0000u);
            fb.x = __uint_as_float(yb.x << 16); fb.y = __uint_as_float(yb.x & 0xffff0000u); fb.z = __uint_as_float(yb.y << 16); fb.w = __uint_as_float(yb.y & 0xffff0000u);
            v[j] = xv * ALPHA + fa * wa + fb * wb; s += (v[j].x + v[j].y) + (v[j].z + v[j].w); }
        const float mean = wave_sum(s) * (1.f / 1024.f); float s2 = 0.f;
#pragma unroll
        for (int j = 0; j < 4; ++j) { v[j] = v[j] - mean; s2 += (v[j].x * v[j].x + v[j].y * v[j].y) + (v[j].z * v[j].z + v[j].w * v[j].w); }
        const float rstd = rsqrtf(wave_sum(s2) * (1.f / 1024.f) + LN_EPS);
#pragma unroll
        for (int j = 0; j < 4; ++j) { const f32x4 gg = *(const f32x4*)(g2 + 256 * j + 4 * lane), bb = *(const f32x4*)(b2 + 256 * j + 4 * lane);
            *(f32x4*)(row + 256 * j + 4 * lane) = v[j] * rstd * gg + bb; }
    }
}

template <bool COOP>
__global__ void __launch_bounds__(512, 2) k_fwd(Params p) {
    extern __shared__ __attribute__((aligned(16))) unsigned char lds[];
    const int lo = p.ph_lo, hi = p.ph_hi;
#define RUN_PHASE(k, call) do { if (((PHASE_MASK >> (k)) & 1) && lo <= (k) && (k) < hi) { call; if (COOP && (k) + 1 < hi) { cg::this_grid().sync(); } } } while (0)
    RUN_PHASE(0, phase_prologue(p, lds));
    RUN_PHASE(1, phase_proj(p, lds));
    RUN_PHASE(2, phase_rope(p, lds));
    RUN_PHASE(3, (phase_hgrn_naive(p, lds), __syncthreads(), phase_attn_naive<true>(p, lds), __syncthreads(), phase_attn_naive<false>(p, lds)));
    RUN_PHASE(4, phase_merge(p, lds));
    RUN_PHASE(5, phase_wout(p, lds));
    RUN_PHASE(6, phase_ln1_route(p, lds));
    RUN_PHASE(7, phase_dispatch(p, lds));
    RUN_PHASE(8, phase_exp_gu(p, lds));
    RUN_PHASE(9, phase_exp_dn(p, lds));
    RUN_PHASE(10, phase_final(p, lds));
#undef RUN_PHASE
}

extern "C" void kernel_launch(void* const* d_in, const int* in_sizes, int n_in, void* d_out, int out_size, void* d_ws, size_t ws_size, hipStream_t stream) {
    static int grid = 0;
    if (grid == 0) {
        if (n_in != 26 || in_sizes[0] != NTOK * DM || out_size != NTOK * DM || ws_size < WS_END) {
            fprintf(stderr, "kernel_launch: unexpected shapes: n_in %d in0 %d out %d ws %zu (need >= %zu)\n", n_in, n_in > 0 ? in_sizes[0] : -1, out_size, ws_size, (size_t)WS_END); grid = -1; return; }
        int dev = 0, cus = 0, per_cu = 0;
        hipGetDevice(&dev); hipDeviceGetAttribute(&cus, hipDeviceAttributeMultiprocessorCount, dev);
        if (MK_ONE_LAUNCH) {
            hipFuncSetAttribute((const void*)k_fwd<true>, hipFuncAttributeMaxDynamicSharedMemorySize, LDS_BYTES);
            hipOccupancyMaxActiveBlocksPerMultiprocessor(&per_cu, (const void*)k_fwd<true>, 512, LDS_BYTES);
            if (per_cu < 1) { fprintf(stderr, "kernel_launch: occupancy query says %d blocks/CU\n", per_cu); per_cu = 1; }
            grid = cus * 1;
        } else {
            hipFuncSetAttribute((const void*)k_fwd<false>, hipFuncAttributeMaxDynamicSharedMemorySize, LDS_BYTES);
            grid = cus;
        }
        (void)hipGetLastError();
    }
    if (grid < 0) return;
    Params p{};
    for (int i = 0; i < 26; ++i) p.in[i] = d_in[i];
    p.out = (float*)d_out; p.ws = (unsigned char*)d_ws;
    if (MK_ONE_LAUNCH) {
        p.ph_lo = 0; p.ph_hi = NPHASE;
        void* args[] = {&p};
        hipError_t e = hipLaunchCooperativeKernel((const void*)k_fwd<true>, dim3(grid), dim3(512), args, LDS_BYTES, stream);
        if (e != hipSuccess) fprintf(stderr, "cooperative launch failed: %s (grid %d)\n", hipGetErrorString(e), grid);
    } else {
        for (int ph = 0; ph < NPHASE; ++ph) { p.ph_lo = ph; p.ph_hi = ph + 1; hipLaunchKernelGGL(k_fwd<false>, dim3(grid), dim3(512), LDS_BYTES, stream, p); }
    }
}
```

```cpp
#include <hip/hip_runtime.h>
#include <hip/hip_cooperative_groups.h>
#include <cstdio>
#include <cstdint>
namespace cg = cooperative_groups;

#ifndef PHASE_MASK
#define PHASE_MASK 0xffff
#endif
#ifndef USE_PG8
#define USE_PG8 0x1f
#endif
#ifndef MK_ONE_LAUNCH
#define MK_ONE_LAUNCH 1
#endif

typedef unsigned short bf16_t;
typedef short bf16x8 __attribute__((ext_vector_type(8)));
typedef float f32x4 __attribute__((ext_vector_type(4)));
typedef unsigned u32x4 __attribute__((ext_vector_type(4)));
typedef unsigned u32x2 __attribute__((ext_vector_type(2)));

constexpr int NTOK = 65536, DM = 1024, SEQ = 4096, NBATCH = 16, NMEM = 256, NEXP = 32;
constexpr int NSLOT = 2 * NTOK + NEXP * 256;
constexpr float ALPHA = 1.189207115002721f;
constexpr float LN_EPS = 1e-5f, RMS_EPS = 1e-6f;
constexpr float LOG2E = 1.4426950408889634f;
constexpr float QSCALE_DF = 0.125f * LOG2E;
constexpr float QSCALE_MEM = 0.08838834764831845f * LOG2E;
constexpr float LAM_INIT = 0.2f;
constexpr int NPHASE = 11;

constexpr size_t MiB = (size_t)1 << 20;
constexpr size_t WS_CTL = 0;
constexpr size_t WS_SCAL = 1 * MiB;
constexpr size_t WS_ROPE = 2 * MiB;
constexpr size_t WS_RECI = 6 * MiB;
constexpr size_t WS_RECW = 7 * MiB;
constexpr size_t WS_WT_IN = 8 * MiB;
constexpr size_t WS_WT_G = 16 * MiB;
constexpr size_t WS_WT_MKV = 22 * MiB;
constexpr size_t WS_WT_B = 24 * MiB;
constexpr size_t WS_WT_OUT = 27 * MiB;
constexpr size_t WS_WT_R = 29 * MiB;
constexpr size_t WS_WT_GU = 30 * MiB;
constexpr size_t WS_WT_DN = 94 * MiB;
constexpr size_t WS_MEMB = 126 * MiB;
constexpr size_t WS_MKV = 134 * MiB;
constexpr size_t WS_DEC = 142 * MiB;
constexpr size_t WS_LOGITS = 144 * MiB;
constexpr size_t WS_HG = 176 * MiB;
constexpr size_t WS_DQK = 432 * MiB;
constexpr size_t WS_DV = 560 * MiB;
constexpr size_t WS_MQ = 624 * MiB;
constexpr size_t WS_XB = 688 * MiB;
constexpr size_t WS_Y = 816 * MiB;
constexpr size_t WS_END = 1008 * MiB;
constexpr size_t WS_MERGED = WS_HG;
constexpr size_t WS_X1B = WS_DV;
constexpr size_t WS_XS = WS_HG;
constexpr size_t WS_H = 448 * MiB;
constexpr size_t WS_YB = 584 * MiB;
constexpr int LDS_BYTES = 147456;

struct Params { const void* in[26]; float* out; unsigned char* ws; int ph_lo, ph_hi; };

__device__ __forceinline__ float bf2f(bf16_t v) { return __uint_as_float(((unsigned)v) << 16); }
__device__ __forceinline__ bf16_t f2bf(float f) { unsigned u = __float_as_uint(f); u += 0x7fffu + ((u >> 16) & 1u); return (bf16_t)(u >> 16); }
__device__ __forceinline__ unsigned pk2(float lo, float hi) { return (unsigned)f2bf(lo) | ((unsigned)f2bf(hi) << 16); }
__device__ __forceinline__ float sigmoidf_(float x) { return __builtin_amdgcn_rcpf(1.f + __expf(-x)); }
__device__ __forceinline__ float siluf_(float x) { return x * __builtin_amdgcn_rcpf(1.f + __expf(-x)); }
__device__ __forceinline__ float wave_sum(float v) {
#pragma unroll
    for (int o = 1; o < 64; o <<= 1) v += __shfl_xor(v, o);
    return v;
}
__device__ __forceinline__ float wave_max(float v) {
#pragma unroll
    for (int o = 1; o < 64; o <<= 1) v = fmaxf(v, __shfl_xor(v, o));
    return v;
}
#define LDS_WAIT() asm volatile("s_waitcnt lgkmcnt(0)" ::: "memory")

__device__ __forceinline__ void tr_item(const float* W, int K, int N, bf16_t* WT, int dst_row0, float* scr, int k0, int n0, int lane) {
#pragma unroll 8
    for (int i = 0; i < 32; ++i) { const int kk = 2 * i + (lane >> 5); scr[kk * 33 + (lane & 31)] = W[(size_t)(k0 + kk) * N + n0 + (lane & 31)]; }
    LDS_WAIT();
    const int c = lane & 7;
#pragma unroll
    for (int j = 0; j < 4; ++j) { const int n = (lane >> 3) + 8 * j; const float* s = scr + (8 * c) * 33 + n;
        u32x4 o; o.x = pk2(s[0 * 33], s[1 * 33]); o.y = pk2(s[2 * 33], s[3 * 33]); o.z = pk2(s[4 * 33], s[5 * 33]); o.w = pk2(s[6 * 33], s[7 * 33]);
        *(u32x4*)(WT + (size_t)(dst_row0 + n) * K + k0 + 8 * c) = o; }
    LDS_WAIT();
}
__device__ __forceinline__ void tr_job(const float* W, int K, int N, int ne, bf16_t* WT, int erow, int blk, int blkstride, int base, float* scr, int gw, int ngw, int lane) {
    const int nkb = K / 64, nnb = N / 32, per = nkb * nnb, total = per * ne;
    for (int it = gw; it < total; it += ngw) {
        const int e = it / per, r = it % per, kb = r / nnb, nb = r % nnb, n0 = nb * 32;
        tr_item(W + (size_t)e * K * N, K, N, WT, base + e * erow + (n0 / blk) * blkstride + (n0 % blk), scr, kb * 64, n0, lane);
    }
}
__device__ __forceinline__ void sincos_acc(float ang, float& c, float& s) {
    const double a = (double)ang;
    const double q = rint(a * 0.63661977236758134308);
    const double r = fma(-q, 1.57079632679489661923, a) - q * 6.12323399573676603587e-17;
    const double r2 = r * r;
    double sp = 1.0 / 6227020800.0; sp = fma(sp, r2, -1.0 / 39916800.0); sp = fma(sp, r2, 1.0 / 362880.0); sp = fma(sp, r2, -1.0 / 5040.0);
    sp = fma(sp, r2, 1.0 / 120.0); sp = fma(sp, r2, -1.0 / 6.0); sp = fma(sp, r2, 1.0); const double sr = sp * r;
    double cp = 1.0 / 479001600.0; cp = fma(cp, r2, -1.0 / 3628800.0); cp = fma(cp, r2, 1.0 / 40320.0); cp = fma(cp, r2, -1.0 / 720.0);
    cp = fma(cp, r2, 1.0 / 24.0); cp = fma(cp, r2, -0.5); const double cr = fma(cp, r2, 1.0);
    const int qi = ((int)q) & 3;
    const double cc = (qi == 0) ? cr : (qi == 1) ? -sr : (qi == 2) ? -cr : sr;
    const double ss = (qi == 0) ? sr : (qi == 1) ? cr : (qi == 2) ? -sr : -cr;
    c = (float)cc; s = (float)ss;
}
__device__ __forceinline__ void phase_prologue(const Params& p, unsigned char* lds) {
    const int tid = threadIdx.x, lane = tid & 63, wave = tid >> 6;
    const int gw = blockIdx.x * 8 + wave, ngw = gridDim.x * 8;
    const size_t gt = (size_t)blockIdx.x * 512 + tid, ngt = (size_t)gridDim.x * 512;
    unsigned char* ws = p.ws;
    float* scr = (float*)lds + wave * (64 * 33);
    tr_job((const float*)p.in[3], 1024, 4096, 1, (bf16_t*)(ws + WS_WT_IN), 0, 4096, 0, 0, scr, gw, ngw, lane);
    tr_job((const float*)p.in[4], 1024, 3072, 1, (bf16_t*)(ws + WS_WT_G), 0, 3072, 0, 0, scr, gw, ngw, lane);
    tr_job((const float*)p.in[12], 1024, 1024, 1, (bf16_t*)(ws + WS_WT_MKV), 0, 1024, 0, 0, scr, gw, ngw, lane);
    tr_job((const float*)p.in[13], 512, 1024, 1, (bf16_t*)(ws + WS_WT_B), 0, 1024, 0, 0, scr, gw, ngw, lane);
    tr_job((const float*)p.in[14], 512, 1024, 1, (bf16_t*)(ws + WS_WT_B), 0, 1024, 0, 1024, scr, gw, ngw, lane);
    tr_job((const float*)p.in[15], 512, 1024, 1, (bf16_t*)(ws + WS_WT_B), 0, 1024, 0, 2048, scr, gw, ngw, lane);
    tr_job((const float*)p.in[16], 1024, 1024, 1, (bf16_t*)(ws + WS_WT_OUT), 0, 1024, 0, 0, scr, gw, ngw, lane);
    tr_job((const float*)p.in[21], 1024, 512, 32, (bf16_t*)(ws + WS_WT_GU), 1024, 128, 256, 0, scr, gw, ngw, lane);
    tr_job((const float*)p.in[22], 1024, 512, 32, (bf16_t*)(ws + WS_WT_GU), 1024, 128, 256, 128, scr, gw, ngw, lane);
    tr_job((const float*)p.in[23], 512, 1024, 32, (bf16_t*)(ws + WS_WT_DN), 1024, 1024, 0, 0, scr, gw, ngw, lane);
    { const float* wg = (const float*)p.in[19]; const float* we = (const float*)p.in[20]; bf16_t* wr = (bf16_t*)(ws + WS_WT_R);
      for (size_t i = gt; i < 256 * 1024; i += ngt) { const int r = (int)(i >> 10), k = (int)(i & 1023);
          const float v = r < 4 ? wg[k * 4 + r] : (r < 36 ? we[k * 32 + (r - 4)] : 0.f); wr[i] = f2bf(v); } }
    { const float* x = (const float*)p.in[0]; bf16_t* xb = (bf16_t*)(ws + WS_XB);
      for (size_t i = gt; i < (size_t)NTOK * DM / 8; i += ngt) { const f32x4 a = *(const f32x4*)(x + i * 8), b = *(const f32x4*)(x + i * 8 + 4);
          u32x4 o; o.x = pk2(a.x, a.y); o.y = pk2(a.z, a.w); o.z = pk2(b.x, b.y); o.w = pk2(b.z, b.w); *(u32x4*)(xb + i * 8) = o; }
      const float* mm = (const float*)p.in[1]; bf16_t* mb = (bf16_t*)(ws + WS_MEMB);
      for (size_t i = gt; i < (size_t)NBATCH * NMEM * DM / 8; i += ngt) { const f32x4 a = *(const f32x4*)(mm + i * 8), b = *(const f32x4*)(mm + i * 8 + 4);
          u32x4 o; o.x = pk2(a.x, a.y); o.y = pk2(a.z, a.w); o.z = pk2(b.x, b.y); o.w = pk2(b.z, b.w); *(u32x4*)(mb + i * 8) = o; } }
    { const int* pos = (const int*)p.in[2]; float* rope = (float*)(ws + WS_ROPE);
      for (size_t i = gt; i < (size_t)NTOK * 8; i += ngt) { const int tk = (int)(i >> 3), fi = (int)(i & 7);
          const float invf = fi == 0 ? 1.0f : fi == 1 ? 0.1939227432012558f : fi == 2 ? 0.03760603070259094f : fi == 3 ? 0.007292664609849453f : fi == 4 ? 0.0014142135623842478f
                           : fi == 5 ? 0.00027424818836152554f : fi == 6 ? 5.3182957344688475e-05f : 1.0313385246263351e-05f;
          const float ang = (float)pos[tk] * invf; float c, s; sincos_acc(ang, c, s); rope[i * 2] = c; rope[i * 2 + 1] = s; } }
    if (blockIdx.x == 0) {
        float* sc = (float*)(ws + WS_SCAL); const float* lbs = (const float*)p.in[5];
        { const float a = lbs[tid], b = lbs[512 + tid]; sc[tid] = 1.f / (1.f + expf(b - a)); }
        if (wave == 0) {
            const float* q1 = (const float*)p.in[7]; const float* k1 = (const float*)p.in[8]; const float* q2 = (const float*)p.in[9]; const float* k2 = (const float*)p.in[10];
            const float s1 = wave_sum(q1[lane] * k1[lane]), s2 = wave_sum(q2[lane] * k2[lane]);
            if (lane == 0) sc[512] = expf(s1) - expf(s2) + LAM_INIT;
        }
        if (tid < 64) ((int*)(ws + WS_CTL))[tid] = 0;
    }
}

struct SgCtx { int t, wr, wc, fr, fq; unsigned char* sA; unsigned char* sB; };
__device__ __forceinline__ SgCtx sg_ctx(unsigned char* lds) {
    SgCtx c; const int tid = threadIdx.x; c.t = tid & 255; const int team = tid >> 8; const int wid = c.t >> 6, lane = c.t & 63;
    c.wr = wid >> 1; c.wc = wid & 1; c.fr = lane & 15; c.fq = lane >> 4; c.sA = lds + team * 16384; c.sB = c.sA + 8192; return c;
}
__device__ __forceinline__ void sg_zero(f32x4 (&acc)[4][2]) {
#pragma unroll
    for (int m = 0; m < 4; ++m)
#pragma unroll
        for (int n = 0; n < 2; ++n) acc[m][n] = (f32x4){0.f, 0.f, 0.f, 0.f};
}
__device__ __forceinline__ void sg_tile(f32x4 (&acc)[4][2], const bf16_t* a0, const bf16_t* a1, const bf16_t* b0, int K, const SgCtx& c) {
    const int bo = c.t * 16;
#pragma unroll 1
    for (int kt = 0; kt < K; kt += 32) {
        const bf16x8 va0 = *(const bf16x8*)(a0 + kt), va1 = *(const bf16x8*)(a1 + kt), vb0 = *(const bf16x8*)(b0 + kt);
        *(bf16x8*)(c.sA + bo) = va0; *(bf16x8*)(c.sA + bo + 4096) = va1; *(bf16x8*)(c.sB + bo) = vb0;
        __syncthreads();
        bf16x8 At[4], Bt[2];
#pragma unroll
        for (int m = 0; m < 4; ++m) At[m] = *(const bf16x8*)(c.sA + (c.wr * 64 + m * 16 + c.fr) * 64 + c.fq * 16);
#pragma unroll
        for (int n = 0; n < 2; ++n) Bt[n] = *(const bf16x8*)(c.sB + (c.wc * 32 + n * 16 + c.fr) * 64 + c.fq * 16);
#pragma unroll
        for (int m = 0; m < 4; ++m)
#pragma unroll
            for (int n = 0; n < 2; ++n) acc[m][n] = __builtin_amdgcn_mfma_f32_16x16x32_bf16(At[m], Bt[n], acc[m][n], 0, 0, 0);
        __syncthreads();
    }
}
#define SG_R0(c) ((c).t >> 2)
#define SG_C0(c) (((c).t & 3) * 8)
template <class F> __device__ __forceinline__ void sg_store_bf16(const f32x4 (&acc)[4][2], bf16_t* dst, size_t ld, const SgCtx& c, F f) {
    bf16_t* base = dst + (size_t)(c.wr * 64 + c.fq * 4) * ld + c.wc * 32 + c.fr;
#pragma unroll
    for (int m = 0; m < 4; ++m)
#pragma unroll
        for (int j = 0; j < 4; ++j) { bf16_t* pr = base + (size_t)(m * 16 + j) * ld;
#pragma unroll
            for (int n = 0; n < 2; ++n) pr[n * 16] = f2bf(f(acc[m][n][j], c.wc * 32 + n * 16));
            asm volatile("" ::: "memory"); }
}
struct FIdent { __device__ __forceinline__ float operator()(float v, int) const { return v; } };
struct FSilu { __device__ __forceinline__ float operator()(float v, int) const { return siluf_(v); } };
struct FQScale { __device__ __forceinline__ float operator()(float v, int d0) const { return d0 >= 16 ? v * QSCALE_DF : v; } };

__device__ __forceinline__ void phase_proj(const Params& p, unsigned char* lds) {
    const SgCtx c = sg_ctx(lds); const int team = threadIdx.x >> 8; unsigned char* ws = p.ws;
    const bf16_t* XB = (const bf16_t*)(ws + WS_XB); const bf16_t* WT = (const bf16_t*)(ws + WS_WT_IN);
    bf16_t* HG = (bf16_t*)(ws + WS_HG); bf16_t* DQK = (bf16_t*)(ws + WS_DQK); bf16_t* DV = (bf16_t*)(ws + WS_DV); bf16_t* MQ = (bf16_t*)(ws + WS_MQ);
    const int r0 = SG_R0(c), c0 = SG_C0(c);
    { const int ntiles = 512 * 64;
      for (int tb = 2 * blockIdx.x; tb < ntiles; tb += 2 * gridDim.x) {
        const int tile = tb + team; const int tm = tile >> 6, tn = tile & 63;
        f32x4 acc[4][2]; sg_zero(acc);
        sg_tile(acc, XB + (size_t)(tm * 128 + r0) * 1024 + c0, XB + (size_t)(tm * 128 + r0 + 64) * 1024 + c0, WT + (size_t)(tn * 64 + r0) * 1024 + c0, 1024, c);
        const size_t mrow = (size_t)tm * 128; const int n0 = tn * 64;
        if (n0 < 2048) { const int g = n0 >> 9; bf16_t* d = HG + mrow * 2048 + n0; if (g == 0 || g == 3) sg_store_bf16(acc, d, 2048, c, FSilu()); else sg_store_bf16(acc, d, 2048, c, FIdent()); }
        else if (n0 < 3072) { bf16_t* d = DQK + mrow * 1024 + (n0 - 2048); if (n0 < 2560) sg_store_bf16(acc, d, 1024, c, FQScale()); else sg_store_bf16(acc, d, 1024, c, FIdent()); }
        else if (n0 < 3584) sg_store_bf16(acc, DV + mrow * 512 + (n0 - 3072), 512, c, FIdent());
        else sg_store_bf16(acc, MQ + mrow * 512 + (n0 - 3584), 512, c, FIdent());
      } }
    { const bf16_t* MB = (const bf16_t*)(ws + WS_MEMB); const bf16_t* WK = (const bf16_t*)(ws + WS_WT_MKV); bf16_t* MKV = (bf16_t*)(ws + WS_MKV);
      const int ntiles = 32 * 16;
      for (int tb = 2 * blockIdx.x; tb < ntiles; tb += 2 * gridDim.x) {
        const int tile = tb + team; const int tm = tile >> 4, tn = tile & 15;
        f32x4 acc[4][2]; sg_zero(acc);
        sg_tile(acc, MB + (size_t)(tm * 128 + r0) * 1024 + c0, MB + (size_t)(tm * 128 + r0 + 64) * 1024 + c0, WK + (size_t)(tn * 64 + r0) * 1024 + c0, 1024, c);
        sg_store_bf16(acc, MKV + (size_t)tm * 128 * 1024 + tn * 64, 1024, c, FIdent());
      } }
}
__device__ __forceinline__ void phase_rope(const Params& p, unsigned char* lds) {
    unsigned char* ws = p.ws; bf16_t* DQK = (bf16_t*)(ws + WS_DQK); const float* rope = (const float*)(ws + WS_ROPE);
    const size_t gt = (size_t)blockIdx.x * 512 + threadIdx.x, ngt = (size_t)gridDim.x * 512;
    for (size_t i = gt; i < (size_t)NTOK * 128; i += ngt) {
        const size_t m = i >> 7; const int rem = (int)(i & 127), gh = rem >> 3, fi = rem & 7;
        bf16_t* q = DQK + m * 1024 + gh * 64;
        const float t1 = bf2f(q[fi]), t2 = bf2f(q[8 + fi]); const float cs = rope[(m * 8 + fi) * 2], sn = rope[(m * 8 + fi) * 2 + 1];
        float o1 = t1 * cs - t2 * sn, o2 = t2 * cs + t1 * sn;
        if (gh < 8) { o1 *= QSCALE_DF; o2 *= QSCALE_DF; }
        q[fi] = f2bf(o1); q[8 + fi] = f2bf(o2);
    }
}
__device__ __forceinline__ void phase_hgrn_naive(const Params& p, unsigned char* lds) {
    unsigned char* ws = p.ws; const bf16_t* HG = (const bf16_t*)(ws + WS_HG); bf16_t* Y = (bf16_t*)(ws + WS_Y);
    const float* lower0 = (const float*)(ws + WS_SCAL); const float* gain = (const float*)p.in[6];
    float* fs = (float*)lds; float* ks = fs + 128; float* qs = ks + 128; float* part = qs + 128; float* red = part + 512;
    const int tid = threadIdx.x, v = tid & 127, kq = tid >> 7, lane = tid & 63, wave = tid >> 6;
    for (int bh = blockIdx.x; bh < 64; bh += gridDim.x) {
        const int b = bh >> 2, h = bh & 3;
        float S[32];
#pragma unroll
        for (int i = 0; i < 32; ++i) S[i] = 0.f;
        const float lbv = lower0[h * 128 + v], gn = gain[h * 128 + v];
        for (int t = 0; t < SEQ; ++t) {
            const size_t m = (size_t)b * SEQ + t; const bf16_t* row = HG + m * 2048 + h * 128;
            if (tid < 128) { const float fp = bf2f(row[512 + v]); const float f = lbv + (1.f - lbv) * sigmoidf_(fp); fs[v] = f; ks[v] = 1.f - f; qs[v] = bf2f(row[v]); }
            const float vv = bf2f(row[1024 + v]);
            __syncthreads();
            float o = 0.f;
#pragma unroll
            for (int i = 0; i < 32; ++i) { const int k = kq * 32 + i; S[i] = fs[k] * S[i] + ks[k] * vv; o += qs[k] * S[i]; }
            part[kq * 128 + v] = o;
            __syncthreads();
            float ot = 0.f;
            if (tid < 128) { ot = part[v] + part[128 + v] + part[256 + v] + part[384 + v]; const float sq = wave_sum(ot * ot); if (lane == 0) red[wave] = sq; }
            __syncthreads();
            if (tid < 128) { const float ms = (red[0] + red[1]) * (1.f / 128.f); const float y = ot * rsqrtf(ms + RMS_EPS) * gn * bf2f(row[1536 + v]); Y[m * 1536 + h * 128 + v] = f2bf(y); }
        }
        __syncthreads();
    }
}
template <bool DIFF>
__device__ __forceinline__ void phase_attn_naive(const Params& p, unsigned char* lds) {
    constexpr int DQ = DIFF ? 64 : 128, NMAP = DIFF ? 2 : 1;
    unsigned char* ws = p.ws; const int tid = threadIdx.x, lane = tid & 63, wave = tid >> 6;
    float* wbuf = (float*)lds + wave * 4096; float* qbuf = (float*)(lds + 131072) + wave * 128;
    const bf16_t* DQK = (const bf16_t*)(ws + WS_DQK); const bf16_t* DV = (const bf16_t*)(ws + WS_DV); const bf16_t* MQ = (const bf16_t*)(ws + WS_MQ); const bf16_t* MKV = (const bf16_t*)(ws + WS_MKV);
    bf16_t* Y = (bf16_t*)(ws + WS_Y); const float lam = ((const float*)(ws + WS_SCAL))[512]; const float* sub_gain = (const float*)p.in[11];
    const int gw = blockIdx.x * 8 + wave, ngw = gridDim.x * 8; const int nrows = NTOK * 4;
    for (int r = gw; r < nrows; r += ngw) {
        int b, h, nk; size_t m; const bf16_t *Q, *K, *V; int kp, vp;
        if (DIFF) { const int bh = r >> 12, i = r & 4095; b = bh >> 2; h = bh & 3; m = (size_t)b * SEQ + i; nk = i + 1;
            Q = DQK + m * 1024 + h * 64; K = DQK + (size_t)b * SEQ * 1024 + 512 + h * 64; kp = 1024; V = DV + (size_t)b * SEQ * 512 + h * 128; vp = 512; }
        else { m = (size_t)(r >> 2); h = r & 3; b = (int)(m >> 12); nk = NMEM;
            Q = MQ + m * 512 + h * 128; K = MKV + (size_t)b * NMEM * 1024 + h * 128; kp = 1024; V = MKV + (size_t)b * NMEM * 1024 + 512 + h * 128; vp = 1024; }
        if (DIFF) { qbuf[lane] = bf2f(Q[lane]); qbuf[64 + lane] = bf2f(Q[256 + lane]); }
        else { qbuf[lane] = bf2f(Q[lane]) * QSCALE_MEM; qbuf[64 + lane] = bf2f(Q[64 + lane]) * QSCALE_MEM; }
        LDS_WAIT();
        float mx[NMAP], ls[NMAP];
#pragma unroll
        for (int a = 0; a < NMAP; ++a) { mx[a] = -1e30f; ls[a] = 0.f; }
        for (int j = lane; j < nk; j += 64) {
#pragma unroll
            for (int a = 0; a < NMAP; ++a) {
                const bf16_t* kr = K + (size_t)j * kp + a * 256; float s = 0.f;
#pragma unroll 2
                for (int cc = 0; cc < DQ / 8; ++cc) { const bf16x8 kv = *(const bf16x8*)(kr + cc * 8);
#pragma unroll
                    for (int e = 0; e < 8; ++e) s += qbuf[a * 64 + cc * 8 + e] * bf2f((bf16_t)kv[e]); }
                if (s > mx[a]) { ls[a] = ls[a] * exp2f(mx[a] - s) + 1.f; mx[a] = s; } else ls[a] += exp2f(s - mx[a]);
            }
        }
        float M[NMAP], Linv[NMAP];
#pragma unroll
        for (int a = 0; a < NMAP; ++a) { M[a] = wave_max(mx[a]); const float l = wave_sum(ls[a] * exp2f(mx[a] - M[a])); Linv[a] = 1.f / l; }
        for (int j = lane; j < nk; j += 64) {
            float w = 0.f;
#pragma unroll
            for (int a = 0; a < NMAP; ++a) {
                const bf16_t* kr = K + (size_t)j * kp + a * 256; float s = 0.f;
#pragma unroll 2
                for (int cc = 0; cc < DQ / 8; ++cc) { const bf16x8 kv = *(const bf16x8*)(kr + cc * 8);
#pragma unroll
                    for (int e = 0; e < 8; ++e) s += qbuf[a * 64 + cc * 8 + e] * bf2f((bf16_t)kv[e]); }
                const float pj = exp2f(s - M[a]) * Linv[a]; w = (a == 0) ? pj : w - lam * pj;
            }
            wbuf[j] = w;
        }
        LDS_WAIT();
        float a0 = 0.f, a1 = 0.f; const bf16_t* vb = V + 2 * lane;
        for (int j = 0; j < nk; ++j) { const float w = wbuf[j]; const unsigned u = *(const unsigned*)(vb + (size_t)j * vp); a0 += w * __uint_as_float(u << 16); a1 += w * __uint_as_float(u & 0xffff0000u); }
        if (DIFF) { const float ms = wave_sum(a0 * a0 + a1 * a1) * (1.f / 128.f); const float rs = rsqrtf(ms + RMS_EPS) * (1.f - LAM_INIT);
            *(unsigned*)(Y + m * 1536 + 512 + h * 128 + 2 * lane) = pk2(a0 * rs * sub_gain[2 * lane], a1 * rs * sub_gain[2 * lane + 1]); }
        else *(unsigned*)(Y + m * 1536 + 1024 + h * 128 + 2 * lane) = pk2(a0, a1);
        LDS_WAIT();
    }
}
__device__ __forceinline__ void phase_merge(const Params& p, unsigned char* lds) {
    const SgCtx c = sg_ctx(lds); const int team = threadIdx.x >> 8; unsigned char* ws = p.ws;
    const bf16_t* XB = (const bf16_t*)(ws + WS_XB); const bf16_t* WG = (const bf16_t*)(ws + WS_WT_G); const bf16_t* Y = (const bf16_t*)(ws + WS_Y); const bf16_t* WB = (const bf16_t*)(ws + WS_WT_B);
    bf16_t* MG = (bf16_t*)(ws + WS_MERGED); const int r0 = SG_R0(c), c0 = SG_C0(c);
    const int ntiles = 512 * 16;
    for (int tb = 2 * blockIdx.x; tb < ntiles; tb += 2 * gridDim.x) {
        const int tile = tb + team; const int tm = tile >> 4, tn = tile & 15;
        f32x4 sum[4][2]; sg_zero(sum);
#pragma unroll 1
        for (int br = 0; br < 3; ++br) {
            f32x4 ag[4][2]; sg_zero(ag);
            sg_tile(ag, XB + (size_t)(tm * 128 + r0) * 1024 + c0, XB + (size_t)(tm * 128 + r0 + 64) * 1024 + c0, WG + (size_t)(br * 1024 + tn * 64 + r0) * 1024 + c0, 1024, c);
            f32x4 ay[4][2]; sg_zero(ay);
            sg_tile(ay, Y + (size_t)(tm * 128 + r0) * 1536 + br * 512 + c0, Y + (size_t)(tm * 128 + r0 + 64) * 1536 + br * 512 + c0, WB + (size_t)(br * 1024 + tn * 64 + r0) * 512 + c0, 512, c);
#pragma unroll
            for (int m = 0; m < 4; ++m)
#pragma unroll
                for (int n = 0; n < 2; ++n)
#pragma unroll
                    for (int j = 0; j < 4; ++j) sum[m][n][j] += sigmoidf_(ag[m][n][j]) * ay[m][n][j];
        }
        sg_store_bf16(sum, MG + (size_t)tm * 128 * 1024 + tn * 64, 1024, c, FIdent());
    }
}
__device__ __forceinline__ void phase_wout(const Params& p, unsigned char* lds) {
    const SgCtx c = sg_ctx(lds); const int team = threadIdx.x >> 8; unsigned char* ws = p.ws;
    const bf16_t* MG = (const bf16_t*)(ws + WS_MERGED); const bf16_t* WO = (const bf16_t*)(ws + WS_WT_OUT); const float* x = (const float*)p.in[0]; float* pre = p.out;
    const int r0 = SG_R0(c), c0 = SG_C0(c); const int ntiles = 512 * 16;
    for (int tb = 2 * blockIdx.x; tb < ntiles; tb += 2 * gridDim.x) {
        const int tile = tb + team; const int tm = tile >> 4, tn = tile & 15;
        f32x4 acc[4][2]; sg_zero(acc);
        sg_tile(acc, MG + (size_t)(tm * 128 + r0) * 1024 + c0, MG + (size_t)(tm * 128 + r0 + 64) * 1024 + c0, WO + (size_t)(tn * 64 + r0) * 1024 + c0, 1024, c);
        { const size_t off = ((size_t)tm * 128 + c.wr * 64 + c.fq * 4) * 1024 + tn * 64 + c.wc * 32 + c.fr;
#pragma unroll
          for (int m = 0; m < 4; ++m)
#pragma unroll
              for (int j = 0; j < 4; ++j) { const size_t o2 = off + (size_t)(m * 16 + j) * 1024;
#pragma unroll
                  for (int n = 0; n < 2; ++n) pre[o2 + n * 16] = ALPHA * x[o2 + n * 16] + acc[m][n][j];
                  asm volatile("" ::: "memory"); } }
    }
}
__device__ __forceinline__ void phase_ln1_route(const Params& p, unsigned char* lds) {
    unsigned char* ws = p.ws; const int tid = threadIdx.x, lane = tid & 63, wave = tid >> 6;
    float* x1f = p.out; bf16_t* x1b = (bf16_t*)(ws + WS_X1B); const float* g1 = (const float*)p.in[17]; const float* b1 = (const float*)p.in[18];
    const float* wg = (const float*)p.in[19]; const float* we = (const float*)p.in[20];
    int* cnt = (int*)(ws + WS_CTL); int* reci = (int*)(ws + WS_RECI); float* recw = (float*)(ws + WS_RECW);
    const int gw = blockIdx.x * 8 + wave, ngw = gridDim.x * 8;
    for (int t = gw; t < NTOK; t += ngw) {
        float* row = x1f + (size_t)t * 1024; f32x4 v[4]; float s = 0.f;
#pragma unroll
        for (int j = 0; j < 4; ++j) { v[j] = *(const f32x4*)(row + 256 * j + 4 * lane); s += (v[j].x + v[j].y) + (v[j].z + v[j].w); }
        const float mean = wave_sum(s) * (1.f / 1024.f); float s2 = 0.f;
#pragma unroll
        for (int j = 0; j < 4; ++j) { v[j] = v[j] - mean; s2 += (v[j].x * v[j].x + v[j].y * v[j].y) + (v[j].z * v[j].z + v[j].w * v[j].w); }
        const float rstd = rsqrtf(wave_sum(s2) * (1.f / 1024.f) + LN_EPS);
#pragma unroll
        for (int j = 0; j < 4; ++j) { const f32x4 gg = *(const f32x4*)(g1 + 256 * j + 4 * lane), bb = *(const f32x4*)(b1 + 256 * j + 4 * lane);
            v[j] = v[j] * rstd * gg + bb; *(f32x4*)(row + 256 * j + 4 * lane) = v[j];
            u32x2 o; o.x = pk2(v[j].x, v[j].y); o.y = pk2(v[j].z, v[j].w); *(u32x2*)(x1b + (size_t)t * 1024 + 256 * j + 4 * lane) = o; }
        float lg[36];
#pragma unroll
        for (int i = 0; i < 36; ++i) lg[i] = 0.f;
#pragma unroll
        for (int j = 0; j < 4; ++j)
#pragma unroll
            for (int e = 0; e < 4; ++e) { const int k = 256 * j + 4 * lane + e; const float xv = v[j][e];
                const f32x4 g4 = *(const f32x4*)(wg + k * 4);
#pragma unroll
                for (int q = 0; q < 4; ++q) lg[q] += xv * g4[q];
#pragma unroll
                for (int q8 = 0; q8 < 8; ++q8) { const f32x4 e4 = *(const f32x4*)(we + k * 32 + q8 * 4);
#pragma unroll
                    for (int q = 0; q < 4; ++q) lg[4 + q8 * 4 + q] += xv * e4[q]; } }
#pragma unroll
        for (int i = 0; i < 36; ++i) lg[i] = wave_sum(lg[i]);
        int gi = 0; float gm = lg[0];
#pragma unroll
        for (int q = 1; q < 4; ++q) if (lg[q] > gm) { gm = lg[q]; gi = q; }
        float gs = 0.f;
#pragma unroll
        for (int q = 0; q < 4; ++q) gs += expf(lg[q] - gm);
        const float group_w = 1.f / gs;
        float ig[8];
#pragma unroll
        for (int i = 0; i < 8; ++i) ig[i] = gi == 0 ? lg[4 + i] : gi == 1 ? lg[12 + i] : gi == 2 ? lg[20 + i] : lg[28 + i];
        int i1 = 0; float l1 = ig[0];
#pragma unroll
        for (int i = 1; i < 8; ++i) if (ig[i] > l1) { l1 = ig[i]; i1 = i; }
        int i2 = -1; float l2 = -3.0e38f;
#pragma unroll
        for (int i = 0; i < 8; ++i) if (i != i1 && ig[i] > l2) { l2 = ig[i]; i2 = i; }
        const float e2 = expf(l2 - l1); const float w1 = group_w / (1.f + e2), w2 = group_w * e2 / (1.f + e2);
        if (lane == 0) { const int ea = gi * 8 + i1, eb = gi * 8 + i2; const int pa = atomicAdd(cnt + ea, 1), pb = atomicAdd(cnt + eb, 1);
            reci[t * 4 + 0] = ea; reci[t * 4 + 1] = eb; reci[t * 4 + 2] = pa; reci[t * 4 + 3] = pb; recw[t * 2] = w1; recw[t * 2 + 1] = w2; }
    }
}
__device__ __forceinline__ int expert_layout(const int* cnt, int lane, int& tiles, int& endi) {
    tiles = (lane < 32) ? ((cnt[lane] + 255) >> 8) : 0; int x = tiles;
#pragma unroll
    for (int o = 1; o < 32; o <<= 1) { const int y = __shfl_up(x, o); if (lane >= o) x += y; }
    endi = x; return __shfl(x, 31);
}
__device__ __forceinline__ int expert_of_tile(int rt, int lane, int endi) { return __popcll(__ballot(lane < 32 && endi <= rt)); }
__device__ __forceinline__ void phase_dispatch(const Params& p, unsigned char* lds) {
    unsigned char* ws = p.ws; const int tid = threadIdx.x, lane = tid & 63, wave = tid >> 6;
    const int* cnt = (const int*)(ws + WS_CTL); int* reci = (int*)(ws + WS_RECI); const bf16_t* x1b = (const bf16_t*)(ws + WS_X1B); bf16_t* xs = (bf16_t*)(ws + WS_XS);
    int tiles, endi; expert_layout(cnt, lane, tiles, endi); const int base = endi - tiles;
    const int gw = blockIdx.x * 8 + wave, ngw = gridDim.x * 8;
    for (int t = gw; t < NTOK; t += ngw) {
        const int ea = reci[t * 4], eb = reci[t * 4 + 1], pa = reci[t * 4 + 2], pb = reci[t * 4 + 3];
        const int sa = __shfl(base, ea) * 256 + pa, sb = __shfl(base, eb) * 256 + pb;
        const u32x4 a = *(const u32x4*)(x1b + (size_t)t * 1024 + lane * 8), b = *(const u32x4*)(x1b + (size_t)t * 1024 + 512 + lane * 8);
        *(u32x4*)(xs + (size_t)sa * 1024 + lane * 8) = a; *(u32x4*)(xs + (size_t)sa * 1024 + 512 + lane * 8) = b;
        *(u32x4*)(xs + (size_t)sb * 1024 + lane * 8) = a; *(u32x4*)(xs + (size_t)sb * 1024 + 512 + lane * 8) = b;
        if (lane == 0) { reci[t * 4 + 2] = sa; reci[t * 4 + 3] = sb; }
    }
}
__device__ __forceinline__ void phase_exp_gu(const Params& p, unsigned char* lds) {
    const SgCtx c = sg_ctx(lds); const int team = threadIdx.x >> 8, lane = threadIdx.x & 63; unsigned char* ws = p.ws;
    const int* cnt = (const int*)(ws + WS_CTL); const bf16_t* XS = (const bf16_t*)(ws + WS_XS); const bf16_t* WGU = (const bf16_t*)(ws + WS_WT_GU); bf16_t* H = (bf16_t*)(ws + WS_H);
    int tiles, endi; const int nt256 = expert_layout(cnt, lane, tiles, endi);
    const int r0 = SG_R0(c), c0 = SG_C0(c); const int ntiles = nt256 * 2 * 8;
    for (int tb = 2 * blockIdx.x; tb < ntiles; tb += 2 * gridDim.x) {
        int tile = tb + team; const bool valid = tile < ntiles; if (!valid) tile = ntiles - 1;
        const int rt = tile >> 3, tn = tile & 7; const int e = expert_of_tile(rt >> 1, lane, endi);
        const bf16_t* a0 = XS + (size_t)(rt * 128 + r0) * 1024 + c0; const bf16_t* a1 = a0 + (size_t)64 * 1024;
        const bf16_t* bg = WGU + (size_t)(e * 1024 + (tn >> 1) * 256 + (tn & 1) * 64 + r0) * 1024 + c0;
        f32x4 ag[4][2]; sg_zero(ag); sg_tile(ag, a0, a1, bg, 1024, c);
        f32x4 au[4][2]; sg_zero(au); sg_tile(au, a0, a1, bg + (size_t)128 * 1024, 1024, c);
#pragma unroll
        for (int m = 0; m < 4; ++m)
#pragma unroll
            for (int n = 0; n < 2; ++n)
#pragma unroll
                for (int j = 0; j < 4; ++j) ag[m][n][j] = siluf_(ag[m][n][j]) * au[m][n][j];
        if (valid) sg_store_bf16(ag, H + (size_t)rt * 128 * 512 + tn * 64, 512, c, FIdent());
    }
}
__device__ __forceinline__ void phase_exp_dn(const Params& p, unsigned char* lds) {
    const SgCtx c = sg_ctx(lds); const int team = threadIdx.x >> 8, lane = threadIdx.x & 63; unsigned char* ws = p.ws;
    const int* cnt = (const int*)(ws + WS_CTL); const bf16_t* H = (const bf16_t*)(ws + WS_H); const bf16_t* WDN = (const bf16_t*)(ws + WS_WT_DN); bf16_t* YB = (bf16_t*)(ws + WS_YB);
    int tiles, endi; const int nt256 = expert_layout(cnt, lane, tiles, endi);
    const int r0 = SG_R0(c), c0 = SG_C0(c); const int ntiles = nt256 * 2 * 16;
    for (int tb = 2 * blockIdx.x; tb < ntiles; tb += 2 * gridDim.x) {
        int tile = tb + team; const bool valid = tile < ntiles; if (!valid) tile = ntiles - 1;
        const int rt = tile >> 4, tn = tile & 15; const int e = expert_of_tile(rt >> 1, lane, endi);
        const bf16_t* a0 = H + (size_t)(rt * 128 + r0) * 512 + c0; const bf16_t* b0 = WDN + (size_t)(e * 1024 + tn * 64 + r0) * 512 + c0;
        f32x4 acc[4][2]; sg_zero(acc); sg_tile(acc, a0, a0 + (size_t)64 * 512, b0, 512, c);
        if (valid) sg_store_bf16(acc, YB + (size_t)rt * 128 * 1024 + tn * 64, 1024, c, FIdent());
    }
}
__device__ __forceinline__ void phase_final(const Params& p, unsigned char* lds) {
    unsigned char* ws = p.ws; const int tid = threadIdx.x, lane = tid & 63, wave = tid >> 6;
    float* out = p.out; const bf16_t* YB = (const bf16_t*)(ws + WS_YB); const int* reci = (const int*)(ws + WS_RECI); const float* recw = (const float*)(ws + WS_RECW);
    const float* g2 = (const float*)p.in[24]; const float* b2 = (const float*)p.in[25];
    const int gw = blockIdx.x * 8 + wave, ngw = gridDim.x * 8;
    for (int t = gw; t < NTOK; t += ngw) {
        float* row = out + (size_t)t * 1024; const int sa = reci[t * 4 + 2], sb = reci[t * 4 + 3]; const float wa = recw[t * 2], wb = recw[t * 2 + 1];
        f32x4 v[4]; float s = 0.f;
#pragma unroll
        for (int j = 0; j < 4; ++j) { const f32x4 xv = *(const f32x4*)(row + 256 * j + 4 * lane);
            const u32x2 ya = *(const u32x2*)(YB + (size_t)sa * 1024 + 256 * j + 4 * lane), yb = *(const u32x2*)(YB + (size_t)sb * 1024 + 256 * j + 4 * lane);
            f32x4 fa, fb; fa.x = __uint_as_float(ya.x << 16); fa.y = __uint_as_float(ya.x & 0xffff0000u); fa.z = __uint_as_float(ya.y << 16); fa.w = __uint_as_float(ya.y & 0xffff0000u);
            fb.x = __uint_as_float(yb.x << 16); fb.y = __uint_as_float(yb.x & 0xffff0000u); fb.z = __uint_as_float(yb.y << 16); fb.w = __uint_as_float(yb.y & 0xffff0000u);
            v[j] = xv * ALPHA + fa * wa + fb * wb; s += (v[j].x + v[j].y) + (v[j].z + v[j].w); }
        const float mean = wave_sum(s) * (1.f / 1024.f); float s2 = 0.f;
#pragma unroll
        for (int j = 0; j < 4; ++j) { v[j] = v[j] - mean; s2 += (v[j].x * v[j].x + v[j].y * v[j].y) + (v[j].z * v[j].z + v[j].w * v[j].w); }
        const float rstd = rsqrtf(wave_sum(s2) * (1.f / 1024.f) + LN_EPS);
#pragma unroll
        for (int j = 0; j < 4; ++j) { const f32x4 gg = *(const f32x4*)(g2 + 256 * j + 4 * lane), bb = *(const f32x4*)(b2 + 256 * j + 4 * lane);
            *(f32x4*)(row + 256 * j + 4 * lane) = v[j] * rstd * gg + bb; }
    }
}

namespace pg8 {
#define PG8_LAS __attribute__((address_space(3)))
constexpr int BM = 256, BK = 64, HALF = 128, HTB = HALF * BK * 2, STAGE_BYTES = 8 * HTB, NXCD = 8, WGM = 8;
__host__ __device__ __forceinline__ int lds_byte(int r, int c) { const int st = (r >> 4) * 2 + (c >> 5), rr = r & 15, cc = c & 31, ob = rr * 64 + cc * 2; return st * 1024 + (ob ^ (((ob >> 9) & 1) << 5)); }
__host__ __device__ __forceinline__ void stage_rc(int b, int& R, int& C) { const int st = b / 1024, sb = b % 1024, swz = sb ^ (((sb >> 9) & 1) << 5); R = (st >> 1) * 16 + swz / 64; C = (st & 1) * 32 + (swz % 64) / 2; }
__host__ __device__ __forceinline__ int perm32(int rho) { const int n = rho >> 4, i = rho & 15; return 8 * (i >> 2) + 4 * n + (i & 3); }
struct Unit { int pm, pn, aux, nt, lda, ldb; const char* a; const char* b; };
typedef float f32x2_t __attribute__((ext_vector_type(2))); typedef __bf16 bf16x2_t __attribute__((ext_vector_type(2)));
__device__ __forceinline__ unsigned cvt_pk_bf16(float lo, float hi) { f32x2_t v = {lo, hi}; bf16x2_t b = __builtin_convertvector(v, bf16x2_t); return __builtin_bit_cast(unsigned, b); }
__device__ __forceinline__ bool static_tile(int i, int G, int c, int nM, int nN, int& pm, int& pn) {
    const int nwg = nM * nN; const long L = (long)i * G + c; if (L >= nwg) return false;
    int wgid = (int)L; { const int q = nwg / NXCD, r = nwg % NXCD, xcd = wgid % NXCD, off = wgid / NXCD; wgid = (xcd < r ? xcd * (q + 1) : r * (q + 1) + (xcd - r) * q) + off; }
    const int nig = WGM * nN, gid = wgid / nig, fm = gid * WGM, gsz = (nM - fm) < WGM ? (nM - fm) : WGM;
    pm = fm + ((wgid % nig) % gsz); pn = (wgid % nig) / gsz; return true;
}
template <class Epi, class Sched, bool ALIGN_EPI>
__device__ __forceinline__ void gemm_phase(PG8_LAS unsigned char* lds, const Sched& S, const Epi& E) {
    const int tid = threadIdx.x, wid = __builtin_amdgcn_readfirstlane(tid >> 6), lane = tid & 63, wr = wid >> 2, wc = wid & 3, fr = lane & 15, fq = lane >> 4;
    const size_t kstep = (size_t)(BK * 2);
    const unsigned ldsw = (unsigned)wid * 1024u;
    const int aoff = lds_byte(wr * 64 + fr, fq * 8), boff = lds_byte(wc * 32 + fr, fq * 8);
#define PG8_VOFF(LDA, LDB) do { int t_ = threadIdx.x; asm volatile("" : "+v"(t_)); _Pragma("unroll") for (int i_ = 0; i_ < 2; ++i_) { int R_, C_; stage_rc(t_ * 16 + i_ * 8192, R_, C_); \
        const int Rb_ = Epi::PERM ? ((R_ & ~31) + perm32(R_ & 31)) : R_; voffA[i_] = (unsigned)(R_ * (LDA) + C_) * 2u; voffB[i_] = (unsigned)(Rb_ * (LDB) + C_) * 2u; } } while (0)
#define PG8_SA(b, h) (((b) * 2 + (h)) * HTB)
#define PG8_SB(b, h) ((4 + (b) * 2 + (h)) * HTB)
#define PG8_STAGE(bufoff, gbase, voff) do { _Pragma("unroll") for (int _i = 0; _i < 2; ++_i) \
        __builtin_amdgcn_global_load_lds((const unsigned*)((const char*)(gbase) + (voff)[_i]), (PG8_LAS unsigned*)(lds + (bufoff) + ldsw + _i * 8192), 16, 0, 0); } while (0)
#define PG8_LDA(dst, b, h) do { _Pragma("unroll") for (int m = 0; m < 4; ++m) _Pragma("unroll") for (int k = 0; k < 2; ++k) dst[m][k] = *(const PG8_LAS bf16x8*)(lds + PG8_SA(b, h) + aoff + m * 2048 + k * 1024); } while (0)
#define PG8_LDB(dst, b, h) do { _Pragma("unroll") for (int n = 0; n < 2; ++n) _Pragma("unroll") for (int k = 0; k < 2; ++k) dst[n][k] = *(const PG8_LAS bf16x8*)(lds + PG8_SB(b, h) + boff + n * 2048 + k * 1024); } while (0)
#define PG8_MMA(ai, bj, At, Bt) do { __builtin_amdgcn_s_setprio(1); _Pragma("unroll") for (int m = 0; m < 4; ++m) _Pragma("unroll") for (int n = 0; n < 2; ++n) _Pragma("unroll") for (int k = 0; k < 2; ++k) \
        acc[ai][bj][m][n] = __builtin_amdgcn_mfma_f32_16x16x32_bf16(Bt[n][k], At[m][k], acc[ai][bj][m][n], 0, 0, 0); __builtin_amdgcn_s_setprio(0); } while (0)
#define PG8_WAIT_V(n) asm volatile("s_waitcnt vmcnt(" #n ")" ::: "memory")
#define PG8_WAIT_L(n) asm volatile("s_waitcnt lgkmcnt(" #n ")" ::: "memory")
#define PG8_BAR __builtin_amdgcn_s_barrier()
#define PG8_SCHED __builtin_amdgcn_sched_barrier(0)
#define PG8_H1(p, ld) ((p) + (size_t)HALF * (ld) * 2)
    Unit cur, nxt; int ui = 0;
    if (!S.next(0, cur)) return;
    f32x4 acc[2][2][4][2];
#pragma unroll
    for (int a = 0; a < 2; ++a)
#pragma unroll
        for (int b = 0; b < 2; ++b)
#pragma unroll
            for (int m = 0; m < 4; ++m)
#pragma unroll
                for (int n = 0; n < 2; ++n) acc[a][b][m][n] = (f32x4){0.f, 0.f, 0.f, 0.f};
    bf16x8 At[4][2], B0[2][2], B1[2][2];
    unsigned voffA[2], voffB[2];
    PG8_VOFF(cur.lda, cur.ldb);
    PG8_STAGE(PG8_SB(0, 0), cur.b, voffB); PG8_STAGE(PG8_SB(0, 1), PG8_H1(cur.b, cur.ldb), voffB); PG8_STAGE(PG8_SA(0, 0), cur.a, voffA); PG8_STAGE(PG8_SA(0, 1), PG8_H1(cur.a, cur.lda), voffA);
    if (wr == 1) PG8_BAR;
    PG8_WAIT_V(2); PG8_BAR;
    PG8_STAGE(PG8_SB(1, 0), cur.b + kstep, voffB); PG8_STAGE(PG8_SA(1, 0), cur.a + kstep, voffA); PG8_STAGE(PG8_SB(1, 1), PG8_H1(cur.b, cur.ldb) + kstep, voffB);
    PG8_WAIT_V(6); PG8_BAR;
    for (;;) {
        const bool has_next = S.next(ui + 1, nxt);
        if (!has_next) nxt = cur;
        const int nt = cur.nt;
        for (int t = 0; t < nt; t += 2) {
            const bool last = (t == nt - 2);
            PG8_LDB(B0, 0, 0); PG8_LDB(B1, 0, 1); PG8_SCHED; PG8_LDA(At, 0, 0); PG8_STAGE(PG8_SA(1, 1), PG8_H1(cur.a, cur.lda) + (size_t)(t + 1) * kstep, voffA);
            if (last) PG8_VOFF(nxt.lda, nxt.ldb);
            const char* a2 = last ? nxt.a : cur.a + (size_t)(t + 2) * kstep; const char* b2 = last ? nxt.b : cur.b + (size_t)(t + 2) * kstep;
            const int lda2 = last ? nxt.lda : cur.lda, ldb2 = last ? nxt.ldb : cur.ldb;
            PG8_WAIT_V(8); PG8_WAIT_L(0); PG8_BAR; PG8_MMA(0, 0, At, B0); PG8_MMA(0, 1, At, B1); PG8_BAR; PG8_SCHED;
            PG8_LDA(At, 0, 1); PG8_STAGE(PG8_SB(0, 0), b2, voffB); PG8_STAGE(PG8_SB(0, 1), PG8_H1(b2, ldb2), voffB); PG8_STAGE(PG8_SA(0, 0), a2, voffA);
            PG8_WAIT_V(8); PG8_WAIT_L(0); PG8_BAR; PG8_MMA(1, 0, At, B0); PG8_MMA(1, 1, At, B1); PG8_BAR; PG8_SCHED;
            PG8_LDB(B0, 1, 0); PG8_LDB(B1, 1, 1); PG8_SCHED; PG8_LDA(At, 1, 0); PG8_STAGE(PG8_SA(0, 1), PG8_H1(a2, lda2), voffA);
            PG8_WAIT_V(8); PG8_WAIT_L(0); PG8_BAR; PG8_MMA(0, 0, At, B0); PG8_MMA(0, 1, At, B1); PG8_BAR; PG8_SCHED;
            PG8_LDA(At, 1, 1); PG8_STAGE(PG8_SB(1, 0), b2 + kstep, voffB); PG8_STAGE(PG8_SB(1, 1), PG8_H1(b2, ldb2) + kstep, voffB); PG8_STAGE(PG8_SA(1, 0), a2 + kstep, voffA);
            PG8_WAIT_V(8); PG8_WAIT_L(0); PG8_BAR; PG8_MMA(1, 0, At, B0); PG8_MMA(1, 1, At, B1); PG8_BAR; PG8_SCHED;
        }
        if constexpr (ALIGN_EPI) { if (wr == 0) PG8_BAR; }
        E(acc, cur, wr, wc, fr, fq);
        if (!has_next) break;
#pragma unroll
        for (int a = 0; a < 2; ++a)
#pragma unroll
            for (int b = 0; b < 2; ++b)
#pragma unroll
                for (int m = 0; m < 4; ++m)
#pragma unroll
                    for (int n = 0; n < 2; ++n) acc[a][b][m][n] = (f32x4){0.f, 0.f, 0.f, 0.f};
        cur = nxt; ++ui;
        if constexpr (ALIGN_EPI) { if (wr == 1) PG8_BAR; }
    }
    PG8_WAIT_V(0);
    if constexpr (!ALIGN_EPI) { if (wr == 0) PG8_BAR; }
    PG8_BAR;
#undef PG8_VOFF
#undef PG8_H1
#undef PG8_SA
#undef PG8_SB
#undef PG8_STAGE
#undef PG8_LDA
#undef PG8_LDB
#undef PG8_MMA
#undef PG8_WAIT_V
#undef PG8_WAIT_L
#undef PG8_BAR
#undef PG8_SCHED
}
struct SchedPlain {
    const char* A; const char* B; int nM, nN, lda, ldb, nt, G, c;
    __device__ __forceinline__ bool next(int i, Unit& u) const {
        int pm, pn; if (!static_tile(i, G, c, nM, nN, pm, pn)) return false;
        u.pm = pm; u.pn = pn; u.aux = 0; u.nt = nt; u.lda = lda; u.ldb = ldb; u.a = A + (size_t)pm * BM * lda * 2; u.b = B + (size_t)pn * BM * ldb * 2; return true; }
};
struct SchedMerge {
    const char* XB; const char* WG; const char* Y; const char* WB; int G, c;
    __device__ __forceinline__ bool next(int i, Unit& u) const {
        const int ti = i / 6, sub = i - ti * 6, br = sub >> 1; int pm, pn; if (!static_tile(ti, G, c, 256, 4, pm, pn)) return false;
        u.pm = pm; u.pn = pn; u.aux = sub;
        if ((sub & 1) == 0) { u.nt = 16; u.lda = 1024; u.ldb = 1024; u.a = XB + (size_t)pm * BM * 1024 * 2; u.b = WG + (size_t)(br * 1024 + pn * BM) * 1024 * 2; }
        else { u.nt = 8; u.lda = 1536; u.ldb = 512; u.a = Y + ((size_t)pm * BM * 1536 + br * 512) * 2; u.b = WB + (size_t)(br * 1024 + pn * BM) * 512 * 2; }
        return true; }
};
struct SchedExp {
    const char* A; const char* B; int lda, ldb, nt, total, G, c; size_t bexp; const PG8_LAS int* tab;
    __device__ __forceinline__ bool next(int i, Unit& u) const {
        const long L = (long)i * G + c; if (L >= total) return false;
        int id = (int)L; { const int q = total / NXCD, r = total % NXCD, xcd = id % NXCD, off = id / NXCD; id = (xcd < r ? xcd * (q + 1) : r * (q + 1) + (xcd - r) * q) + off; }
        const int rt = id >> 2, pn = id & 3; const int e = __builtin_amdgcn_readfirstlane(tab[rt]);
        u.pm = rt; u.pn = pn; u.aux = e; u.nt = nt; u.lda = lda; u.ldb = ldb; u.a = A + (size_t)rt * BM * lda * 2; u.b = B + (size_t)e * bexp + (size_t)pn * BM * ldb * 2; return true; }
};
struct EpiBf16 {
    static constexpr bool PERM = true; bf16_t* O; int ldc;
    __device__ __forceinline__ void operator()(const f32x4 (&acc)[2][2][4][2], const Unit& u, int wr, int wc, int fr, int fq) const {
        bf16_t* base = O + (size_t)(u.pm * BM + wr * 64 + fr) * ldc + u.pn * BM + wc * 32 + 8 * fq;
#pragma unroll
        for (int ai = 0; ai < 2; ++ai)
#pragma unroll
            for (int m = 0; m < 4; ++m) { bf16_t* rowp = base + (size_t)(ai * HALF + m * 16) * ldc;
#pragma unroll
                for (int bj = 0; bj < 2; ++bj) { const f32x4 v0 = acc[ai][bj][m][0], v1 = acc[ai][bj][m][1];
                    u32x4 w; w.x = cvt_pk_bf16(v0[0], v0[1]); w.y = cvt_pk_bf16(v0[2], v0[3]); w.z = cvt_pk_bf16(v1[0], v1[1]); w.w = cvt_pk_bf16(v1[2], v1[3]);
                    *(u32x4*)(rowp + bj * HALF) = w; } }
    }
};
struct EpiProj {
    static constexpr bool PERM = true; bf16_t *HG, *DQK, *DV, *MQ; const float* rope;
    __device__ __forceinline__ void operator()(const f32x4 (&acc)[2][2][4][2], const Unit& u, int wr, int wc, int fr, int fq) const {
        const int pn = u.pn; bf16_t* dst; int ld, mode;
        if (pn < 8) { dst = HG + pn * 256; ld = 2048; mode = (pn < 2 || pn >= 6) ? 1 : 0; }
        else if (pn < 12) { dst = DQK + (pn - 8) * 256; ld = 1024; mode = pn < 10 ? 2 : 3; }
        else if (pn < 14) { dst = DV + (pn - 12) * 256; ld = 512; mode = 0; }
        else { dst = MQ + (pn - 14) * 256; ld = 512; mode = 0; }
        const int row0 = u.pm * BM + wr * 64 + fr; const bool rot = (mode >= 2) && ((wc & 1) == 0);
#pragma unroll
        for (int ai = 0; ai < 2; ++ai)
#pragma unroll
            for (int m = 0; m < 4; ++m) { const int row = row0 + ai * HALF + m * 16; bf16_t* rowp = dst + (size_t)row * ld + wc * 32 + 8 * fq;
                f32x4 r0 = {1.f, 0.f, 1.f, 0.f}, r1 = r0, r2 = r0, r3 = r0;
                if (rot) { const f32x4* rp = (const f32x4*)(rope + (size_t)row * 16); r0 = rp[0]; r1 = rp[1]; r2 = rp[2]; r3 = rp[3]; }
#pragma unroll
                for (int bj = 0; bj < 2; ++bj) { f32x4 v0 = acc[ai][bj][m][0], v1 = acc[ai][bj][m][1];
                    if (mode == 1) {
#pragma unroll
                        for (int e = 0; e < 4; ++e) { v0[e] = siluf_(v0[e]); v1[e] = siluf_(v1[e]); } }
                    if (rot) {
                        f32x4 p0, p1;
#pragma unroll
                        for (int e = 0; e < 4; ++e) { p0[e] = __shfl_xor(v0[e], 16); p1[e] = __shfl_xor(v1[e], 16); }
                        const float sg = (fq == 0) ? -1.f : 1.f;
                        if (fq < 2) {
                            v0[0] = v0[0] * r0[0] + sg * p0[0] * r0[1]; v0[1] = v0[1] * r0[2] + sg * p0[1] * r0[3]; v0[2] = v0[2] * r1[0] + sg * p0[2] * r1[1]; v0[3] = v0[3] * r1[2] + sg * p0[3] * r1[3];
                            v1[0] = v1[0] * r2[0] + sg * p1[0] * r2[1]; v1[1] = v1[1] * r2[2] + sg * p1[1] * r2[3]; v1[2] = v1[2] * r3[0] + sg * p1[2] * r3[1]; v1[3] = v1[3] * r3[2] + sg * p1[3] * r3[3]; } }
                    if (mode == 2) { v0 = v0 * QSCALE_DF; v1 = v1 * QSCALE_DF; }
                    u32x4 w; w.x = cvt_pk_bf16(v0[0], v0[1]); w.y = cvt_pk_bf16(v0[2], v0[3]); w.z = cvt_pk_bf16(v1[0], v1[1]); w.w = cvt_pk_bf16(v1[2], v1[3]);
                    *(u32x4*)(rowp + bj * HALF) = w; }
                asm volatile("" ::: "memory"); }
    }
};
__device__ __forceinline__ u32x4 ld16_sc1(const unsigned char* p) {
    const unsigned long long a = __hip_atomic_load((const unsigned long long*)p, __ATOMIC_RELAXED, __HIP_MEMORY_SCOPE_AGENT), b = __hip_atomic_load((const unsigned long long*)p + 1, __ATOMIC_RELAXED, __HIP_MEMORY_SCOPE_AGENT);
    u32x4 r; r.x = (unsigned)a; r.y = (unsigned)(a >> 32); r.z = (unsigned)b; r.w = (unsigned)(b >> 32); return r; }
struct EpiMerge {
    static constexpr bool PERM = true; bf16_t* MG; unsigned char* scrG; unsigned char* scrS;
    static __device__ __forceinline__ void unpack8(const u32x4 w, float (&o)[8]) {
        o[0] = __uint_as_float(w.x << 16); o[1] = __uint_as_float(w.x & 0xffff0000u); o[2] = __uint_as_float(w.y << 16); o[3] = __uint_as_float(w.y & 0xffff0000u);
        o[4] = __uint_as_float(w.z << 16); o[5] = __uint_as_float(w.z & 0xffff0000u); o[6] = __uint_as_float(w.w << 16); o[7] = __uint_as_float(w.w & 0xffff0000u); }
    __device__ __forceinline__ void operator()(const f32x4 (&acc)[2][2][4][2], const Unit& u, int wr, int wc, int fr, int fq) const {
        const int sub = u.aux, br = sub >> 1; const int wid = wr * 4 + wc, lane = fq * 16 + fr;
        unsigned lo = ((unsigned)wid * 16u * 64u + (unsigned)lane) * 16u; asm volatile("" : "+v"(lo));
        if ((sub & 1) == 0) {
#pragma unroll
            for (int ai = 0; ai < 2; ++ai)
#pragma unroll
                for (int bj = 0; bj < 2; ++bj)
#pragma unroll
                    for (int m = 0; m < 4; ++m) { const int g = (ai * 2 + bj) * 4 + m; const f32x4 v0 = acc[ai][bj][m][0], v1 = acc[ai][bj][m][1];
                        u32x4 w; w.x = cvt_pk_bf16(sigmoidf_(v0[0]), sigmoidf_(v0[1])); w.y = cvt_pk_bf16(sigmoidf_(v0[2]), sigmoidf_(v0[3]));
                        w.z = cvt_pk_bf16(sigmoidf_(v1[0]), sigmoidf_(v1[1])); w.w = cvt_pk_bf16(sigmoidf_(v1[2]), sigmoidf_(v1[3]));
                        *(u32x4*)(scrG + (lo + (unsigned)g * 1024u)) = w; asm volatile("" ::: "memory"); }
        } else {
            bf16_t* base = MG + (size_t)(u.pm * BM + wr * 64 + fr) * 1024 + u.pn * BM + wc * 32 + 8 * fq;
#pragma unroll
            for (int ai = 0; ai < 2; ++ai)
#pragma unroll
                for (int bj = 0; bj < 2; ++bj)
#pragma unroll
                    for (int m = 0; m < 4; ++m) { const int g = (ai * 2 + bj) * 4 + m; const f32x4 v0 = acc[ai][bj][m][0], v1 = acc[ai][bj][m][1];
                        float gt[8], o[8]; unpack8(*(const u32x4*)(scrG + (lo + (unsigned)g * 1024u)), gt);
                        o[0] = gt[0] * v0[0]; o[1] = gt[1] * v0[1]; o[2] = gt[2] * v0[2]; o[3] = gt[3] * v0[3]; o[4] = gt[4] * v1[0]; o[5] = gt[5] * v1[1]; o[6] = gt[6] * v1[2]; o[7] = gt[7] * v1[3];
                        if (br > 0) { float pv[8]; unpack8(*(const u32x4*)(scrS + (lo + (unsigned)g * 1024u)), pv);
#pragma unroll
                            for (int e = 0; e < 8; ++e) o[e] += pv[e]; }
                        u32x4 w; w.x = cvt_pk_bf16(o[0], o[1]); w.y = cvt_pk_bf16(o[2], o[3]); w.z = cvt_pk_bf16(o[4], o[5]); w.w = cvt_pk_bf16(o[6], o[7]);
                        if (br < 2) *(u32x4*)(scrS + (lo + (unsigned)g * 1024u)) = w; else *(u32x4*)(base + (size_t)(ai * HALF + m * 16) * 1024 + bj * HALF) = w;
                        asm volatile("" ::: "memory"); }
        }
    }
};
struct EpiWout {
    static constexpr bool PERM = false; const float* x; float* out;
    __device__ __forceinline__ void operator()(const f32x4 (&acc)[2][2][4][2], const Unit& u, int wr, int wc, int fr, int fq) const {
        const size_t off0 = (size_t)(u.pm * BM + wr * 64 + fr) * 1024 + u.pn * BM + wc * 32 + 4 * fq;
#pragma unroll
        for (int ai = 0; ai < 2; ++ai)
#pragma unroll
            for (int m = 0; m < 4; ++m) { const size_t off = off0 + (size_t)(ai * HALF + m * 16) * 1024;
#pragma unroll
                for (int bj = 0; bj < 2; ++bj)
#pragma unroll
                    for (int n = 0; n < 2; ++n) { const f32x4 xv = *(const f32x4*)(x + off + bj * HALF + n * 16); *(f32x4*)(out + off + bj * HALF + n * 16) = xv * ALPHA + acc[ai][bj][m][n]; }
                if (m & 1) asm volatile("" ::: "memory"); }
    }
};
struct EpiSwiglu {
    static constexpr bool PERM = true; bf16_t* H;
    __device__ __forceinline__ void operator()(const f32x4 (&acc)[2][2][4][2], const Unit& u, int wr, int wc, int fr, int fq) const {
        bf16_t* base = H + (size_t)(u.pm * BM + wr * 64 + fr) * 512 + u.pn * HALF + wc * 32 + 8 * fq;
#pragma unroll
        for (int ai = 0; ai < 2; ++ai)
#pragma unroll
            for (int m = 0; m < 4; ++m) { const f32x4 g0 = acc[ai][0][m][0], g1 = acc[ai][0][m][1], u0 = acc[ai][1][m][0], u1 = acc[ai][1][m][1];
                u32x4 w; w.x = cvt_pk_bf16(siluf_(g0[0]) * u0[0], siluf_(g0[1]) * u0[1]); w.y = cvt_pk_bf16(siluf_(g0[2]) * u0[2], siluf_(g0[3]) * u0[3]);
                w.z = cvt_pk_bf16(siluf_(g1[0]) * u1[0], siluf_(g1[1]) * u1[1]); w.w = cvt_pk_bf16(siluf_(g1[2]) * u1[2], siluf_(g1[3]) * u1[3]);
                *(u32x4*)(base + (size_t)(ai * HALF + m * 16) * 512) = w; }
    }
};
}

#define LASP(p) ((__attribute__((address_space(3))) unsigned char*)(p))
__device__ __forceinline__ void phase_proj_pg8(const Params& p, unsigned char* lds) {
    unsigned char* ws = p.ws;
    { pg8::SchedPlain S{(const char*)(ws + WS_XB), (const char*)(ws + WS_WT_IN), 256, 16, 1024, 1024, 16, (int)gridDim.x, (int)blockIdx.x};
      pg8::EpiProj E{(bf16_t*)(ws + WS_HG), (bf16_t*)(ws + WS_DQK), (bf16_t*)(ws + WS_DV), (bf16_t*)(ws + WS_MQ), (const float*)(ws + WS_ROPE)};
      pg8::gemm_phase<pg8::EpiProj, pg8::SchedPlain, true>(LASP(lds), S, E); }
    { pg8::SchedPlain S{(const char*)(ws + WS_MEMB), (const char*)(ws + WS_WT_MKV), 16, 4, 1024, 1024, 16, (int)gridDim.x, (int)blockIdx.x};
      pg8::EpiBf16 E{(bf16_t*)(ws + WS_MKV), 1024};
      pg8::gemm_phase<pg8::EpiBf16, pg8::SchedPlain, true>(LASP(lds), S, E); }
}
constexpr size_t WS_SCR = WS_DQK;
__device__ __forceinline__ void phase_merge_pg8(const Params& p, unsigned char* lds) {
    unsigned char* ws = p.ws;
    pg8::SchedMerge S{(const char*)(ws + WS_XB), (const char*)(ws + WS_WT_G), (const char*)(ws + WS_Y), (const char*)(ws + WS_WT_B), (int)gridDim.x, (int)blockIdx.x};
    pg8::EpiMerge E{(bf16_t*)(ws + WS_MERGED), ws + WS_SCR + (size_t)blockIdx.x * 262144, ws + WS_SCR + (size_t)blockIdx.x * 262144 + 131072};
    pg8::gemm_phase<pg8::EpiMerge, pg8::SchedMerge, true>(LASP(lds), S, E);
}
__device__ __forceinline__ void phase_wout_pg8(const Params& p, unsigned char* lds) {
    unsigned char* ws = p.ws;
    pg8::SchedPlain S{(const char*)(ws + WS_MERGED), (const char*)(ws + WS_WT_OUT), 256, 4, 1024, 1024, 16, (int)gridDim.x, (int)blockIdx.x};
    pg8::EpiWout E{(const float*)p.in[0], p.out};
    pg8::gemm_phase<pg8::EpiWout, pg8::SchedPlain, true>(LASP(lds), S, E);
}
constexpr int LDS_TAB = 131072;
__device__ __forceinline__ int exp_table(const Params& p, unsigned char* lds) {
    const int lane = threadIdx.x & 63; int tiles, endi; const int nt256 = expert_layout((const int*)(p.ws + WS_CTL), lane, tiles, endi);
    int* tab = (int*)(lds + LDS_TAB);
    for (int rt = threadIdx.x >> 6; rt < nt256; rt += 8) { const int e = expert_of_tile(rt, lane, endi); if (lane == 0) tab[rt] = e; }
    __syncthreads(); return nt256;
}
__device__ __forceinline__ void phase_exp_gu_pg8(const Params& p, unsigned char* lds) {
    unsigned char* ws = p.ws; const int nt256 = exp_table(p, lds);
    pg8::SchedExp S{(const char*)(ws + WS_XS), (const char*)(ws + WS_WT_GU), 1024, 1024, 16, nt256 * 4, (int)gridDim.x, (int)blockIdx.x, (size_t)1024 * 1024 * 2, (const __attribute__((address_space(3))) int*)LASP(lds + LDS_TAB)};
    pg8::EpiSwiglu E{(bf16_t*)(ws + WS_H)};
    pg8::gemm_phase<pg8::EpiSwiglu, pg8::SchedExp, true>(LASP(lds), S, E);
}
__device__ __forceinline__ void phase_exp_dn_pg8(const Params& p, unsigned char* lds) {
    unsigned char* ws = p.ws; const int nt256 = exp_table(p, lds);
    pg8::SchedExp S{(const char*)(ws + WS_H), (const char*)(ws + WS_WT_DN), 512, 512, 8, nt256 * 4, (int)gridDim.x, (int)blockIdx.x, (size_t)1024 * 512 * 2, (const __attribute__((address_space(3))) int*)LASP(lds + LDS_TAB)};
    pg8::EpiBf16 E{(bf16_t*)(ws + WS_YB), 1024};
    pg8::gemm_phase<pg8::EpiBf16, pg8::SchedExp, true>(LASP(lds), S, E);
}

template <bool COOP>
__global__ void __launch_bounds__(512, 2) k_fwd(Params p) {
    extern __shared__ __attribute__((aligned(16))) unsigned char lds[];
    const int lo = p.ph_lo, hi = p.ph_hi;
#define RUN_PHASE(k, call) do { if (((PHASE_MASK >> (k)) & 1) && lo <= (k) && (k) < hi) { call; if (COOP && (k) + 1 < hi) { cg::this_grid().sync(); } } } while (0)
    RUN_PHASE(0, phase_prologue(p, lds));
    RUN_PHASE(1, ((USE_PG8 & 1) ? phase_proj_pg8(p, lds) : phase_proj(p, lds)));
    RUN_PHASE(2, ((USE_PG8 & 1) ? (void)0 : phase_rope(p, lds)));
    RUN_PHASE(3, (phase_hgrn_naive(p, lds), __syncthreads(), phase_attn_naive<true>(p, lds), __syncthreads(), phase_attn_naive<false>(p, lds)));
    RUN_PHASE(4, ((USE_PG8 & 2) ? phase_merge_pg8(p, lds) : phase_merge(p, lds)));
    RUN_PHASE(5, ((USE_PG8 & 4) ? phase_wout_pg8(p, lds) : phase_wout(p, lds)));
    RUN_PHASE(6, phase_ln1_route(p, lds));
    RUN_PHASE(7, phase_dispatch(p, lds));
    RUN_PHASE(8, ((USE_PG8 & 8) ? phase_exp_gu_pg8(p, lds) : phase_exp_gu(p, lds)));
    RUN_PHASE(9, ((USE_PG8 & 16) ? phase_exp_dn_pg8(p, lds) : phase_exp_dn(p, lds)));
    RUN_PHASE(10, phase_final(p, lds));
#undef RUN_PHASE
}

extern "C" void kernel_launch(void* const* d_in, const int* in_sizes, int n_in, void* d_out, int out_size, void* d_ws, size_t ws_size, hipStream_t stream) {
    static int grid = 0;
    if (grid == 0) {
        if (n_in != 26 || in_sizes[0] != NTOK * DM || out_size != NTOK * DM || ws_size < WS_END) {
            fprintf(stderr, "kernel_launch: unexpected shapes: n_in %d in0 %d out %d ws %zu (need >= %zu)\n", n_in, n_in > 0 ? in_sizes[0] : -1, out_size, ws_size, (size_t)WS_END); grid = -1; return; }
        int dev = 0, cus = 0, per_cu = 0;
        hipGetDevice(&dev); hipDeviceGetAttribute(&cus, hipDeviceAttributeMultiprocessorCount, dev);
        if (MK_ONE_LAUNCH) {
            hipFuncSetAttribute((const void*)k_fwd<true>, hipFuncAttributeMaxDynamicSharedMemorySize, LDS_BYTES);
            hipOccupancyMaxActiveBlocksPerMultiprocessor(&per_cu, (const void*)k_fwd<true>, 512, LDS_BYTES);
            if (per_cu < 1) { fprintf(stderr, "kernel_launch: occupancy query says %d blocks/CU\n", per_cu); per_cu = 1; }
            grid = cus * 1;
        } else {
            hipFuncSetAttribute((const void*)k_fwd<false>, hipFuncAttributeMaxDynamicSharedMemorySize, LDS_BYTES);
            grid = cus;
        }
        (void)hipGetLastError();
    }
    if (grid < 0) return;
    Params p{};
    for (int i = 0; i < 26; ++i) p.in[i] = d_in[i];
    p.out = (float*)d_out; p.ws = (unsigned char*)d_ws;
    if (MK_ONE_LAUNCH) {
        p.ph_lo = 0; p.ph_hi = NPHASE;
        void* args[] = {&p};
        hipError_t e = hipLaunchCooperativeKernel((const void*)k_fwd<true>, dim3(grid), dim3(512), args, LDS_BYTES, stream);
        if (e != hipSuccess) fprintf(stderr, "cooperative launch failed: %s (grid %d)\n", hipGetErrorString(e), grid);
    } else {
        for (int ph = 0; ph < NPHASE; ++ph) { p.ph_lo = ph; p.ph_hi = ph + 1; hipLaunchKernelGGL(k_fwd<false>, dim3(grid), dim3(512), LDS_BYTES, stream, p); }
    }
}
```

```cpp
#include <hip/hip_runtime.h>
#include <hip/hip_cooperative_groups.h>
#include <cstdio>
#include <cstdint>
namespace cg = cooperative_groups;

#ifndef PHASE_MASK
#define PHASE_MASK 0xffff
#endif
#ifndef USE_PG8
#define USE_PG8 0x1f
#endif
#ifndef USE_OPT
#define USE_OPT 0x1
#endif
#ifndef MK_ONE_LAUNCH
#define MK_ONE_LAUNCH 1
#endif

typedef unsigned short bf16_t;
typedef short bf16x8 __attribute__((ext_vector_type(8)));
typedef float f32x4 __attribute__((ext_vector_type(4)));
typedef unsigned u32x4 __attribute__((ext_vector_type(4)));
typedef unsigned u32x2 __attribute__((ext_vector_type(2)));

constexpr int NTOK = 65536, DM = 1024, SEQ = 4096, NBATCH = 16, NMEM = 256, NEXP = 32;
constexpr int NSLOT = 2 * NTOK + NEXP * 256;
constexpr float ALPHA = 1.189207115002721f;
constexpr float LN_EPS = 1e-5f, RMS_EPS = 1e-6f;
constexpr float LOG2E = 1.4426950408889634f;
constexpr float QSCALE_DF = 0.125f * LOG2E;
constexpr float QSCALE_MEM = 0.08838834764831845f * LOG2E;
constexpr float LAM_INIT = 0.2f;
constexpr int NPHASE = 11;

constexpr size_t MiB = (size_t)1 << 20;
constexpr size_t WS_CTL = 0;
constexpr size_t WS_SCAL = 1 * MiB;
constexpr size_t WS_ROPE = 2 * MiB;
constexpr size_t WS_RECI = 6 * MiB;
constexpr size_t WS_RECW = 7 * MiB;
constexpr size_t WS_WT_IN = 8 * MiB;
constexpr size_t WS_WT_G = 16 * MiB;
constexpr size_t WS_WT_MKV = 22 * MiB;
constexpr size_t WS_WT_B = 24 * MiB;
constexpr size_t WS_WT_OUT = 27 * MiB;
constexpr size_t WS_WT_R = 29 * MiB;
constexpr size_t WS_WT_GU = 30 * MiB;
constexpr size_t WS_WT_DN = 94 * MiB;
constexpr size_t WS_MEMB = 126 * MiB;
constexpr size_t WS_MKV = 134 * MiB;
constexpr size_t WS_DEC = 142 * MiB;
constexpr size_t WS_LOGITS = 144 * MiB;
constexpr size_t WS_HG = 176 * MiB;
constexpr size_t WS_DQK = 432 * MiB;
constexpr size_t WS_DV = 560 * MiB;
constexpr size_t WS_MQ = 624 * MiB;
constexpr size_t WS_XB = 688 * MiB;
constexpr size_t WS_Y = 816 * MiB;
constexpr size_t WS_END = 1008 * MiB;
constexpr size_t WS_MERGED = WS_HG;
constexpr size_t WS_X1B = WS_DV;
constexpr size_t WS_XS = WS_HG;
constexpr size_t WS_H = 448 * MiB;
constexpr size_t WS_YB = 584 * MiB;
constexpr int LDS_BYTES = 147456;

struct Params { const void* in[26]; float* out; unsigned char* ws; int ph_lo, ph_hi; };

__device__ __forceinline__ float bf2f(bf16_t v) { return __uint_as_float(((unsigned)v) << 16); }
__device__ __forceinline__ bf16_t f2bf(float f) { unsigned u = __float_as_uint(f); u += 0x7fffu + ((u >> 16) & 1u); return (bf16_t)(u >> 16); }
__device__ __forceinline__ unsigned pk2(float lo, float hi) { return (unsigned)f2bf(lo) | ((unsigned)f2bf(hi) << 16); }
__device__ __forceinline__ float sigmoidf_(float x) { return __builtin_amdgcn_rcpf(1.f + __expf(-x)); }
__device__ __forceinline__ float siluf_(float x) { return x * __builtin_amdgcn_rcpf(1.f + __expf(-x)); }
__device__ __forceinline__ float wave_sum(float v) {
#pragma unroll
    for (int o = 1; o < 64; o <<= 1) v += __shfl_xor(v, o);
    return v;
}
__device__ __forceinline__ float wave_max(float v) {
#pragma unroll
    for (int o = 1; o < 64; o <<= 1) v = fmaxf(v, __shfl_xor(v, o));
    return v;
}
#define LDS_WAIT() asm volatile("s_waitcnt lgkmcnt(0)" ::: "memory")

__device__ __forceinline__ void tr_item(const float* W, int K, int N, bf16_t* WT, int dst_row0, float* scr, int k0, int n0, int lane) {
#pragma unroll 8
    for (int i = 0; i < 32; ++i) { const int kk = 2 * i + (lane >> 5); scr[kk * 33 + (lane & 31)] = W[(size_t)(k0 + kk) * N + n0 + (lane & 31)]; }
    LDS_WAIT();
    const int c = lane & 7;
#pragma unroll
    for (int j = 0; j < 4; ++j) { const int n = (lane >> 3) + 8 * j; const float* s = scr + (8 * c) * 33 + n;
        u32x4 o; o.x = pk2(s[0 * 33], s[1 * 33]); o.y = pk2(s[2 * 33], s[3 * 33]); o.z = pk2(s[4 * 33], s[5 * 33]); o.w = pk2(s[6 * 33], s[7 * 33]);
        *(u32x4*)(WT + (size_t)(dst_row0 + n) * K + k0 + 8 * c) = o; }
    LDS_WAIT();
}
__device__ __forceinline__ void tr_job(const float* W, int K, int N, int ne, bf16_t* WT, int erow, int blk, int blkstride, int base, float* scr, int gw, int ngw, int lane) {
    const int nkb = K / 64, nnb = N / 32, per = nkb * nnb, total = per * ne;
    for (int it = gw; it < total; it += ngw) {
        const int e = it / per, r = it % per, kb = r / nnb, nb = r % nnb, n0 = nb * 32;
        tr_item(W + (size_t)e * K * N, K, N, WT, base + e * erow + (n0 / blk) * blkstride + (n0 % blk), scr, kb * 64, n0, lane);
    }
}
__device__ __forceinline__ void sincos_acc(float ang, float& c, float& s) {
    const double a = (double)ang;
    const double q = rint(a * 0.63661977236758134308);
    const double r = fma(-q, 1.57079632679489661923, a) - q * 6.12323399573676603587e-17;
    const double r2 = r * r;
    double sp = 1.0 / 6227020800.0; sp = fma(sp, r2, -1.0 / 39916800.0); sp = fma(sp, r2, 1.0 / 362880.0); sp = fma(sp, r2, -1.0 / 5040.0);
    sp = fma(sp, r2, 1.0 / 120.0); sp = fma(sp, r2, -1.0 / 6.0); sp = fma(sp, r2, 1.0); const double sr = sp * r;
    double cp = 1.0 / 479001600.0; cp = fma(cp, r2, -1.0 / 3628800.0); cp = fma(cp, r2, 1.0 / 40320.0); cp = fma(cp, r2, -1.0 / 720.0);
    cp = fma(cp, r2, 1.0 / 24.0); cp = fma(cp, r2, -0.5); const double cr = fma(cp, r2, 1.0);
    const int qi = ((int)q) & 3;
    const double cc = (qi == 0) ? cr : (qi == 1) ? -sr : (qi == 2) ? -cr : sr;
    const double ss = (qi == 0) ? sr : (qi == 1) ? cr : (qi == 2) ? -sr : -cr;
    c = (float)cc; s = (float)ss;
}
__device__ __forceinline__ void phase_prologue(const Params& p, unsigned char* lds) {
    const int tid = threadIdx.x, lane = tid & 63, wave = tid >> 6;
    const int gw = blockIdx.x * 8 + wave, ngw = gridDim.x * 8;
    const size_t gt = (size_t)blockIdx.x * 512 + tid, ngt = (size_t)gridDim.x * 512;
    unsigned char* ws = p.ws;
    float* scr = (float*)lds + wave * (64 * 33);
    tr_job((const float*)p.in[3], 1024, 4096, 1, (bf16_t*)(ws + WS_WT_IN), 0, 4096, 0, 0, scr, gw, ngw, lane);
    tr_job((const float*)p.in[4], 1024, 3072, 1, (bf16_t*)(ws + WS_WT_G), 0, 3072, 0, 0, scr, gw, ngw, lane);
    tr_job((const float*)p.in[12], 1024, 1024, 1, (bf16_t*)(ws + WS_WT_MKV), 0, 1024, 0, 0, scr, gw, ngw, lane);
    tr_job((const float*)p.in[13], 512, 1024, 1, (bf16_t*)(ws + WS_WT_B), 0, 1024, 0, 0, scr, gw, ngw, lane);
    tr_job((const float*)p.in[14], 512, 1024, 1, (bf16_t*)(ws + WS_WT_B), 0, 1024, 0, 1024, scr, gw, ngw, lane);
    tr_job((const float*)p.in[15], 512, 1024, 1, (bf16_t*)(ws + WS_WT_B), 0, 1024, 0, 2048, scr, gw, ngw, lane);
    tr_job((const float*)p.in[16], 1024, 1024, 1, (bf16_t*)(ws + WS_WT_OUT), 0, 1024, 0, 0, scr, gw, ngw, lane);
    tr_job((const float*)p.in[21], 1024, 512, 32, (bf16_t*)(ws + WS_WT_GU), 1024, 128, 256, 0, scr, gw, ngw, lane);
    tr_job((const float*)p.in[22], 1024, 512, 32, (bf16_t*)(ws + WS_WT_GU), 1024, 128, 256, 128, scr, gw, ngw, lane);
    tr_job((const float*)p.in[23], 512, 1024, 32, (bf16_t*)(ws + WS_WT_DN), 1024, 1024, 0, 0, scr, gw, ngw, lane);
    { const float* wg = (const float*)p.in[19]; const float* we = (const float*)p.in[20]; bf16_t* wr = (bf16_t*)(ws + WS_WT_R);
      for (size_t i = gt; i < 256 * 1024; i += ngt) { const int r = (int)(i >> 10), k = (int)(i & 1023);
          const float v = r < 4 ? wg[k * 4 + r] : (r < 36 ? we[k * 32 + (r - 4)] : 0.f); wr[i] = f2bf(v); } }
    { const float* x = (const float*)p.in[0]; bf16_t* xb = (bf16_t*)(ws + WS_XB);
      for (size_t i = gt; i < (size_t)NTOK * DM / 8; i += ngt) { const f32x4 a = *(const f32x4*)(x + i * 8), b = *(const f32x4*)(x + i * 8 + 4);
          u32x4 o; o.x = pk2(a.x, a.y); o.y = pk2(a.z, a.w); o.z = pk2(b.x, b.y); o.w = pk2(b.z, b.w); *(u32x4*)(xb + i * 8) = o; }
      const float* mm = (const float*)p.in[1]; bf16_t* mb = (bf16_t*)(ws + WS_MEMB);
      for (size_t i = gt; i < (size_t)NBATCH * NMEM * DM / 8; i += ngt) { const f32x4 a = *(const f32x4*)(mm + i * 8), b = *(const f32x4*)(mm + i * 8 + 4);
          u32x4 o; o.x = pk2(a.x, a.y); o.y = pk2(a.z, a.w); o.z = pk2(b.x, b.y); o.w = pk2(b.z, b.w); *(u32x4*)(mb + i * 8) = o; } }
    { const int* pos = (const int*)p.in[2]; float* rope = (float*)(ws + WS_ROPE);
      for (size_t i = gt; i < (size_t)NTOK * 8; i += ngt) { const int tk = (int)(i >> 3), fi = (int)(i & 7);
          const float invf = fi == 0 ? 1.0f : fi == 1 ? 0.1939227432012558f : fi == 2 ? 0.03760603070259094f : fi == 3 ? 0.007292664609849453f : fi == 4 ? 0.0014142135623842478f
                           : fi == 5 ? 0.00027424818836152554f : fi == 6 ? 5.3182957344688475e-05f : 1.0313385246263351e-05f;
          const float ang = (float)pos[tk] * invf; float c, s; sincos_acc(ang, c, s); rope[i * 2] = c; rope[i * 2 + 1] = s; } }
    if (blockIdx.x == 0) {
        float* sc = (float*)(ws + WS_SCAL); const float* lbs = (const float*)p.in[5];
        { const float a = lbs[tid], b = lbs[512 + tid]; sc[tid] = 1.f / (1.f + expf(b - a)); }
        if (wave == 0) {
            const float* q1 = (const float*)p.in[7]; const float* k1 = (const float*)p.in[8]; const float* q2 = (const float*)p.in[9]; const float* k2 = (const float*)p.in[10];
            const float s1 = wave_sum(q1[lane] * k1[lane]), s2 = wave_sum(q2[lane] * k2[lane]);
            if (lane == 0) sc[512] = expf(s1) - expf(s2) + LAM_INIT;
        }
        if (tid < 64) ((int*)(ws + WS_CTL))[tid] = 0;
    }
}

struct SgCtx { int t, wr, wc, fr, fq; unsigned char* sA; unsigned char* sB; };
__device__ __forceinline__ SgCtx sg_ctx(unsigned char* lds) {
    SgCtx c; const int tid = threadIdx.x; c.t = tid & 255; const int team = tid >> 8; const int wid = c.t >> 6, lane = c.t & 63;
    c.wr = wid >> 1; c.wc = wid & 1; c.fr = lane & 15; c.fq = lane >> 4; c.sA = lds + team * 16384; c.sB = c.sA + 8192; return c;
}
__device__ __forceinline__ void sg_zero(f32x4 (&acc)[4][2]) {
#pragma unroll
    for (int m = 0; m < 4; ++m)
#pragma unroll
        for (int n = 0; n < 2; ++n) acc[m][n] = (f32x4){0.f, 0.f, 0.f, 0.f};
}
__device__ __forceinline__ void sg_tile(f32x4 (&acc)[4][2], const bf16_t* a0, const bf16_t* a1, const bf16_t* b0, int K, const SgCtx& c) {
    const int bo = c.t * 16;
#pragma unroll 1
    for (int kt = 0; kt < K; kt += 32) {
        const bf16x8 va0 = *(const bf16x8*)(a0 + kt), va1 = *(const bf16x8*)(a1 + kt), vb0 = *(const bf16x8*)(b0 + kt);
        *(bf16x8*)(c.sA + bo) = va0; *(bf16x8*)(c.sA + bo + 4096) = va1; *(bf16x8*)(c.sB + bo) = vb0;
        __syncthreads();
        bf16x8 At[4], Bt[2];
#pragma unroll
        for (int m = 0; m < 4; ++m) At[m] = *(const bf16x8*)(c.sA + (c.wr * 64 + m * 16 + c.fr) * 64 + c.fq * 16);
#pragma unroll
        for (int n = 0; n < 2; ++n) Bt[n] = *(const bf16x8*)(c.sB + (c.wc * 32 + n * 16 + c.fr) * 64 + c.fq * 16);
#pragma unroll
        for (int m = 0; m < 4; ++m)
#pragma unroll
            for (int n = 0; n < 2; ++n) acc[m][n] = __builtin_amdgcn_mfma_f32_16x16x32_bf16(At[m], Bt[n], acc[m][n], 0, 0, 0);
        __syncthreads();
    }
}
#define SG_R0(c) ((c).t >> 2)
#define SG_C0(c) (((c).t & 3) * 8)
template <class F> __device__ __forceinline__ void sg_store_bf16(const f32x4 (&acc)[4][2], bf16_t* dst, size_t ld, const SgCtx& c, F f) {
    bf16_t* base = dst + (size_t)(c.wr * 64 + c.fq * 4) * ld + c.wc * 32 + c.fr;
#pragma unroll
    for (int m = 0; m < 4; ++m)
#pragma unroll
        for (int j = 0; j < 4; ++j) { bf16_t* pr = base + (size_t)(m * 16 + j) * ld;
#pragma unroll
            for (int n = 0; n < 2; ++n) pr[n * 16] = f2bf(f(acc[m][n][j], c.wc * 32 + n * 16));
            asm volatile("" ::: "memory"); }
}
struct FIdent { __device__ __forceinline__ float operator()(float v, int) const { return v; } };
struct FSilu { __device__ __forceinline__ float operator()(float v, int) const { return siluf_(v); } };
struct FQScale { __device__ __forceinline__ float operator()(float v, int d0) const { return d0 >= 16 ? v * QSCALE_DF : v; } };

__device__ __forceinline__ void phase_proj(const Params& p, unsigned char* lds) {
    const SgCtx c = sg_ctx(lds); const int team = threadIdx.x >> 8; unsigned char* ws = p.ws;
    const bf16_t* XB = (const bf16_t*)(ws + WS_XB); const bf16_t* WT = (const bf16_t*)(ws + WS_WT_IN);
    bf16_t* HG = (bf16_t*)(ws + WS_HG); bf16_t* DQK = (bf16_t*)(ws + WS_DQK); bf16_t* DV = (bf16_t*)(ws + WS_DV); bf16_t* MQ = (bf16_t*)(ws + WS_MQ);
    const int r0 = SG_R0(c), c0 = SG_C0(c);
    { const int ntiles = 512 * 64;
      for (int tb = 2 * blockIdx.x; tb < ntiles; tb += 2 * gridDim.x) {
        const int tile = tb + team; const int tm = tile >> 6, tn = tile & 63;
        f32x4 acc[4][2]; sg_zero(acc);
        sg_tile(acc, XB + (size_t)(tm * 128 + r0) * 1024 + c0, XB + (size_t)(tm * 128 + r0 + 64) * 1024 + c0, WT + (size_t)(tn * 64 + r0) * 1024 + c0, 1024, c);
        const size_t mrow = (size_t)tm * 128; const int n0 = tn * 64;
        if (n0 < 2048) { const int g = n0 >> 9; bf16_t* d = HG + mrow * 2048 + n0; if (g == 0 || g == 3) sg_store_bf16(acc, d, 2048, c, FSilu()); else sg_store_bf16(acc, d, 2048, c, FIdent()); }
        else if (n0 < 3072) { bf16_t* d = DQK + mrow * 1024 + (n0 - 2048); if (n0 < 2560) sg_store_bf16(acc, d, 1024, c, FQScale()); else sg_store_bf16(acc, d, 1024, c, FIdent()); }
        else if (n0 < 3584) sg_store_bf16(acc, DV + mrow * 512 + (n0 - 3072), 512, c, FIdent());
        else sg_store_bf16(acc, MQ + mrow * 512 + (n0 - 3584), 512, c, FIdent());
      } }
    { const bf16_t* MB = (const bf16_t*)(ws + WS_MEMB); const bf16_t* WK = (const bf16_t*)(ws + WS_WT_MKV); bf16_t* MKV = (bf16_t*)(ws + WS_MKV);
      const int ntiles = 32 * 16;
      for (int tb = 2 * blockIdx.x; tb < ntiles; tb += 2 * gridDim.x) {
        const int tile = tb + team; const int tm = tile >> 4, tn = tile & 15;
        f32x4 acc[4][2]; sg_zero(acc);
        sg_tile(acc, MB + (size_t)(tm * 128 + r0) * 1024 + c0, MB + (size_t)(tm * 128 + r0 + 64) * 1024 + c0, WK + (size_t)(tn * 64 + r0) * 1024 + c0, 1024, c);
        sg_store_bf16(acc, MKV + (size_t)tm * 128 * 1024 + tn * 64, 1024, c, FIdent());
      } }
}
__device__ __forceinline__ void phase_rope(const Params& p, unsigned char* lds) {
    unsigned char* ws = p.ws; bf16_t* DQK = (bf16_t*)(ws + WS_DQK); const float* rope = (const float*)(ws + WS_ROPE);
    const size_t gt = (size_t)blockIdx.x * 512 + threadIdx.x, ngt = (size_t)gridDim.x * 512;
    for (size_t i = gt; i < (size_t)NTOK * 128; i += ngt) {
        const size_t m = i >> 7; const int rem = (int)(i & 127), gh = rem >> 3, fi = rem & 7;
        bf16_t* q = DQK + m * 1024 + gh * 64;
        const float t1 = bf2f(q[fi]), t2 = bf2f(q[8 + fi]); const float cs = rope[(m * 8 + fi) * 2], sn = rope[(m * 8 + fi) * 2 + 1];
        float o1 = t1 * cs - t2 * sn, o2 = t2 * cs + t1 * sn;
        if (gh < 8) { o1 *= QSCALE_DF; o2 *= QSCALE_DF; }
        q[fi] = f2bf(o1); q[8 + fi] = f2bf(o2);
    }
}
__device__ __forceinline__ void phase_hgrn_naive(const Params& p, unsigned char* lds) {
    unsigned char* ws = p.ws; const bf16_t* HG = (const bf16_t*)(ws + WS_HG); bf16_t* Y = (bf16_t*)(ws + WS_Y);
    const float* lower0 = (const float*)(ws + WS_SCAL); const float* gain = (const float*)p.in[6];
    float* fs = (float*)lds; float* ks = fs + 128; float* qs = ks + 128; float* part = qs + 128; float* red = part + 512;
    const int tid = threadIdx.x, v = tid & 127, kq = tid >> 7, lane = tid & 63, wave = tid >> 6;
    for (int bh = blockIdx.x; bh < 64; bh += gridDim.x) {
        const int b = bh >> 2, h = bh & 3;
        float S[32];
#pragma unroll
        for (int i = 0; i < 32; ++i) S[i] = 0.f;
        const float lbv = lower0[h * 128 + v], gn = gain[h * 128 + v];
        for (int t = 0; t < SEQ; ++t) {
            const size_t m = (size_t)b * SEQ + t; const bf16_t* row = HG + m * 2048 + h * 128;
            if (tid < 128) { const float fp = bf2f(row[512 + v]); const float f = lbv + (1.f - lbv) * sigmoidf_(fp); fs[v] = f; ks[v] = 1.f - f; qs[v] = bf2f(row[v]); }
            const float vv = bf2f(row[1024 + v]);
            __syncthreads();
            float o = 0.f;
#pragma unroll
            for (int i = 0; i < 32; ++i) { const int k = kq * 32 + i; S[i] = fs[k] * S[i] + ks[k] * vv; o += qs[k] * S[i]; }
            part[kq * 128 + v] = o;
            __syncthreads();
            float ot = 0.f;
            if (tid < 128) { ot = part[v] + part[128 + v] + part[256 + v] + part[384 + v]; const float sq = wave_sum(ot * ot); if (lane == 0) red[wave] = sq; }
            __syncthreads();
            if (tid < 128) { const float ms = (red[0] + red[1]) * (1.f / 128.f); const float y = ot * rsqrtf(ms + RMS_EPS) * gn * bf2f(row[1536 + v]); Y[m * 1536 + h * 128 + v] = f2bf(y); }
        }
        __syncthreads();
    }
}
template <bool DIFF>
__device__ __forceinline__ void phase_attn_naive(const Params& p, unsigned char* lds) {
    constexpr int DQ = DIFF ? 64 : 128, NMAP = DIFF ? 2 : 1;
    unsigned char* ws = p.ws; const int tid = threadIdx.x, lane = tid & 63, wave = tid >> 6;
    float* wbuf = (float*)lds + wave * 4096; float* qbuf = (float*)(lds + 131072) + wave * 128;
    const bf16_t* DQK = (const bf16_t*)(ws + WS_DQK); const bf16_t* DV = (const bf16_t*)(ws + WS_DV); const bf16_t* MQ = (const bf16_t*)(ws + WS_MQ); const bf16_t* MKV = (const bf16_t*)(ws + WS_MKV);
    bf16_t* Y = (bf16_t*)(ws + WS_Y); const float lam = ((const float*)(ws + WS_SCAL))[512]; const float* sub_gain = (const float*)p.in[11];
    const int gw = blockIdx.x * 8 + wave, ngw = gridDim.x * 8; const int nrows = NTOK * 4;
    for (int r = gw; r < nrows; r += ngw) {
        int b, h, nk; size_t m; const bf16_t *Q, *K, *V; int kp, vp;
        if (DIFF) { const int bh = r >> 12, i = r & 4095; b = bh >> 2; h = bh & 3; m = (size_t)b * SEQ + i; nk = i + 1;
            Q = DQK + m * 1024 + h * 64; K = DQK + (size_t)b * SEQ * 1024 + 512 + h * 64; kp = 1024; V = DV + (size_t)b * SEQ * 512 + h * 128; vp = 512; }
        else { m = (size_t)(r >> 2); h = r & 3; b = (int)(m >> 12); nk = NMEM;
            Q = MQ + m * 512 + h * 128; K = MKV + (size_t)b * NMEM * 1024 + h * 128; kp = 1024; V = MKV + (size_t)b * NMEM * 1024 + 512 + h * 128; vp = 1024; }
        if (DIFF) { qbuf[lane] = bf2f(Q[lane]); qbuf[64 + lane] = bf2f(Q[256 + lane]); }
        else { qbuf[lane] = bf2f(Q[lane]) * QSCALE_MEM; qbuf[64 + lane] = bf2f(Q[64 + lane]) * QSCALE_MEM; }
        LDS_WAIT();
        float mx[NMAP], ls[NMAP];
#pragma unroll
        for (int a = 0; a < NMAP; ++a) { mx[a] = -1e30f; ls[a] = 0.f; }
        for (int j = lane; j < nk; j += 64) {
#pragma unroll
            for (int a = 0; a < NMAP; ++a) {
                const bf16_t* kr = K + (size_t)j * kp + a * 256; float s = 0.f;
#pragma unroll 2
                for (int cc = 0; cc < DQ / 8; ++cc) { const bf16x8 kv = *(const bf16x8*)(kr + cc * 8);
#pragma unroll
                    for (int e = 0; e < 8; ++e) s += qbuf[a * 64 + cc * 8 + e] * bf2f((bf16_t)kv[e]); }
                if (s > mx[a]) { ls[a] = ls[a] * exp2f(mx[a] - s) + 1.f; mx[a] = s; } else ls[a] += exp2f(s - mx[a]);
            }
        }
        float M[NMAP], Linv[NMAP];
#pragma unroll
        for (int a = 0; a < NMAP; ++a) { M[a] = wave_max(mx[a]); const float l = wave_sum(ls[a] * exp2f(mx[a] - M[a])); Linv[a] = 1.f / l; }
        for (int j = lane; j < nk; j += 64) {
            float w = 0.f;
#pragma unroll
            for (int a = 0; a < NMAP; ++a) {
                const bf16_t* kr = K + (size_t)j * kp + a * 256; float s = 0.f;
#pragma unroll 2
                for (int cc = 0; cc < DQ / 8; ++cc) { const bf16x8 kv = *(const bf16x8*)(kr + cc * 8);
#pragma unroll
                    for (int e = 0; e < 8; ++e) s += qbuf[a * 64 + cc * 8 + e] * bf2f((bf16_t)kv[e]); }
                const float pj = exp2f(s - M[a]) * Linv[a]; w = (a == 0) ? pj : w - lam * pj;
            }
            wbuf[j] = w;
        }
        LDS_WAIT();
        float a0 = 0.f, a1 = 0.f; const bf16_t* vb = V + 2 * lane;
        for (int j = 0; j < nk; ++j) { const float w = wbuf[j]; const unsigned u = *(const unsigned*)(vb + (size_t)j * vp); a0 += w * __uint_as_float(u << 16); a1 += w * __uint_as_float(u & 0xffff0000u); }
        if (DIFF) { const float ms = wave_sum(a0 * a0 + a1 * a1) * (1.f / 128.f); const float rs = rsqrtf(ms + RMS_EPS) * (1.f - LAM_INIT);
            *(unsigned*)(Y + m * 1536 + 512 + h * 128 + 2 * lane) = pk2(a0 * rs * sub_gain[2 * lane], a1 * rs * sub_gain[2 * lane + 1]); }
        else *(unsigned*)(Y + m * 1536 + 1024 + h * 128 + 2 * lane) = pk2(a0, a1);
        LDS_WAIT();
    }
}
__device__ __forceinline__ void phase_merge(const Params& p, unsigned char* lds) {
    const SgCtx c = sg_ctx(lds); const int team = threadIdx.x >> 8; unsigned char* ws = p.ws;
    const bf16_t* XB = (const bf16_t*)(ws + WS_XB); const bf16_t* WG = (const bf16_t*)(ws + WS_WT_G); const bf16_t* Y = (const bf16_t*)(ws + WS_Y); const bf16_t* WB = (const bf16_t*)(ws + WS_WT_B);
    bf16_t* MG = (bf16_t*)(ws + WS_MERGED); const int r0 = SG_R0(c), c0 = SG_C0(c);
    const int ntiles = 512 * 16;
    for (int tb = 2 * blockIdx.x; tb < ntiles; tb += 2 * gridDim.x) {
        const int tile = tb + team; const int tm = tile >> 4, tn = tile & 15;
        f32x4 sum[4][2]; sg_zero(sum);
#pragma unroll 1
        for (int br = 0; br < 3; ++br) {
            f32x4 ag[4][2]; sg_zero(ag);
            sg_tile(ag, XB + (size_t)(tm * 128 + r0) * 1024 + c0, XB + (size_t)(tm * 128 + r0 + 64) * 1024 + c0, WG + (size_t)(br * 1024 + tn * 64 + r0) * 1024 + c0, 1024, c);
            f32x4 ay[4][2]; sg_zero(ay);
            sg_tile(ay, Y + (size_t)(tm * 128 + r0) * 1536 + br * 512 + c0, Y + (size_t)(tm * 128 + r0 + 64) * 1536 + br * 512 + c0, WB + (size_t)(br * 1024 + tn * 64 + r0) * 512 + c0, 512, c);
#pragma unroll
            for (int m = 0; m < 4; ++m)
#pragma unroll
                for (int n = 0; n < 2; ++n)
#pragma unroll
                    for (int j = 0; j < 4; ++j) sum[m][n][j] += sigmoidf_(ag[m][n][j]) * ay[m][n][j];
        }
        sg_store_bf16(sum, MG + (size_t)tm * 128 * 1024 + tn * 64, 1024, c, FIdent());
    }
}
__device__ __forceinline__ void phase_wout(const Params& p, unsigned char* lds) {
    const SgCtx c = sg_ctx(lds); const int team = threadIdx.x >> 8; unsigned char* ws = p.ws;
    const bf16_t* MG = (const bf16_t*)(ws + WS_MERGED); const bf16_t* WO = (const bf16_t*)(ws + WS_WT_OUT); const float* x = (const float*)p.in[0]; float* pre = p.out;
    const int r0 = SG_R0(c), c0 = SG_C0(c); const int ntiles = 512 * 16;
    for (int tb = 2 * blockIdx.x; tb < ntiles; tb += 2 * gridDim.x) {
        const int tile = tb + team; const int tm = tile >> 4, tn = tile & 15;
        f32x4 acc[4][2]; sg_zero(acc);
        sg_tile(acc, MG + (size_t)(tm * 128 + r0) * 1024 + c0, MG + (size_t)(tm * 128 + r0 + 64) * 1024 + c0, WO + (size_t)(tn * 64 + r0) * 1024 + c0, 1024, c);
        { const size_t off = ((size_t)tm * 128 + c.wr * 64 + c.fq * 4) * 1024 + tn * 64 + c.wc * 32 + c.fr;
#pragma unroll
          for (int m = 0; m < 4; ++m)
#pragma unroll
              for (int j = 0; j < 4; ++j) { const size_t o2 = off + (size_t)(m * 16 + j) * 1024;
#pragma unroll
                  for (int n = 0; n < 2; ++n) pre[o2 + n * 16] = ALPHA * x[o2 + n * 16] + acc[m][n][j];
                  asm volatile("" ::: "memory"); } }
    }
}
__device__ __forceinline__ void phase_ln1_route(const Params& p, unsigned char* lds) {
    unsigned char* ws = p.ws; const int tid = threadIdx.x, lane = tid & 63, wave = tid >> 6;
    float* x1f = p.out; bf16_t* x1b = (bf16_t*)(ws + WS_X1B); const float* g1 = (const float*)p.in[17]; const float* b1 = (const float*)p.in[18];
    const float* wg = (const float*)p.in[19]; const float* we = (const float*)p.in[20];
    int* cnt = (int*)(ws + WS_CTL); int* reci = (int*)(ws + WS_RECI); float* recw = (float*)(ws + WS_RECW);
    const int gw = blockIdx.x * 8 + wave, ngw = gridDim.x * 8;
    for (int t = gw; t < NTOK; t += ngw) {
        float* row = x1f + (size_t)t * 1024; f32x4 v[4]; float s = 0.f;
#pragma unroll
        for (int j = 0; j < 4; ++j) { v[j] = *(const f32x4*)(row + 256 * j + 4 * lane); s += (v[j].x + v[j].y) + (v[j].z + v[j].w); }
        const float mean = wave_sum(s) * (1.f / 1024.f); float s2 = 0.f;
#pragma unroll
        for (int j = 0; j < 4; ++j) { v[j] = v[j] - mean; s2 += (v[j].x * v[j].x + v[j].y * v[j].y) + (v[j].z * v[j].z + v[j].w * v[j].w); }
        const float rstd = rsqrtf(wave_sum(s2) * (1.f / 1024.f) + LN_EPS);
#pragma unroll
        for (int j = 0; j < 4; ++j) { const f32x4 gg = *(const f32x4*)(g1 + 256 * j + 4 * lane), bb = *(const f32x4*)(b1 + 256 * j + 4 * lane);
            v[j] = v[j] * rstd * gg + bb; *(f32x4*)(row + 256 * j + 4 * lane) = v[j];
            u32x2 o; o.x = pk2(v[j].x, v[j].y); o.y = pk2(v[j].z, v[j].w); *(u32x2*)(x1b + (size_t)t * 1024 + 256 * j + 4 * lane) = o; }
        float lg[36];
#pragma unroll
        for (int i = 0; i < 36; ++i) lg[i] = 0.f;
#pragma unroll
        for (int j = 0; j < 4; ++j)
#pragma unroll
            for (int e = 0; e < 4; ++e) { const int k = 256 * j + 4 * lane + e; const float xv = v[j][e];
                const f32x4 g4 = *(const f32x4*)(wg + k * 4);
#pragma unroll
                for (int q = 0; q < 4; ++q) lg[q] += xv * g4[q];
#pragma unroll
                for (int q8 = 0; q8 < 8; ++q8) { const f32x4 e4 = *(const f32x4*)(we + k * 32 + q8 * 4);
#pragma unroll
                    for (int q = 0; q < 4; ++q) lg[4 + q8 * 4 + q] += xv * e4[q]; } }
#pragma unroll
        for (int i = 0; i < 36; ++i) lg[i] = wave_sum(lg[i]);
        int gi = 0; float gm = lg[0];
#pragma unroll
        for (int q = 1; q < 4; ++q) if (lg[q] > gm) { gm = lg[q]; gi = q; }
        float gs = 0.f;
#pragma unroll
        for (int q = 0; q < 4; ++q) gs += expf(lg[q] - gm);
        const float group_w = 1.f / gs;
        float ig[8];
#pragma unroll
        for (int i = 0; i < 8; ++i) ig[i] = gi == 0 ? lg[4 + i] : gi == 1 ? lg[12 + i] : gi == 2 ? lg[20 + i] : lg[28 + i];
        int i1 = 0; float l1 = ig[0];
#pragma unroll
        for (int i = 1; i < 8; ++i) if (ig[i] > l1) { l1 = ig[i]; i1 = i; }
        int i2 = -1; float l2 = -3.0e38f;
#pragma unroll
        for (int i = 0; i < 8; ++i) if (i != i1 && ig[i] > l2) { l2 = ig[i]; i2 = i; }
        const float e2 = expf(l2 - l1); const float w1 = group_w / (1.f + e2), w2 = group_w * e2 / (1.f + e2);
        if (lane == 0) { const int ea = gi * 8 + i1, eb = gi * 8 + i2; const int pa = atomicAdd(cnt + ea, 1), pb = atomicAdd(cnt + eb, 1);
            reci[t * 4 + 0] = ea; reci[t * 4 + 1] = eb; reci[t * 4 + 2] = pa; reci[t * 4 + 3] = pb; recw[t * 2] = w1; recw[t * 2 + 1] = w2; }
    }
}
__device__ __forceinline__ int expert_layout(const int* cnt, int lane, int& tiles, int& endi) {
    tiles = (lane < 32) ? ((cnt[lane] + 255) >> 8) : 0; int x = tiles;
#pragma unroll
    for (int o = 1; o < 32; o <<= 1) { const int y = __shfl_up(x, o); if (lane >= o) x += y; }
    endi = x; return __shfl(x, 31);
}
__device__ __forceinline__ int expert_of_tile(int rt, int lane, int endi) { return __popcll(__ballot(lane < 32 && endi <= rt)); }
__device__ __forceinline__ void phase_dispatch(const Params& p, unsigned char* lds) {
    unsigned char* ws = p.ws; const int tid = threadIdx.x, lane = tid & 63, wave = tid >> 6;
    const int* cnt = (const int*)(ws + WS_CTL); int* reci = (int*)(ws + WS_RECI); const bf16_t* x1b = (const bf16_t*)(ws + WS_X1B); bf16_t* xs = (bf16_t*)(ws + WS_XS);
    int tiles, endi; expert_layout(cnt, lane, tiles, endi); const int base = endi - tiles;
    const int gw = blockIdx.x * 8 + wave, ngw = gridDim.x * 8;
    for (int t = gw; t < NTOK; t += ngw) {
        const int ea = reci[t * 4], eb = reci[t * 4 + 1], pa = reci[t * 4 + 2], pb = reci[t * 4 + 3];
        const int sa = __shfl(base, ea) * 256 + pa, sb = __shfl(base, eb) * 256 + pb;
        const u32x4 a = *(const u32x4*)(x1b + (size_t)t * 1024 + lane * 8), b = *(const u32x4*)(x1b + (size_t)t * 1024 + 512 + lane * 8);
        *(u32x4*)(xs + (size_t)sa * 1024 + lane * 8) = a; *(u32x4*)(xs + (size_t)sa * 1024 + 512 + lane * 8) = b;
        *(u32x4*)(xs + (size_t)sb * 1024 + lane * 8) = a; *(u32x4*)(xs + (size_t)sb * 1024 + 512 + lane * 8) = b;
        if (lane == 0) { reci[t * 4 + 2] = sa; reci[t * 4 + 3] = sb; }
    }
}
__device__ __forceinline__ void phase_exp_gu(const Params& p, unsigned char* lds) {
    const SgCtx c = sg_ctx(lds); const int team = threadIdx.x >> 8, lane = threadIdx.x & 63; unsigned char* ws = p.ws;
    const int* cnt = (const int*)(ws + WS_CTL); const bf16_t* XS = (const bf16_t*)(ws + WS_XS); const bf16_t* WGU = (const bf16_t*)(ws + WS_WT_GU); bf16_t* H = (bf16_t*)(ws + WS_H);
    int tiles, endi; const int nt256 = expert_layout(cnt, lane, tiles, endi);
    const int r0 = SG_R0(c), c0 = SG_C0(c); const int ntiles = nt256 * 2 * 8;
    for (int tb = 2 * blockIdx.x; tb < ntiles; tb += 2 * gridDim.x) {
        int tile = tb + team; const bool valid = tile < ntiles; if (!valid) tile = ntiles - 1;
        const int rt = tile >> 3, tn = tile & 7; const int e = expert_of_tile(rt >> 1, lane, endi);
        const bf16_t* a0 = XS + (size_t)(rt * 128 + r0) * 1024 + c0; const bf16_t* a1 = a0 + (size_t)64 * 1024;
        const bf16_t* bg = WGU + (size_t)(e * 1024 + (tn >> 1) * 256 + (tn & 1) * 64 + r0) * 1024 + c0;
        f32x4 ag[4][2]; sg_zero(ag); sg_tile(ag, a0, a1, bg, 1024, c);
        f32x4 au[4][2]; sg_zero(au); sg_tile(au, a0, a1, bg + (size_t)128 * 1024, 1024, c);
#pragma unroll
        for (int m = 0; m < 4; ++m)
#pragma unroll
            for (int n = 0; n < 2; ++n)
#pragma unroll
                for (int j = 0; j < 4; ++j) ag[m][n][j] = siluf_(ag[m][n][j]) * au[m][n][j];
        if (valid) sg_store_bf16(ag, H + (size_t)rt * 128 * 512 + tn * 64, 512, c, FIdent());
    }
}
__device__ __forceinline__ void phase_exp_dn(const Params& p, unsigned char* lds) {
    const SgCtx c = sg_ctx(lds); const int team = threadIdx.x >> 8, lane = threadIdx.x & 63; unsigned char* ws = p.ws;
    const int* cnt = (const int*)(ws + WS_CTL); const bf16_t* H = (const bf16_t*)(ws + WS_H); const bf16_t* WDN = (const bf16_t*)(ws + WS_WT_DN); bf16_t* YB = (bf16_t*)(ws + WS_YB);
    int tiles, endi; const int nt256 = expert_layout(cnt, lane, tiles, endi);
    const int r0 = SG_R0(c), c0 = SG_C0(c); const int ntiles = nt256 * 2 * 16;
    for (int tb = 2 * blockIdx.x; tb < ntiles; tb += 2 * gridDim.x) {
        int tile = tb + team; const bool valid = tile < ntiles; if (!valid) tile = ntiles - 1;
        const int rt = tile >> 4, tn = tile & 15; const int e = expert_of_tile(rt >> 1, lane, endi);
        const bf16_t* a0 = H + (size_t)(rt * 128 + r0) * 512 + c0; const bf16_t* b0 = WDN + (size_t)(e * 1024 + tn * 64 + r0) * 512 + c0;
        f32x4 acc[4][2]; sg_zero(acc); sg_tile(acc, a0, a0 + (size_t)64 * 512, b0, 512, c);
        if (valid) sg_store_bf16(acc, YB + (size_t)rt * 128 * 1024 + tn * 64, 1024, c, FIdent());
    }
}
__device__ __forceinline__ void phase_final(const Params& p, unsigned char* lds) {
    unsigned char* ws = p.ws; const int tid = threadIdx.x, lane = tid & 63, wave = tid >> 6;
    float* out = p.out; const bf16_t* YB = (const bf16_t*)(ws + WS_YB); const int* reci = (const int*)(ws + WS_RECI); const float* recw = (const float*)(ws + WS_RECW);
    const float* g2 = (const float*)p.in[24]; const float* b2 = (const float*)p.in[25];
    const int gw = blockIdx.x * 8 + wave, ngw = gridDim.x * 8;
    for (int t = gw; t < NTOK; t += ngw) {
        float* row = out + (size_t)t * 1024; const int sa = reci[t * 4 + 2], sb = reci[t * 4 + 3]; const float wa = recw[t * 2], wb = recw[t * 2 + 1];
        f32x4 v[4]; float s = 0.f;
#pragma unroll
        for (int j = 0; j < 4; ++j) { const f32x4 xv = *(const f32x4*)(row + 256 * j + 4 * lane);
            const u32x2 ya = *(const u32x2*)(YB + (size_t)sa * 1024 + 256 * j + 4 * lane), yb = *(const u32x2*)(YB + (size_t)sb * 1024 + 256 * j + 4 * lane);
            f32x4 fa, fb; fa.x = __uint_as_float(ya.x << 16); fa.y = __uint_as_float(ya.x & 0xffff0000u); fa.z = __uint_as_float(ya.y << 16); fa.w = __uint_as_float(ya.y & 0xffff0000u);
            fb.x = __uint_as_float(yb.x << 16); fb.y = __uint_as_float(yb.x & 0xffff0000u); fb.z = __uint_as_float(yb.y << 16); fb.w = __uint_as_float(yb.y & 0xffff0000u);
            v[j] = xv * ALPHA + fa * wa + fb * wb; s += (v[j].x + v[j].y) + (v[j].z + v[j].w); }
        const float mean = wave_sum(s) * (1.f / 1024.f); float s2 = 0.f;
#pragma unroll
        for (int j = 0; j < 4; ++j) { v[j] = v[j] - mean; s2 += (v[j].x * v[j].x + v[j].y * v[j].y) + (v[j].z * v[j].z + v[j].w * v[j].w); }
        const float rstd = rsqrtf(wave_sum(s2) * (1.f / 1024.f) + LN_EPS);
#pragma unroll
        for (int j = 0; j < 4; ++j) { const f32x4 gg = *(const f32x4*)(g2 + 256 * j + 4 * lane), bb = *(const f32x4*)(b2 + 256 * j + 4 * lane);
            *(f32x4*)(row + 256 * j + 4 * lane) = v[j] * rstd * gg + bb; }
    }
}

namespace pg8 {
#define PG8_LAS __attribute__((address_space(3)))
constexpr int BM = 256, BK = 64, HALF = 128, HTB = HALF * BK * 2, STAGE_BYTES = 8 * HTB, NXCD = 8, WGM = 8;
__host__ __device__ __forceinline__ int lds_byte(int r, int c) { const int st = (r >> 4) * 2 + (c >> 5), rr = r & 15, cc = c & 31, ob = rr * 64 + cc * 2; return st * 1024 + (ob ^ (((ob >> 9) & 1) << 5)); }
__host__ __device__ __forceinline__ void stage_rc(int b, int& R, int& C) { const int st = b / 1024, sb = b % 1024, swz = sb ^ (((sb >> 9) & 1) << 5); R = (st >> 1) * 16 + swz / 64; C = (st & 1) * 32 + (swz % 64) / 2; }
__host__ __device__ __forceinline__ int perm32(int rho) { const int n = rho >> 4, i = rho & 15; return 8 * (i >> 2) + 4 * n + (i & 3); }
struct Unit { int pm, pn, aux, nt, lda, ldb; const char* a; const char* b; };
typedef float f32x2_t __attribute__((ext_vector_type(2))); typedef __bf16 bf16x2_t __attribute__((ext_vector_type(2)));
__device__ __forceinline__ unsigned cvt_pk_bf16(float lo, float hi) { f32x2_t v = {lo, hi}; bf16x2_t b = __builtin_convertvector(v, bf16x2_t); return __builtin_bit_cast(unsigned, b); }
__device__ __forceinline__ bool static_tile(int i, int G, int c, int nM, int nN, int& pm, int& pn) {
    const int nwg = nM * nN; const long L = (long)i * G + c; if (L >= nwg) return false;
    int wgid = (int)L; { const int q = nwg / NXCD, r = nwg % NXCD, xcd = wgid % NXCD, off = wgid / NXCD; wgid = (xcd < r ? xcd * (q + 1) : r * (q + 1) + (xcd - r) * q) + off; }
    const int nig = WGM * nN, gid = wgid / nig, fm = gid * WGM, gsz = (nM - fm) < WGM ? (nM - fm) : WGM;
    pm = fm + ((wgid % nig) % gsz); pn = (wgid % nig) / gsz; return true;
}
template <class Epi, class Sched, bool ALIGN_EPI>
__device__ __forceinline__ void gemm_phase(PG8_LAS unsigned char* lds, const Sched& S, const Epi& E) {
    const int tid = threadIdx.x, wid = __builtin_amdgcn_readfirstlane(tid >> 6), lane = tid & 63, wr = wid >> 2, wc = wid & 3, fr = lane & 15, fq = lane >> 4;
    const size_t kstep = (size_t)(BK * 2);
    const unsigned ldsw = (unsigned)wid * 1024u;
    const int aoff = lds_byte(wr * 64 + fr, fq * 8), boff = lds_byte(wc * 32 + fr, fq * 8);
#define PG8_VOFF(LDA, LDB) do { int t_ = threadIdx.x; asm volatile("" : "+v"(t_)); _Pragma("unroll") for (int i_ = 0; i_ < 2; ++i_) { int R_, C_; stage_rc(t_ * 16 + i_ * 8192, R_, C_); \
        const int Rb_ = Epi::PERM ? ((R_ & ~31) + perm32(R_ & 31)) : R_; voffA[i_] = (unsigned)(R_ * (LDA) + C_) * 2u; voffB[i_] = (unsigned)(Rb_ * (LDB) + C_) * 2u; } } while (0)
#define PG8_SA(b, h) (((b) * 2 + (h)) * HTB)
#define PG8_SB(b, h) ((4 + (b) * 2 + (h)) * HTB)
#define PG8_STAGE(bufoff, gbase, voff) do { _Pragma("unroll") for (int _i = 0; _i < 2; ++_i) \
        __builtin_amdgcn_global_load_lds((const unsigned*)((const char*)(gbase) + (voff)[_i]), (PG8_LAS unsigned*)(lds + (bufoff) + ldsw + _i * 8192), 16, 0, 0); } while (0)
#define PG8_LDA(dst, b, h) do { _Pragma("unroll") for (int m = 0; m < 4; ++m) _Pragma("unroll") for (int k = 0; k < 2; ++k) dst[m][k] = *(const PG8_LAS bf16x8*)(lds + PG8_SA(b, h) + aoff + m * 2048 + k * 1024); } while (0)
#define PG8_LDB(dst, b, h) do { _Pragma("unroll") for (int n = 0; n < 2; ++n) _Pragma("unroll") for (int k = 0; k < 2; ++k) dst[n][k] = *(const PG8_LAS bf16x8*)(lds + PG8_SB(b, h) + boff + n * 2048 + k * 1024); } while (0)
#define PG8_MMA(ai, bj, At, Bt) do { __builtin_amdgcn_s_setprio(1); _Pragma("unroll") for (int m = 0; m < 4; ++m) _Pragma("unroll") for (int n = 0; n < 2; ++n) _Pragma("unroll") for (int k = 0; k < 2; ++k) \
        acc[ai][bj][m][n] = __builtin_amdgcn_mfma_f32_16x16x32_bf16(Bt[n][k], At[m][k], acc[ai][bj][m][n], 0, 0, 0); __builtin_amdgcn_s_setprio(0); } while (0)
#define PG8_WAIT_V(n) asm volatile("s_waitcnt vmcnt(" #n ")" ::: "memory")
#define PG8_WAIT_L(n) asm volatile("s_waitcnt lgkmcnt(" #n ")" ::: "memory")
#define PG8_BAR __builtin_amdgcn_s_barrier()
#define PG8_SCHED __builtin_amdgcn_sched_barrier(0)
#define PG8_H1(p, ld) ((p) + (size_t)HALF * (ld) * 2)
    Unit cur, nxt; int ui = 0;
    if (!S.next(0, cur)) return;
    f32x4 acc[2][2][4][2];
#pragma unroll
    for (int a = 0; a < 2; ++a)
#pragma unroll
        for (int b = 0; b < 2; ++b)
#pragma unroll
            for (int m = 0; m < 4; ++m)
#pragma unroll
                for (int n = 0; n < 2; ++n) acc[a][b][m][n] = (f32x4){0.f, 0.f, 0.f, 0.f};
    bf16x8 At[4][2], B0[2][2], B1[2][2];
    unsigned voffA[2], voffB[2];
    PG8_VOFF(cur.lda, cur.ldb);
    PG8_STAGE(PG8_SB(0, 0), cur.b, voffB); PG8_STAGE(PG8_SB(0, 1), PG8_H1(cur.b, cur.ldb), voffB); PG8_STAGE(PG8_SA(0, 0), cur.a, voffA); PG8_STAGE(PG8_SA(0, 1), PG8_H1(cur.a, cur.lda), voffA);
    if (wr == 1) PG8_BAR;
    PG8_WAIT_V(2); PG8_BAR;
    PG8_STAGE(PG8_SB(1, 0), cur.b + kstep, voffB); PG8_STAGE(PG8_SA(1, 0), cur.a + kstep, voffA); PG8_STAGE(PG8_SB(1, 1), PG8_H1(cur.b, cur.ldb) + kstep, voffB);
    PG8_WAIT_V(6); PG8_BAR;
    for (;;) {
        const bool has_next = S.next(ui + 1, nxt);
        if (!has_next) nxt = cur;
        const int nt = cur.nt;
        for (int t = 0; t < nt; t += 2) {
            const bool last = (t == nt - 2);
            PG8_LDB(B0, 0, 0); PG8_LDB(B1, 0, 1); PG8_SCHED; PG8_LDA(At, 0, 0); PG8_STAGE(PG8_SA(1, 1), PG8_H1(cur.a, cur.lda) + (size_t)(t + 1) * kstep, voffA);
            if (last) PG8_VOFF(nxt.lda, nxt.ldb);
            const char* a2 = last ? nxt.a : cur.a + (size_t)(t + 2) * kstep; const char* b2 = last ? nxt.b : cur.b + (size_t)(t + 2) * kstep;
            const int lda2 = last ? nxt.lda : cur.lda, ldb2 = last ? nxt.ldb : cur.ldb;
            PG8_WAIT_V(8); PG8_WAIT_L(0); PG8_BAR; PG8_MMA(0, 0, At, B0); PG8_MMA(0, 1, At, B1); PG8_BAR; PG8_SCHED;
            PG8_LDA(At, 0, 1); PG8_STAGE(PG8_SB(0, 0), b2, voffB); PG8_STAGE(PG8_SB(0, 1), PG8_H1(b2, ldb2), voffB); PG8_STAGE(PG8_SA(0, 0), a2, voffA);
            PG8_WAIT_V(8); PG8_WAIT_L(0); PG8_BAR; PG8_MMA(1, 0, At, B0); PG8_MMA(1, 1, At, B1); PG8_BAR; PG8_SCHED;
            PG8_LDB(B0, 1, 0); PG8_LDB(B1, 1, 1); PG8_SCHED; PG8_LDA(At, 1, 0); PG8_STAGE(PG8_SA(0, 1), PG8_H1(a2, lda2), voffA);
            PG8_WAIT_V(8); PG8_WAIT_L(0); PG8_BAR; PG8_MMA(0, 0, At, B0); PG8_MMA(0, 1, At, B1); PG8_BAR; PG8_SCHED;
            PG8_LDA(At, 1, 1); PG8_STAGE(PG8_SB(1, 0), b2 + kstep, voffB); PG8_STAGE(PG8_SB(1, 1), PG8_H1(b2, ldb2) + kstep, voffB); PG8_STAGE(PG8_SA(1, 0), a2 + kstep, voffA);
            PG8_WAIT_V(8); PG8_WAIT_L(0); PG8_BAR; PG8_MMA(1, 0, At, B0); PG8_MMA(1, 1, At, B1); PG8_BAR; PG8_SCHED;
        }
        if constexpr (ALIGN_EPI) { if (wr == 0) PG8_BAR; }
        E(acc, cur, wr, wc, fr, fq);
        if (!has_next) break;
#pragma unroll
        for (int a = 0; a < 2; ++a)
#pragma unroll
            for (int b = 0; b < 2; ++b)
#pragma unroll
                for (int m = 0; m < 4; ++m)
#pragma unroll
                    for (int n = 0; n < 2; ++n) acc[a][b][m][n] = (f32x4){0.f, 0.f, 0.f, 0.f};
        cur = nxt; ++ui;
        if constexpr (ALIGN_EPI) { if (wr == 1) PG8_BAR; }
    }
    PG8_WAIT_V(0);
    if constexpr (!ALIGN_EPI) { if (wr == 0) PG8_BAR; }
    PG8_BAR;
#undef PG8_VOFF
#undef PG8_H1
#undef PG8_SA
#undef PG8_SB
#undef PG8_STAGE
#undef PG8_LDA
#undef PG8_LDB
#undef PG8_MMA
#undef PG8_WAIT_V
#undef PG8_WAIT_L
#undef PG8_BAR
#undef PG8_SCHED
}
struct SchedPlain {
    const char* A; const char* B; int nM, nN, lda, ldb, nt, G, c;
    __device__ __forceinline__ bool next(int i, Unit& u) const {
        int pm, pn; if (!static_tile(i, G, c, nM, nN, pm, pn)) return false;
        u.pm = pm; u.pn = pn; u.aux = 0; u.nt = nt; u.lda = lda; u.ldb = ldb; u.a = A + (size_t)pm * BM * lda * 2; u.b = B + (size_t)pn * BM * ldb * 2; return true; }
};
struct SchedMerge {
    const char* XB; const char* WG; const char* Y; const char* WB; int G, c;
    __device__ __forceinline__ bool next(int i, Unit& u) const {
        const int ti = i / 6, sub = i - ti * 6, br = sub >> 1; int pm, pn; if (!static_tile(ti, G, c, 256, 4, pm, pn)) return false;
        u.pm = pm; u.pn = pn; u.aux = sub;
        if ((sub & 1) == 0) { u.nt = 16; u.lda = 1024; u.ldb = 1024; u.a = XB + (size_t)pm * BM * 1024 * 2; u.b = WG + (size_t)(br * 1024 + pn * BM) * 1024 * 2; }
        else { u.nt = 8; u.lda = 1536; u.ldb = 512; u.a = Y + ((size_t)pm * BM * 1536 + br * 512) * 2; u.b = WB + (size_t)(br * 1024 + pn * BM) * 512 * 2; }
        return true; }
};
struct SchedExp {
    const char* A; const char* B; int lda, ldb, nt, total, G, c; size_t bexp; const PG8_LAS int* tab;
    __device__ __forceinline__ bool next(int i, Unit& u) const {
        const long L = (long)i * G + c; if (L >= total) return false;
        int id = (int)L; { const int q = total / NXCD, r = total % NXCD, xcd = id % NXCD, off = id / NXCD; id = (xcd < r ? xcd * (q + 1) : r * (q + 1) + (xcd - r) * q) + off; }
        const int rt = id >> 2, pn = id & 3; const int e = __builtin_amdgcn_readfirstlane(tab[rt]);
        u.pm = rt; u.pn = pn; u.aux = e; u.nt = nt; u.lda = lda; u.ldb = ldb; u.a = A + (size_t)rt * BM * lda * 2; u.b = B + (size_t)e * bexp + (size_t)pn * BM * ldb * 2; return true; }
};
struct EpiBf16 {
    static constexpr bool PERM = true; bf16_t* O; int ldc;
    __device__ __forceinline__ void operator()(const f32x4 (&acc)[2][2][4][2], const Unit& u, int wr, int wc, int fr, int fq) const {
        bf16_t* base = O + (size_t)(u.pm * BM + wr * 64 + fr) * ldc + u.pn * BM + wc * 32 + 8 * fq;
#pragma unroll
        for (int ai = 0; ai < 2; ++ai)
#pragma unroll
            for (int m = 0; m < 4; ++m) { bf16_t* rowp = base + (size_t)(ai * HALF + m * 16) * ldc;
#pragma unroll
                for (int bj = 0; bj < 2; ++bj) { const f32x4 v0 = acc[ai][bj][m][0], v1 = acc[ai][bj][m][1];
                    u32x4 w; w.x = cvt_pk_bf16(v0[0], v0[1]); w.y = cvt_pk_bf16(v0[2], v0[3]); w.z = cvt_pk_bf16(v1[0], v1[1]); w.w = cvt_pk_bf16(v1[2], v1[3]);
                    *(u32x4*)(rowp + bj * HALF) = w; } }
    }
};
struct EpiProj {
    static constexpr bool PERM = true; bf16_t *HG, *DQK, *DV, *MQ; const float* rope;
    __device__ __forceinline__ void operator()(const f32x4 (&acc)[2][2][4][2], const Unit& u, int wr, int wc, int fr, int fq) const {
        const int pn = u.pn; bf16_t* dst; int ld, mode;
        if (pn < 8) { dst = HG + pn * 256; ld = 2048; mode = (pn < 2 || pn >= 6) ? 1 : 0; }
        else if (pn < 12) { dst = DQK + (pn - 8) * 256; ld = 1024; mode = pn < 10 ? 2 : 3; }
        else if (pn < 14) { dst = DV + (pn - 12) * 256; ld = 512; mode = 0; }
        else { dst = MQ + (pn - 14) * 256; ld = 512; mode = 0; }
        const int row0 = u.pm * BM + wr * 64 + fr; const bool rot = (mode >= 2) && ((wc & 1) == 0);
#pragma unroll
        for (int ai = 0; ai < 2; ++ai)
#pragma unroll
            for (int m = 0; m < 4; ++m) { const int row = row0 + ai * HALF + m * 16; bf16_t* rowp = dst + (size_t)row * ld + wc * 32 + 8 * fq;
                f32x4 r0 = {1.f, 0.f, 1.f, 0.f}, r1 = r0, r2 = r0, r3 = r0;
                if (rot) { const f32x4* rp = (const f32x4*)(rope + (size_t)row * 16); r0 = rp[0]; r1 = rp[1]; r2 = rp[2]; r3 = rp[3]; }
#pragma unroll
                for (int bj = 0; bj < 2; ++bj) { f32x4 v0 = acc[ai][bj][m][0], v1 = acc[ai][bj][m][1];
                    if (mode == 1) {
#pragma unroll
                        for (int e = 0; e < 4; ++e) { v0[e] = siluf_(v0[e]); v1[e] = siluf_(v1[e]); } }
                    if (rot) {
                        f32x4 p0, p1;
#pragma unroll
                        for (int e = 0; e < 4; ++e) { p0[e] = __shfl_xor(v0[e], 16); p1[e] = __shfl_xor(v1[e], 16); }
                        const float sg = (fq == 0) ? -1.f : 1.f;
                        if (fq < 2) {
                            v0[0] = v0[0] * r0[0] + sg * p0[0] * r0[1]; v0[1] = v0[1] * r0[2] + sg * p0[1] * r0[3]; v0[2] = v0[2] * r1[0] + sg * p0[2] * r1[1]; v0[3] = v0[3] * r1[2] + sg * p0[3] * r1[3];
                            v1[0] = v1[0] * r2[0] + sg * p1[0] * r2[1]; v1[1] = v1[1] * r2[2] + sg * p1[1] * r2[3]; v1[2] = v1[2] * r3[0] + sg * p1[2] * r3[1]; v1[3] = v1[3] * r3[2] + sg * p1[3] * r3[3]; } }
                    if (mode == 2) { v0 = v0 * QSCALE_DF; v1 = v1 * QSCALE_DF; }
                    u32x4 w; w.x = cvt_pk_bf16(v0[0], v0[1]); w.y = cvt_pk_bf16(v0[2], v0[3]); w.z = cvt_pk_bf16(v1[0], v1[1]); w.w = cvt_pk_bf16(v1[2], v1[3]);
                    *(u32x4*)(rowp + bj * HALF) = w; }
                asm volatile("" ::: "memory"); }
    }
};
__device__ __forceinline__ u32x4 ld16_sc1(const unsigned char* p) {
    const unsigned long long a = __hip_atomic_load((const unsigned long long*)p, __ATOMIC_RELAXED, __HIP_MEMORY_SCOPE_AGENT), b = __hip_atomic_load((const unsigned long long*)p + 1, __ATOMIC_RELAXED, __HIP_MEMORY_SCOPE_AGENT);
    u32x4 r; r.x = (unsigned)a; r.y = (unsigned)(a >> 32); r.z = (unsigned)b; r.w = (unsigned)(b >> 32); return r; }
__device__ __forceinline__ void unpack8(const u32x4 w, float (&o)[8]) {
    o[0] = __uint_as_float(w.x << 16); o[1] = __uint_as_float(w.x & 0xffff0000u); o[2] = __uint_as_float(w.y << 16); o[3] = __uint_as_float(w.y & 0xffff0000u);
    o[4] = __uint_as_float(w.z << 16); o[5] = __uint_as_float(w.z & 0xffff0000u); o[6] = __uint_as_float(w.w << 16); o[7] = __uint_as_float(w.w & 0xffff0000u); }
struct EpiMerge {
    static constexpr bool PERM = true; bf16_t* MG; unsigned char* scrG; unsigned char* scrS;
    static __device__ __forceinline__ void unpack8_(const u32x4 w, float (&o)[8]) {
        o[0] = __uint_as_float(w.x << 16); o[1] = __uint_as_float(w.x & 0xffff0000u); o[2] = __uint_as_float(w.y << 16); o[3] = __uint_as_float(w.y & 0xffff0000u);
        o[4] = __uint_as_float(w.z << 16); o[5] = __uint_as_float(w.z & 0xffff0000u); o[6] = __uint_as_float(w.w << 16); o[7] = __uint_as_float(w.w & 0xffff0000u); }
    __device__ __forceinline__ void operator()(const f32x4 (&acc)[2][2][4][2], const Unit& u, int wr, int wc, int fr, int fq) const {
        const int sub = u.aux, br = sub >> 1; const int wid = wr * 4 + wc, lane = fq * 16 + fr;
        unsigned lo = ((unsigned)wid * 16u * 64u + (unsigned)lane) * 16u; asm volatile("" : "+v"(lo));
        if ((sub & 1) == 0) {
#pragma unroll
            for (int ai = 0; ai < 2; ++ai)
#pragma unroll
                for (int bj = 0; bj < 2; ++bj)
#pragma unroll
                    for (int m = 0; m < 4; ++m) { const int g = (ai * 2 + bj) * 4 + m; const f32x4 v0 = acc[ai][bj][m][0], v1 = acc[ai][bj][m][1];
                        u32x4 w; w.x = cvt_pk_bf16(sigmoidf_(v0[0]), sigmoidf_(v0[1])); w.y = cvt_pk_bf16(sigmoidf_(v0[2]), sigmoidf_(v0[3]));
                        w.z = cvt_pk_bf16(sigmoidf_(v1[0]), sigmoidf_(v1[1])); w.w = cvt_pk_bf16(sigmoidf_(v1[2]), sigmoidf_(v1[3]));
                        *(u32x4*)(scrG + (lo + (unsigned)g * 1024u)) = w; asm volatile("" ::: "memory"); }
        } else {
            bf16_t* base = MG + (size_t)(u.pm * BM + wr * 64 + fr) * 1024 + u.pn * BM + wc * 32 + 8 * fq;
#pragma unroll
            for (int ai = 0; ai < 2; ++ai)
#pragma unroll
                for (int bj = 0; bj < 2; ++bj)
#pragma unroll
                    for (int m = 0; m < 4; ++m) { const int g = (ai * 2 + bj) * 4 + m; const f32x4 v0 = acc[ai][bj][m][0], v1 = acc[ai][bj][m][1];
                        float gt[8], o[8]; unpack8(*(const u32x4*)(scrG + (lo + (unsigned)g * 1024u)), gt);
                        o[0] = gt[0] * v0[0]; o[1] = gt[1] * v0[1]; o[2] = gt[2] * v0[2]; o[3] = gt[3] * v0[3]; o[4] = gt[4] * v1[0]; o[5] = gt[5] * v1[1]; o[6] = gt[6] * v1[2]; o[7] = gt[7] * v1[3];
                        if (br > 0) { float pv[8]; unpack8(*(const u32x4*)(scrS + (lo + (unsigned)g * 1024u)), pv);
#pragma unroll
                            for (int e = 0; e < 8; ++e) o[e] += pv[e]; }
                        u32x4 w; w.x = cvt_pk_bf16(o[0], o[1]); w.y = cvt_pk_bf16(o[2], o[3]); w.z = cvt_pk_bf16(o[4], o[5]); w.w = cvt_pk_bf16(o[6], o[7]);
                        if (br < 2) *(u32x4*)(scrS + (lo + (unsigned)g * 1024u)) = w; else *(u32x4*)(base + (size_t)(ai * HALF + m * 16) * 1024 + bj * HALF) = w;
                        asm volatile("" ::: "memory"); }
        }
    }
};
struct EpiWout {
    static constexpr bool PERM = false; const float* x; float* out;
    __device__ __forceinline__ void operator()(const f32x4 (&acc)[2][2][4][2], const Unit& u, int wr, int wc, int fr, int fq) const {
        const size_t off0 = (size_t)(u.pm * BM + wr * 64 + fr) * 1024 + u.pn * BM + wc * 32 + 4 * fq;
#pragma unroll
        for (int ai = 0; ai < 2; ++ai)
#pragma unroll
            for (int m = 0; m < 4; ++m) { const size_t off = off0 + (size_t)(ai * HALF + m * 16) * 1024;
#pragma unroll
                for (int bj = 0; bj < 2; ++bj)
#pragma unroll
                    for (int n = 0; n < 2; ++n) { const f32x4 xv = *(const f32x4*)(x + off + bj * HALF + n * 16); *(f32x4*)(out + off + bj * HALF + n * 16) = xv * ALPHA + acc[ai][bj][m][n]; }
                if (m & 1) asm volatile("" ::: "memory"); }
    }
};
struct EpiSwiglu {
    static constexpr bool PERM = true; bf16_t* H;
    __device__ __forceinline__ void operator()(const f32x4 (&acc)[2][2][4][2], const Unit& u, int wr, int wc, int fr, int fq) const {
        bf16_t* base = H + (size_t)(u.pm * BM + wr * 64 + fr) * 512 + u.pn * HALF + wc * 32 + 8 * fq;
#pragma unroll
        for (int ai = 0; ai < 2; ++ai)
#pragma unroll
            for (int m = 0; m < 4; ++m) { const f32x4 g0 = acc[ai][0][m][0], g1 = acc[ai][0][m][1], u0 = acc[ai][1][m][0], u1 = acc[ai][1][m][1];
                u32x4 w; w.x = cvt_pk_bf16(siluf_(g0[0]) * u0[0], siluf_(g0[1]) * u0[1]); w.y = cvt_pk_bf16(siluf_(g0[2]) * u0[2], siluf_(g0[3]) * u0[3]);
                w.z = cvt_pk_bf16(siluf_(g1[0]) * u1[0], siluf_(g1[1]) * u1[1]); w.w = cvt_pk_bf16(siluf_(g1[2]) * u1[2], siluf_(g1[3]) * u1[3]);
                *(u32x4*)(base + (size_t)(ai * HALF + m * 16) * 512) = w; }
    }
};
}

#define LASP(p) ((__attribute__((address_space(3))) unsigned char*)(p))
__device__ __forceinline__ void phase_proj_pg8(const Params& p, unsigned char* lds) {
    unsigned char* ws = p.ws;
    { pg8::SchedPlain S{(const char*)(ws + WS_XB), (const char*)(ws + WS_WT_IN), 256, 16, 1024, 1024, 16, (int)gridDim.x, (int)blockIdx.x};
      pg8::EpiProj E{(bf16_t*)(ws + WS_HG), (bf16_t*)(ws + WS_DQK), (bf16_t*)(ws + WS_DV), (bf16_t*)(ws + WS_MQ), (const float*)(ws + WS_ROPE)};
      pg8::gemm_phase<pg8::EpiProj, pg8::SchedPlain, true>(LASP(lds), S, E); }
    { pg8::SchedPlain S{(const char*)(ws + WS_MEMB), (const char*)(ws + WS_WT_MKV), 16, 4, 1024, 1024, 16, (int)gridDim.x, (int)blockIdx.x};
      pg8::EpiBf16 E{(bf16_t*)(ws + WS_MKV), 1024};
      pg8::gemm_phase<pg8::EpiBf16, pg8::SchedPlain, true>(LASP(lds), S, E); }
}
constexpr size_t WS_SCR = WS_DQK;
__device__ __forceinline__ void phase_merge_pg8(const Params& p, unsigned char* lds) {
    unsigned char* ws = p.ws;
    pg8::SchedMerge S{(const char*)(ws + WS_XB), (const char*)(ws + WS_WT_G), (const char*)(ws + WS_Y), (const char*)(ws + WS_WT_B), (int)gridDim.x, (int)blockIdx.x};
    pg8::EpiMerge E{(bf16_t*)(ws + WS_MERGED), ws + WS_SCR + (size_t)blockIdx.x * 262144, ws + WS_SCR + (size_t)blockIdx.x * 262144 + 131072};
    pg8::gemm_phase<pg8::EpiMerge, pg8::SchedMerge, true>(LASP(lds), S, E);
}
__device__ __forceinline__ void phase_wout_pg8(const Params& p, unsigned char* lds) {
    unsigned char* ws = p.ws;
    pg8::SchedPlain S{(const char*)(ws + WS_MERGED), (const char*)(ws + WS_WT_OUT), 256, 4, 1024, 1024, 16, (int)gridDim.x, (int)blockIdx.x};
    pg8::EpiWout E{(const float*)p.in[0], p.out};
    pg8::gemm_phase<pg8::EpiWout, pg8::SchedPlain, true>(LASP(lds), S, E);
}
constexpr int LDS_TAB = 131072;
__device__ __forceinline__ int exp_table(const Params& p, unsigned char* lds) {
    const int lane = threadIdx.x & 63; int tiles, endi; const int nt256 = expert_layout((const int*)(p.ws + WS_CTL), lane, tiles, endi);
    int* tab = (int*)(lds + LDS_TAB);
    for (int rt = threadIdx.x >> 6; rt < nt256; rt += 8) { const int e = expert_of_tile(rt, lane, endi); if (lane == 0) tab[rt] = e; }
    __syncthreads(); return nt256;
}
__device__ __forceinline__ void phase_exp_gu_pg8(const Params& p, unsigned char* lds) {
    unsigned char* ws = p.ws; const int nt256 = exp_table(p, lds);
    pg8::SchedExp S{(const char*)(ws + WS_XS), (const char*)(ws + WS_WT_GU), 1024, 1024, 16, nt256 * 4, (int)gridDim.x, (int)blockIdx.x, (size_t)1024 * 1024 * 2, (const __attribute__((address_space(3))) int*)LASP(lds + LDS_TAB)};
    pg8::EpiSwiglu E{(bf16_t*)(ws + WS_H)};
    pg8::gemm_phase<pg8::EpiSwiglu, pg8::SchedExp, true>(LASP(lds), S, E);
}
__device__ __forceinline__ void phase_exp_dn_pg8(const Params& p, unsigned char* lds) {
    unsigned char* ws = p.ws; const int nt256 = exp_table(p, lds);
    pg8::SchedExp S{(const char*)(ws + WS_H), (const char*)(ws + WS_WT_DN), 512, 512, 8, nt256 * 4, (int)gridDim.x, (int)blockIdx.x, (size_t)1024 * 512 * 2, (const __attribute__((address_space(3))) int*)LASP(lds + LDS_TAB)};
    pg8::EpiBf16 E{(bf16_t*)(ws + WS_YB), 1024};
    pg8::gemm_phase<pg8::EpiBf16, pg8::SchedExp, true>(LASP(lds), S, E);
}

#include <hip/hip_bf16.h>
namespace attn64 {
using bf16=__hip_bfloat16;
using bf16x8=__attribute__((ext_vector_type(8)))short;
using s16x4=__attribute__((ext_vector_type(4)))short;
using f32x16=__attribute__((ext_vector_type(16)))float;
using u32x4=__attribute__((ext_vector_type(4)))unsigned;
constexpr int SEQ=4096,D=64;
constexpr int NW=8,QBLK=32,QB=QBLK*NW,KVBLK=64,NQB=SEQ/QB;
constexpr int ATTN_UNIT_ROWS=QB;
__device__ __forceinline__ int crow(int r,int hi){return (r&3)+8*(r>>2)+4*hi;}
#define SBAR() __builtin_amdgcn_sched_barrier(0)
__device__ __forceinline__ void cmask(f32x16&p0,f32x16&p1,int jb,int qrel,int hi){
  const float NEG=-INFINITY; const int dq=qrel-64*jb-4*hi;
  #pragma unroll
  for(int r=0;r<16;++r){const int c=(r&3)+8*(r>>2); if(c>dq)p0[r]=NEG; if(c+32>dq)p1[r]=NEG;}
}

constexpr int NSLOT=3, SLOTB=8192;
constexpr int LDS_K=0, LDS_V=NSLOT*SLOTB, LDS_WS=2*NSLOT*SLOTB, LDS_OST=LDS_WS+NW*64*4, LDS_BYTES=LDS_OST+NW*4096;
constexpr float C2=0.125f*1.4426950408889634f;
__device__ __forceinline__ void glds16(const void*gsrc,unsigned lds_dst){unsigned keep;
  asm volatile("s_mov_b32 %0, m0\n\ts_mov_b32 m0, %2\n\ts_nop 0\n\tglobal_load_lds_dwordx4 %1, off\n\ts_mov_b32 m0, %0":"=&s"(keep):"v"(gsrc),"s"(lds_dst):"memory");}
__device__ __forceinline__ float max3f(float a,float b,float c){float r;asm("v_max3_f32 %0, %1, %2, %3":"=v"(r):"v"(a),"v"(b),"v"(c));return r;}
__device__ __forceinline__ float max2f(float a,float b){float r;asm("v_max_f32_e32 %0, %1, %2":"=v"(r):"v"(a),"v"(b));return r;}
__device__ __forceinline__ float fadd_s(float a,float b){float r;asm("v_add_f32_e32 %0, %1, %2":"=v"(r):"v"(a),"v"(b));return r;}
__device__ __forceinline__ float fsub_s(float a,float b){float r;asm("v_sub_f32_e32 %0, %1, %2":"=v"(r):"v"(a),"v"(b));return r;}
typedef float f32x2_t __attribute__((ext_vector_type(2))); typedef __bf16 bf16x2_t __attribute__((ext_vector_type(2)));
__device__ __forceinline__ unsigned cvtpk_s(float lo,float hi){f32x2_t v={lo,hi};bf16x2_t b=__builtin_convertvector(v,bf16x2_t);return __builtin_bit_cast(unsigned,b);}
#define WAIT_BAR(N) asm volatile("s_waitcnt vmcnt(" #N ") lgkmcnt(0)\n\ts_barrier":::"memory")

__device__ __forceinline__ void qkt(f32x16&p0,f32x16&p1,const char*Kslot,const bf16x8*qr,const f32x16&negm,int r32,int hi){
  const char*kb=Kslot+hi*1024+r32*16;
  #pragma unroll
  for(int d0=0;d0<4;++d0){
    const bf16x8 b0=*reinterpret_cast<const bf16x8*>(kb+d0*2048);
    const bf16x8 b1=*reinterpret_cast<const bf16x8*>(kb+d0*2048+512);
    if(d0==0){p0=__builtin_amdgcn_mfma_f32_32x32x16_bf16(b0,qr[0],negm,0,0,0);p1=__builtin_amdgcn_mfma_f32_32x32x16_bf16(b1,qr[0],negm,0,0,0);}
    else{p0=__builtin_amdgcn_mfma_f32_32x32x16_bf16(b0,qr[d0],p0,0,0,0);p1=__builtin_amdgcn_mfma_f32_32x32x16_bf16(b1,qr[d0],p1,0,0,0);}}
}
typedef __attribute__((address_space(3))) const char* lds_cptr;
typedef short v4i16_t __attribute__((ext_vector_type(4)));
__device__ __forceinline__ void kload8(bf16x8*kf,lds_cptr kp){
  kf[0]=*(const __attribute__((address_space(3))) bf16x8*)(kp);      kf[1]=*(const __attribute__((address_space(3))) bf16x8*)(kp+512);
  kf[2]=*(const __attribute__((address_space(3))) bf16x8*)(kp+2048); kf[3]=*(const __attribute__((address_space(3))) bf16x8*)(kp+2560);
  kf[4]=*(const __attribute__((address_space(3))) bf16x8*)(kp+4096); kf[5]=*(const __attribute__((address_space(3))) bf16x8*)(kp+4608);
  kf[6]=*(const __attribute__((address_space(3))) bf16x8*)(kp+6144); kf[7]=*(const __attribute__((address_space(3))) bf16x8*)(kp+6656);
}
__device__ __forceinline__ void kload2(bf16x8*kf,lds_cptr kp,int j){ kf[2*j]=*(const __attribute__((address_space(3))) bf16x8*)(kp+j*2048); kf[2*j+1]=*(const __attribute__((address_space(3))) bf16x8*)(kp+j*2048+512); }
__device__ __forceinline__ s16x4 vtr(lds_cptr p){ return __builtin_bit_cast(s16x4,__builtin_amdgcn_ds_read_tr16_b64_v4i16((__attribute__((address_space(3))) v4i16_t*)p)); }
__device__ __forceinline__ float rowmax(const f32x16&p0,const f32x16&p1){
  float a=max3f(p0[0],p0[1],p1[0]),b=max3f(p0[2],p0[3],p1[1]);a=max3f(a,p1[2],p1[3]);
  #pragma unroll
  for(int r=4;r<16;r+=4){a=max3f(a,p0[r],p0[r+1]);b=max3f(b,p0[r+2],p0[r+3]);a=max3f(a,p1[r],p1[r+1]);b=max3f(b,p1[r+2],p1[r+3]);}
  const float m=max2f(a,b);
  auto rr=__builtin_amdgcn_permlane32_swap(__float_as_uint(m),__float_as_uint(m),false,false);
  return max2f(__uint_as_float(rr[0]),__uint_as_float(rr[1]));
}
__device__ __forceinline__ void pv(f32x16*o,int vb,bf16x8 pa0,bf16x8 pa1,bf16x8 pa2,bf16x8 pa3){
  #pragma unroll
  for(int d0=0;d0<2;++d0){s16x4 lo[4],hi[4];
    #pragma unroll
    for(int ks=0;ks<4;++ks){
      asm volatile("ds_read_b64_tr_b16 %0,%1 offset:%c2":"=&v"(lo[ks]):"v"(vb),"i"(d0*4096+ks*1024):"memory");
      asm volatile("ds_read_b64_tr_b16 %0,%1 offset:%c2":"=&v"(hi[ks]):"v"(vb),"i"(d0*4096+ks*1024+512):"memory");}
    asm volatile("s_waitcnt lgkmcnt(0)":::"memory");SBAR();
    #define PK(k) (bf16x8){lo[k][0],lo[k][1],lo[k][2],lo[k][3],hi[k][0],hi[k][1],hi[k][2],hi[k][3]}
    o[d0]=__builtin_amdgcn_mfma_f32_32x32x16_bf16(pa0,PK(0),o[d0],0,0,0);
    o[d0]=__builtin_amdgcn_mfma_f32_32x32x16_bf16(pa1,PK(1),o[d0],0,0,0);
    o[d0]=__builtin_amdgcn_mfma_f32_32x32x16_bf16(pa2,PK(2),o[d0],0,0,0);
    o[d0]=__builtin_amdgcn_mfma_f32_32x32x16_bf16(pa3,PK(3),o[d0],0,0,0);
    #undef PK
  }
}

#ifndef ATTN_STORE16
#define ATTN_STORE16(p,v) (*(u32x4*)(p)=(v))
#endif
template<int THRL,int PQ,int PK,int PV,int PO> __device__ __forceinline__ void attn_unit(int qb,const bf16*Qs,const bf16*__restrict__ Ks,const bf16*__restrict__ Vs,bf16*Os,char*shm){
  const int tid=threadIdx.x,lane=tid&63,r32=lane&31,hi=lane>>5; const int wid=__builtin_amdgcn_readfirstlane(tid>>6);
  const int q0=qb*QB;
  const bf16*Qw=Qs+(long)(q0+wid*QBLK)*PQ;
  const bf16*Kh=Ks,*Vh=Vs;
  const unsigned lds0=(unsigned)(uintptr_t)shm;
  float*wsf=(float*)(shm+LDS_WS)+wid*64;
  const bf16*ksrc=Kh+(long)lane*PK+wid*8;
  const bf16*vsrc=Vh+(long)(16*(wid&3)+(lane>>2))*PV+(wid>>2)*32+(lane&3)*8;
  const unsigned kdst=lds0+LDS_K+wid*1024, vdst=lds0+LDS_V+wid*1024;
  #define DMA_K(t,slot) glds16(ksrc+(long)(t)*KVBLK*PK,(unsigned)__builtin_amdgcn_readfirstlane(kdst+(slot)))
  #define DMA_V(t,slot) glds16(vsrc+(long)(t)*KVBLK*PV,(unsigned)__builtin_amdgcn_readfirstlane(vdst+(slot)))
  const int vb0=(int)(lds0+LDS_V)+((lane>>4)&1)*32+(lane&3)*8+(4*hi+((lane&15)>>2))*64;
  const char*Kbase=shm+LDS_K; bf16x8 kf[8];
  const lds_cptr shm3=(lds_cptr)shm; const lds_cptr kp0=shm3+LDS_K+hi*1024+r32*16; const lds_cptr vp0=shm3+LDS_V+((lane>>4)&1)*32+(lane&3)*8+(4*hi+((lane&15)>>2))*64;
  const int NT=(q0+QB)/KVBLK;
  DMA_K(0,0);DMA_V(0,0);DMA_K(1,SLOTB);
  bf16x8 qr[4];
  #pragma unroll
  for(int d0=0;d0<4;++d0)qr[d0]=*reinterpret_cast<const bf16x8*>(&Qw[(long)r32*PQ+d0*16+hi*8]);
  float mhat=0.f,l_reg=0.f;f32x16 o[2];f32x16 negm;{float z_=0.f;asm volatile("":"+v"(z_));
  _Pragma("unroll") for(int r=0;r<16;++r){o[0][r]=z_;o[1][r]=z_;negm[r]=z_;}}asm volatile("":"+v"(negm));
  const int qrel=wid*QBLK+r32;
  #define CMASK(P0,P1,t) do{int jb_=(t)-(NT-4); if(jb_>=0)cmask(P0,P1,jb_,qrel,hi);}while(0)
  bool resc=false;
  #define START(P0,P1) do{ const float rm=rowmax(P0,P1); resc=false; \
    { const float dl=rm; mhat=fadd_s(mhat,dl); \
      _Pragma("unroll") for(int r=0;r<16;++r){P0[r]=fsub_s(P0[r],dl);P1[r]=fsub_s(P1[r],dl);} \
      _Pragma("unroll") for(int r=0;r<16;++r)negm[r]=-mhat; asm volatile("":"+v"(negm)); } \
    _Pragma("unroll") for(int r=0;r<16;++r)P0[r]=__builtin_amdgcn_exp2f(P0[r]); }while(0)
  #define RESC() do{ if(resc){ asm volatile("s_waitcnt lgkmcnt(0)":::"memory"); \
      _Pragma("unroll") for(int d_=0;d_<2;++d_) _Pragma("unroll") for(int r=0;r<16;++r)o[d_][r]*=wsf[crow(r,hi)]; } }while(0)
  f32x16 pA0,pA1,pB0,pB1;
  int sl_prev=0,sl_cur=0,sl_next=SLOTB;
  #define ROT() do{sl_prev=sl_cur;sl_cur=sl_next;sl_next=(sl_next==(NSLOT-1)*SLOTB)?0:sl_next+SLOTB;}while(0)
  DMA_K(2,2*SLOTB);
  WAIT_BAR(3);
  qkt(pA0,pA1,Kbase,qr,negm,r32,hi);asm volatile("s_nop 15\n\ts_nop 7":"+v"(pA0),"+v"(pA1));CMASK(pA0,pA1,0);
  START(pA0,pA1);
  _Pragma("unroll") for(int r=0;r<16;++r)pA1[r]=__builtin_amdgcn_exp2f(pA1[r]);
  WAIT_BAR(0);
  DMA_K(3,0);DMA_V(1,SLOTB);
  ROT();
  kload8(kf,kp0+sl_cur);
  WAIT_BAR(2);
  s16x4 vlo[8],vhi[8]; u32x4 pw0,pw1,pw2,pw3;
  #define PKW(P,B) cvtpk_s(P[B],P[B+1])
  #define PAF(k) __builtin_bit_cast(bf16x8,pw##k)
  #define VFR(i) (bf16x8){vlo[i][0],vlo[i][1],vlo[i][2],vlo[i][3],vhi[i][0],vhi[i][1],vhi[i][2],vhi[i][3]}
  #define PIN(x) asm volatile("":"+v"(x))
  #define MX3(a,b,c) __builtin_fmaxf(__builtin_fmaxf((a),(b)),(c))
  #define GAPA(MF,A0,A1,A2,A3,W0,W1,PW) do{ MF; sacc+=A0; sacc+=A1; sacc+=A2; sacc+=A3; PIN(sacc); W0; W1; PIN(PW); SBAR(); }while(0)
  #define EX(v) __builtin_amdgcn_exp2f(v)
  #define GAPB(MF,X,B) do{ MF; X[B]=EX(X[B]); X[B+1]=EX(X[B+1]); X[B+2]=EX(X[B+2]); X[B+3]=EX(X[B+3]); PIN(X); SBAR(); }while(0)
  #define VRD(i) do{ vlo[i]=vtr(vp_+(((i)>>2)*4096+((i)&3)*1024)); vhi[i]=vtr(vp_+(((i)>>2)*4096+((i)&3)*1024+512)); }while(0)
  #define KRD(G,j) do{ if(G){ kload2(kf,kp0+sl_next,j); SBAR(); } }while(0)
  #define STEP(C0,C1,P0,P1,t,GK,GV,GL) do{ SBAR(); \
    const lds_cptr vp_=vp0+sl_prev; \
    VRD(0); SBAR(); float sacc=(P0[0]+P0[1]); \
    GAPA(C0=__builtin_amdgcn_mfma_f32_32x32x16_bf16(kf[0],qr[0],negm,0,0,0), P0[2],P0[3],P0[4],P0[5],     pw0[0]=PKW(P0,0), pw0[1]=PKW(P0,2), pw0); \
    VRD(4); SBAR(); GAPA(C1=__builtin_amdgcn_mfma_f32_32x32x16_bf16(kf[1],qr[0],negm,0,0,0), P0[6],P0[7],P0[8],P0[9],     pw0[2]=PKW(P0,4), pw0[3]=PKW(P0,6), pw0); \
    VRD(1); SBAR(); GAPA(C0=__builtin_amdgcn_mfma_f32_32x32x16_bf16(kf[2],qr[1],C0,0,0,0),   P0[10],P0[11],P0[12],P0[13], pw1[0]=PKW(P0,8), pw1[1]=PKW(P0,10), pw1); \
    VRD(5); SBAR(); GAPA(C1=__builtin_amdgcn_mfma_f32_32x32x16_bf16(kf[3],qr[1],C1,0,0,0),   P0[14],P0[15],P1[0],P1[1],   pw1[2]=PKW(P0,12),pw1[3]=PKW(P0,14), pw1); \
    VRD(2); SBAR(); GAPA(C0=__builtin_amdgcn_mfma_f32_32x32x16_bf16(kf[4],qr[2],C0,0,0,0),   P1[2],P1[3],P1[4],P1[5],     pw2[0]=PKW(P1,0), pw2[1]=PKW(P1,2), pw2); \
    VRD(6); SBAR(); GAPA(C1=__builtin_amdgcn_mfma_f32_32x32x16_bf16(kf[5],qr[2],C1,0,0,0),   P1[6],P1[7],P1[8],P1[9],     pw2[2]=PKW(P1,4), pw2[3]=PKW(P1,6), pw2); \
    VRD(3); SBAR(); GAPA(C0=__builtin_amdgcn_mfma_f32_32x32x16_bf16(kf[6],qr[3],C0,0,0,0),   P1[10],P1[11],P1[12],P1[13], pw3[0]=PKW(P1,8), pw3[1]=PKW(P1,10), pw3); \
    VRD(7); SBAR(); GAPA(C1=__builtin_amdgcn_mfma_f32_32x32x16_bf16(kf[7],qr[3],C1,0,0,0),   P1[14],P1[15],0.f,0.f,       pw3[2]=PKW(P1,12),pw3[3]=PKW(P1,14), pw3); \
    l_reg+=sacc; \
    if(GK){DMA_K((t)+3,sl_cur);} if(GV){DMA_V((t)+1,sl_next);} \
    CMASK(C0,C1,t); \
    { float a=MX3(C0[0],C0[1],C1[0]),b=MX3(C0[2],C0[3],C1[1]); a=MX3(a,C1[2],C1[3]); \
      _Pragma("unroll") for(int r=4;r<16;r+=4){a=MX3(a,C0[r],C0[r+1]);b=MX3(b,C0[r+2],C0[r+3]);a=MX3(a,C1[r],C1[r+1]);b=MX3(b,C1[r+2],C1[r+3]);} \
      float rm=__builtin_fmaxf(a,b); { auto rr=__builtin_amdgcn_permlane32_swap(__float_as_uint(rm),__float_as_uint(rm),false,false); rm=__builtin_fmaxf(__uint_as_float(rr[0]),__uint_as_float(rr[1])); } \
      resc=false; \
      if(__builtin_expect(__any(rm>(float)THRL),0)){ const float dl=__builtin_fmaxf(rm,0.f); mhat+=dl; \
        _Pragma("unroll") for(int r=0;r<16;++r){C0[r]-=dl;C1[r]-=dl;} \
        _Pragma("unroll") for(int r=0;r<16;++r)negm[r]=-mhat; asm volatile("":"+v"(negm)); \
        const float f=__builtin_amdgcn_exp2f(-dl); l_reg*=f; if(hi==0)wsf[r32]=f; resc=true; } } \
    SBAR(); \
    GAPB(o[0]=__builtin_amdgcn_mfma_f32_32x32x16_bf16(PAF(0),VFR(0),o[0],0,0,0), C0,0); \
    GAPB(o[1]=__builtin_amdgcn_mfma_f32_32x32x16_bf16(PAF(0),VFR(4),o[1],0,0,0), C0,4); \
    KRD(GL,0); GAPB(o[0]=__builtin_amdgcn_mfma_f32_32x32x16_bf16(PAF(1),VFR(1),o[0],0,0,0), C0,8); \
    KRD(GL,1); GAPB(o[1]=__builtin_amdgcn_mfma_f32_32x32x16_bf16(PAF(1),VFR(5),o[1],0,0,0), C0,12); \
    KRD(GL,2); GAPB(o[0]=__builtin_amdgcn_mfma_f32_32x32x16_bf16(PAF(2),VFR(2),o[0],0,0,0), C1,0); \
    KRD(GL,3); GAPB(o[1]=__builtin_amdgcn_mfma_f32_32x32x16_bf16(PAF(2),VFR(6),o[1],0,0,0), C1,4); \
    GAPB(o[0]=__builtin_amdgcn_mfma_f32_32x32x16_bf16(PAF(3),VFR(3),o[0],0,0,0), C1,8); \
    GAPB(o[1]=__builtin_amdgcn_mfma_f32_32x32x16_bf16(PAF(3),VFR(7),o[1],0,0,0), C1,12); \
    }while(0)
  int t=1;
  #undef CMASK
  #define CMASK(P0,P1,t) do{}while(0)
  for(;t+5<NT;t+=2){
    STEP(pB0,pB1,pA0,pA1,t,true,true,true);     WAIT_BAR(2); RESC(); ROT();
    STEP(pA0,pA1,pB0,pB1,t+1,true,true,true);   WAIT_BAR(2); RESC(); ROT();
  }
  #undef CMASK
  #define CMASK(P0,P1,t) do{int jb_=(t)-(NT-4); if(jb_>=0)cmask(P0,P1,jb_,qrel,hi);}while(0)
  #define ENDW(tt) do{ if((tt)+3<NT){WAIT_BAR(2);} else if((tt)+2<NT){WAIT_BAR(1);} else {WAIT_BAR(0);} }while(0)
  for(;t+1<NT;t+=2){
    STEP(pB0,pB1,pA0,pA1,t,(t+3<NT),(t+1<NT),(t+1<NT));       ENDW(t);   RESC(); ROT();
    STEP(pA0,pA1,pB0,pB1,t+1,(t+4<NT),(t+2<NT),(t+2<NT));     ENDW(t+1); RESC(); ROT();
  }
  STEP(pB0,pB1,pA0,pA1,NT-1,false,false,false); RESC();
  { float sacc=pB0[0]+pB0[1]; _Pragma("unroll") for(int r=2;r<16;++r)sacc+=pB0[r]; _Pragma("unroll") for(int r=0;r<16;++r)sacc+=pB1[r]; l_reg+=sacc;
    pw0=(u32x4){PKW(pB0,0),PKW(pB0,2),PKW(pB0,4),PKW(pB0,6)};pw1=(u32x4){PKW(pB0,8),PKW(pB0,10),PKW(pB0,12),PKW(pB0,14)};pw2=(u32x4){PKW(pB1,0),PKW(pB1,2),PKW(pB1,4),PKW(pB1,6)};pw3=(u32x4){PKW(pB1,8),PKW(pB1,10),PKW(pB1,12),PKW(pB1,14)};
    SBAR(); pv(o,vb0+sl_cur,PAF(0),PAF(1),PAF(2),PAF(3)); }
  #undef PKW
  #undef PAF
  #undef VFR
  #undef PIN
  #undef MX3
  #undef GAPA
  #undef GAPB
  #undef EX
  #undef VRD
  #undef KRD
  #undef STEP
  #undef ENDW
  {auto rr=__builtin_amdgcn_permlane32_swap(__float_as_uint(l_reg),__float_as_uint(l_reg),false,false);l_reg=__uint_as_float(rr[0])+__uint_as_float(rr[1]);}
  if(hi==0)wsf[32+r32]=l_reg;asm volatile("s_waitcnt lgkmcnt(0)":::"memory");
  float rli[16];
  #pragma unroll
  for(int r=0;r<16;++r)rli[r]=__builtin_amdgcn_rcpf(wsf[32+crow(r,hi)]);
  bf16*Ow=Os+(long)(q0+wid*QBLK)*PO;
  { bf16*stg=(bf16*)(shm+LDS_OST)+wid*2048;
    #pragma unroll
    for(int r=0;r<16;++r){const int orow=crow(r,hi);
      #pragma unroll
      for(int d0=0;d0<2;++d0)stg[orow*64+d0*32+r32]=__float2bfloat16(o[d0][r]*rli[r]);}
    asm volatile("s_waitcnt lgkmcnt(0)":::"memory");
    #pragma unroll
    for(int i=0;i<4;++i){const int row=i*8+(lane>>3),ch=lane&7; const u32x4 v=*(const u32x4*)(stg+row*64+ch*8); ATTN_STORE16(Ow+(long)row*PO+ch*8,v);} }
  asm volatile("s_waitcnt lgkmcnt(0)\n\ts_barrier":::"memory");
  #undef DMA_K
  #undef DMA_V
  #undef CMASK
  #undef START
  #undef RESC
  #undef ROT
}
constexpr int ATTN_LDS_BYTES=LDS_BYTES;
#undef SBAR
#undef WAIT_BAR
}

__device__ __forceinline__ void phase_diffattn(const Params& p, unsigned char* lds) {
    using attn64::bf16; unsigned char* ws = p.ws;
    const bf16* DQK = (const bf16*)(ws + WS_DQK); const bf16* DV = (const bf16*)(ws + WS_DV); bf16* O12 = (bf16*)p.out;
    const int G = gridDim.x, bx = blockIdx.x; const int vcu = (G % 8 == 0) ? (bx % 8) * (G / 8) + bx / 8 : bx;
    for (int vh = vcu; vh < 256; vh += G) {
        const int bh = vh >> 2, run = vh & 3, b = bh >> 2, h = bh & 3; const size_t row0 = (size_t)b * SEQ;
        const bf16* Qs = DQK + row0 * 1024 + (run >> 1) * 256 + h * 64; const bf16* Ks = DQK + row0 * 1024 + 512 + (run >> 1) * 256 + h * 64;
        const bf16* Vs = DV + row0 * 512 + h * 128 + (run & 1) * 64; bf16* Os = O12 + row0 * 1024 + h * 256 + run * 64;
        for (int qb = 15; qb >= 0; --qb) attn64::attn_unit<8, 1024, 1024, 512, 1024>(qb, Qs, Ks, Vs, Os, (char*)lds);
    }
}
__device__ __forceinline__ void phase_diffcombine(const Params& p, unsigned char* lds) {
    unsigned char* ws = p.ws; const bf16_t* O12 = (const bf16_t*)p.out; bf16_t* Y = (bf16_t*)(ws + WS_Y);
    const float lam = ((const float*)(ws + WS_SCAL))[512]; const float* sub_gain = (const float*)p.in[11];
    const int lane = threadIdx.x & 63, wave = threadIdx.x >> 6; const int gw = blockIdx.x * 8 + wave, ngw = gridDim.x * 8;
    const int h = lane >> 4, d0 = (lane & 15) * 8;
    float gn[8];
#pragma unroll
    for (int e = 0; e < 8; ++e) gn[e] = sub_gain[d0 + e] * (1.f - LAM_INIT);
    for (int t = gw; t < NTOK; t += ngw) {
        const u32x4 a = *(const u32x4*)(O12 + (size_t)t * 1024 + h * 256 + d0), b = *(const u32x4*)(O12 + (size_t)t * 1024 + h * 256 + 128 + d0);
        float o1[8], o2[8], o[8]; pg8::unpack8(a, o1); pg8::unpack8(b, o2); float sq = 0.f;
#pragma unroll
        for (int e = 0; e < 8; ++e) { o[e] = o1[e] - lam * o2[e]; sq += o[e] * o[e]; }
        sq += __shfl_xor(sq, 1); sq += __shfl_xor(sq, 2); sq += __shfl_xor(sq, 4); sq += __shfl_xor(sq, 8);
        const float rs = rsqrtf(sq * (1.f / 128.f) + RMS_EPS);
        u32x4 w; w.x = pk2(o[0] * rs * gn[0], o[1] * rs * gn[1]); w.y = pk2(o[2] * rs * gn[2], o[3] * rs * gn[3]); w.z = pk2(o[4] * rs * gn[4], o[5] * rs * gn[5]); w.w = pk2(o[6] * rs * gn[6], o[7] * rs * gn[7]);
        *(u32x4*)(Y + (size_t)t * 1536 + 512 + h * 128 + d0) = w;
    }
}

template <bool COOP> __device__ __forceinline__ void cg_or_nothing() { if (COOP) cg::this_grid().sync(); }
template <bool COOP>
__global__ void __launch_bounds__(512, 2) k_fwd(Params p) {
    extern __shared__ __attribute__((aligned(16))) unsigned char lds[];
    const int lo = p.ph_lo, hi = p.ph_hi;
#define RUN_PHASE(k, call) do { if (((PHASE_MASK >> (k)) & 1) && lo <= (k) && (k) < hi) { call; if (COOP && (k) + 1 < hi) { cg::this_grid().sync(); } } } while (0)
    RUN_PHASE(0, phase_prologue(p, lds));
    RUN_PHASE(1, ((USE_PG8 & 1) ? phase_proj_pg8(p, lds) : (phase_proj(p, lds), cg_or_nothing<COOP>(), phase_rope(p, lds))));
    RUN_PHASE(2, (phase_hgrn_naive(p, lds), __syncthreads(), (USE_OPT & 1) ? phase_diffattn(p, lds) : phase_attn_naive<true>(p, lds), __syncthreads(), phase_attn_naive<false>(p, lds)));
    RUN_PHASE(3, ((USE_OPT & 1) ? phase_diffcombine(p, lds) : (void)0));
    RUN_PHASE(4, ((USE_PG8 & 2) ? phase_merge_pg8(p, lds) : phase_merge(p, lds)));
    RUN_PHASE(5, ((USE_PG8 & 4) ? phase_wout_pg8(p, lds) : phase_wout(p, lds)));
    RUN_PHASE(6, phase_ln1_route(p, lds));
    RUN_PHASE(7, phase_dispatch(p, lds));
    RUN_PHASE(8, ((USE_PG8 & 8) ? phase_exp_gu_pg8(p, lds) : phase_exp_gu(p, lds)));
    RUN_PHASE(9, ((USE_PG8 & 16) ? phase_exp_dn_pg8(p, lds) : phase_exp_dn(p, lds)));
    RUN_PHASE(10, phase_final(p, lds));
#undef RUN_PHASE
}

extern "C" void kernel_launch(void* const* d_in, const int* in_sizes, int n_in, void* d_out, int out_size, void* d_ws, size_t ws_size, hipStream_t stream) {
    static int grid = 0;
    if (grid == 0) {
        if (n_in != 26 || in_sizes[0] != NTOK * DM || out_size != NTOK * DM || ws_size < WS_END) {
            fprintf(stderr, "kernel_launch: unexpected shapes: n_in %d in0 %d out %d ws %zu (need >= %zu)\n", n_in, n_in > 0 ? in_sizes[0] : -1, out_size, ws_size, (size_t)WS_END); grid = -1; return; }
        int dev = 0, cus = 0, per_cu = 0;
        hipGetDevice(&dev); hipDeviceGetAttribute(&cus, hipDeviceAttributeMultiprocessorCount, dev);
        if (MK_ONE_LAUNCH) {
            hipFuncSetAttribute((const void*)k_fwd<true>, hipFuncAttributeMaxDynamicSharedMemorySize, LDS_BYTES);
            hipOccupancyMaxActiveBlocksPerMultiprocessor(&per_cu, (const void*)k_fwd<true>, 512, LDS_BYTES);
            if (per_cu < 1) { fprintf(stderr, "kernel_launch: occupancy query says %d blocks/CU\n", per_cu); per_cu = 1; }
            grid = cus * 1;
        } else {
            hipFuncSetAttribute((const void*)k_fwd<false>, hipFuncAttributeMaxDynamicSharedMemorySize, LDS_BYTES);
            grid = cus;
        }
        (void)hipGetLastError();
    }
    if (grid < 0) return;
    Params p{};
    for (int i = 0; i < 26; ++i) p.in[i] = d_in[i];
    p.out = (float*)d_out; p.ws = (unsigned char*)d_ws;
    if (MK_ONE_LAUNCH) {
        p.ph_lo = 0; p.ph_hi = NPHASE;
        void* args[] = {&p};
        hipError_t e = hipLaunchCooperativeKernel((const void*)k_fwd<true>, dim3(grid), dim3(512), args, LDS_BYTES, stream);
        if (e != hipSuccess) fprintf(stderr, "cooperative launch failed: %s (grid %d)\n", hipGetErrorString(e), grid);
    } else {
        for (int ph = 0; ph < NPHASE; ++ph) { p.ph_lo = ph; p.ph_hi = ph + 1; hipLaunchKernelGGL(k_fwd<false>, dim3(grid), dim3(512), LDS_BYTES, stream, p); }
    }
}
```

```cpp
#include <hip/hip_runtime.h>
#include <hip/hip_cooperative_groups.h>
#include <cstdio>
#include <cstdint>
namespace cg = cooperative_groups;

#ifndef PHASE_MASK
#define PHASE_MASK 0xffff
#endif
#ifndef USE_PG8
#define USE_PG8 0x1f
#endif
#ifndef USE_OPT
#define USE_OPT 0x3
#endif
#ifndef MK_ONE_LAUNCH
#define MK_ONE_LAUNCH 1
#endif

typedef unsigned short bf16_t;
typedef short bf16x8 __attribute__((ext_vector_type(8)));
typedef float f32x4 __attribute__((ext_vector_type(4)));
typedef unsigned u32x4 __attribute__((ext_vector_type(4)));
typedef unsigned u32x2 __attribute__((ext_vector_type(2)));

constexpr int NTOK = 65536, DM = 1024, SEQ = 4096, NBATCH = 16, NMEM = 256, NEXP = 32;
constexpr int NSLOT = 2 * NTOK + NEXP * 256;
constexpr float ALPHA = 1.189207115002721f;
constexpr float LN_EPS = 1e-5f, RMS_EPS = 1e-6f;
constexpr float LOG2E = 1.4426950408889634f;
constexpr float QSCALE_DF = 0.125f * LOG2E;
constexpr float QSCALE_MEM = 0.08838834764831845f * LOG2E;
constexpr float LAM_INIT = 0.2f;
constexpr int NPHASE = 12;

constexpr size_t MiB = (size_t)1 << 20;
constexpr size_t WS_CTL = 0;
constexpr size_t WS_SCAL = 1 * MiB;
constexpr size_t WS_ROPE = 2 * MiB;
constexpr size_t WS_RECI = 6 * MiB;
constexpr size_t WS_RECW = 7 * MiB;
constexpr size_t WS_WT_IN = 8 * MiB;
constexpr size_t WS_WT_G = 16 * MiB;
constexpr size_t WS_WT_MKV = 22 * MiB;
constexpr size_t WS_WT_B = 24 * MiB;
constexpr size_t WS_WT_OUT = 27 * MiB;
constexpr size_t WS_WT_R = 29 * MiB;
constexpr size_t WS_WT_GU = 30 * MiB;
constexpr size_t WS_WT_DN = 94 * MiB;
constexpr size_t WS_MEMB = 126 * MiB;
constexpr size_t WS_MKV = 134 * MiB;
constexpr size_t WS_DEC = 142 * MiB;
constexpr size_t WS_LOGITS = 144 * MiB;
constexpr size_t WS_HG = 176 * MiB;
constexpr size_t WS_DQK = 432 * MiB;
constexpr size_t WS_DV = 560 * MiB;
constexpr size_t WS_MQ = 624 * MiB;
constexpr size_t WS_XB = 688 * MiB;
constexpr size_t WS_Y = 816 * MiB;
constexpr size_t WS_END = 1008 * MiB;
constexpr size_t WS_MERGED = WS_HG;
constexpr size_t WS_X1B = WS_DV;
constexpr size_t WS_XS = WS_HG;
constexpr size_t WS_H = 448 * MiB;
constexpr size_t WS_YB = 584 * MiB;
constexpr int LDS_BYTES = 147456;

struct Params { const void* in[26]; float* out; unsigned char* ws; int ph_lo, ph_hi; };

__device__ __forceinline__ float bf2f(bf16_t v) { return __uint_as_float(((unsigned)v) << 16); }
__device__ __forceinline__ bf16_t f2bf(float f) { unsigned u = __float_as_uint(f); u += 0x7fffu + ((u >> 16) & 1u); return (bf16_t)(u >> 16); }
__device__ __forceinline__ unsigned pk2(float lo, float hi) { return (unsigned)f2bf(lo) | ((unsigned)f2bf(hi) << 16); }
__device__ __forceinline__ float sigmoidf_(float x) { return __builtin_amdgcn_rcpf(1.f + __expf(-x)); }
__device__ __forceinline__ float siluf_(float x) { return x * __builtin_amdgcn_rcpf(1.f + __expf(-x)); }
__device__ __forceinline__ float wave_sum(float v) {
#pragma unroll
    for (int o = 1; o < 64; o <<= 1) v += __shfl_xor(v, o);
    return v;
}
__device__ __forceinline__ float wave_max(float v) {
#pragma unroll
    for (int o = 1; o < 64; o <<= 1) v = fmaxf(v, __shfl_xor(v, o));
    return v;
}
#define LDS_WAIT() asm volatile("s_waitcnt lgkmcnt(0)" ::: "memory")

__device__ __forceinline__ void tr_item(const float* W, int K, int N, bf16_t* WT, int dst_row0, float* scr, int k0, int n0, int lane) {
#pragma unroll 8
    for (int i = 0; i < 32; ++i) { const int kk = 2 * i + (lane >> 5); scr[kk * 33 + (lane & 31)] = W[(size_t)(k0 + kk) * N + n0 + (lane & 31)]; }
    LDS_WAIT();
    const int c = lane & 7;
#pragma unroll
    for (int j = 0; j < 4; ++j) { const int n = (lane >> 3) + 8 * j; const float* s = scr + (8 * c) * 33 + n;
        u32x4 o; o.x = pk2(s[0 * 33], s[1 * 33]); o.y = pk2(s[2 * 33], s[3 * 33]); o.z = pk2(s[4 * 33], s[5 * 33]); o.w = pk2(s[6 * 33], s[7 * 33]);
        *(u32x4*)(WT + (size_t)(dst_row0 + n) * K + k0 + 8 * c) = o; }
    LDS_WAIT();
}
__device__ __forceinline__ void tr_job(const float* W, int K, int N, int ne, bf16_t* WT, int erow, int blk, int blkstride, int base, float* scr, int gw, int ngw, int lane) {
    const int nkb = K / 64, nnb = N / 32, per = nkb * nnb, total = per * ne;
    for (int it = gw; it < total; it += ngw) {
        const int e = it / per, r = it % per, kb = r / nnb, nb = r % nnb, n0 = nb * 32;
        tr_item(W + (size_t)e * K * N, K, N, WT, base + e * erow + (n0 / blk) * blkstride + (n0 % blk), scr, kb * 64, n0, lane);
    }
}
__device__ __forceinline__ void sincos_acc(float ang, float& c, float& s) {
    const double a = (double)ang;
    const double q = rint(a * 0.63661977236758134308);
    const double r = fma(-q, 1.57079632679489661923, a) - q * 6.12323399573676603587e-17;
    const double r2 = r * r;
    double sp = 1.0 / 6227020800.0; sp = fma(sp, r2, -1.0 / 39916800.0); sp = fma(sp, r2, 1.0 / 362880.0); sp = fma(sp, r2, -1.0 / 5040.0);
    sp = fma(sp, r2, 1.0 / 120.0); sp = fma(sp, r2, -1.0 / 6.0); sp = fma(sp, r2, 1.0); const double sr = sp * r;
    double cp = 1.0 / 479001600.0; cp = fma(cp, r2, -1.0 / 3628800.0); cp = fma(cp, r2, 1.0 / 40320.0); cp = fma(cp, r2, -1.0 / 720.0);
    cp = fma(cp, r2, 1.0 / 24.0); cp = fma(cp, r2, -0.5); const double cr = fma(cp, r2, 1.0);
    const int qi = ((int)q) & 3;
    const double cc = (qi == 0) ? cr : (qi == 1) ? -sr : (qi == 2) ? -cr : sr;
    const double ss = (qi == 0) ? sr : (qi == 1) ? cr : (qi == 2) ? -sr : -cr;
    c = (float)cc; s = (float)ss;
}
__device__ __forceinline__ void phase_prologue(const Params& p, unsigned char* lds) {
    const int tid = threadIdx.x, lane = tid & 63, wave = tid >> 6;
    const int gw = blockIdx.x * 8 + wave, ngw = gridDim.x * 8;
    const size_t gt = (size_t)blockIdx.x * 512 + tid, ngt = (size_t)gridDim.x * 512;
    unsigned char* ws = p.ws;
    float* scr = (float*)lds + wave * (64 * 33);
    tr_job((const float*)p.in[3], 1024, 4096, 1, (bf16_t*)(ws + WS_WT_IN), 0, 4096, 0, 0, scr, gw, ngw, lane);
    tr_job((const float*)p.in[4], 1024, 3072, 1, (bf16_t*)(ws + WS_WT_G), 0, 3072, 0, 0, scr, gw, ngw, lane);
    tr_job((const float*)p.in[12], 1024, 1024, 1, (bf16_t*)(ws + WS_WT_MKV), 0, 1024, 0, 0, scr, gw, ngw, lane);
    tr_job((const float*)p.in[13], 512, 1024, 1, (bf16_t*)(ws + WS_WT_B), 0, 1024, 0, 0, scr, gw, ngw, lane);
    tr_job((const float*)p.in[14], 512, 1024, 1, (bf16_t*)(ws + WS_WT_B), 0, 1024, 0, 1024, scr, gw, ngw, lane);
    tr_job((const float*)p.in[15], 512, 1024, 1, (bf16_t*)(ws + WS_WT_B), 0, 1024, 0, 2048, scr, gw, ngw, lane);
    tr_job((const float*)p.in[16], 1024, 1024, 1, (bf16_t*)(ws + WS_WT_OUT), 0, 1024, 0, 0, scr, gw, ngw, lane);
    tr_job((const float*)p.in[21], 1024, 512, 32, (bf16_t*)(ws + WS_WT_GU), 1024, 128, 256, 0, scr, gw, ngw, lane);
    tr_job((const float*)p.in[22], 1024, 512, 32, (bf16_t*)(ws + WS_WT_GU), 1024, 128, 256, 128, scr, gw, ngw, lane);
    tr_job((const float*)p.in[23], 512, 1024, 32, (bf16_t*)(ws + WS_WT_DN), 1024, 1024, 0, 0, scr, gw, ngw, lane);
    { const float* wg = (const float*)p.in[19]; const float* we = (const float*)p.in[20]; bf16_t* wr = (bf16_t*)(ws + WS_WT_R);
      for (size_t i = gt; i < 256 * 1024; i += ngt) { const int r = (int)(i >> 10), k = (int)(i & 1023);
          const float v = r < 4 ? wg[k * 4 + r] : (r < 36 ? we[k * 32 + (r - 4)] : 0.f); wr[i] = f2bf(v); } }
    { const float* x = (const float*)p.in[0]; bf16_t* xb = (bf16_t*)(ws + WS_XB);
      for (size_t i = gt; i < (size_t)NTOK * DM / 8; i += ngt) { const f32x4 a = *(const f32x4*)(x + i * 8), b = *(const f32x4*)(x + i * 8 + 4);
          u32x4 o; o.x = pk2(a.x, a.y); o.y = pk2(a.z, a.w); o.z = pk2(b.x, b.y); o.w = pk2(b.z, b.w); *(u32x4*)(xb + i * 8) = o; }
      const float* mm = (const float*)p.in[1]; bf16_t* mb = (bf16_t*)(ws + WS_MEMB);
      for (size_t i = gt; i < (size_t)NBATCH * NMEM * DM / 8; i += ngt) { const f32x4 a = *(const f32x4*)(mm + i * 8), b = *(const f32x4*)(mm + i * 8 + 4);
          u32x4 o; o.x = pk2(a.x, a.y); o.y = pk2(a.z, a.w); o.z = pk2(b.x, b.y); o.w = pk2(b.z, b.w); *(u32x4*)(mb + i * 8) = o; } }
    { const int* pos = (const int*)p.in[2]; float* rope = (float*)(ws + WS_ROPE);
      for (size_t i = gt; i < (size_t)NTOK * 8; i += ngt) { const int tk = (int)(i >> 3), fi = (int)(i & 7);
          const float invf = fi == 0 ? 1.0f : fi == 1 ? 0.1939227432012558f : fi == 2 ? 0.03760603070259094f : fi == 3 ? 0.007292664609849453f : fi == 4 ? 0.0014142135623842478f
                           : fi == 5 ? 0.00027424818836152554f : fi == 6 ? 5.3182957344688475e-05f : 1.0313385246263351e-05f;
          const float ang = (float)pos[tk] * invf; float c, s; sincos_acc(ang, c, s); rope[i * 2] = c; rope[i * 2 + 1] = s; } }
    if (blockIdx.x == 0) {
        float* sc = (float*)(ws + WS_SCAL); const float* lbs = (const float*)p.in[5];
        { const float a = lbs[tid], b = lbs[512 + tid]; sc[tid] = 1.f / (1.f + expf(b - a)); }
        if (wave == 0) {
            const float* q1 = (const float*)p.in[7]; const float* k1 = (const float*)p.in[8]; const float* q2 = (const float*)p.in[9]; const float* k2 = (const float*)p.in[10];
            const float s1 = wave_sum(q1[lane] * k1[lane]), s2 = wave_sum(q2[lane] * k2[lane]);
            if (lane == 0) sc[512] = expf(s1) - expf(s2) + LAM_INIT;
        }
        if (tid < 64) ((int*)(ws + WS_CTL))[tid] = 0;
    }
}

struct SgCtx { int t, wr, wc, fr, fq; unsigned char* sA; unsigned char* sB; };
__device__ __forceinline__ SgCtx sg_ctx(unsigned char* lds) {
    SgCtx c; const int tid = threadIdx.x; c.t = tid & 255; const int team = tid >> 8; const int wid = c.t >> 6, lane = c.t & 63;
    c.wr = wid >> 1; c.wc = wid & 1; c.fr = lane & 15; c.fq = lane >> 4; c.sA = lds + team * 16384; c.sB = c.sA + 8192; return c;
}
__device__ __forceinline__ void sg_zero(f32x4 (&acc)[4][2]) {
#pragma unroll
    for (int m = 0; m < 4; ++m)
#pragma unroll
        for (int n = 0; n < 2; ++n) acc[m][n] = (f32x4){0.f, 0.f, 0.f, 0.f};
}
__device__ __forceinline__ void sg_tile(f32x4 (&acc)[4][2], const bf16_t* a0, const bf16_t* a1, const bf16_t* b0, int K, const SgCtx& c) {
    const int bo = c.t * 16;
#pragma unroll 1
    for (int kt = 0; kt < K; kt += 32) {
        const bf16x8 va0 = *(const bf16x8*)(a0 + kt), va1 = *(const bf16x8*)(a1 + kt), vb0 = *(const bf16x8*)(b0 + kt);
        *(bf16x8*)(c.sA + bo) = va0; *(bf16x8*)(c.sA + bo + 4096) = va1; *(bf16x8*)(c.sB + bo) = vb0;
        __syncthreads();
        bf16x8 At[4], Bt[2];
#pragma unroll
        for (int m = 0; m < 4; ++m) At[m] = *(const bf16x8*)(c.sA + (c.wr * 64 + m * 16 + c.fr) * 64 + c.fq * 16);
#pragma unroll
        for (int n = 0; n < 2; ++n) Bt[n] = *(const bf16x8*)(c.sB + (c.wc * 32 + n * 16 + c.fr) * 64 + c.fq * 16);
#pragma unroll
        for (int m = 0; m < 4; ++m)
#pragma unroll
            for (int n = 0; n < 2; ++n) acc[m][n] = __builtin_amdgcn_mfma_f32_16x16x32_bf16(At[m], Bt[n], acc[m][n], 0, 0, 0);
        __syncthreads();
    }
}
#define SG_R0(c) ((c).t >> 2)
#define SG_C0(c) (((c).t & 3) * 8)
template <class F> __device__ __forceinline__ void sg_store_bf16(const f32x4 (&acc)[4][2], bf16_t* dst, size_t ld, const SgCtx& c, F f) {
    bf16_t* base = dst + (size_t)(c.wr * 64 + c.fq * 4) * ld + c.wc * 32 + c.fr;
#pragma unroll
    for (int m = 0; m < 4; ++m)
#pragma unroll
        for (int j = 0; j < 4; ++j) { bf16_t* pr = base + (size_t)(m * 16 + j) * ld;
#pragma unroll
            for (int n = 0; n < 2; ++n) pr[n * 16] = f2bf(f(acc[m][n][j], c.wc * 32 + n * 16));
            asm volatile("" ::: "memory"); }
}
struct FIdent { __device__ __forceinline__ float operator()(float v, int) const { return v; } };
struct FSilu { __device__ __forceinline__ float operator()(float v, int) const { return siluf_(v); } };
struct FQScale { __device__ __forceinline__ float operator()(float v, int d0) const { return d0 >= 16 ? v * QSCALE_DF : v; } };

__device__ __forceinline__ void phase_proj(const Params& p, unsigned char* lds) {
    const SgCtx c = sg_ctx(lds); const int team = threadIdx.x >> 8; unsigned char* ws = p.ws;
    const bf16_t* XB = (const bf16_t*)(ws + WS_XB); const bf16_t* WT = (const bf16_t*)(ws + WS_WT_IN);
    bf16_t* HG = (bf16_t*)(ws + WS_HG); bf16_t* DQK = (bf16_t*)(ws + WS_DQK); bf16_t* DV = (bf16_t*)(ws + WS_DV); bf16_t* MQ = (bf16_t*)(ws + WS_MQ);
    const int r0 = SG_R0(c), c0 = SG_C0(c);
    { const int ntiles = 512 * 64;
      for (int tb = 2 * blockIdx.x; tb < ntiles; tb += 2 * gridDim.x) {
        const int tile = tb + team; const int tm = tile >> 6, tn = tile & 63;
        f32x4 acc[4][2]; sg_zero(acc);
        sg_tile(acc, XB + (size_t)(tm * 128 + r0) * 1024 + c0, XB + (size_t)(tm * 128 + r0 + 64) * 1024 + c0, WT + (size_t)(tn * 64 + r0) * 1024 + c0, 1024, c);
        const size_t mrow = (size_t)tm * 128; const int n0 = tn * 64;
        if (n0 < 2048) { const int g = n0 >> 9; bf16_t* d = HG + mrow * 2048 + n0; if (g == 0 || g == 3) sg_store_bf16(acc, d, 2048, c, FSilu()); else sg_store_bf16(acc, d, 2048, c, FIdent()); }
        else if (n0 < 3072) { bf16_t* d = DQK + mrow * 1024 + (n0 - 2048); if (n0 < 2560) sg_store_bf16(acc, d, 1024, c, FQScale()); else sg_store_bf16(acc, d, 1024, c, FIdent()); }
        else if (n0 < 3584) sg_store_bf16(acc, DV + mrow * 512 + (n0 - 3072), 512, c, FIdent());
        else sg_store_bf16(acc, MQ + mrow * 512 + (n0 - 3584), 512, c, FIdent());
      } }
    { const bf16_t* MB = (const bf16_t*)(ws + WS_MEMB); const bf16_t* WK = (const bf16_t*)(ws + WS_WT_MKV); bf16_t* MKV = (bf16_t*)(ws + WS_MKV);
      const int ntiles = 32 * 16;
      for (int tb = 2 * blockIdx.x; tb < ntiles; tb += 2 * gridDim.x) {
        const int tile = tb + team; const int tm = tile >> 4, tn = tile & 15;
        f32x4 acc[4][2]; sg_zero(acc);
        sg_tile(acc, MB + (size_t)(tm * 128 + r0) * 1024 + c0, MB + (size_t)(tm * 128 + r0 + 64) * 1024 + c0, WK + (size_t)(tn * 64 + r0) * 1024 + c0, 1024, c);
        sg_store_bf16(acc, MKV + (size_t)tm * 128 * 1024 + tn * 64, 1024, c, FIdent());
      } }
}
__device__ __forceinline__ void phase_rope(const Params& p, unsigned char* lds) {
    unsigned char* ws = p.ws; bf16_t* DQK = (bf16_t*)(ws + WS_DQK); const float* rope = (const float*)(ws + WS_ROPE);
    const size_t gt = (size_t)blockIdx.x * 512 + threadIdx.x, ngt = (size_t)gridDim.x * 512;
    for (size_t i = gt; i < (size_t)NTOK * 128; i += ngt) {
        const size_t m = i >> 7; const int rem = (int)(i & 127), gh = rem >> 3, fi = rem & 7;
        bf16_t* q = DQK + m * 1024 + gh * 64;
        const float t1 = bf2f(q[fi]), t2 = bf2f(q[8 + fi]); const float cs = rope[(m * 8 + fi) * 2], sn = rope[(m * 8 + fi) * 2 + 1];
        float o1 = t1 * cs - t2 * sn, o2 = t2 * cs + t1 * sn;
        if (gh < 8) { o1 *= QSCALE_DF; o2 *= QSCALE_DF; }
        q[fi] = f2bf(o1); q[8 + fi] = f2bf(o2);
    }
}
__device__ __forceinline__ void phase_hgrn_naive(const Params& p, unsigned char* lds) {
    unsigned char* ws = p.ws; const bf16_t* HG = (const bf16_t*)(ws + WS_HG); bf16_t* Y = (bf16_t*)(ws + WS_Y);
    const float* lower0 = (const float*)(ws + WS_SCAL); const float* gain = (const float*)p.in[6];
    float* fs = (float*)lds; float* ks = fs + 128; float* qs = ks + 128; float* part = qs + 128; float* red = part + 512;
    const int tid = threadIdx.x, v = tid & 127, kq = tid >> 7, lane = tid & 63, wave = tid >> 6;
    for (int bh = blockIdx.x; bh < 64; bh += gridDim.x) {
        const int b = bh >> 2, h = bh & 3;
        float S[32];
#pragma unroll
        for (int i = 0; i < 32; ++i) S[i] = 0.f;
        const float lbv = lower0[h * 128 + v], gn = gain[h * 128 + v];
        for (int t = 0; t < SEQ; ++t) {
            const size_t m = (size_t)b * SEQ + t; const bf16_t* row = HG + m * 2048 + h * 128;
            if (tid < 128) { const float fp = bf2f(row[512 + v]); const float f = lbv + (1.f - lbv) * sigmoidf_(fp); fs[v] = f; ks[v] = 1.f - f; qs[v] = bf2f(row[v]); }
            const float vv = bf2f(row[1024 + v]);
            __syncthreads();
            float o = 0.f;
#pragma unroll
            for (int i = 0; i < 32; ++i) { const int k = kq * 32 + i; S[i] = fs[k] * S[i] + ks[k] * vv; o += qs[k] * S[i]; }
            part[kq * 128 + v] = o;
            __syncthreads();
            float ot = 0.f;
            if (tid < 128) { ot = part[v] + part[128 + v] + part[256 + v] + part[384 + v]; const float sq = wave_sum(ot * ot); if (lane == 0) red[wave] = sq; }
            __syncthreads();
            if (tid < 128) { const float ms = (red[0] + red[1]) * (1.f / 128.f); const float y = ot * rsqrtf(ms + RMS_EPS) * gn * bf2f(row[1536 + v]); Y[m * 1536 + h * 128 + v] = f2bf(y); }
        }
        __syncthreads();
    }
}
template <bool DIFF>
__device__ __forceinline__ void phase_attn_naive(const Params& p, unsigned char* lds) {
    constexpr int DQ = DIFF ? 64 : 128, NMAP = DIFF ? 2 : 1;
    unsigned char* ws = p.ws; const int tid = threadIdx.x, lane = tid & 63, wave = tid >> 6;
    float* wbuf = (float*)lds + wave * 4096; float* qbuf = (float*)(lds + 131072) + wave * 128;
    const bf16_t* DQK = (const bf16_t*)(ws + WS_DQK); const bf16_t* DV = (const bf16_t*)(ws + WS_DV); const bf16_t* MQ = (const bf16_t*)(ws + WS_MQ); const bf16_t* MKV = (const bf16_t*)(ws + WS_MKV);
    bf16_t* Y = (bf16_t*)(ws + WS_Y); const float lam = ((const float*)(ws + WS_SCAL))[512]; const float* sub_gain = (const float*)p.in[11];
    const int gw = blockIdx.x * 8 + wave, ngw = gridDim.x * 8; const int nrows = NTOK * 4;
    for (int r = gw; r < nrows; r += ngw) {
        int b, h, nk; size_t m; const bf16_t *Q, *K, *V; int kp, vp;
        if (DIFF) { const int bh = r >> 12, i = r & 4095; b = bh >> 2; h = bh & 3; m = (size_t)b * SEQ + i; nk = i + 1;
            Q = DQK + m * 1024 + h * 64; K = DQK + (size_t)b * SEQ * 1024 + 512 + h * 64; kp = 1024; V = DV + (size_t)b * SEQ * 512 + h * 128; vp = 512; }
        else { m = (size_t)(r >> 2); h = r & 3; b = (int)(m >> 12); nk = NMEM;
            Q = MQ + m * 512 + h * 128; K = MKV + (size_t)b * NMEM * 1024 + h * 128; kp = 1024; V = MKV + (size_t)b * NMEM * 1024 + 512 + h * 128; vp = 1024; }
        if (DIFF) { qbuf[lane] = bf2f(Q[lane]); qbuf[64 + lane] = bf2f(Q[256 + lane]); }
        else { qbuf[lane] = bf2f(Q[lane]) * QSCALE_MEM; qbuf[64 + lane] = bf2f(Q[64 + lane]) * QSCALE_MEM; }
        LDS_WAIT();
        float mx[NMAP], ls[NMAP];
#pragma unroll
        for (int a = 0; a < NMAP; ++a) { mx[a] = -1e30f; ls[a] = 0.f; }
        for (int j = lane; j < nk; j += 64) {
#pragma unroll
            for (int a = 0; a < NMAP; ++a) {
                const bf16_t* kr = K + (size_t)j * kp + a * 256; float s = 0.f;
#pragma unroll 2
                for (int cc = 0; cc < DQ / 8; ++cc) { const bf16x8 kv = *(const bf16x8*)(kr + cc * 8);
#pragma unroll
                    for (int e = 0; e < 8; ++e) s += qbuf[a * 64 + cc * 8 + e] * bf2f((bf16_t)kv[e]); }
                if (s > mx[a]) { ls[a] = ls[a] * exp2f(mx[a] - s) + 1.f; mx[a] = s; } else ls[a] += exp2f(s - mx[a]);
            }
        }
        float M[NMAP], Linv[NMAP];
#pragma unroll
        for (int a = 0; a < NMAP; ++a) { M[a] = wave_max(mx[a]); const float l = wave_sum(ls[a] * exp2f(mx[a] - M[a])); Linv[a] = 1.f / l; }
        for (int j = lane; j < nk; j += 64) {
            float w = 0.f;
#pragma unroll
            for (int a = 0; a < NMAP; ++a) {
                const bf16_t* kr = K + (size_t)j * kp + a * 256; float s = 0.f;
#pragma unroll 2
                for (int cc = 0; cc < DQ / 8; ++cc) { const bf16x8 kv = *(const bf16x8*)(kr + cc * 8);
#pragma unroll
                    for (int e = 0; e < 8; ++e) s += qbuf[a * 64 + cc * 8 + e] * bf2f((bf16_t)kv[e]); }
                const float pj = exp2f(s - M[a]) * Linv[a]; w = (a == 0) ? pj : w - lam * pj;
            }
            wbuf[j] = w;
        }
        LDS_WAIT();
        float a0 = 0.f, a1 = 0.f; const bf16_t* vb = V + 2 * lane;
        for (int j = 0; j < nk; ++j) { const float w = wbuf[j]; const unsigned u = *(const unsigned*)(vb + (size_t)j * vp); a0 += w * __uint_as_float(u << 16); a1 += w * __uint_as_float(u & 0xffff0000u); }
        if (DIFF) { const float ms = wave_sum(a0 * a0 + a1 * a1) * (1.f / 128.f); const float rs = rsqrtf(ms + RMS_EPS) * (1.f - LAM_INIT);
            *(unsigned*)(Y + m * 1536 + 512 + h * 128 + 2 * lane) = pk2(a0 * rs * sub_gain[2 * lane], a1 * rs * sub_gain[2 * lane + 1]); }
        else *(unsigned*)(Y + m * 1536 + 1024 + h * 128 + 2 * lane) = pk2(a0, a1);
        LDS_WAIT();
    }
}
__device__ __forceinline__ void phase_merge(const Params& p, unsigned char* lds) {
    const SgCtx c = sg_ctx(lds); const int team = threadIdx.x >> 8; unsigned char* ws = p.ws;
    const bf16_t* XB = (const bf16_t*)(ws + WS_XB); const bf16_t* WG = (const bf16_t*)(ws + WS_WT_G); const bf16_t* Y = (const bf16_t*)(ws + WS_Y); const bf16_t* WB = (const bf16_t*)(ws + WS_WT_B);
    bf16_t* MG = (bf16_t*)(ws + WS_MERGED); const int r0 = SG_R0(c), c0 = SG_C0(c);
    const int ntiles = 512 * 16;
    for (int tb = 2 * blockIdx.x; tb < ntiles; tb += 2 * gridDim.x) {
        const int tile = tb + team; const int tm = tile >> 4, tn = tile & 15;
        f32x4 sum[4][2]; sg_zero(sum);
#pragma unroll 1
        for (int br = 0; br < 3; ++br) {
            f32x4 ag[4][2]; sg_zero(ag);
            sg_tile(ag, XB + (size_t)(tm * 128 + r0) * 1024 + c0, XB + (size_t)(tm * 128 + r0 + 64) * 1024 + c0, WG + (size_t)(br * 1024 + tn * 64 + r0) * 1024 + c0, 1024, c);
            f32x4 ay[4][2]; sg_zero(ay);
            sg_tile(ay, Y + (size_t)(tm * 128 + r0) * 1536 + br * 512 + c0, Y + (size_t)(tm * 128 + r0 + 64) * 1536 + br * 512 + c0, WB + (size_t)(br * 1024 + tn * 64 + r0) * 512 + c0, 512, c);
#pragma unroll
            for (int m = 0; m < 4; ++m)
#pragma unroll
                for (int n = 0; n < 2; ++n)
#pragma unroll
                    for (int j = 0; j < 4; ++j) sum[m][n][j] += sigmoidf_(ag[m][n][j]) * ay[m][n][j];
        }
        sg_store_bf16(sum, MG + (size_t)tm * 128 * 1024 + tn * 64, 1024, c, FIdent());
    }
}
__device__ __forceinline__ void phase_wout(const Params& p, unsigned char* lds) {
    const SgCtx c = sg_ctx(lds); const int team = threadIdx.x >> 8; unsigned char* ws = p.ws;
    const bf16_t* MG = (const bf16_t*)(ws + WS_MERGED); const bf16_t* WO = (const bf16_t*)(ws + WS_WT_OUT); const float* x = (const float*)p.in[0]; float* pre = p.out;
    const int r0 = SG_R0(c), c0 = SG_C0(c); const int ntiles = 512 * 16;
    for (int tb = 2 * blockIdx.x; tb < ntiles; tb += 2 * gridDim.x) {
        const int tile = tb + team; const int tm = tile >> 4, tn = tile & 15;
        f32x4 acc[4][2]; sg_zero(acc);
        sg_tile(acc, MG + (size_t)(tm * 128 + r0) * 1024 + c0, MG + (size_t)(tm * 128 + r0 + 64) * 1024 + c0, WO + (size_t)(tn * 64 + r0) * 1024 + c0, 1024, c);
        { const size_t off = ((size_t)tm * 128 + c.wr * 64 + c.fq * 4) * 1024 + tn * 64 + c.wc * 32 + c.fr;
#pragma unroll
          for (int m = 0; m < 4; ++m)
#pragma unroll
              for (int j = 0; j < 4; ++j) { const size_t o2 = off + (size_t)(m * 16 + j) * 1024;
#pragma unroll
                  for (int n = 0; n < 2; ++n) pre[o2 + n * 16] = ALPHA * x[o2 + n * 16] + acc[m][n][j];
                  asm volatile("" ::: "memory"); } }
    }
}
__device__ __forceinline__ void phase_ln1_route(const Params& p, unsigned char* lds) {
    unsigned char* ws = p.ws; const int tid = threadIdx.x, lane = tid & 63, wave = tid >> 6;
    float* x1f = p.out; bf16_t* x1b = (bf16_t*)(ws + WS_X1B); const float* g1 = (const float*)p.in[17]; const float* b1 = (const float*)p.in[18];
    const float* wg = (const float*)p.in[19]; const float* we = (const float*)p.in[20];
    int* cnt = (int*)(ws + WS_CTL); int* reci = (int*)(ws + WS_RECI); float* recw = (float*)(ws + WS_RECW);
    const int gw = blockIdx.x * 8 + wave, ngw = gridDim.x * 8;
    for (int t = gw; t < NTOK; t += ngw) {
        float* row = x1f + (size_t)t * 1024; f32x4 v[4]; float s = 0.f;
#pragma unroll
        for (int j = 0; j < 4; ++j) { v[j] = *(const f32x4*)(row + 256 * j + 4 * lane); s += (v[j].x + v[j].y) + (v[j].z + v[j].w); }
        const float mean = wave_sum(s) * (1.f / 1024.f); float s2 = 0.f;
#pragma unroll
        for (int j = 0; j < 4; ++j) { v[j] = v[j] - mean; s2 += (v[j].x * v[j].x + v[j].y * v[j].y) + (v[j].z * v[j].z + v[j].w * v[j].w); }
        const float rstd = rsqrtf(wave_sum(s2) * (1.f / 1024.f) + LN_EPS);
#pragma unroll
        for (int j = 0; j < 4; ++j) { const f32x4 gg = *(const f32x4*)(g1 + 256 * j + 4 * lane), bb = *(const f32x4*)(b1 + 256 * j + 4 * lane);
            v[j] = v[j] * rstd * gg + bb; *(f32x4*)(row + 256 * j + 4 * lane) = v[j];
            u32x2 o; o.x = pk2(v[j].x, v[j].y); o.y = pk2(v[j].z, v[j].w); *(u32x2*)(x1b + (size_t)t * 1024 + 256 * j + 4 * lane) = o; }
        float lg[36];
#pragma unroll
        for (int i = 0; i < 36; ++i) lg[i] = 0.f;
#pragma unroll
        for (int j = 0; j < 4; ++j)
#pragma unroll
            for (int e = 0; e < 4; ++e) { const int k = 256 * j + 4 * lane + e; const float xv = v[j][e];
                const f32x4 g4 = *(const f32x4*)(wg + k * 4);
#pragma unroll
                for (int q = 0; q < 4; ++q) lg[q] += xv * g4[q];
#pragma unroll
                for (int q8 = 0; q8 < 8; ++q8) { const f32x4 e4 = *(const f32x4*)(we + k * 32 + q8 * 4);
#pragma unroll
                    for (int q = 0; q < 4; ++q) lg[4 + q8 * 4 + q] += xv * e4[q]; } }
#pragma unroll
        for (int i = 0; i < 36; ++i) lg[i] = wave_sum(lg[i]);
        int gi = 0; float gm = lg[0];
#pragma unroll
        for (int q = 1; q < 4; ++q) if (lg[q] > gm) { gm = lg[q]; gi = q; }
        float gs = 0.f;
#pragma unroll
        for (int q = 0; q < 4; ++q) gs += expf(lg[q] - gm);
        const float group_w = 1.f / gs;
        float ig[8];
#pragma unroll
        for (int i = 0; i < 8; ++i) ig[i] = gi == 0 ? lg[4 + i] : gi == 1 ? lg[12 + i] : gi == 2 ? lg[20 + i] : lg[28 + i];
        int i1 = 0; float l1 = ig[0];
#pragma unroll
        for (int i = 1; i < 8; ++i) if (ig[i] > l1) { l1 = ig[i]; i1 = i; }
        int i2 = -1; float l2 = -3.0e38f;
#pragma unroll
        for (int i = 0; i < 8; ++i) if (i != i1 && ig[i] > l2) { l2 = ig[i]; i2 = i; }
        const float e2 = expf(l2 - l1); const float w1 = group_w / (1.f + e2), w2 = group_w * e2 / (1.f + e2);
        if (lane == 0) { const int ea = gi * 8 + i1, eb = gi * 8 + i2; const int pa = atomicAdd(cnt + ea, 1), pb = atomicAdd(cnt + eb, 1);
            reci[t * 4 + 0] = ea; reci[t * 4 + 1] = eb; reci[t * 4 + 2] = pa; reci[t * 4 + 3] = pb; recw[t * 2] = w1; recw[t * 2 + 1] = w2; }
    }
}
__device__ __forceinline__ int expert_layout(const int* cnt, int lane, int& tiles, int& endi) {
    tiles = (lane < 32) ? ((cnt[lane] + 255) >> 8) : 0; int x = tiles;
#pragma unroll
    for (int o = 1; o < 32; o <<= 1) { const int y = __shfl_up(x, o); if (lane >= o) x += y; }
    endi = x; return __shfl(x, 31);
}
__device__ __forceinline__ int expert_of_tile(int rt, int lane, int endi) { return __popcll(__ballot(lane < 32 && endi <= rt)); }
__device__ __forceinline__ void phase_dispatch(const Params& p, unsigned char* lds) {
    unsigned char* ws = p.ws; const int tid = threadIdx.x, lane = tid & 63, wave = tid >> 6;
    const int* cnt = (const int*)(ws + WS_CTL); int* reci = (int*)(ws + WS_RECI); const bf16_t* x1b = (const bf16_t*)(ws + WS_X1B); bf16_t* xs = (bf16_t*)(ws + WS_XS);
    int tiles, endi; expert_layout(cnt, lane, tiles, endi); const int base = endi - tiles;
    const int gw = blockIdx.x * 8 + wave, ngw = gridDim.x * 8;
    for (int t = gw; t < NTOK; t += ngw) {
        const int ea = reci[t * 4], eb = reci[t * 4 + 1], pa = reci[t * 4 + 2], pb = reci[t * 4 + 3];
        const int sa = __shfl(base, ea) * 256 + pa, sb = __shfl(base, eb) * 256 + pb;
        const u32x4 a = *(const u32x4*)(x1b + (size_t)t * 1024 + lane * 8), b = *(const u32x4*)(x1b + (size_t)t * 1024 + 512 + lane * 8);
        *(u32x4*)(xs + (size_t)sa * 1024 + lane * 8) = a; *(u32x4*)(xs + (size_t)sa * 1024 + 512 + lane * 8) = b;
        *(u32x4*)(xs + (size_t)sb * 1024 + lane * 8) = a; *(u32x4*)(xs + (size_t)sb * 1024 + 512 + lane * 8) = b;
        if (lane == 0) { reci[t * 4 + 2] = sa; reci[t * 4 + 3] = sb; }
    }
}
__device__ __forceinline__ void phase_exp_gu(const Params& p, unsigned char* lds) {
    const SgCtx c = sg_ctx(lds); const int team = threadIdx.x >> 8, lane = threadIdx.x & 63; unsigned char* ws = p.ws;
    const int* cnt = (const int*)(ws + WS_CTL); const bf16_t* XS = (const bf16_t*)(ws + WS_XS); const bf16_t* WGU = (const bf16_t*)(ws + WS_WT_GU); bf16_t* H = (bf16_t*)(ws + WS_H);
    int tiles, endi; const int nt256 = expert_layout(cnt, lane, tiles, endi);
    const int r0 = SG_R0(c), c0 = SG_C0(c); const int ntiles = nt256 * 2 * 8;
    for (int tb = 2 * blockIdx.x; tb < ntiles; tb += 2 * gridDim.x) {
        int tile = tb + team; const bool valid = tile < ntiles; if (!valid) tile = ntiles - 1;
        const int rt = tile >> 3, tn = tile & 7; const int e = expert_of_tile(rt >> 1, lane, endi);
        const bf16_t* a0 = XS + (size_t)(rt * 128 + r0) * 1024 + c0; const bf16_t* a1 = a0 + (size_t)64 * 1024;
        const bf16_t* bg = WGU + (size_t)(e * 1024 + (tn >> 1) * 256 + (tn & 1) * 64 + r0) * 1024 + c0;
        f32x4 ag[4][2]; sg_zero(ag); sg_tile(ag, a0, a1, bg, 1024, c);
        f32x4 au[4][2]; sg_zero(au); sg_tile(au, a0, a1, bg + (size_t)128 * 1024, 1024, c);
#pragma unroll
        for (int m = 0; m < 4; ++m)
#pragma unroll
            for (int n = 0; n < 2; ++n)
#pragma unroll
                for (int j = 0; j < 4; ++j) ag[m][n][j] = siluf_(ag[m][n][j]) * au[m][n][j];
        if (valid) sg_store_bf16(ag, H + (size_t)rt * 128 * 512 + tn * 64, 512, c, FIdent());
    }
}
__device__ __forceinline__ void phase_exp_dn(const Params& p, unsigned char* lds) {
    const SgCtx c = sg_ctx(lds); const int team = threadIdx.x >> 8, lane = threadIdx.x & 63; unsigned char* ws = p.ws;
    const int* cnt = (const int*)(ws + WS_CTL); const bf16_t* H = (const bf16_t*)(ws + WS_H); const bf16_t* WDN = (const bf16_t*)(ws + WS_WT_DN); bf16_t* YB = (bf16_t*)(ws + WS_YB);
    int tiles, endi; const int nt256 = expert_layout(cnt, lane, tiles, endi);
    const int r0 = SG_R0(c), c0 = SG_C0(c); const int ntiles = nt256 * 2 * 16;
    for (int tb = 2 * blockIdx.x; tb < ntiles; tb += 2 * gridDim.x) {
        int tile = tb + team; const bool valid = tile < ntiles; if (!valid) tile = ntiles - 1;
        const int rt = tile >> 4, tn = tile & 15; const int e = expert_of_tile(rt >> 1, lane, endi);
        const bf16_t* a0 = H + (size_t)(rt * 128 + r0) * 512 + c0; const bf16_t* b0 = WDN + (size_t)(e * 1024 + tn * 64 + r0) * 512 + c0;
        f32x4 acc[4][2]; sg_zero(acc); sg_tile(acc, a0, a0 + (size_t)64 * 512, b0, 512, c);
        if (valid) sg_store_bf16(acc, YB + (size_t)rt * 128 * 1024 + tn * 64, 1024, c, FIdent());
    }
}
__device__ __forceinline__ void phase_final(const Params& p, unsigned char* lds) {
    unsigned char* ws = p.ws; const int tid = threadIdx.x, lane = tid & 63, wave = tid >> 6;
    float* out = p.out; const bf16_t* YB = (const bf16_t*)(ws + WS_YB); const int* reci = (const int*)(ws + WS_RECI); const float* recw = (const float*)(ws + WS_RECW);
    const float* g2 = (const float*)p.in[24]; const float* b2 = (const float*)p.in[25];
    const int gw = blockIdx.x * 8 + wave, ngw = gridDim.x * 8;
    for (int t = gw; t < NTOK; t += ngw) {
        float* row = out + (size_t)t * 1024; const int sa = reci[t * 4 + 2], sb = reci[t * 4 + 3]; const float wa = recw[t * 2], wb = recw[t * 2 + 1];
        f32x4 v[4]; float s = 0.f;
#pragma unroll
        for (int j = 0; j < 4; ++j) { const f32x4 xv = *(const f32x4*)(row + 256 * j + 4 * lane);
            const u32x2 ya = *(const u32x2*)(YB + (size_t)sa * 1024 + 256 * j + 4 * lane), yb = *(const u32x2*)(YB + (size_t)sb * 1024 + 256 * j + 4 * lane);
            f32x4 fa, fb; fa.x = __uint_as_float(ya.x << 16); fa.y = __uint_as_float(ya.x & 0xffff0000u); fa.z = __uint_as_float(ya.y << 16); fa.w = __uint_as_float(ya.y & 0xffff0000u);
            fb.x = __uint_as_float(yb.x << 16); fb.y = __uint_as_float(yb.x & 0xffff0000u); fb.z = __uint_as_float(yb.y << 16); fb.w = __uint_as_float(yb.y & 0xffff0000u);
            v[j] = xv * ALPHA + fa * wa + fb * wb; s += (v[j].x + v[j].y) + (v[j].z + v[j].w); }
        const float mean = wave_sum(s) * (1.f / 1024.f); float s2 = 0.f;
#pragma unroll
        for (int j = 0; j < 4; ++j) { v[j] = v[j] - mean; s2 += (v[j].x * v[j].x + v[j].y * v[j].y) + (v[j].z * v[j].z + v[j].w * v[j].w); }
        const float rstd = rsqrtf(wave_sum(s2) * (1.f / 1024.f) + LN_EPS);
#pragma unroll
        for (int j = 0; j < 4; ++j) { const f32x4 gg = *(const f32x4*)(g2 + 256 * j + 4 * lane), bb = *(const f32x4*)(b2 + 256 * j + 4 * lane);
            *(f32x4*)(row + 256 * j + 4 * lane) = v[j] * rstd * gg + bb; }
    }
}

namespace pg8 {
#define PG8_LAS __attribute__((address_space(3)))
constexpr int BM = 256, BK = 64, HALF = 128, HTB = HALF * BK * 2, STAGE_BYTES = 8 * HTB, NXCD = 8, WGM = 8;
__host__ __device__ __forceinline__ int lds_byte(int r, int c) { const int st = (r >> 4) * 2 + (c >> 5), rr = r & 15, cc = c & 31, ob = rr * 64 + cc * 2; return st * 1024 + (ob ^ (((ob >> 9) & 1) << 5)); }
__host__ __device__ __forceinline__ void stage_rc(int b, int& R, int& C) { const int st = b / 1024, sb = b % 1024, swz = sb ^ (((sb >> 9) & 1) << 5); R = (st >> 1) * 16 + swz / 64; C = (st & 1) * 32 + (swz % 64) / 2; }
__host__ __device__ __forceinline__ int perm32(int rho) { const int n = rho >> 4, i = rho & 15; return 8 * (i >> 2) + 4 * n + (i & 3); }
struct Unit { int pm, pn, aux, nt, lda, ldb; const char* a; const char* b; };
typedef float f32x2_t __attribute__((ext_vector_type(2))); typedef __bf16 bf16x2_t __attribute__((ext_vector_type(2)));
__device__ __forceinline__ unsigned cvt_pk_bf16(float lo, float hi) { f32x2_t v = {lo, hi}; bf16x2_t b = __builtin_convertvector(v, bf16x2_t); return __builtin_bit_cast(unsigned, b); }
__device__ __forceinline__ bool static_tile(int i, int G, int c, int nM, int nN, int& pm, int& pn) {
    const int nwg = nM * nN; const long L = (long)i * G + c; if (L >= nwg) return false;
    int wgid = (int)L; { const int q = nwg / NXCD, r = nwg % NXCD, xcd = wgid % NXCD, off = wgid / NXCD; wgid = (xcd < r ? xcd * (q + 1) : r * (q + 1) + (xcd - r) * q) + off; }
    const int nig = WGM * nN, gid = wgid / nig, fm = gid * WGM, gsz = (nM - fm) < WGM ? (nM - fm) : WGM;
    pm = fm + ((wgid % nig) % gsz); pn = (wgid % nig) / gsz; return true;
}
template <class Epi, class Sched, bool ALIGN_EPI>
__device__ __forceinline__ void gemm_phase(PG8_LAS unsigned char* lds, const Sched& S, const Epi& E) {
    const int tid = threadIdx.x, wid = __builtin_amdgcn_readfirstlane(tid >> 6), lane = tid & 63, wr = wid >> 2, wc = wid & 3, fr = lane & 15, fq = lane >> 4;
    const size_t kstep = (size_t)(BK * 2);
    const unsigned ldsw = (unsigned)wid * 1024u;
    const int aoff = lds_byte(wr * 64 + fr, fq * 8), boff = lds_byte(wc * 32 + fr, fq * 8);
#define PG8_VOFF(LDA, LDB) do { int t_ = threadIdx.x; asm volatile("" : "+v"(t_)); _Pragma("unroll") for (int i_ = 0; i_ < 2; ++i_) { int R_, C_; stage_rc(t_ * 16 + i_ * 8192, R_, C_); \
        const int Rb_ = Epi::PERM ? ((R_ & ~31) + perm32(R_ & 31)) : R_; voffA[i_] = (unsigned)(R_ * (LDA) + C_) * 2u; voffB[i_] = (unsigned)(Rb_ * (LDB) + C_) * 2u; } } while (0)
#define PG8_SA(b, h) (((b) * 2 + (h)) * HTB)
#define PG8_SB(b, h) ((4 + (b) * 2 + (h)) * HTB)
#define PG8_STAGE(bufoff, gbase, voff) do { _Pragma("unroll") for (int _i = 0; _i < 2; ++_i) \
        __builtin_amdgcn_global_load_lds((const unsigned*)((const char*)(gbase) + (voff)[_i]), (PG8_LAS unsigned*)(lds + (bufoff) + ldsw + _i * 8192), 16, 0, 0); } while (0)
#define PG8_LDA(dst, b, h) do { _Pragma("unroll") for (int m = 0; m < 4; ++m) _Pragma("unroll") for (int k = 0; k < 2; ++k) dst[m][k] = *(const PG8_LAS bf16x8*)(lds + PG8_SA(b, h) + aoff + m * 2048 + k * 1024); } while (0)
#define PG8_LDB(dst, b, h) do { _Pragma("unroll") for (int n = 0; n < 2; ++n) _Pragma("unroll") for (int k = 0; k < 2; ++k) dst[n][k] = *(const PG8_LAS bf16x8*)(lds + PG8_SB(b, h) + boff + n * 2048 + k * 1024); } while (0)
#define PG8_MMA(ai, bj, At, Bt) do { __builtin_amdgcn_s_setprio(1); _Pragma("unroll") for (int m = 0; m < 4; ++m) _Pragma("unroll") for (int n = 0; n < 2; ++n) _Pragma("unroll") for (int k = 0; k < 2; ++k) \
        acc[ai][bj][m][n] = __builtin_amdgcn_mfma_f32_16x16x32_bf16(Bt[n][k], At[m][k], acc[ai][bj][m][n], 0, 0, 0); __builtin_amdgcn_s_setprio(0); } while (0)
#define PG8_WAIT_V(n) asm volatile("s_waitcnt vmcnt(" #n ")" ::: "memory")
#define PG8_WAIT_L(n) asm volatile("s_waitcnt lgkmcnt(" #n ")" ::: "memory")
#define PG8_BAR __builtin_amdgcn_s_barrier()
#define PG8_SCHED __builtin_amdgcn_sched_barrier(0)
#define PG8_H1(p, ld) ((p) + (size_t)HALF * (ld) * 2)
    Unit cur, nxt; int ui = 0;
    if (!S.next(0, cur)) return;
    f32x4 acc[2][2][4][2];
#pragma unroll
    for (int a = 0; a < 2; ++a)
#pragma unroll
        for (int b = 0; b < 2; ++b)
#pragma unroll
            for (int m = 0; m < 4; ++m)
#pragma unroll
                for (int n = 0; n < 2; ++n) acc[a][b][m][n] = (f32x4){0.f, 0.f, 0.f, 0.f};
    bf16x8 At[4][2], B0[2][2], B1[2][2];
    unsigned voffA[2], voffB[2];
    PG8_VOFF(cur.lda, cur.ldb);
    PG8_STAGE(PG8_SB(0, 0), cur.b, voffB); PG8_STAGE(PG8_SB(0, 1), PG8_H1(cur.b, cur.ldb), voffB); PG8_STAGE(PG8_SA(0, 0), cur.a, voffA); PG8_STAGE(PG8_SA(0, 1), PG8_H1(cur.a, cur.lda), voffA);
    if (wr == 1) PG8_BAR;
    PG8_WAIT_V(2); PG8_BAR;
    PG8_STAGE(PG8_SB(1, 0), cur.b + kstep, voffB); PG8_STAGE(PG8_SA(1, 0), cur.a + kstep, voffA); PG8_STAGE(PG8_SB(1, 1), PG8_H1(cur.b, cur.ldb) + kstep, voffB);
    PG8_WAIT_V(6); PG8_BAR;
    for (;;) {
        const bool has_next = S.next(ui + 1, nxt);
        if (!has_next) nxt = cur;
        const int nt = cur.nt;
        for (int t = 0; t < nt; t += 2) {
            const bool last = (t == nt - 2);
            PG8_LDB(B0, 0, 0); PG8_LDB(B1, 0, 1); PG8_SCHED; PG8_LDA(At, 0, 0); PG8_STAGE(PG8_SA(1, 1), PG8_H1(cur.a, cur.lda) + (size_t)(t + 1) * kstep, voffA);
            if (last) PG8_VOFF(nxt.lda, nxt.ldb);
            const char* a2 = last ? nxt.a : cur.a + (size_t)(t + 2) * kstep; const char* b2 = last ? nxt.b : cur.b + (size_t)(t + 2) * kstep;
            const int lda2 = last ? nxt.lda : cur.lda, ldb2 = last ? nxt.ldb : cur.ldb;
            PG8_WAIT_V(8); PG8_WAIT_L(0); PG8_BAR; PG8_MMA(0, 0, At, B0); PG8_MMA(0, 1, At, B1); PG8_BAR; PG8_SCHED;
            PG8_LDA(At, 0, 1); PG8_STAGE(PG8_SB(0, 0), b2, voffB); PG8_STAGE(PG8_SB(0, 1), PG8_H1(b2, ldb2), voffB); PG8_STAGE(PG8_SA(0, 0), a2, voffA);
            PG8_WAIT_V(8); PG8_WAIT_L(0); PG8_BAR; PG8_MMA(1, 0, At, B0); PG8_MMA(1, 1, At, B1); PG8_BAR; PG8_SCHED;
            PG8_LDB(B0, 1, 0); PG8_LDB(B1, 1, 1); PG8_SCHED; PG8_LDA(At, 1, 0); PG8_STAGE(PG8_SA(0, 1), PG8_H1(a2, lda2), voffA);
            PG8_WAIT_V(8); PG8_WAIT_L(0); PG8_BAR; PG8_MMA(0, 0, At, B0); PG8_MMA(0, 1, At, B1); PG8_BAR; PG8_SCHED;
            PG8_LDA(At, 1, 1); PG8_STAGE(PG8_SB(1, 0), b2 + kstep, voffB); PG8_STAGE(PG8_SB(1, 1), PG8_H1(b2, ldb2) + kstep, voffB); PG8_STAGE(PG8_SA(1, 0), a2 + kstep, voffA);
            PG8_WAIT_V(8); PG8_WAIT_L(0); PG8_BAR; PG8_MMA(1, 0, At, B0); PG8_MMA(1, 1, At, B1); PG8_BAR; PG8_SCHED;
        }
        if constexpr (ALIGN_EPI) { if (wr == 0) PG8_BAR; }
        E(acc, cur, wr, wc, fr, fq);
        if (!has_next) break;
#pragma unroll
        for (int a = 0; a < 2; ++a)
#pragma unroll
            for (int b = 0; b < 2; ++b)
#pragma unroll
                for (int m = 0; m < 4; ++m)
#pragma unroll
                    for (int n = 0; n < 2; ++n) acc[a][b][m][n] = (f32x4){0.f, 0.f, 0.f, 0.f};
        cur = nxt; ++ui;
        if constexpr (ALIGN_EPI) { if (wr == 1) PG8_BAR; }
    }
    PG8_WAIT_V(0);
    if constexpr (!ALIGN_EPI) { if (wr == 0) PG8_BAR; }
    PG8_BAR;
#undef PG8_VOFF
#undef PG8_H1
#undef PG8_SA
#undef PG8_SB
#undef PG8_STAGE
#undef PG8_LDA
#undef PG8_LDB
#undef PG8_MMA
#undef PG8_WAIT_V
#undef PG8_WAIT_L
#undef PG8_BAR
#undef PG8_SCHED
}
struct SchedPlain {
    const char* A; const char* B; int nM, nN, lda, ldb, nt, G, c;
    __device__ __forceinline__ bool next(int i, Unit& u) const {
        int pm, pn; if (!static_tile(i, G, c, nM, nN, pm, pn)) return false;
        u.pm = pm; u.pn = pn; u.aux = 0; u.nt = nt; u.lda = lda; u.ldb = ldb; u.a = A + (size_t)pm * BM * lda * 2; u.b = B + (size_t)pn * BM * ldb * 2; return true; }
};
struct SchedMerge {
    const char* XB; const char* WG; const char* Y; const char* WB; int G, c;
    __device__ __forceinline__ bool next(int i, Unit& u) const {
        const int ti = i / 6, sub = i - ti * 6, br = sub >> 1; int pm, pn; if (!static_tile(ti, G, c, 256, 4, pm, pn)) return false;
        u.pm = pm; u.pn = pn; u.aux = sub;
        if ((sub & 1) == 0) { u.nt = 16; u.lda = 1024; u.ldb = 1024; u.a = XB + (size_t)pm * BM * 1024 * 2; u.b = WG + (size_t)(br * 1024 + pn * BM) * 1024 * 2; }
        else { u.nt = 8; u.lda = 1536; u.ldb = 512; u.a = Y + ((size_t)pm * BM * 1536 + br * 512) * 2; u.b = WB + (size_t)(br * 1024 + pn * BM) * 512 * 2; }
        return true; }
};
struct SchedExp {
    const char* A; const char* B; int lda, ldb, nt, total, G, c; size_t bexp; const PG8_LAS int* tab;
    __device__ __forceinline__ bool next(int i, Unit& u) const {
        const long L = (long)i * G + c; if (L >= total) return false;
        int id = (int)L; { const int q = total / NXCD, r = total % NXCD, xcd = id % NXCD, off = id / NXCD; id = (xcd < r ? xcd * (q + 1) : r * (q + 1) + (xcd - r) * q) + off; }
        const int rt = id >> 2, pn = id & 3; const int e = __builtin_amdgcn_readfirstlane(tab[rt]);
        u.pm = rt; u.pn = pn; u.aux = e; u.nt = nt; u.lda = lda; u.ldb = ldb; u.a = A + (size_t)rt * BM * lda * 2; u.b = B + (size_t)e * bexp + (size_t)pn * BM * ldb * 2; return true; }
};
struct EpiBf16 {
    static constexpr bool PERM = true; bf16_t* O; int ldc;
    __device__ __forceinline__ void operator()(const f32x4 (&acc)[2][2][4][2], const Unit& u, int wr, int wc, int fr, int fq) const {
        bf16_t* base = O + (size_t)(u.pm * BM + wr * 64 + fr) * ldc + u.pn * BM + wc * 32 + 8 * fq;
#pragma unroll
        for (int ai = 0; ai < 2; ++ai)
#pragma unroll
            for (int m = 0; m < 4; ++m) { bf16_t* rowp = base + (size_t)(ai * HALF + m * 16) * ldc;
#pragma unroll
                for (int bj = 0; bj < 2; ++bj) { const f32x4 v0 = acc[ai][bj][m][0], v1 = acc[ai][bj][m][1];
                    u32x4 w; w.x = cvt_pk_bf16(v0[0], v0[1]); w.y = cvt_pk_bf16(v0[2], v0[3]); w.z = cvt_pk_bf16(v1[0], v1[1]); w.w = cvt_pk_bf16(v1[2], v1[3]);
                    *(u32x4*)(rowp + bj * HALF) = w; } }
    }
};
struct EpiProj {
    static constexpr bool PERM = true; bf16_t *HG, *DQK, *DV, *MQ; const float* rope;
    __device__ __forceinline__ void operator()(const f32x4 (&acc)[2][2][4][2], const Unit& u, int wr, int wc, int fr, int fq) const {
        const int pn = u.pn; bf16_t* dst; int ld, mode;
        if (pn < 8) { dst = HG + pn * 256; ld = 2048; mode = (pn < 2 || pn >= 6) ? 1 : 0; }
        else if (pn < 12) { dst = DQK + (pn - 8) * 256; ld = 1024; mode = pn < 10 ? 2 : 3; }
        else if (pn < 14) { dst = DV + (pn - 12) * 256; ld = 512; mode = 0; }
        else { dst = MQ + (pn - 14) * 256; ld = 512; mode = 0; }
        const int row0 = u.pm * BM + wr * 64 + fr; const bool rot = (mode >= 2) && ((wc & 1) == 0);
#pragma unroll
        for (int ai = 0; ai < 2; ++ai)
#pragma unroll
            for (int m = 0; m < 4; ++m) { const int row = row0 + ai * HALF + m * 16; bf16_t* rowp = dst + (size_t)row * ld + wc * 32 + 8 * fq;
                f32x4 r0 = {1.f, 0.f, 1.f, 0.f}, r1 = r0, r2 = r0, r3 = r0;
                if (rot) { const f32x4* rp = (const f32x4*)(rope + (size_t)row * 16); r0 = rp[0]; r1 = rp[1]; r2 = rp[2]; r3 = rp[3]; }
#pragma unroll
                for (int bj = 0; bj < 2; ++bj) { f32x4 v0 = acc[ai][bj][m][0], v1 = acc[ai][bj][m][1];
                    if (mode == 1) {
#pragma unroll
                        for (int e = 0; e < 4; ++e) { v0[e] = siluf_(v0[e]); v1[e] = siluf_(v1[e]); } }
                    if (rot) {
                        f32x4 p0, p1;
#pragma unroll
                        for (int e = 0; e < 4; ++e) { p0[e] = __shfl_xor(v0[e], 16); p1[e] = __shfl_xor(v1[e], 16); }
                        const float sg = (fq == 0) ? -1.f : 1.f;
                        if (fq < 2) {
                            v0[0] = v0[0] * r0[0] + sg * p0[0] * r0[1]; v0[1] = v0[1] * r0[2] + sg * p0[1] * r0[3]; v0[2] = v0[2] * r1[0] + sg * p0[2] * r1[1]; v0[3] = v0[3] * r1[2] + sg * p0[3] * r1[3];
                            v1[0] = v1[0] * r2[0] + sg * p1[0] * r2[1]; v1[1] = v1[1] * r2[2] + sg * p1[1] * r2[3]; v1[2] = v1[2] * r3[0] + sg * p1[2] * r3[1]; v1[3] = v1[3] * r3[2] + sg * p1[3] * r3[3]; } }
                    if (mode == 2) { v0 = v0 * QSCALE_DF; v1 = v1 * QSCALE_DF; }
                    u32x4 w; w.x = cvt_pk_bf16(v0[0], v0[1]); w.y = cvt_pk_bf16(v0[2], v0[3]); w.z = cvt_pk_bf16(v1[0], v1[1]); w.w = cvt_pk_bf16(v1[2], v1[3]);
                    *(u32x4*)(rowp + bj * HALF) = w; }
                asm volatile("" ::: "memory"); }
    }
};
__device__ __forceinline__ u32x4 ld16_sc1(const unsigned char* p) {
    const unsigned long long a = __hip_atomic_load((const unsigned long long*)p, __ATOMIC_RELAXED, __HIP_MEMORY_SCOPE_AGENT), b = __hip_atomic_load((const unsigned long long*)p + 1, __ATOMIC_RELAXED, __HIP_MEMORY_SCOPE_AGENT);
    u32x4 r; r.x = (unsigned)a; r.y = (unsigned)(a >> 32); r.z = (unsigned)b; r.w = (unsigned)(b >> 32); return r; }
__device__ __forceinline__ void unpack8(const u32x4 w, float (&o)[8]) {
    o[0] = __uint_as_float(w.x << 16); o[1] = __uint_as_float(w.x & 0xffff0000u); o[2] = __uint_as_float(w.y << 16); o[3] = __uint_as_float(w.y & 0xffff0000u);
    o[4] = __uint_as_float(w.z << 16); o[5] = __uint_as_float(w.z & 0xffff0000u); o[6] = __uint_as_float(w.w << 16); o[7] = __uint_as_float(w.w & 0xffff0000u); }
struct EpiMerge {
    static constexpr bool PERM = true; bf16_t* MG; unsigned char* scrG; unsigned char* scrS;
    static __device__ __forceinline__ void unpack8_(const u32x4 w, float (&o)[8]) {
        o[0] = __uint_as_float(w.x << 16); o[1] = __uint_as_float(w.x & 0xffff0000u); o[2] = __uint_as_float(w.y << 16); o[3] = __uint_as_float(w.y & 0xffff0000u);
        o[4] = __uint_as_float(w.z << 16); o[5] = __uint_as_float(w.z & 0xffff0000u); o[6] = __uint_as_float(w.w << 16); o[7] = __uint_as_float(w.w & 0xffff0000u); }
    __device__ __forceinline__ void operator()(const f32x4 (&acc)[2][2][4][2], const Unit& u, int wr, int wc, int fr, int fq) const {
        const int sub = u.aux, br = sub >> 1; const int wid = wr * 4 + wc, lane = fq * 16 + fr;
        unsigned lo = ((unsigned)wid * 16u * 64u + (unsigned)lane) * 16u; asm volatile("" : "+v"(lo));
        if ((sub & 1) == 0) {
#pragma unroll
            for (int ai = 0; ai < 2; ++ai)
#pragma unroll
                for (int bj = 0; bj < 2; ++bj)
#pragma unroll
                    for (int m = 0; m < 4; ++m) { const int g = (ai * 2 + bj) * 4 + m; const f32x4 v0 = acc[ai][bj][m][0], v1 = acc[ai][bj][m][1];
                        u32x4 w; w.x = cvt_pk_bf16(sigmoidf_(v0[0]), sigmoidf_(v0[1])); w.y = cvt_pk_bf16(sigmoidf_(v0[2]), sigmoidf_(v0[3]));
                        w.z = cvt_pk_bf16(sigmoidf_(v1[0]), sigmoidf_(v1[1])); w.w = cvt_pk_bf16(sigmoidf_(v1[2]), sigmoidf_(v1[3]));
                        *(u32x4*)(scrG + (lo + (unsigned)g * 1024u)) = w; asm volatile("" ::: "memory"); }
        } else {
            bf16_t* base = MG + (size_t)(u.pm * BM + wr * 64 + fr) * 1024 + u.pn * BM + wc * 32 + 8 * fq;
#pragma unroll
            for (int ai = 0; ai < 2; ++ai)
#pragma unroll
                for (int bj = 0; bj < 2; ++bj)
#pragma unroll
                    for (int m = 0; m < 4; ++m) { const int g = (ai * 2 + bj) * 4 + m; const f32x4 v0 = acc[ai][bj][m][0], v1 = acc[ai][bj][m][1];
                        float gt[8], o[8]; unpack8(*(const u32x4*)(scrG + (lo + (unsigned)g * 1024u)), gt);
                        o[0] = gt[0] * v0[0]; o[1] = gt[1] * v0[1]; o[2] = gt[2] * v0[2]; o[3] = gt[3] * v0[3]; o[4] = gt[4] * v1[0]; o[5] = gt[5] * v1[1]; o[6] = gt[6] * v1[2]; o[7] = gt[7] * v1[3];
                        if (br > 0) { float pv[8]; unpack8(*(const u32x4*)(scrS + (lo + (unsigned)g * 1024u)), pv);
#pragma unroll
                            for (int e = 0; e < 8; ++e) o[e] += pv[e]; }
                        u32x4 w; w.x = cvt_pk_bf16(o[0], o[1]); w.y = cvt_pk_bf16(o[2], o[3]); w.z = cvt_pk_bf16(o[4], o[5]); w.w = cvt_pk_bf16(o[6], o[7]);
                        if (br < 2) *(u32x4*)(scrS + (lo + (unsigned)g * 1024u)) = w; else *(u32x4*)(base + (size_t)(ai * HALF + m * 16) * 1024 + bj * HALF) = w;
                        asm volatile("" ::: "memory"); }
        }
    }
};
struct EpiWout {
    static constexpr bool PERM = false; const float* x; float* out;
    __device__ __forceinline__ void operator()(const f32x4 (&acc)[2][2][4][2], const Unit& u, int wr, int wc, int fr, int fq) const {
        const size_t off0 = (size_t)(u.pm * BM + wr * 64 + fr) * 1024 + u.pn * BM + wc * 32 + 4 * fq;
#pragma unroll
        for (int ai = 0; ai < 2; ++ai)
#pragma unroll
            for (int m = 0; m < 4; ++m) { const size_t off = off0 + (size_t)(ai * HALF + m * 16) * 1024;
#pragma unroll
                for (int bj = 0; bj < 2; ++bj)
#pragma unroll
                    for (int n = 0; n < 2; ++n) { const f32x4 xv = *(const f32x4*)(x + off + bj * HALF + n * 16); *(f32x4*)(out + off + bj * HALF + n * 16) = xv * ALPHA + acc[ai][bj][m][n]; }
                if (m & 1) asm volatile("" ::: "memory"); }
    }
};
struct EpiSwiglu {
    static constexpr bool PERM = true; bf16_t* H;
    __device__ __forceinline__ void operator()(const f32x4 (&acc)[2][2][4][2], const Unit& u, int wr, int wc, int fr, int fq) const {
        bf16_t* base = H + (size_t)(u.pm * BM + wr * 64 + fr) * 512 + u.pn * HALF + wc * 32 + 8 * fq;
#pragma unroll
        for (int ai = 0; ai < 2; ++ai)
#pragma unroll
            for (int m = 0; m < 4; ++m) { const f32x4 g0 = acc[ai][0][m][0], g1 = acc[ai][0][m][1], u0 = acc[ai][1][m][0], u1 = acc[ai][1][m][1];
                u32x4 w; w.x = cvt_pk_bf16(siluf_(g0[0]) * u0[0], siluf_(g0[1]) * u0[1]); w.y = cvt_pk_bf16(siluf_(g0[2]) * u0[2], siluf_(g0[3]) * u0[3]);
                w.z = cvt_pk_bf16(siluf_(g1[0]) * u1[0], siluf_(g1[1]) * u1[1]); w.w = cvt_pk_bf16(siluf_(g1[2]) * u1[2], siluf_(g1[3]) * u1[3]);
                *(u32x4*)(base + (size_t)(ai * HALF + m * 16) * 512) = w; }
    }
};
}

#define LASP(p) ((__attribute__((address_space(3))) unsigned char*)(p))
__device__ __forceinline__ void phase_proj_pg8(const Params& p, unsigned char* lds) {
    unsigned char* ws = p.ws;
    { pg8::SchedPlain S{(const char*)(ws + WS_XB), (const char*)(ws + WS_WT_IN), 256, 16, 1024, 1024, 16, (int)gridDim.x, (int)blockIdx.x};
      pg8::EpiProj E{(bf16_t*)(ws + WS_HG), (bf16_t*)(ws + WS_DQK), (bf16_t*)(ws + WS_DV), (bf16_t*)(ws + WS_MQ), (const float*)(ws + WS_ROPE)};
      pg8::gemm_phase<pg8::EpiProj, pg8::SchedPlain, true>(LASP(lds), S, E); }
    { pg8::SchedPlain S{(const char*)(ws + WS_MEMB), (const char*)(ws + WS_WT_MKV), 16, 4, 1024, 1024, 16, (int)gridDim.x, (int)blockIdx.x};
      pg8::EpiBf16 E{(bf16_t*)(ws + WS_MKV), 1024};
      pg8::gemm_phase<pg8::EpiBf16, pg8::SchedPlain, true>(LASP(lds), S, E); }
}
constexpr size_t WS_SCR = WS_DQK;
__device__ __forceinline__ void phase_merge_pg8(const Params& p, unsigned char* lds) {
    unsigned char* ws = p.ws;
    pg8::SchedMerge S{(const char*)(ws + WS_XB), (const char*)(ws + WS_WT_G), (const char*)(ws + WS_Y), (const char*)(ws + WS_WT_B), (int)gridDim.x, (int)blockIdx.x};
    pg8::EpiMerge E{(bf16_t*)(ws + WS_MERGED), ws + WS_SCR + (size_t)blockIdx.x * 262144, ws + WS_SCR + (size_t)blockIdx.x * 262144 + 131072};
    pg8::gemm_phase<pg8::EpiMerge, pg8::SchedMerge, true>(LASP(lds), S, E);
}
__device__ __forceinline__ void phase_wout_pg8(const Params& p, unsigned char* lds) {
    unsigned char* ws = p.ws;
    pg8::SchedPlain S{(const char*)(ws + WS_MERGED), (const char*)(ws + WS_WT_OUT), 256, 4, 1024, 1024, 16, (int)gridDim.x, (int)blockIdx.x};
    pg8::EpiWout E{(const float*)p.in[0], p.out};
    pg8::gemm_phase<pg8::EpiWout, pg8::SchedPlain, true>(LASP(lds), S, E);
}
constexpr int LDS_TAB = 131072;
__device__ __forceinline__ int exp_table(const Params& p, unsigned char* lds) {
    const int lane = threadIdx.x & 63; int tiles, endi; const int nt256 = expert_layout((const int*)(p.ws + WS_CTL), lane, tiles, endi);
    int* tab = (int*)(lds + LDS_TAB);
    for (int rt = threadIdx.x >> 6; rt < nt256; rt += 8) { const int e = expert_of_tile(rt, lane, endi); if (lane == 0) tab[rt] = e; }
    __syncthreads(); return nt256;
}
__device__ __forceinline__ void phase_exp_gu_pg8(const Params& p, unsigned char* lds) {
    unsigned char* ws = p.ws; const int nt256 = exp_table(p, lds);
    pg8::SchedExp S{(const char*)(ws + WS_XS), (const char*)(ws + WS_WT_GU), 1024, 1024, 16, nt256 * 4, (int)gridDim.x, (int)blockIdx.x, (size_t)1024 * 1024 * 2, (const __attribute__((address_space(3))) int*)LASP(lds + LDS_TAB)};
    pg8::EpiSwiglu E{(bf16_t*)(ws + WS_H)};
    pg8::gemm_phase<pg8::EpiSwiglu, pg8::SchedExp, true>(LASP(lds), S, E);
}
__device__ __forceinline__ void phase_exp_dn_pg8(const Params& p, unsigned char* lds) {
    unsigned char* ws = p.ws; const int nt256 = exp_table(p, lds);
    pg8::SchedExp S{(const char*)(ws + WS_H), (const char*)(ws + WS_WT_DN), 512, 512, 8, nt256 * 4, (int)gridDim.x, (int)blockIdx.x, (size_t)1024 * 512 * 2, (const __attribute__((address_space(3))) int*)LASP(lds + LDS_TAB)};
    pg8::EpiBf16 E{(bf16_t*)(ws + WS_YB), 1024};
    pg8::gemm_phase<pg8::EpiBf16, pg8::SchedExp, true>(LASP(lds), S, E);
}

#include <hip/hip_bf16.h>
namespace attn64 {
using bf16=__hip_bfloat16;
using bf16x8=__attribute__((ext_vector_type(8)))short;
using s16x4=__attribute__((ext_vector_type(4)))short;
using f32x16=__attribute__((ext_vector_type(16)))float;
using u32x4=__attribute__((ext_vector_type(4)))unsigned;
constexpr int SEQ=4096,D=64;
constexpr int NW=8,QBLK=32,QB=QBLK*NW,KVBLK=64,NQB=SEQ/QB;
constexpr int ATTN_UNIT_ROWS=QB;
__device__ __forceinline__ int crow(int r,int hi){return (r&3)+8*(r>>2)+4*hi;}
#define SBAR() __builtin_amdgcn_sched_barrier(0)
__device__ __forceinline__ void cmask(f32x16&p0,f32x16&p1,int jb,int qrel,int hi){
  const float NEG=-INFINITY; const int dq=qrel-64*jb-4*hi;
  #pragma unroll
  for(int r=0;r<16;++r){const int c=(r&3)+8*(r>>2); if(c>dq)p0[r]=NEG; if(c+32>dq)p1[r]=NEG;}
}

constexpr int NSLOT=3, SLOTB=8192;
constexpr int LDS_K=0, LDS_V=NSLOT*SLOTB, LDS_WS=2*NSLOT*SLOTB, LDS_OST=LDS_WS+NW*64*4, LDS_BYTES=LDS_OST+NW*4096;
constexpr float C2=0.125f*1.4426950408889634f;
__device__ __forceinline__ void glds16(const void*gsrc,unsigned lds_dst){unsigned keep;
  asm volatile("s_mov_b32 %0, m0\n\ts_mov_b32 m0, %2\n\ts_nop 0\n\tglobal_load_lds_dwordx4 %1, off\n\ts_mov_b32 m0, %0":"=&s"(keep):"v"(gsrc),"s"(lds_dst):"memory");}
__device__ __forceinline__ float max3f(float a,float b,float c){float r;asm("v_max3_f32 %0, %1, %2, %3":"=v"(r):"v"(a),"v"(b),"v"(c));return r;}
__device__ __forceinline__ float max2f(float a,float b){float r;asm("v_max_f32_e32 %0, %1, %2":"=v"(r):"v"(a),"v"(b));return r;}
__device__ __forceinline__ float fadd_s(float a,float b){float r;asm("v_add_f32_e32 %0, %1, %2":"=v"(r):"v"(a),"v"(b));return r;}
__device__ __forceinline__ float fsub_s(float a,float b){float r;asm("v_sub_f32_e32 %0, %1, %2":"=v"(r):"v"(a),"v"(b));return r;}
typedef float f32x2_t __attribute__((ext_vector_type(2))); typedef __bf16 bf16x2_t __attribute__((ext_vector_type(2)));
__device__ __forceinline__ unsigned cvtpk_s(float lo,float hi){f32x2_t v={lo,hi};bf16x2_t b=__builtin_convertvector(v,bf16x2_t);return __builtin_bit_cast(unsigned,b);}
#define WAIT_BAR(N) asm volatile("s_waitcnt vmcnt(" #N ") lgkmcnt(0)\n\ts_barrier":::"memory")

__device__ __forceinline__ void qkt(f32x16&p0,f32x16&p1,const char*Kslot,const bf16x8*qr,const f32x16&negm,int r32,int hi){
  const char*kb=Kslot+hi*1024+r32*16;
  #pragma unroll
  for(int d0=0;d0<4;++d0){
    const bf16x8 b0=*reinterpret_cast<const bf16x8*>(kb+d0*2048);
    const bf16x8 b1=*reinterpret_cast<const bf16x8*>(kb+d0*2048+512);
    if(d0==0){p0=__builtin_amdgcn_mfma_f32_32x32x16_bf16(b0,qr[0],negm,0,0,0);p1=__builtin_amdgcn_mfma_f32_32x32x16_bf16(b1,qr[0],negm,0,0,0);}
    else{p0=__builtin_amdgcn_mfma_f32_32x32x16_bf16(b0,qr[d0],p0,0,0,0);p1=__builtin_amdgcn_mfma_f32_32x32x16_bf16(b1,qr[d0],p1,0,0,0);}}
}
typedef __attribute__((address_space(3))) const char* lds_cptr;
typedef short v4i16_t __attribute__((ext_vector_type(4)));
__device__ __forceinline__ void kload8(bf16x8*kf,lds_cptr kp){
  kf[0]=*(const __attribute__((address_space(3))) bf16x8*)(kp);      kf[1]=*(const __attribute__((address_space(3))) bf16x8*)(kp+512);
  kf[2]=*(const __attribute__((address_space(3))) bf16x8*)(kp+2048); kf[3]=*(const __attribute__((address_space(3))) bf16x8*)(kp+2560);
  kf[4]=*(const __attribute__((address_space(3))) bf16x8*)(kp+4096); kf[5]=*(const __attribute__((address_space(3))) bf16x8*)(kp+4608);
  kf[6]=*(const __attribute__((address_space(3))) bf16x8*)(kp+6144); kf[7]=*(const __attribute__((address_space(3))) bf16x8*)(kp+6656);
}
__device__ __forceinline__ void kload2(bf16x8*kf,lds_cptr kp,int j){ kf[2*j]=*(const __attribute__((address_space(3))) bf16x8*)(kp+j*2048); kf[2*j+1]=*(const __attribute__((address_space(3))) bf16x8*)(kp+j*2048+512); }
__device__ __forceinline__ s16x4 vtr(lds_cptr p){ return __builtin_bit_cast(s16x4,__builtin_amdgcn_ds_read_tr16_b64_v4i16((__attribute__((address_space(3))) v4i16_t*)p)); }
__device__ __forceinline__ float rowmax(const f32x16&p0,const f32x16&p1){
  float a=max3f(p0[0],p0[1],p1[0]),b=max3f(p0[2],p0[3],p1[1]);a=max3f(a,p1[2],p1[3]);
  #pragma unroll
  for(int r=4;r<16;r+=4){a=max3f(a,p0[r],p0[r+1]);b=max3f(b,p0[r+2],p0[r+3]);a=max3f(a,p1[r],p1[r+1]);b=max3f(b,p1[r+2],p1[r+3]);}
  const float m=max2f(a,b);
  auto rr=__builtin_amdgcn_permlane32_swap(__float_as_uint(m),__float_as_uint(m),false,false);
  return max2f(__uint_as_float(rr[0]),__uint_as_float(rr[1]));
}
__device__ __forceinline__ void pv(f32x16*o,int vb,bf16x8 pa0,bf16x8 pa1,bf16x8 pa2,bf16x8 pa3){
  #pragma unroll
  for(int d0=0;d0<2;++d0){s16x4 lo[4],hi[4];
    #pragma unroll
    for(int ks=0;ks<4;++ks){
      asm volatile("ds_read_b64_tr_b16 %0,%1 offset:%c2":"=&v"(lo[ks]):"v"(vb),"i"(d0*4096+ks*1024):"memory");
      asm volatile("ds_read_b64_tr_b16 %0,%1 offset:%c2":"=&v"(hi[ks]):"v"(vb),"i"(d0*4096+ks*1024+512):"memory");}
    asm volatile("s_waitcnt lgkmcnt(0)":::"memory");SBAR();
    #define PK(k) (bf16x8){lo[k][0],lo[k][1],lo[k][2],lo[k][3],hi[k][0],hi[k][1],hi[k][2],hi[k][3]}
    o[d0]=__builtin_amdgcn_mfma_f32_32x32x16_bf16(pa0,PK(0),o[d0],0,0,0);
    o[d0]=__builtin_amdgcn_mfma_f32_32x32x16_bf16(pa1,PK(1),o[d0],0,0,0);
    o[d0]=__builtin_amdgcn_mfma_f32_32x32x16_bf16(pa2,PK(2),o[d0],0,0,0);
    o[d0]=__builtin_amdgcn_mfma_f32_32x32x16_bf16(pa3,PK(3),o[d0],0,0,0);
    #undef PK
  }
}

#ifndef ATTN_STORE16
#define ATTN_STORE16(p,v) (*(u32x4*)(p)=(v))
#endif
template<int THRL,int PQ,int PK,int PV,int PO> __device__ __forceinline__ void attn_unit(int qb,const bf16*Qs,const bf16*__restrict__ Ks,const bf16*__restrict__ Vs,bf16*Os,char*shm){
  const int tid=threadIdx.x,lane=tid&63,r32=lane&31,hi=lane>>5; const int wid=__builtin_amdgcn_readfirstlane(tid>>6);
  const int q0=qb*QB;
  const bf16*Qw=Qs+(long)(q0+wid*QBLK)*PQ;
  const bf16*Kh=Ks,*Vh=Vs;
  const unsigned lds0=(unsigned)(uintptr_t)shm;
  float*wsf=(float*)(shm+LDS_WS)+wid*64;
  const bf16*ksrc=Kh+(long)lane*PK+wid*8;
  const bf16*vsrc=Vh+(long)(16*(wid&3)+(lane>>2))*PV+(wid>>2)*32+(lane&3)*8;
  const unsigned kdst=lds0+LDS_K+wid*1024, vdst=lds0+LDS_V+wid*1024;
  #define DMA_K(t,slot) glds16(ksrc+(long)(t)*KVBLK*PK,(unsigned)__builtin_amdgcn_readfirstlane(kdst+(slot)))
  #define DMA_V(t,slot) glds16(vsrc+(long)(t)*KVBLK*PV,(unsigned)__builtin_amdgcn_readfirstlane(vdst+(slot)))
  const int vb0=(int)(lds0+LDS_V)+((lane>>4)&1)*32+(lane&3)*8+(4*hi+((lane&15)>>2))*64;
  const char*Kbase=shm+LDS_K; bf16x8 kf[8];
  const lds_cptr shm3=(lds_cptr)shm; const lds_cptr kp0=shm3+LDS_K+hi*1024+r32*16; const lds_cptr vp0=shm3+LDS_V+((lane>>4)&1)*32+(lane&3)*8+(4*hi+((lane&15)>>2))*64;
  const int NT=(q0+QB)/KVBLK;
  DMA_K(0,0);DMA_V(0,0);DMA_K(1,SLOTB);
  bf16x8 qr[4];
  #pragma unroll
  for(int d0=0;d0<4;++d0)qr[d0]=*reinterpret_cast<const bf16x8*>(&Qw[(long)r32*PQ+d0*16+hi*8]);
  float mhat=0.f,l_reg=0.f;f32x16 o[2];f32x16 negm;{float z_=0.f;asm volatile("":"+v"(z_));
  _Pragma("unroll") for(int r=0;r<16;++r){o[0][r]=z_;o[1][r]=z_;negm[r]=z_;}}asm volatile("":"+v"(negm));
  const int qrel=wid*QBLK+r32;
  #define CMASK(P0,P1,t) do{int jb_=(t)-(NT-4); if(jb_>=0)cmask(P0,P1,jb_,qrel,hi);}while(0)
  bool resc=false;
  #define START(P0,P1) do{ const float rm=rowmax(P0,P1); resc=false; \
    { const float dl=rm; mhat=fadd_s(mhat,dl); \
      _Pragma("unroll") for(int r=0;r<16;++r){P0[r]=fsub_s(P0[r],dl);P1[r]=fsub_s(P1[r],dl);} \
      _Pragma("unroll") for(int r=0;r<16;++r)negm[r]=-mhat; asm volatile("":"+v"(negm)); } \
    _Pragma("unroll") for(int r=0;r<16;++r)P0[r]=__builtin_amdgcn_exp2f(P0[r]); }while(0)
  #define RESC() do{ if(resc){ asm volatile("s_waitcnt lgkmcnt(0)":::"memory"); \
      _Pragma("unroll") for(int d_=0;d_<2;++d_) _Pragma("unroll") for(int r=0;r<16;++r)o[d_][r]*=wsf[crow(r,hi)]; } }while(0)
  f32x16 pA0,pA1,pB0,pB1;
  int sl_prev=0,sl_cur=0,sl_next=SLOTB;
  #define ROT() do{sl_prev=sl_cur;sl_cur=sl_next;sl_next=(sl_next==(NSLOT-1)*SLOTB)?0:sl_next+SLOTB;}while(0)
  DMA_K(2,2*SLOTB);
  WAIT_BAR(3);
  qkt(pA0,pA1,Kbase,qr,negm,r32,hi);asm volatile("s_nop 15\n\ts_nop 7":"+v"(pA0),"+v"(pA1));CMASK(pA0,pA1,0);
  START(pA0,pA1);
  _Pragma("unroll") for(int r=0;r<16;++r)pA1[r]=__builtin_amdgcn_exp2f(pA1[r]);
  WAIT_BAR(0);
  DMA_K(3,0);DMA_V(1,SLOTB);
  ROT();
  kload8(kf,kp0+sl_cur);
  WAIT_BAR(2);
  s16x4 vlo[8],vhi[8]; u32x4 pw0,pw1,pw2,pw3;
  #define PKW(P,B) cvtpk_s(P[B],P[B+1])
  #define PAF(k) __builtin_bit_cast(bf16x8,pw##k)
  #define VFR(i) (bf16x8){vlo[i][0],vlo[i][1],vlo[i][2],vlo[i][3],vhi[i][0],vhi[i][1],vhi[i][2],vhi[i][3]}
  #define PIN(x) asm volatile("":"+v"(x))
  #define MX3(a,b,c) __builtin_fmaxf(__builtin_fmaxf((a),(b)),(c))
  #define GAPA(MF,A0,A1,A2,A3,W0,W1,PW) do{ MF; sacc+=A0; sacc+=A1; sacc+=A2; sacc+=A3; PIN(sacc); W0; W1; PIN(PW); SBAR(); }while(0)
  #define EX(v) __builtin_amdgcn_exp2f(v)
  #define GAPB(MF,X,B) do{ MF; X[B]=EX(X[B]); X[B+1]=EX(X[B+1]); X[B+2]=EX(X[B+2]); X[B+3]=EX(X[B+3]); PIN(X); SBAR(); }while(0)
  #define VRD(i) do{ vlo[i]=vtr(vp_+(((i)>>2)*4096+((i)&3)*1024)); vhi[i]=vtr(vp_+(((i)>>2)*4096+((i)&3)*1024+512)); }while(0)
  #define KRD(G,j) do{ if(G){ kload2(kf,kp0+sl_next,j); SBAR(); } }while(0)
  #define STEP(C0,C1,P0,P1,t,GK,GV,GL) do{ SBAR(); \
    const lds_cptr vp_=vp0+sl_prev; \
    VRD(0); SBAR(); float sacc=(P0[0]+P0[1]); \
    GAPA(C0=__builtin_amdgcn_mfma_f32_32x32x16_bf16(kf[0],qr[0],negm,0,0,0), P0[2],P0[3],P0[4],P0[5],     pw0[0]=PKW(P0,0), pw0[1]=PKW(P0,2), pw0); \
    VRD(4); SBAR(); GAPA(C1=__builtin_amdgcn_mfma_f32_32x32x16_bf16(kf[1],qr[0],negm,0,0,0), P0[6],P0[7],P0[8],P0[9],     pw0[2]=PKW(P0,4), pw0[3]=PKW(P0,6), pw0); \
    VRD(1); SBAR(); GAPA(C0=__builtin_amdgcn_mfma_f32_32x32x16_bf16(kf[2],qr[1],C0,0,0,0),   P0[10],P0[11],P0[12],P0[13], pw1[0]=PKW(P0,8), pw1[1]=PKW(P0,10), pw1); \
    VRD(5); SBAR(); GAPA(C1=__builtin_amdgcn_mfma_f32_32x32x16_bf16(kf[3],qr[1],C1,0,0,0),   P0[14],P0[15],P1[0],P1[1],   pw1[2]=PKW(P0,12),pw1[3]=PKW(P0,14), pw1); \
    VRD(2); SBAR(); GAPA(C0=__builtin_amdgcn_mfma_f32_32x32x16_bf16(kf[4],qr[2],C0,0,0,0),   P1[2],P1[3],P1[4],P1[5],     pw2[0]=PKW(P1,0), pw2[1]=PKW(P1,2), pw2); \
    VRD(6); SBAR(); GAPA(C1=__builtin_amdgcn_mfma_f32_32x32x16_bf16(kf[5],qr[2],C1,0,0,0),   P1[6],P1[7],P1[8],P1[9],     pw2[2]=PKW(P1,4), pw2[3]=PKW(P1,6), pw2); \
    VRD(3); SBAR(); GAPA(C0=__builtin_amdgcn_mfma_f32_32x32x16_bf16(kf[6],qr[3],C0,0,0,0),   P1[10],P1[11],P1[12],P1[13], pw3[0]=PKW(P1,8), pw3[1]=PKW(P1,10), pw3); \
    VRD(7); SBAR(); GAPA(C1=__builtin_amdgcn_mfma_f32_32x32x16_bf16(kf[7],qr[3],C1,0,0,0),   P1[14],P1[15],0.f,0.f,       pw3[2]=PKW(P1,12),pw3[3]=PKW(P1,14), pw3); \
    l_reg+=sacc; \
    if(GK){DMA_K((t)+3,sl_cur);} if(GV){DMA_V((t)+1,sl_next);} \
    CMASK(C0,C1,t); \
    { float a=MX3(C0[0],C0[1],C1[0]),b=MX3(C0[2],C0[3],C1[1]); a=MX3(a,C1[2],C1[3]); \
      _Pragma("unroll") for(int r=4;r<16;r+=4){a=MX3(a,C0[r],C0[r+1]);b=MX3(b,C0[r+2],C0[r+3]);a=MX3(a,C1[r],C1[r+1]);b=MX3(b,C1[r+2],C1[r+3]);} \
      float rm=__builtin_fmaxf(a,b); { auto rr=__builtin_amdgcn_permlane32_swap(__float_as_uint(rm),__float_as_uint(rm),false,false); rm=__builtin_fmaxf(__uint_as_float(rr[0]),__uint_as_float(rr[1])); } \
      resc=false; \
      if(__builtin_expect(__any(rm>(float)THRL),0)){ const float dl=__builtin_fmaxf(rm,0.f); mhat+=dl; \
        _Pragma("unroll") for(int r=0;r<16;++r){C0[r]-=dl;C1[r]-=dl;} \
        _Pragma("unroll") for(int r=0;r<16;++r)negm[r]=-mhat; asm volatile("":"+v"(negm)); \
        const float f=__builtin_amdgcn_exp2f(-dl); l_reg*=f; if(hi==0)wsf[r32]=f; resc=true; } } \
    SBAR(); \
    GAPB(o[0]=__builtin_amdgcn_mfma_f32_32x32x16_bf16(PAF(0),VFR(0),o[0],0,0,0), C0,0); \
    GAPB(o[1]=__builtin_amdgcn_mfma_f32_32x32x16_bf16(PAF(0),VFR(4),o[1],0,0,0), C0,4); \
    KRD(GL,0); GAPB(o[0]=__builtin_amdgcn_mfma_f32_32x32x16_bf16(PAF(1),VFR(1),o[0],0,0,0), C0,8); \
    KRD(GL,1); GAPB(o[1]=__builtin_amdgcn_mfma_f32_32x32x16_bf16(PAF(1),VFR(5),o[1],0,0,0), C0,12); \
    KRD(GL,2); GAPB(o[0]=__builtin_amdgcn_mfma_f32_32x32x16_bf16(PAF(2),VFR(2),o[0],0,0,0), C1,0); \
    KRD(GL,3); GAPB(o[1]=__builtin_amdgcn_mfma_f32_32x32x16_bf16(PAF(2),VFR(6),o[1],0,0,0), C1,4); \
    GAPB(o[0]=__builtin_amdgcn_mfma_f32_32x32x16_bf16(PAF(3),VFR(3),o[0],0,0,0), C1,8); \
    GAPB(o[1]=__builtin_amdgcn_mfma_f32_32x32x16_bf16(PAF(3),VFR(7),o[1],0,0,0), C1,12); \
    }while(0)
  int t=1;
  #undef CMASK
  #define CMASK(P0,P1,t) do{}while(0)
  for(;t+5<NT;t+=2){
    STEP(pB0,pB1,pA0,pA1,t,true,true,true);     WAIT_BAR(2); RESC(); ROT();
    STEP(pA0,pA1,pB0,pB1,t+1,true,true,true);   WAIT_BAR(2); RESC(); ROT();
  }
  #undef CMASK
  #define CMASK(P0,P1,t) do{int jb_=(t)-(NT-4); if(jb_>=0)cmask(P0,P1,jb_,qrel,hi);}while(0)
  #define ENDW(tt) do{ if((tt)+3<NT){WAIT_BAR(2);} else if((tt)+2<NT){WAIT_BAR(1);} else {WAIT_BAR(0);} }while(0)
  for(;t+1<NT;t+=2){
    STEP(pB0,pB1,pA0,pA1,t,(t+3<NT),(t+1<NT),(t+1<NT));       ENDW(t);   RESC(); ROT();
    STEP(pA0,pA1,pB0,pB1,t+1,(t+4<NT),(t+2<NT),(t+2<NT));     ENDW(t+1); RESC(); ROT();
  }
  STEP(pB0,pB1,pA0,pA1,NT-1,false,false,false); RESC();
  { float sacc=pB0[0]+pB0[1]; _Pragma("unroll") for(int r=2;r<16;++r)sacc+=pB0[r]; _Pragma("unroll") for(int r=0;r<16;++r)sacc+=pB1[r]; l_reg+=sacc;
    pw0=(u32x4){PKW(pB0,0),PKW(pB0,2),PKW(pB0,4),PKW(pB0,6)};pw1=(u32x4){PKW(pB0,8),PKW(pB0,10),PKW(pB0,12),PKW(pB0,14)};pw2=(u32x4){PKW(pB1,0),PKW(pB1,2),PKW(pB1,4),PKW(pB1,6)};pw3=(u32x4){PKW(pB1,8),PKW(pB1,10),PKW(pB1,12),PKW(pB1,14)};
    SBAR(); pv(o,vb0+sl_cur,PAF(0),PAF(1),PAF(2),PAF(3)); }
  #undef PKW
  #undef PAF
  #undef VFR
  #undef PIN
  #undef MX3
  #undef GAPA
  #undef GAPB
  #undef EX
  #undef VRD
  #undef KRD
  #undef STEP
  #undef ENDW
  {auto rr=__builtin_amdgcn_permlane32_swap(__float_as_uint(l_reg),__float_as_uint(l_reg),false,false);l_reg=__uint_as_float(rr[0])+__uint_as_float(rr[1]);}
  if(hi==0)wsf[32+r32]=l_reg;asm volatile("s_waitcnt lgkmcnt(0)":::"memory");
  float rli[16];
  #pragma unroll
  for(int r=0;r<16;++r)rli[r]=__builtin_amdgcn_rcpf(wsf[32+crow(r,hi)]);
  bf16*Ow=Os+(long)(q0+wid*QBLK)*PO;
  { bf16*stg=(bf16*)(shm+LDS_OST)+wid*2048;
    #pragma unroll
    for(int r=0;r<16;++r){const int orow=crow(r,hi);
      #pragma unroll
      for(int d0=0;d0<2;++d0)stg[orow*64+d0*32+r32]=__float2bfloat16(o[d0][r]*rli[r]);}
    asm volatile("s_waitcnt lgkmcnt(0)":::"memory");
    #pragma unroll
    for(int i=0;i<4;++i){const int row=i*8+(lane>>3),ch=lane&7; const u32x4 v=*(const u32x4*)(stg+row*64+ch*8); ATTN_STORE16(Ow+(long)row*PO+ch*8,v);} }
  asm volatile("s_waitcnt lgkmcnt(0)\n\ts_barrier":::"memory");
  #undef DMA_K
  #undef DMA_V
  #undef CMASK
  #undef START
  #undef RESC
  #undef ROT
}
constexpr int ATTN_LDS_BYTES=LDS_BYTES;
#undef SBAR
#undef WAIT_BAR
}

__device__ __forceinline__ void phase_diffattn(const Params& p, unsigned char* lds) {
    using attn64::bf16; unsigned char* ws = p.ws;
    const bf16* DQK = (const bf16*)(ws + WS_DQK); const bf16* DV = (const bf16*)(ws + WS_DV); bf16* O12 = (bf16*)p.out + (size_t)NTOK * 1024;
    const int G = gridDim.x, bx = blockIdx.x; const int vcu = (G % 8 == 0) ? (bx % 8) * (G / 8) + bx / 8 : bx;
    for (int vh = vcu; vh < 256; vh += G) {
        const int bh = vh >> 2, run = vh & 3, b = bh >> 2, h = bh & 3; const size_t row0 = (size_t)b * SEQ;
        const bf16* Qs = DQK + row0 * 1024 + (run >> 1) * 256 + h * 64; const bf16* Ks = DQK + row0 * 1024 + 512 + (run >> 1) * 256 + h * 64;
        const bf16* Vs = DV + row0 * 512 + h * 128 + (run & 1) * 64; bf16* Os = O12 + row0 * 1024 + h * 256 + run * 64;
        for (int qb = 15; qb >= 0; --qb) attn64::attn_unit<8, 1024, 1024, 512, 1024>(qb, Qs, Ks, Vs, Os, (char*)lds);
    }
}
__device__ __forceinline__ void phase_diffcombine(const Params& p, unsigned char* lds) {
    unsigned char* ws = p.ws; const bf16_t* O12 = (const bf16_t*)p.out + (size_t)NTOK * 1024; bf16_t* Y = (bf16_t*)(ws + WS_Y);
    const float lam = ((const float*)(ws + WS_SCAL))[512]; const float* sub_gain = (const float*)p.in[11];
    const int lane = threadIdx.x & 63, wave = threadIdx.x >> 6; const int gw = blockIdx.x * 8 + wave, ngw = gridDim.x * 8;
    const int h = lane >> 4, d0 = (lane & 15) * 8;
    float gn[8];
#pragma unroll
    for (int e = 0; e < 8; ++e) gn[e] = sub_gain[d0 + e] * (1.f - LAM_INIT);
    for (int t = gw; t < NTOK; t += ngw) {
        const u32x4 a = *(const u32x4*)(O12 + (size_t)t * 1024 + h * 256 + d0), b = *(const u32x4*)(O12 + (size_t)t * 1024 + h * 256 + 128 + d0);
        float o1[8], o2[8], o[8]; pg8::unpack8(a, o1); pg8::unpack8(b, o2); float sq = 0.f;
#pragma unroll
        for (int e = 0; e < 8; ++e) { o[e] = o1[e] - lam * o2[e]; sq += o[e] * o[e]; }
        sq += __shfl_xor(sq, 1); sq += __shfl_xor(sq, 2); sq += __shfl_xor(sq, 4); sq += __shfl_xor(sq, 8);
        const float rs = rsqrtf(sq * (1.f / 128.f) + RMS_EPS);
        u32x4 w; w.x = pk2(o[0] * rs * gn[0], o[1] * rs * gn[1]); w.y = pk2(o[2] * rs * gn[2], o[3] * rs * gn[3]); w.z = pk2(o[4] * rs * gn[4], o[5] * rs * gn[5]); w.w = pk2(o[6] * rs * gn[6], o[7] * rs * gn[7]);
        *(u32x4*)(Y + (size_t)t * 1536 + 512 + h * 128 + d0) = w;
    }
}

namespace hg {
constexpr int ROWQ = 272, ROWT = 144;
constexpr int L_QR = 0, L_FR = 17408, L_VR = 34816, L_VT = 52224, L_KT = 70656, L_TOT = 89088, L_SSQ = 91136;
__device__ __forceinline__ void load_tile(unsigned char* dst, const bf16_t* src, int tid) {
    const int r = tid >> 3, c = tid & 7;
    const u32x4 a = *(const u32x4*)(src + (size_t)r * 2048 + c * 8), b = *(const u32x4*)(src + (size_t)r * 2048 + 64 + c * 8);
    *(u32x4*)(dst + r * ROWQ + c * 16) = a; *(u32x4*)(dst + r * ROWQ + 128 + c * 16) = b;
}
__device__ __forceinline__ u32x4 pack8(const float* v) { u32x4 w; w.x = pk2(v[0], v[1]); w.y = pk2(v[2], v[3]); w.z = pk2(v[4], v[5]); w.w = pk2(v[6], v[7]); return w; }
__device__ __forceinline__ void gate_scan(unsigned char* lds, int k, int seg, float lbv, float (&kk)[16], float (&cs)[16], float& offset, float& total) {
    float run = 0.f;
#pragma unroll
    for (int i = 0; i < 16; ++i) { const float fp = bf2f(*(const bf16_t*)(lds + L_FR + (16 * seg + i) * ROWQ + k * 2)); const float sg = sigmoidf_(fp);
        const float f = lbv + (1.f - lbv) * sg; kk[i] = (1.f - lbv) * (1.f - sg); run += __logf(f); cs[i] = run; }
    float* tot = (float*)(lds + L_TOT); tot[seg * 128 + k] = run;
    __syncthreads();
    const float t0 = tot[k], t1 = tot[128 + k], t2 = tot[256 + k], t3 = tot[384 + k];
    offset = (seg > 0 ? t0 : 0.f) + (seg > 1 ? t1 : 0.f) + (seg > 2 ? t2 : 0.f); total = (t0 + t1) + (t2 + t3);
}
__device__ __forceinline__ void write_vt(unsigned char* lds, int k, int seg) {
    float v[16];
#pragma unroll
    for (int i = 0; i < 16; ++i) v[i] = bf2f(*(const bf16_t*)(lds + L_VR + (16 * seg + i) * ROWQ + k * 2));
    *(u32x4*)(lds + L_VT + k * ROWT + seg * 32) = pack8(v); *(u32x4*)(lds + L_VT + k * ROWT + seg * 32 + 16) = pack8(v + 8);
}
}
__device__ __forceinline__ void phase_hgrn_A(const Params& p, unsigned char* lds) {
    using namespace hg; unsigned char* ws = p.ws; const bf16_t* HG = (const bf16_t*)(ws + WS_HG); const float* lower0 = (const float*)(ws + WS_SCAL);
    bf16_t* US = (bf16_t*)p.out; float* DEC = (float*)(ws + WS_DEC);
    const int tid = threadIdx.x, lane = tid & 63, w = tid >> 6, fr = lane & 15, fq = lane >> 4, k = tid & 127, seg = tid >> 7;
    for (int item = blockIdx.x; item < 4096; item += gridDim.x) {
        const int bh = item >> 6, c = item & 63, b = bh >> 2, h = bh & 3; const bf16_t* row0 = HG + ((size_t)b * SEQ + c * 64) * 2048 + h * 128;
        load_tile(lds + L_FR, row0 + 512, tid); load_tile(lds + L_VR, row0 + 1024, tid);
        __syncthreads();
        float kk[16], cs[16], offset, total; const float lbv = lower0[h * 128 + k];
        write_vt(lds, k, seg);
        gate_scan(lds, k, seg, lbv, kk, cs, offset, total);
        { float ke[16];
#pragma unroll
          for (int i = 0; i < 16; ++i) ke[i] = kk[i] * __expf(total - (offset + cs[i]));
          *(u32x4*)(lds + L_KT + k * ROWT + seg * 32) = pack8(ke); *(u32x4*)(lds + L_KT + k * ROWT + seg * 32 + 16) = pack8(ke + 8);
          if (seg == 0) DEC[(size_t)item * 128 + k] = __expf(total); }
        __syncthreads();
        const bf16x8 a0 = *(const bf16x8*)(lds + L_KT + (16 * w + fr) * ROWT + fq * 16), a1 = *(const bf16x8*)(lds + L_KT + (16 * w + fr) * ROWT + 64 + fq * 16);
        unsigned char* uT = lds + L_FR;
#pragma unroll
        for (int j = 0; j < 8; ++j) {
            const bf16x8 b0 = *(const bf16x8*)(lds + L_VT + (16 * j + fr) * ROWT + fq * 16), b1 = *(const bf16x8*)(lds + L_VT + (16 * j + fr) * ROWT + 64 + fq * 16);
            f32x4 acc = {0.f, 0.f, 0.f, 0.f};
            acc = __builtin_amdgcn_mfma_f32_16x16x32_bf16(a0, b0, acc, 0, 0, 0); acc = __builtin_amdgcn_mfma_f32_16x16x32_bf16(a1, b1, acc, 0, 0, 0);
            u32x2 o; o.x = pk2(acc[0], acc[1]); o.y = pk2(acc[2], acc[3]);
            *(u32x2*)(uT + (16 * j + fr) * ROWQ + (16 * w + 4 * fq) * 2) = o; }
        __syncthreads();
        bf16_t* dst = US + (size_t)item * 16384;
#pragma unroll
        for (int i = 0; i < 4; ++i) { const int ch = tid + 512 * i, v = ch >> 4, kc = ch & 15; *(u32x4*)(dst + v * 128 + kc * 8) = *(const u32x4*)(uT + v * ROWQ + kc * 16); }
        __syncthreads();
    }
}
__device__ __forceinline__ void phase_hgrn_B(const Params& p, unsigned char* lds) {
    unsigned char* ws = p.ws; bf16_t* US = (bf16_t*)p.out; const float* DEC = (const float*)(ws + WS_DEC);
    const size_t gt = (size_t)blockIdx.x * 512 + threadIdx.x, ngt = (size_t)gridDim.x * 512;
    for (size_t e = gt; e < (size_t)64 * 128 * 16; e += ngt) {
        const int kc = (int)(e & 15), v = (int)((e >> 4) & 127), bh = (int)(e >> 11);
        bf16_t* pu = US + (size_t)bh * 64 * 16384 + v * 128 + kc * 8; const float* pd = DEC + (size_t)bh * 64 * 128 + kc * 8;
        float S[8];
#pragma unroll
        for (int i = 0; i < 8; ++i) S[i] = 0.f;
#pragma unroll 4
        for (int c = 0; c < 64; ++c) {
            const u32x4 uw = *(const u32x4*)(pu + (size_t)c * 16384); const f32x4 d0 = *(const f32x4*)(pd + c * 128), d1 = *(const f32x4*)(pd + c * 128 + 4);
            float u[8]; pg8::unpack8(uw, u);
            *(u32x4*)(pu + (size_t)c * 16384) = hg::pack8(S);
            S[0] = d0[0] * S[0] + u[0]; S[1] = d0[1] * S[1] + u[1]; S[2] = d0[2] * S[2] + u[2]; S[3] = d0[3] * S[3] + u[3];
            S[4] = d1[0] * S[4] + u[4]; S[5] = d1[1] * S[5] + u[5]; S[6] = d1[2] * S[6] + u[6]; S[7] = d1[3] * S[7] + u[7];
        }
    }
}
__device__ __forceinline__ void phase_hgrn_C(const Params& p, unsigned char* lds) {
    using namespace hg; unsigned char* ws = p.ws; const bf16_t* HG = (const bf16_t*)(ws + WS_HG); const float* lower0 = (const float*)(ws + WS_SCAL);
    const bf16_t* US = (const bf16_t*)p.out; bf16_t* Y = (bf16_t*)(ws + WS_Y); const float* gain = (const float*)p.in[6];
    const int tid = threadIdx.x, lane = tid & 63, w = tid >> 6, fr = lane & 15, fq = lane >> 4, k = tid & 127, seg = tid >> 7;
    for (int item = blockIdx.x; item < 4096; item += gridDim.x) {
        const int bh = item >> 6, c = item & 63, b = bh >> 2, h = bh & 3; const size_t m0 = (size_t)b * SEQ + c * 64; const bf16_t* row0 = HG + m0 * 2048 + h * 128;
        bf16x8 bS[4];
        { const bf16_t* sp = US + (size_t)item * 16384 + (16 * w + fr) * 128 + fq * 8;
#pragma unroll
          for (int ks = 0; ks < 4; ++ks) bS[ks] = *(const bf16x8*)(sp + ks * 32); }
        load_tile(lds + L_QR, row0, tid); load_tile(lds + L_FR, row0 + 512, tid); load_tile(lds + L_VR, row0 + 1024, tid);
        __syncthreads();
        float kk[16], cs[16], offset, total; const float lbv = lower0[h * 128 + k];
        write_vt(lds, k, seg);
        gate_scan(lds, k, seg, lbv, kk, cs, offset, total);
#pragma unroll
        for (int i = 0; i < 16; ++i) { const float cum = offset + cs[i]; bf16_t* pq = (bf16_t*)(lds + L_QR + (16 * seg + i) * ROWQ + k * 2); bf16_t* pf = (bf16_t*)(lds + L_FR + (16 * seg + i) * ROWQ + k * 2);
            *pq = f2bf(bf2f(*pq) * __expf(cum)); *pf = f2bf(kk[i] * __expf(-cum)); }
        __syncthreads();
        { const int si = w >> 1; bf16x8 a[4];
#pragma unroll
          for (int ks = 0; ks < 4; ++ks) a[ks] = *(const bf16x8*)(lds + L_FR + (16 * si + fr) * ROWQ + ks * 64 + fq * 16);
#pragma unroll
          for (int jj = 0; jj < 2; ++jj) { const int tj = 2 * (w & 1) + jj; f32x4 acc = {0.f, 0.f, 0.f, 0.f};
#pragma unroll
              for (int ks = 0; ks < 4; ++ks) { const bf16x8 bq = *(const bf16x8*)(lds + L_QR + (16 * tj + fr) * ROWQ + ks * 64 + fq * 16); acc = __builtin_amdgcn_mfma_f32_16x16x32_bf16(a[ks], bq, acc, 0, 0, 0); }
              const int t = 16 * tj + fr, s0 = 16 * si + 4 * fq;
              u32x2 o; o.x = pk2(s0 <= t ? acc[0] : 0.f, s0 + 1 <= t ? acc[1] : 0.f); o.y = pk2(s0 + 2 <= t ? acc[2] : 0.f, s0 + 3 <= t ? acc[3] : 0.f);
              *(u32x2*)(lds + L_KT + t * ROWT + s0 * 2) = o; } }
        __syncthreads();
        f32x4 acc[4];
        { const bf16x8 bV0 = *(const bf16x8*)(lds + L_VT + (16 * w + fr) * ROWT + fq * 16), bV1 = *(const bf16x8*)(lds + L_VT + (16 * w + fr) * ROWT + 64 + fq * 16);
#pragma unroll
          for (int tj = 0; tj < 4; ++tj) { f32x4 ac = {0.f, 0.f, 0.f, 0.f};
#pragma unroll
              for (int ks = 0; ks < 4; ++ks) { const bf16x8 aq = *(const bf16x8*)(lds + L_QR + (16 * tj + fr) * ROWQ + ks * 64 + fq * 16); ac = __builtin_amdgcn_mfma_f32_16x16x32_bf16(aq, bS[ks], ac, 0, 0, 0); }
              const bf16x8 ap0 = *(const bf16x8*)(lds + L_KT + (16 * tj + fr) * ROWT + fq * 16), ap1 = *(const bf16x8*)(lds + L_KT + (16 * tj + fr) * ROWT + 64 + fq * 16);
              ac = __builtin_amdgcn_mfma_f32_16x16x32_bf16(ap0, bV0, ac, 0, 0, 0); ac = __builtin_amdgcn_mfma_f32_16x16x32_bf16(ap1, bV1, ac, 0, 0, 0);
              acc[tj] = ac; } }
        float* ssq = (float*)(lds + L_SSQ);
#pragma unroll
        for (int tj = 0; tj < 4; ++tj)
#pragma unroll
            for (int r = 0; r < 4; ++r) { float sq = acc[tj][r] * acc[tj][r]; sq += __shfl_xor(sq, 1); sq += __shfl_xor(sq, 2); sq += __shfl_xor(sq, 4); sq += __shfl_xor(sq, 8);
                if (fr == 0) ssq[w * 64 + 16 * tj + 4 * fq + r] = sq; }
        __syncthreads();
        const float gn = gain[h * 128 + 16 * w + fr];
#pragma unroll
        for (int tj = 0; tj < 4; ++tj)
#pragma unroll
            for (int r = 0; r < 4; ++r) { const int t = 16 * tj + 4 * fq + r; float tot = 0.f;
#pragma unroll
                for (int ww = 0; ww < 8; ++ww) tot += ssq[ww * 64 + t];
                const float gate = bf2f(row0[(size_t)t * 2048 + 1536 + 16 * w + fr]);
                Y[(m0 + t) * 1536 + h * 128 + 16 * w + fr] = f2bf(acc[tj][r] * rsqrtf(tot * (1.f / 128.f) + RMS_EPS) * gn * gate); }
        __syncthreads();
    }
}

template <bool COOP> __device__ __forceinline__ void cg_or_nothing() { if (COOP) cg::this_grid().sync(); }
template <bool COOP>
__global__ void __launch_bounds__(512, 2) k_fwd(Params p) {
    extern __shared__ __attribute__((aligned(16))) unsigned char lds[];
    const int lo = p.ph_lo, hi = p.ph_hi;
#define RUN_PHASE(k, call) do { if (((PHASE_MASK >> (k)) & 1) && lo <= (k) && (k) < hi) { call; if (COOP && (k) + 1 < hi) { cg::this_grid().sync(); } } } while (0)
    RUN_PHASE(0, phase_prologue(p, lds));
    RUN_PHASE(1, ((USE_PG8 & 1) ? phase_proj_pg8(p, lds) : (phase_proj(p, lds), cg_or_nothing<COOP>(), phase_rope(p, lds))));
    RUN_PHASE(2, (((USE_OPT & 2) ? phase_hgrn_A(p, lds) : phase_hgrn_naive(p, lds)), __syncthreads(), (USE_OPT & 1) ? phase_diffattn(p, lds) : phase_attn_naive<true>(p, lds), __syncthreads(), phase_attn_naive<false>(p, lds)));
    RUN_PHASE(3, (((USE_OPT & 2) ? phase_hgrn_B(p, lds) : (void)0), __syncthreads(), (USE_OPT & 1) ? phase_diffcombine(p, lds) : (void)0));
    RUN_PHASE(4, ((USE_OPT & 2) ? phase_hgrn_C(p, lds) : (void)0));
    RUN_PHASE(5, ((USE_PG8 & 2) ? phase_merge_pg8(p, lds) : phase_merge(p, lds)));
    RUN_PHASE(6, ((USE_PG8 & 4) ? phase_wout_pg8(p, lds) : phase_wout(p, lds)));
    RUN_PHASE(7, phase_ln1_route(p, lds));
    RUN_PHASE(8, phase_dispatch(p, lds));
    RUN_PHASE(9, ((USE_PG8 & 8) ? phase_exp_gu_pg8(p, lds) : phase_exp_gu(p, lds)));
    RUN_PHASE(10, ((USE_PG8 & 16) ? phase_exp_dn_pg8(p, lds) : phase_exp_dn(p, lds)));
    RUN_PHASE(11, phase_final(p, lds));
#undef RUN_PHASE
}

extern "C" void kernel_launch(void* const* d_in, const int* in_sizes, int n_in, void* d_out, int out_size, void* d_ws, size_t ws_size, hipStream_t stream) {
    static int grid = 0;
    if (grid == 0) {
        if (n_in != 26 || in_sizes[0] != NTOK * DM || out_size != NTOK * DM || ws_size < WS_END) {
            fprintf(stderr, "kernel_launch: unexpected shapes: n_in %d in0 %d out %d ws %zu (need >= %zu)\n", n_in, n_in > 0 ? in_sizes[0] : -1, out_size, ws_size, (size_t)WS_END); grid = -1; return; }
        int dev = 0, cus = 0, per_cu = 0;
        hipGetDevice(&dev); hipDeviceGetAttribute(&cus, hipDeviceAttributeMultiprocessorCount, dev);
        if (MK_ONE_LAUNCH) {
            hipFuncSetAttribute((const void*)k_fwd<true>, hipFuncAttributeMaxDynamicSharedMemorySize, LDS_BYTES);
            hipOccupancyMaxActiveBlocksPerMultiprocessor(&per_cu, (const void*)k_fwd<true>, 512, LDS_BYTES);
            if (per_cu < 1) { fprintf(stderr, "kernel_launch: occupancy query says %d blocks/CU\n", per_cu); per_cu = 1; }
            grid = cus * 1;
        } else {
            hipFuncSetAttribute((const void*)k_fwd<false>, hipFuncAttributeMaxDynamicSharedMemorySize, LDS_BYTES);
            grid = cus;
        }
        (void)hipGetLastError();
    }
    if (grid < 0) return;
    Params p{};
    for (int i = 0; i < 26; ++i) p.in[i] = d_in[i];
    p.out = (float*)d_out; p.ws = (unsigned char*)d_ws;
    if (MK_ONE_LAUNCH) {
        p.ph_lo = 0; p.ph_hi = NPHASE;
        void* args[] = {&p};
        hipError_t e = hipLaunchCooperativeKernel((const void*)k_fwd<true>, dim3(grid), dim3(512), args, LDS_BYTES, stream);
        if (e != hipSuccess) fprintf(stderr, "cooperative launch failed: %s (grid %d)\n", hipGetErrorString(e), grid);
    } else {
        for (int ph = 0; ph < NPHASE; ++ph) { p.ph_lo = ph; p.ph_hi = ph + 1; hipLaunchKernelGGL(k_fwd<false>, dim3(grid), dim3(512), LDS_BYTES, stream, p); }
    }
}
```

```cpp
#include <hip/hip_runtime.h>
#include <hip/hip_cooperative_groups.h>
#include <cstdio>
#include <cstdint>
namespace cg = cooperative_groups;

#ifndef PHASE_MASK
#define PHASE_MASK 0xffff
#endif
#ifndef USE_PG8
#define USE_PG8 0x1f
#endif
#ifndef USE_OPT
#define USE_OPT 0x7
#endif
#ifndef MK_ONE_LAUNCH
#define MK_ONE_LAUNCH 1
#endif

typedef unsigned short bf16_t;
typedef short bf16x8 __attribute__((ext_vector_type(8)));
typedef float f32x4 __attribute__((ext_vector_type(4)));
typedef unsigned u32x4 __attribute__((ext_vector_type(4)));
typedef unsigned u32x2 __attribute__((ext_vector_type(2)));

constexpr int NTOK = 65536, DM = 1024, SEQ = 4096, NBATCH = 16, NMEM = 256, NEXP = 32;
constexpr int NSLOT = 2 * NTOK + NEXP * 256;
constexpr float ALPHA = 1.189207115002721f;
constexpr float LN_EPS = 1e-5f, RMS_EPS = 1e-6f;
constexpr float LOG2E = 1.4426950408889634f;
constexpr float QSCALE_DF = 0.125f * LOG2E;
constexpr float QSCALE_MEM = 0.08838834764831845f * LOG2E;
constexpr float LAM_INIT = 0.2f;
constexpr int NPHASE = 12;

constexpr size_t MiB = (size_t)1 << 20;
constexpr size_t WS_CTL = 0;
constexpr size_t WS_SCAL = 1 * MiB;
constexpr size_t WS_ROPE = 2 * MiB;
constexpr size_t WS_RECI = 6 * MiB;
constexpr size_t WS_RECW = 7 * MiB;
constexpr size_t WS_WT_IN = 8 * MiB;
constexpr size_t WS_WT_G = 16 * MiB;
constexpr size_t WS_WT_MKV = 22 * MiB;
constexpr size_t WS_WT_B = 24 * MiB;
constexpr size_t WS_WT_OUT = 27 * MiB;
constexpr size_t WS_WT_R = 29 * MiB;
constexpr size_t WS_WT_GU = 30 * MiB;
constexpr size_t WS_WT_DN = 94 * MiB;
constexpr size_t WS_MEMB = 126 * MiB;
constexpr size_t WS_MKV = 134 * MiB;
constexpr size_t WS_DEC = 142 * MiB;
constexpr size_t WS_LOGITS = 144 * MiB;
constexpr size_t WS_HG = 176 * MiB;
constexpr size_t WS_DQK = 432 * MiB;
constexpr size_t WS_DV = 560 * MiB;
constexpr size_t WS_MQ = 624 * MiB;
constexpr size_t WS_XB = 688 * MiB;
constexpr size_t WS_Y = 816 * MiB;
constexpr size_t WS_END = 1008 * MiB;
constexpr size_t WS_MERGED = WS_HG;
constexpr size_t WS_X1B = WS_DV;
constexpr size_t WS_XS = WS_HG;
constexpr size_t WS_H = 448 * MiB;
constexpr size_t WS_YB = 584 * MiB;
constexpr int LDS_BYTES = 147456;

struct Params { const void* in[26]; float* out; unsigned char* ws; int ph_lo, ph_hi; };

__device__ __forceinline__ float bf2f(bf16_t v) { return __uint_as_float(((unsigned)v) << 16); }
__device__ __forceinline__ bf16_t f2bf(float f) { unsigned u = __float_as_uint(f); u += 0x7fffu + ((u >> 16) & 1u); return (bf16_t)(u >> 16); }
__device__ __forceinline__ unsigned pk2(float lo, float hi) { return (unsigned)f2bf(lo) | ((unsigned)f2bf(hi) << 16); }
__device__ __forceinline__ float sigmoidf_(float x) { return __builtin_amdgcn_rcpf(1.f + __expf(-x)); }
__device__ __forceinline__ float siluf_(float x) { return x * __builtin_amdgcn_rcpf(1.f + __expf(-x)); }
__device__ __forceinline__ float wave_sum(float v) {
#pragma unroll
    for (int o = 1; o < 64; o <<= 1) v += __shfl_xor(v, o);
    return v;
}
__device__ __forceinline__ float wave_max(float v) {
#pragma unroll
    for (int o = 1; o < 64; o <<= 1) v = fmaxf(v, __shfl_xor(v, o));
    return v;
}
#define LDS_WAIT() asm volatile("s_waitcnt lgkmcnt(0)" ::: "memory")

__device__ __forceinline__ void tr_item(const float* W, int K, int N, bf16_t* WT, int dst_row0, float* scr, int k0, int n0, int lane) {
#pragma unroll 8
    for (int i = 0; i < 32; ++i) { const int kk = 2 * i + (lane >> 5); scr[kk * 33 + (lane & 31)] = W[(size_t)(k0 + kk) * N + n0 + (lane & 31)]; }
    LDS_WAIT();
    const int c = lane & 7;
#pragma unroll
    for (int j = 0; j < 4; ++j) { const int n = (lane >> 3) + 8 * j; const float* s = scr + (8 * c) * 33 + n;
        u32x4 o; o.x = pk2(s[0 * 33], s[1 * 33]); o.y = pk2(s[2 * 33], s[3 * 33]); o.z = pk2(s[4 * 33], s[5 * 33]); o.w = pk2(s[6 * 33], s[7 * 33]);
        *(u32x4*)(WT + (size_t)(dst_row0 + n) * K + k0 + 8 * c) = o; }
    LDS_WAIT();
}
__device__ __forceinline__ void tr_job(const float* W, int K, int N, int ne, bf16_t* WT, int erow, int blk, int blkstride, int base, float* scr, int gw, int ngw, int lane) {
    const int nkb = K / 64, nnb = N / 32, per = nkb * nnb, total = per * ne;
    for (int it = gw; it < total; it += ngw) {
        const int e = it / per, r = it % per, kb = r / nnb, nb = r % nnb, n0 = nb * 32;
        tr_item(W + (size_t)e * K * N, K, N, WT, base + e * erow + (n0 / blk) * blkstride + (n0 % blk), scr, kb * 64, n0, lane);
    }
}
__device__ __forceinline__ void sincos_acc(float ang, float& c, float& s) {
    const double a = (double)ang;
    const double q = rint(a * 0.63661977236758134308);
    const double r = fma(-q, 1.57079632679489661923, a) - q * 6.12323399573676603587e-17;
    const double r2 = r * r;
    double sp = 1.0 / 6227020800.0; sp = fma(sp, r2, -1.0 / 39916800.0); sp = fma(sp, r2, 1.0 / 362880.0); sp = fma(sp, r2, -1.0 / 5040.0);
    sp = fma(sp, r2, 1.0 / 120.0); sp = fma(sp, r2, -1.0 / 6.0); sp = fma(sp, r2, 1.0); const double sr = sp * r;
    double cp = 1.0 / 479001600.0; cp = fma(cp, r2, -1.0 / 3628800.0); cp = fma(cp, r2, 1.0 / 40320.0); cp = fma(cp, r2, -1.0 / 720.0);
    cp = fma(cp, r2, 1.0 / 24.0); cp = fma(cp, r2, -0.5); const double cr = fma(cp, r2, 1.0);
    const int qi = ((int)q) & 3;
    const double cc = (qi == 0) ? cr : (qi == 1) ? -sr : (qi == 2) ? -cr : sr;
    const double ss = (qi == 0) ? sr : (qi == 1) ? cr : (qi == 2) ? -sr : -cr;
    c = (float)cc; s = (float)ss;
}
__device__ __forceinline__ void phase_prologue(const Params& p, unsigned char* lds) {
    const int tid = threadIdx.x, lane = tid & 63, wave = tid >> 6;
    const int gw = blockIdx.x * 8 + wave, ngw = gridDim.x * 8;
    const size_t gt = (size_t)blockIdx.x * 512 + tid, ngt = (size_t)gridDim.x * 512;
    unsigned char* ws = p.ws;
    float* scr = (float*)lds + wave * (64 * 33);
    tr_job((const float*)p.in[3], 1024, 4096, 1, (bf16_t*)(ws + WS_WT_IN), 0, 4096, 0, 0, scr, gw, ngw, lane);
    tr_job((const float*)p.in[4], 1024, 3072, 1, (bf16_t*)(ws + WS_WT_G), 0, 3072, 0, 0, scr, gw, ngw, lane);
    tr_job((const float*)p.in[12], 1024, 1024, 1, (bf16_t*)(ws + WS_WT_MKV), 0, 1024, 0, 0, scr, gw, ngw, lane);
    tr_job((const float*)p.in[13], 512, 1024, 1, (bf16_t*)(ws + WS_WT_B), 0, 1024, 0, 0, scr, gw, ngw, lane);
    tr_job((const float*)p.in[14], 512, 1024, 1, (bf16_t*)(ws + WS_WT_B), 0, 1024, 0, 1024, scr, gw, ngw, lane);
    tr_job((const float*)p.in[15], 512, 1024, 1, (bf16_t*)(ws + WS_WT_B), 0, 1024, 0, 2048, scr, gw, ngw, lane);
    tr_job((const float*)p.in[16], 1024, 1024, 1, (bf16_t*)(ws + WS_WT_OUT), 0, 1024, 0, 0, scr, gw, ngw, lane);
    tr_job((const float*)p.in[21], 1024, 512, 32, (bf16_t*)(ws + WS_WT_GU), 1024, 128, 256, 0, scr, gw, ngw, lane);
    tr_job((const float*)p.in[22], 1024, 512, 32, (bf16_t*)(ws + WS_WT_GU), 1024, 128, 256, 128, scr, gw, ngw, lane);
    tr_job((const float*)p.in[23], 512, 1024, 32, (bf16_t*)(ws + WS_WT_DN), 1024, 1024, 0, 0, scr, gw, ngw, lane);
    { const float* wg = (const float*)p.in[19]; const float* we = (const float*)p.in[20]; bf16_t* wr = (bf16_t*)(ws + WS_WT_R);
      for (size_t i = gt; i < 256 * 1024; i += ngt) { const int r = (int)(i >> 10), k = (int)(i & 1023);
          const float v = r < 4 ? wg[k * 4 + r] : (r < 36 ? we[k * 32 + (r - 4)] : 0.f); wr[i] = f2bf(v); } }
    { const float* x = (const float*)p.in[0]; bf16_t* xb = (bf16_t*)(ws + WS_XB);
      for (size_t i = gt; i < (size_t)NTOK * DM / 8; i += ngt) { const f32x4 a = *(const f32x4*)(x + i * 8), b = *(const f32x4*)(x + i * 8 + 4);
          u32x4 o; o.x = pk2(a.x, a.y); o.y = pk2(a.z, a.w); o.z = pk2(b.x, b.y); o.w = pk2(b.z, b.w); *(u32x4*)(xb + i * 8) = o; }
      const float* mm = (const float*)p.in[1]; bf16_t* mb = (bf16_t*)(ws + WS_MEMB);
      for (size_t i = gt; i < (size_t)NBATCH * NMEM * DM / 8; i += ngt) { const f32x4 a = *(const f32x4*)(mm + i * 8), b = *(const f32x4*)(mm + i * 8 + 4);
          u32x4 o; o.x = pk2(a.x, a.y); o.y = pk2(a.z, a.w); o.z = pk2(b.x, b.y); o.w = pk2(b.z, b.w); *(u32x4*)(mb + i * 8) = o; } }
    { const int* pos = (const int*)p.in[2]; float* rope = (float*)(ws + WS_ROPE);
      for (size_t i = gt; i < (size_t)NTOK * 8; i += ngt) { const int tk = (int)(i >> 3), fi = (int)(i & 7);
          const float invf = fi == 0 ? 1.0f : fi == 1 ? 0.1939227432012558f : fi == 2 ? 0.03760603070259094f : fi == 3 ? 0.007292664609849453f : fi == 4 ? 0.0014142135623842478f
                           : fi == 5 ? 0.00027424818836152554f : fi == 6 ? 5.3182957344688475e-05f : 1.0313385246263351e-05f;
          const float ang = (float)pos[tk] * invf; float c, s; sincos_acc(ang, c, s); rope[i * 2] = c; rope[i * 2 + 1] = s; } }
    if (blockIdx.x == 0) {
        float* sc = (float*)(ws + WS_SCAL); const float* lbs = (const float*)p.in[5];
        { const float a = lbs[tid], b = lbs[512 + tid]; sc[tid] = 1.f / (1.f + expf(b - a)); }
        if (wave == 0) {
            const float* q1 = (const float*)p.in[7]; const float* k1 = (const float*)p.in[8]; const float* q2 = (const float*)p.in[9]; const float* k2 = (const float*)p.in[10];
            const float s1 = wave_sum(q1[lane] * k1[lane]), s2 = wave_sum(q2[lane] * k2[lane]);
            if (lane == 0) sc[512] = expf(s1) - expf(s2) + LAM_INIT;
        }
        if (tid < 64) ((int*)(ws + WS_CTL))[tid] = 0;
    }
}

struct SgCtx { int t, wr, wc, fr, fq; unsigned char* sA; unsigned char* sB; };
__device__ __forceinline__ SgCtx sg_ctx(unsigned char* lds) {
    SgCtx c; const int tid = threadIdx.x; c.t = tid & 255; const int team = tid >> 8; const int wid = c.t >> 6, lane = c.t & 63;
    c.wr = wid >> 1; c.wc = wid & 1; c.fr = lane & 15; c.fq = lane >> 4; c.sA = lds + team * 16384; c.sB = c.sA + 8192; return c;
}
__device__ __forceinline__ void sg_zero(f32x4 (&acc)[4][2]) {
#pragma unroll
    for (int m = 0; m < 4; ++m)
#pragma unroll
        for (int n = 0; n < 2; ++n) acc[m][n] = (f32x4){0.f, 0.f, 0.f, 0.f};
}
__device__ __forceinline__ void sg_tile(f32x4 (&acc)[4][2], const bf16_t* a0, const bf16_t* a1, const bf16_t* b0, int K, const SgCtx& c) {
    const int bo = c.t * 16;
#pragma unroll 1
    for (int kt = 0; kt < K; kt += 32) {
        const bf16x8 va0 = *(const bf16x8*)(a0 + kt), va1 = *(const bf16x8*)(a1 + kt), vb0 = *(const bf16x8*)(b0 + kt);
        *(bf16x8*)(c.sA + bo) = va0; *(bf16x8*)(c.sA + bo + 4096) = va1; *(bf16x8*)(c.sB + bo) = vb0;
        __syncthreads();
        bf16x8 At[4], Bt[2];
#pragma unroll
        for (int m = 0; m < 4; ++m) At[m] = *(const bf16x8*)(c.sA + (c.wr * 64 + m * 16 + c.fr) * 64 + c.fq * 16);
#pragma unroll
        for (int n = 0; n < 2; ++n) Bt[n] = *(const bf16x8*)(c.sB + (c.wc * 32 + n * 16 + c.fr) * 64 + c.fq * 16);
#pragma unroll
        for (int m = 0; m < 4; ++m)
#pragma unroll
            for (int n = 0; n < 2; ++n) acc[m][n] = __builtin_amdgcn_mfma_f32_16x16x32_bf16(At[m], Bt[n], acc[m][n], 0, 0, 0);
        __syncthreads();
    }
}
#define SG_R0(c) ((c).t >> 2)
#define SG_C0(c) (((c).t & 3) * 8)
template <class F> __device__ __forceinline__ void sg_store_bf16(const f32x4 (&acc)[4][2], bf16_t* dst, size_t ld, const SgCtx& c, F f) {
    bf16_t* base = dst + (size_t)(c.wr * 64 + c.fq * 4) * ld + c.wc * 32 + c.fr;
#pragma unroll
    for (int m = 0; m < 4; ++m)
#pragma unroll
        for (int j = 0; j < 4; ++j) { bf16_t* pr = base + (size_t)(m * 16 + j) * ld;
#pragma unroll
            for (int n = 0; n < 2; ++n) pr[n * 16] = f2bf(f(acc[m][n][j], c.wc * 32 + n * 16));
            asm volatile("" ::: "memory"); }
}
struct FIdent { __device__ __forceinline__ float operator()(float v, int) const { return v; } };
struct FSilu { __device__ __forceinline__ float operator()(float v, int) const { return siluf_(v); } };
struct FQScale { __device__ __forceinline__ float operator()(float v, int d0) const { return d0 >= 16 ? v * QSCALE_DF : v; } };

__device__ __forceinline__ void phase_proj(const Params& p, unsigned char* lds) {
    const SgCtx c = sg_ctx(lds); const int team = threadIdx.x >> 8; unsigned char* ws = p.ws;
    const bf16_t* XB = (const bf16_t*)(ws + WS_XB); const bf16_t* WT = (const bf16_t*)(ws + WS_WT_IN);
    bf16_t* HG = (bf16_t*)(ws + WS_HG); bf16_t* DQK = (bf16_t*)(ws + WS_DQK); bf16_t* DV = (bf16_t*)(ws + WS_DV); bf16_t* MQ = (bf16_t*)(ws + WS_MQ);
    const int r0 = SG_R0(c), c0 = SG_C0(c);
    { const int ntiles = 512 * 64;
      for (int tb = 2 * blockIdx.x; tb < ntiles; tb += 2 * gridDim.x) {
        const int tile = tb + team; const int tm = tile >> 6, tn = tile & 63;
        f32x4 acc[4][2]; sg_zero(acc);
        sg_tile(acc, XB + (size_t)(tm * 128 + r0) * 1024 + c0, XB + (size_t)(tm * 128 + r0 + 64) * 1024 + c0, WT + (size_t)(tn * 64 + r0) * 1024 + c0, 1024, c);
        const size_t mrow = (size_t)tm * 128; const int n0 = tn * 64;
        if (n0 < 2048) { const int g = n0 >> 9; bf16_t* d = HG + mrow * 2048 + n0; if (g == 0 || g == 3) sg_store_bf16(acc, d, 2048, c, FSilu()); else sg_store_bf16(acc, d, 2048, c, FIdent()); }
        else if (n0 < 3072) { bf16_t* d = DQK + mrow * 1024 + (n0 - 2048); if (n0 < 2560) sg_store_bf16(acc, d, 1024, c, FQScale()); else sg_store_bf16(acc, d, 1024, c, FIdent()); }
        else if (n0 < 3584) sg_store_bf16(acc, DV + mrow * 512 + (n0 - 3072), 512, c, FIdent());
        else sg_store_bf16(acc, MQ + mrow * 512 + (n0 - 3584), 512, c, FIdent());
      } }
    { const bf16_t* MB = (const bf16_t*)(ws + WS_MEMB); const bf16_t* WK = (const bf16_t*)(ws + WS_WT_MKV); bf16_t* MKV = (bf16_t*)(ws + WS_MKV);
      const int ntiles = 32 * 16;
      for (int tb = 2 * blockIdx.x; tb < ntiles; tb += 2 * gridDim.x) {
        const int tile = tb + team; const int tm = tile >> 4, tn = tile & 15;
        f32x4 acc[4][2]; sg_zero(acc);
        sg_tile(acc, MB + (size_t)(tm * 128 + r0) * 1024 + c0, MB + (size_t)(tm * 128 + r0 + 64) * 1024 + c0, WK + (size_t)(tn * 64 + r0) * 1024 + c0, 1024, c);
        sg_store_bf16(acc, MKV + (size_t)tm * 128 * 1024 + tn * 64, 1024, c, FIdent());
      } }
}
__device__ __forceinline__ void phase_rope(const Params& p, unsigned char* lds) {
    unsigned char* ws = p.ws; bf16_t* DQK = (bf16_t*)(ws + WS_DQK); const float* rope = (const float*)(ws + WS_ROPE);
    const size_t gt = (size_t)blockIdx.x * 512 + threadIdx.x, ngt = (size_t)gridDim.x * 512;
    for (size_t i = gt; i < (size_t)NTOK * 128; i += ngt) {
        const size_t m = i >> 7; const int rem = (int)(i & 127), gh = rem >> 3, fi = rem & 7;
        bf16_t* q = DQK + m * 1024 + gh * 64;
        const float t1 = bf2f(q[fi]), t2 = bf2f(q[8 + fi]); const float cs = rope[(m * 8 + fi) * 2], sn = rope[(m * 8 + fi) * 2 + 1];
        float o1 = t1 * cs - t2 * sn, o2 = t2 * cs + t1 * sn;
        if (gh < 8) { o1 *= QSCALE_DF; o2 *= QSCALE_DF; }
        q[fi] = f2bf(o1); q[8 + fi] = f2bf(o2);
    }
}
__device__ __forceinline__ void phase_hgrn_naive(const Params& p, unsigned char* lds) {
    unsigned char* ws = p.ws; const bf16_t* HG = (const bf16_t*)(ws + WS_HG); bf16_t* Y = (bf16_t*)(ws + WS_Y);
    const float* lower0 = (const float*)(ws + WS_SCAL); const float* gain = (const float*)p.in[6];
    float* fs = (float*)lds; float* ks = fs + 128; float* qs = ks + 128; float* part = qs + 128; float* red = part + 512;
    const int tid = threadIdx.x, v = tid & 127, kq = tid >> 7, lane = tid & 63, wave = tid >> 6;
    for (int bh = blockIdx.x; bh < 64; bh += gridDim.x) {
        const int b = bh >> 2, h = bh & 3;
        float S[32];
#pragma unroll
        for (int i = 0; i < 32; ++i) S[i] = 0.f;
        const float lbv = lower0[h * 128 + v], gn = gain[h * 128 + v];
        for (int t = 0; t < SEQ; ++t) {
            const size_t m = (size_t)b * SEQ + t; const bf16_t* row = HG + m * 2048 + h * 128;
            if (tid < 128) { const float fp = bf2f(row[512 + v]); const float f = lbv + (1.f - lbv) * sigmoidf_(fp); fs[v] = f; ks[v] = 1.f - f; qs[v] = bf2f(row[v]); }
            const float vv = bf2f(row[1024 + v]);
            __syncthreads();
            float o = 0.f;
#pragma unroll
            for (int i = 0; i < 32; ++i) { const int k = kq * 32 + i; S[i] = fs[k] * S[i] + ks[k] * vv; o += qs[k] * S[i]; }
            part[kq * 128 + v] = o;
            __syncthreads();
            float ot = 0.f;
            if (tid < 128) { ot = part[v] + part[128 + v] + part[256 + v] + part[384 + v]; const float sq = wave_sum(ot * ot); if (lane == 0) red[wave] = sq; }
            __syncthreads();
            if (tid < 128) { const float ms = (red[0] + red[1]) * (1.f / 128.f); const float y = ot * rsqrtf(ms + RMS_EPS) * gn * bf2f(row[1536 + v]); Y[m * 1536 + h * 128 + v] = f2bf(y); }
        }
        __syncthreads();
    }
}
template <bool DIFF>
__device__ __forceinline__ void phase_attn_naive(const Params& p, unsigned char* lds) {
    constexpr int DQ = DIFF ? 64 : 128, NMAP = DIFF ? 2 : 1;
    unsigned char* ws = p.ws; const int tid = threadIdx.x, lane = tid & 63, wave = tid >> 6;
    float* wbuf = (float*)lds + wave * 4096; float* qbuf = (float*)(lds + 131072) + wave * 128;
    const bf16_t* DQK = (const bf16_t*)(ws + WS_DQK); const bf16_t* DV = (const bf16_t*)(ws + WS_DV); const bf16_t* MQ = (const bf16_t*)(ws + WS_MQ); const bf16_t* MKV = (const bf16_t*)(ws + WS_MKV);
    bf16_t* Y = (bf16_t*)(ws + WS_Y); const float lam = ((const float*)(ws + WS_SCAL))[512]; const float* sub_gain = (const float*)p.in[11];
    const int gw = blockIdx.x * 8 + wave, ngw = gridDim.x * 8; const int nrows = NTOK * 4;
    for (int r = gw; r < nrows; r += ngw) {
        int b, h, nk; size_t m; const bf16_t *Q, *K, *V; int kp, vp;
        if (DIFF) { const int bh = r >> 12, i = r & 4095; b = bh >> 2; h = bh & 3; m = (size_t)b * SEQ + i; nk = i + 1;
            Q = DQK + m * 1024 + h * 64; K = DQK + (size_t)b * SEQ * 1024 + 512 + h * 64; kp = 1024; V = DV + (size_t)b * SEQ * 512 + h * 128; vp = 512; }
        else { m = (size_t)(r >> 2); h = r & 3; b = (int)(m >> 12); nk = NMEM;
            Q = MQ + m * 512 + h * 128; K = MKV + (size_t)b * NMEM * 1024 + h * 128; kp = 1024; V = MKV + (size_t)b * NMEM * 1024 + 512 + h * 128; vp = 1024; }
        if (DIFF) { qbuf[lane] = bf2f(Q[lane]); qbuf[64 + lane] = bf2f(Q[256 + lane]); }
        else { qbuf[lane] = bf2f(Q[lane]) * QSCALE_MEM; qbuf[64 + lane] = bf2f(Q[64 + lane]) * QSCALE_MEM; }
        LDS_WAIT();
        float mx[NMAP], ls[NMAP];
#pragma unroll
        for (int a = 0; a < NMAP; ++a) { mx[a] = -1e30f; ls[a] = 0.f; }
        for (int j = lane; j < nk; j += 64) {
#pragma unroll
            for (int a = 0; a < NMAP; ++a) {
                const bf16_t* kr = K + (size_t)j * kp + a * 256; float s = 0.f;
#pragma unroll 2
                for (int cc = 0; cc < DQ / 8; ++cc) { const bf16x8 kv = *(const bf16x8*)(kr + cc * 8);
#pragma unroll
                    for (int e = 0; e < 8; ++e) s += qbuf[a * 64 + cc * 8 + e] * bf2f((bf16_t)kv[e]); }
                if (s > mx[a]) { ls[a] = ls[a] * exp2f(mx[a] - s) + 1.f; mx[a] = s; } else ls[a] += exp2f(s - mx[a]);
            }
        }
        float M[NMAP], Linv[NMAP];
#pragma unroll
        for (int a = 0; a < NMAP; ++a) { M[a] = wave_max(mx[a]); const float l = wave_sum(ls[a] * exp2f(mx[a] - M[a])); Linv[a] = 1.f / l; }
        for (int j = lane; j < nk; j += 64) {
            float w = 0.f;
#pragma unroll
            for (int a = 0; a < NMAP; ++a) {
                const bf16_t* kr = K + (size_t)j * kp + a * 256; float s = 0.f;
#pragma unroll 2
                for (int cc = 0; cc < DQ / 8; ++cc) { const bf16x8 kv = *(const bf16x8*)(kr + cc * 8);
#pragma unroll
                    for (int e = 0; e < 8; ++e) s += qbuf[a * 64 + cc * 8 + e] * bf2f((bf16_t)kv[e]); }
                const float pj = exp2f(s - M[a]) * Linv[a]; w = (a == 0) ? pj : w - lam * pj;
            }
            wbuf[j] = w;
        }
        LDS_WAIT();
        float a0 = 0.f, a1 = 0.f; const bf16_t* vb = V + 2 * lane;
        for (int j = 0; j < nk; ++j) { const float w = wbuf[j]; const unsigned u = *(const unsigned*)(vb + (size_t)j * vp); a0 += w * __uint_as_float(u << 16); a1 += w * __uint_as_float(u & 0xffff0000u); }
        if (DIFF) { const float ms = wave_sum(a0 * a0 + a1 * a1) * (1.f / 128.f); const float rs = rsqrtf(ms + RMS_EPS) * (1.f - LAM_INIT);
            *(unsigned*)(Y + m * 1536 + 512 + h * 128 + 2 * lane) = pk2(a0 * rs * sub_gain[2 * lane], a1 * rs * sub_gain[2 * lane + 1]); }
        else *(unsigned*)(Y + m * 1536 + 1024 + h * 128 + 2 * lane) = pk2(a0, a1);
        LDS_WAIT();
    }
}
__device__ __forceinline__ void phase_merge(const Params& p, unsigned char* lds) {
    const SgCtx c = sg_ctx(lds); const int team = threadIdx.x >> 8; unsigned char* ws = p.ws;
    const bf16_t* XB = (const bf16_t*)(ws + WS_XB); const bf16_t* WG = (const bf16_t*)(ws + WS_WT_G); const bf16_t* Y = (const bf16_t*)(ws + WS_Y); const bf16_t* WB = (const bf16_t*)(ws + WS_WT_B);
    bf16_t* MG = (bf16_t*)(ws + WS_MERGED); const int r0 = SG_R0(c), c0 = SG_C0(c);
    const int ntiles = 512 * 16;
    for (int tb = 2 * blockIdx.x; tb < ntiles; tb += 2 * gridDim.x) {
        const int tile = tb + team; const int tm = tile >> 4, tn = tile & 15;
        f32x4 sum[4][2]; sg_zero(sum);
#pragma unroll 1
        for (int br = 0; br < 3; ++br) {
            f32x4 ag[4][2]; sg_zero(ag);
            sg_tile(ag, XB + (size_t)(tm * 128 + r0) * 1024 + c0, XB + (size_t)(tm * 128 + r0 + 64) * 1024 + c0, WG + (size_t)(br * 1024 + tn * 64 + r0) * 1024 + c0, 1024, c);
            f32x4 ay[4][2]; sg_zero(ay);
            sg_tile(ay, Y + (size_t)(tm * 128 + r0) * 1536 + br * 512 + c0, Y + (size_t)(tm * 128 + r0 + 64) * 1536 + br * 512 + c0, WB + (size_t)(br * 1024 + tn * 64 + r0) * 512 + c0, 512, c);
#pragma unroll
            for (int m = 0; m < 4; ++m)
#pragma unroll
                for (int n = 0; n < 2; ++n)
#pragma unroll
                    for (int j = 0; j < 4; ++j) sum[m][n][j] += sigmoidf_(ag[m][n][j]) * ay[m][n][j];
        }
        sg_store_bf16(sum, MG + (size_t)tm * 128 * 1024 + tn * 64, 1024, c, FIdent());
    }
}
__device__ __forceinline__ void phase_wout(const Params& p, unsigned char* lds) {
    const SgCtx c = sg_ctx(lds); const int team = threadIdx.x >> 8; unsigned char* ws = p.ws;
    const bf16_t* MG = (const bf16_t*)(ws + WS_MERGED); const bf16_t* WO = (const bf16_t*)(ws + WS_WT_OUT); const float* x = (const float*)p.in[0]; float* pre = p.out;
    const int r0 = SG_R0(c), c0 = SG_C0(c); const int ntiles = 512 * 16;
    for (int tb = 2 * blockIdx.x; tb < ntiles; tb += 2 * gridDim.x) {
        const int tile = tb + team; const int tm = tile >> 4, tn = tile & 15;
        f32x4 acc[4][2]; sg_zero(acc);
        sg_tile(acc, MG + (size_t)(tm * 128 + r0) * 1024 + c0, MG + (size_t)(tm * 128 + r0 + 64) * 1024 + c0, WO + (size_t)(tn * 64 + r0) * 1024 + c0, 1024, c);
        { const size_t off = ((size_t)tm * 128 + c.wr * 64 + c.fq * 4) * 1024 + tn * 64 + c.wc * 32 + c.fr;
#pragma unroll
          for (int m = 0; m < 4; ++m)
#pragma unroll
              for (int j = 0; j < 4; ++j) { const size_t o2 = off + (size_t)(m * 16 + j) * 1024;
#pragma unroll
                  for (int n = 0; n < 2; ++n) pre[o2 + n * 16] = ALPHA * x[o2 + n * 16] + acc[m][n][j];
                  asm volatile("" ::: "memory"); } }
    }
}
__device__ __forceinline__ void phase_ln1_route(const Params& p, unsigned char* lds) {
    unsigned char* ws = p.ws; const int tid = threadIdx.x, lane = tid & 63, wave = tid >> 6;
    float* x1f = p.out; bf16_t* x1b = (bf16_t*)(ws + WS_X1B); const float* g1 = (const float*)p.in[17]; const float* b1 = (const float*)p.in[18];
    const float* wg = (const float*)p.in[19]; const float* we = (const float*)p.in[20];
    int* cnt = (int*)(ws + WS_CTL); int* reci = (int*)(ws + WS_RECI); float* recw = (float*)(ws + WS_RECW);
    const int gw = blockIdx.x * 8 + wave, ngw = gridDim.x * 8;
    for (int t = gw; t < NTOK; t += ngw) {
        float* row = x1f + (size_t)t * 1024; f32x4 v[4]; float s = 0.f;
#pragma unroll
        for (int j = 0; j < 4; ++j) { v[j] = *(const f32x4*)(row + 256 * j + 4 * lane); s += (v[j].x + v[j].y) + (v[j].z + v[j].w); }
        const float mean = wave_sum(s) * (1.f / 1024.f); float s2 = 0.f;
#pragma unroll
        for (int j = 0; j < 4; ++j) { v[j] = v[j] - mean; s2 += (v[j].x * v[j].x + v[j].y * v[j].y) + (v[j].z * v[j].z + v[j].w * v[j].w); }
        const float rstd = rsqrtf(wave_sum(s2) * (1.f / 1024.f) + LN_EPS);
#pragma unroll
        for (int j = 0; j < 4; ++j) { const f32x4 gg = *(const f32x4*)(g1 + 256 * j + 4 * lane), bb = *(const f32x4*)(b1 + 256 * j + 4 * lane);
            v[j] = v[j] * rstd * gg + bb; *(f32x4*)(row + 256 * j + 4 * lane) = v[j];
            u32x2 o; o.x = pk2(v[j].x, v[j].y); o.y = pk2(v[j].z, v[j].w); *(u32x2*)(x1b + (size_t)t * 1024 + 256 * j + 4 * lane) = o; }
        float lg[36];
#pragma unroll
        for (int i = 0; i < 36; ++i) lg[i] = 0.f;
#pragma unroll
        for (int j = 0; j < 4; ++j)
#pragma unroll
            for (int e = 0; e < 4; ++e) { const int k = 256 * j + 4 * lane + e; const float xv = v[j][e];
                const f32x4 g4 = *(const f32x4*)(wg + k * 4);
#pragma unroll
                for (int q = 0; q < 4; ++q) lg[q] += xv * g4[q];
#pragma unroll
                for (int q8 = 0; q8 < 8; ++q8) { const f32x4 e4 = *(const f32x4*)(we + k * 32 + q8 * 4);
#pragma unroll
                    for (int q = 0; q < 4; ++q) lg[4 + q8 * 4 + q] += xv * e4[q]; } }
#pragma unroll
        for (int i = 0; i < 36; ++i) lg[i] = wave_sum(lg[i]);
        int gi = 0; float gm = lg[0];
#pragma unroll
        for (int q = 1; q < 4; ++q) if (lg[q] > gm) { gm = lg[q]; gi = q; }
        float gs = 0.f;
#pragma unroll
        for (int q = 0; q < 4; ++q) gs += expf(lg[q] - gm);
        const float group_w = 1.f / gs;
        float ig[8];
#pragma unroll
        for (int i = 0; i < 8; ++i) ig[i] = gi == 0 ? lg[4 + i] : gi == 1 ? lg[12 + i] : gi == 2 ? lg[20 + i] : lg[28 + i];
        int i1 = 0; float l1 = ig[0];
#pragma unroll
        for (int i = 1; i < 8; ++i) if (ig[i] > l1) { l1 = ig[i]; i1 = i; }
        int i2 = -1; float l2 = -3.0e38f;
#pragma unroll
        for (int i = 0; i < 8; ++i) if (i != i1 && ig[i] > l2) { l2 = ig[i]; i2 = i; }
        const float e2 = expf(l2 - l1); const float w1 = group_w / (1.f + e2), w2 = group_w * e2 / (1.f + e2);
        if (lane == 0) { const int ea = gi * 8 + i1, eb = gi * 8 + i2; const int pa = atomicAdd(cnt + ea, 1), pb = atomicAdd(cnt + eb, 1);
            reci[t * 4 + 0] = ea; reci[t * 4 + 1] = eb; reci[t * 4 + 2] = pa; reci[t * 4 + 3] = pb; recw[t * 2] = w1; recw[t * 2 + 1] = w2; }
    }
}
__device__ __forceinline__ int expert_layout(const int* cnt, int lane, int& tiles, int& endi) {
    tiles = (lane < 32) ? ((cnt[lane] + 255) >> 8) : 0; int x = tiles;
#pragma unroll
    for (int o = 1; o < 32; o <<= 1) { const int y = __shfl_up(x, o); if (lane >= o) x += y; }
    endi = x; return __shfl(x, 31);
}
__device__ __forceinline__ int expert_of_tile(int rt, int lane, int endi) { return __popcll(__ballot(lane < 32 && endi <= rt)); }
__device__ __forceinline__ void phase_dispatch(const Params& p, unsigned char* lds) {
    unsigned char* ws = p.ws; const int tid = threadIdx.x, lane = tid & 63, wave = tid >> 6;
    const int* cnt = (const int*)(ws + WS_CTL); int* reci = (int*)(ws + WS_RECI); const bf16_t* x1b = (const bf16_t*)(ws + WS_X1B); bf16_t* xs = (bf16_t*)(ws + WS_XS);
    int tiles, endi; expert_layout(cnt, lane, tiles, endi); const int base = endi - tiles;
    const int gw = blockIdx.x * 8 + wave, ngw = gridDim.x * 8;
    for (int t = gw; t < NTOK; t += ngw) {
        const int ea = reci[t * 4], eb = reci[t * 4 + 1], pa = reci[t * 4 + 2], pb = reci[t * 4 + 3];
        const int sa = __shfl(base, ea) * 256 + pa, sb = __shfl(base, eb) * 256 + pb;
        const u32x4 a = *(const u32x4*)(x1b + (size_t)t * 1024 + lane * 8), b = *(const u32x4*)(x1b + (size_t)t * 1024 + 512 + lane * 8);
        *(u32x4*)(xs + (size_t)sa * 1024 + lane * 8) = a; *(u32x4*)(xs + (size_t)sa * 1024 + 512 + lane * 8) = b;
        *(u32x4*)(xs + (size_t)sb * 1024 + lane * 8) = a; *(u32x4*)(xs + (size_t)sb * 1024 + 512 + lane * 8) = b;
        if (lane == 0) { reci[t * 4 + 2] = sa; reci[t * 4 + 3] = sb; }
    }
}
__device__ __forceinline__ void phase_exp_gu(const Params& p, unsigned char* lds) {
    const SgCtx c = sg_ctx(lds); const int team = threadIdx.x >> 8, lane = threadIdx.x & 63; unsigned char* ws = p.ws;
    const int* cnt = (const int*)(ws + WS_CTL); const bf16_t* XS = (const bf16_t*)(ws + WS_XS); const bf16_t* WGU = (const bf16_t*)(ws + WS_WT_GU); bf16_t* H = (bf16_t*)(ws + WS_H);
    int tiles, endi; const int nt256 = expert_layout(cnt, lane, tiles, endi);
    const int r0 = SG_R0(c), c0 = SG_C0(c); const int ntiles = nt256 * 2 * 8;
    for (int tb = 2 * blockIdx.x; tb < ntiles; tb += 2 * gridDim.x) {
        int tile = tb + team; const bool valid = tile < ntiles; if (!valid) tile = ntiles - 1;
        const int rt = tile >> 3, tn = tile & 7; const int e = expert_of_tile(rt >> 1, lane, endi);
        const bf16_t* a0 = XS + (size_t)(rt * 128 + r0) * 1024 + c0; const bf16_t* a1 = a0 + (size_t)64 * 1024;
        const bf16_t* bg = WGU + (size_t)(e * 1024 + (tn >> 1) * 256 + (tn & 1) * 64 + r0) * 1024 + c0;
        f32x4 ag[4][2]; sg_zero(ag); sg_tile(ag, a0, a1, bg, 1024, c);
        f32x4 au[4][2]; sg_zero(au); sg_tile(au, a0, a1, bg + (size_t)128 * 1024, 1024, c);
#pragma unroll
        for (int m = 0; m < 4; ++m)
#pragma unroll
            for (int n = 0; n < 2; ++n)
#pragma unroll
                for (int j = 0; j < 4; ++j) ag[m][n][j] = siluf_(ag[m][n][j]) * au[m][n][j];
        if (valid) sg_store_bf16(ag, H + (size_t)rt * 128 * 512 + tn * 64, 512, c, FIdent());
    }
}
__device__ __forceinline__ void phase_exp_dn(const Params& p, unsigned char* lds) {
    const SgCtx c = sg_ctx(lds); const int team = threadIdx.x >> 8, lane = threadIdx.x & 63; unsigned char* ws = p.ws;
    const int* cnt = (const int*)(ws + WS_CTL); const bf16_t* H = (const bf16_t*)(ws + WS_H); const bf16_t* WDN = (const bf16_t*)(ws + WS_WT_DN); bf16_t* YB = (bf16_t*)(ws + WS_YB);
    int tiles, endi; const int nt256 = expert_layout(cnt, lane, tiles, endi);
    const int r0 = SG_R0(c), c0 = SG_C0(c); const int ntiles = nt256 * 2 * 16;
    for (int tb = 2 * blockIdx.x; tb < ntiles; tb += 2 * gridDim.x) {
        int tile = tb + team; const bool valid = tile < ntiles; if (!valid) tile = ntiles - 1;
        const int rt = tile >> 4, tn = tile & 15; const int e = expert_of_tile(rt >> 1, lane, endi);
        const bf16_t* a0 = H + (size_t)(rt * 128 + r0) * 512 + c0; const bf16_t* b0 = WDN + (size_t)(e * 1024 + tn * 64 + r0) * 512 + c0;
        f32x4 acc[4][2]; sg_zero(acc); sg_tile(acc, a0, a0 + (size_t)64 * 512, b0, 512, c);
        if (valid) sg_store_bf16(acc, YB + (size_t)rt * 128 * 1024 + tn * 64, 1024, c, FIdent());
    }
}
__device__ __forceinline__ void phase_final(const Params& p, unsigned char* lds) {
    unsigned char* ws = p.ws; const int tid = threadIdx.x, lane = tid & 63, wave = tid >> 6;
    float* out = p.out; const bf16_t* YB = (const bf16_t*)(ws + WS_YB); const int* reci = (const int*)(ws + WS_RECI); const float* recw = (const float*)(ws + WS_RECW);
    const float* g2 = (const float*)p.in[24]; const float* b2 = (const float*)p.in[25];
    const int gw = blockIdx.x * 8 + wave, ngw = gridDim.x * 8;
    for (int t = gw; t < NTOK; t += ngw) {
        float* row = out + (size_t)t * 1024; const int sa = reci[t * 4 + 2], sb = reci[t * 4 + 3]; const float wa = recw[t * 2], wb = recw[t * 2 + 1];
        f32x4 v[4]; float s = 0.f;
#pragma unroll
        for (int j = 0; j < 4; ++j) { const f32x4 xv = *(const f32x4*)(row + 256 * j + 4 * lane);
            const u32x2 ya = *(const u32x2*)(YB + (size_t)sa * 1024 + 256 * j + 4 * lane), yb = *(const u32x2*)(YB + (size_t)sb * 1024 + 256 * j + 4 * lane);
            f32x4 fa, fb; fa.x = __uint_as_float(ya.x << 16); fa.y = __uint_as_float(ya.x & 0xffff0000u); fa.z = __uint_as_float(ya.y << 16); fa.w = __uint_as_float(ya.y & 0xffff0000u);
            fb.x = __uint_as_float(yb.x << 16); fb.y = __uint_as_float(yb.x & 0xffff0000u); fb.z = __uint_as_float(yb.y << 16); fb.w = __uint_as_float(yb.y & 0xffff0000u);
            v[j] = xv * ALPHA + fa * wa + fb * wb; s += (v[j].x + v[j].y) + (v[j].z + v[j].w); }
        const float mean = wave_sum(s) * (1.f / 1024.f); float s2 = 0.f;
#pragma unroll
        for (int j = 0; j < 4; ++j) { v[j] = v[j] - mean; s2 += (v[j].x * v[j].x + v[j].y * v[j].y) + (v[j].z * v[j].z + v[j].w * v[j].w); }
        const float rstd = rsqrtf(wave_sum(s2) * (1.f / 1024.f) + LN_EPS);
#pragma unroll
        for (int j = 0; j < 4; ++j) { const f32x4 gg = *(const f32x4*)(g2 + 256 * j + 4 * lane), bb = *(const f32x4*)(b2 + 256 * j + 4 * lane);
            *(f32x4*)(row + 256 * j + 4 * lane) = v[j] * rstd * gg + bb; }
    }
}

namespace pg8 {
#define PG8_LAS __attribute__((address_space(3)))
constexpr int BM = 256, BK = 64, HALF = 128, HTB = HALF * BK * 2, STAGE_BYTES = 8 * HTB, NXCD = 8, WGM = 8;
__host__ __device__ __forceinline__ int lds_byte(int r, int c) { const int st = (r >> 4) * 2 + (c >> 5), rr = r & 15, cc = c & 31, ob = rr * 64 + cc * 2; return st * 1024 + (ob ^ (((ob >> 9) & 1) << 5)); }
__host__ __device__ __forceinline__ void stage_rc(int b, int& R, int& C) { const int st = b / 1024, sb = b % 1024, swz = sb ^ (((sb >> 9) & 1) << 5); R = (st >> 1) * 16 + swz / 64; C = (st & 1) * 32 + (swz % 64) / 2; }
__host__ __device__ __forceinline__ int perm32(int rho) { const int n = rho >> 4, i = rho & 15; return 8 * (i >> 2) + 4 * n + (i & 3); }
struct Unit { int pm, pn, aux, nt, lda, ldb; const char* a; const char* b; };
typedef float f32x2_t __attribute__((ext_vector_type(2))); typedef __bf16 bf16x2_t __attribute__((ext_vector_type(2)));
__device__ __forceinline__ unsigned cvt_pk_bf16(float lo, float hi) { f32x2_t v = {lo, hi}; bf16x2_t b = __builtin_convertvector(v, bf16x2_t); return __builtin_bit_cast(unsigned, b); }
__device__ __forceinline__ bool static_tile(int i, int G, int c, int nM, int nN, int& pm, int& pn) {
    const int nwg = nM * nN; const long L = (long)i * G + c; if (L >= nwg) return false;
    int wgid = (int)L; { const int q = nwg / NXCD, r = nwg % NXCD, xcd = wgid % NXCD, off = wgid / NXCD; wgid = (xcd < r ? xcd * (q + 1) : r * (q + 1) + (xcd - r) * q) + off; }
    const int nig = WGM * nN, gid = wgid / nig, fm = gid * WGM, gsz = (nM - fm) < WGM ? (nM - fm) : WGM;
    pm = fm + ((wgid % nig) % gsz); pn = (wgid % nig) / gsz; return true;
}
template <class Epi, class Sched, bool ALIGN_EPI>
__device__ __forceinline__ void gemm_phase(PG8_LAS unsigned char* lds, const Sched& S, const Epi& E) {
    const int tid = threadIdx.x, wid = __builtin_amdgcn_readfirstlane(tid >> 6), lane = tid & 63, wr = wid >> 2, wc = wid & 3, fr = lane & 15, fq = lane >> 4;
    const size_t kstep = (size_t)(BK * 2);
    const unsigned ldsw = (unsigned)wid * 1024u;
    const int aoff = lds_byte(wr * 64 + fr, fq * 8), boff = lds_byte(wc * 32 + fr, fq * 8);
#define PG8_VOFF(LDA, LDB) do { int t_ = threadIdx.x; asm volatile("" : "+v"(t_)); _Pragma("unroll") for (int i_ = 0; i_ < 2; ++i_) { int R_, C_; stage_rc(t_ * 16 + i_ * 8192, R_, C_); \
        const int Rb_ = Epi::PERM ? ((R_ & ~31) + perm32(R_ & 31)) : R_; voffA[i_] = (unsigned)(R_ * (LDA) + C_) * 2u; voffB[i_] = (unsigned)(Rb_ * (LDB) + C_) * 2u; } } while (0)
#define PG8_SA(b, h) (((b) * 2 + (h)) * HTB)
#define PG8_SB(b, h) ((4 + (b) * 2 + (h)) * HTB)
#define PG8_STAGE(bufoff, gbase, voff) do { _Pragma("unroll") for (int _i = 0; _i < 2; ++_i) \
        __builtin_amdgcn_global_load_lds((const unsigned*)((const char*)(gbase) + (voff)[_i]), (PG8_LAS unsigned*)(lds + (bufoff) + ldsw + _i * 8192), 16, 0, 0); } while (0)
#define PG8_LDA(dst, b, h) do { _Pragma("unroll") for (int m = 0; m < 4; ++m) _Pragma("unroll") for (int k = 0; k < 2; ++k) dst[m][k] = *(const PG8_LAS bf16x8*)(lds + PG8_SA(b, h) + aoff + m * 2048 + k * 1024); } while (0)
#define PG8_LDB(dst, b, h) do { _Pragma("unroll") for (int n = 0; n < 2; ++n) _Pragma("unroll") for (int k = 0; k < 2; ++k) dst[n][k] = *(const PG8_LAS bf16x8*)(lds + PG8_SB(b, h) + boff + n * 2048 + k * 1024); } while (0)
#define PG8_MMA(ai, bj, At, Bt) do { __builtin_amdgcn_s_setprio(1); _Pragma("unroll") for (int m = 0; m < 4; ++m) _Pragma("unroll") for (int n = 0; n < 2; ++n) _Pragma("unroll") for (int k = 0; k < 2; ++k) \
        acc[ai][bj][m][n] = __builtin_amdgcn_mfma_f32_16x16x32_bf16(Bt[n][k], At[m][k], acc[ai][bj][m][n], 0, 0, 0); __builtin_amdgcn_s_setprio(0); } while (0)
#define PG8_WAIT_V(n) asm volatile("s_waitcnt vmcnt(" #n ")" ::: "memory")
#define PG8_WAIT_L(n) asm volatile("s_waitcnt lgkmcnt(" #n ")" ::: "memory")
#define PG8_BAR __builtin_amdgcn_s_barrier()
#define PG8_SCHED __builtin_amdgcn_sched_barrier(0)
#define PG8_H1(p, ld) ((p) + (size_t)HALF * (ld) * 2)
    Unit cur, nxt; int ui = 0;
    if (!S.next(0, cur)) return;
    f32x4 acc[2][2][4][2];
#pragma unroll
    for (int a = 0; a < 2; ++a)
#pragma unroll
        for (int b = 0; b < 2; ++b)
#pragma unroll
            for (int m = 0; m < 4; ++m)
#pragma unroll
                for (int n = 0; n < 2; ++n) acc[a][b][m][n] = (f32x4){0.f, 0.f, 0.f, 0.f};
    bf16x8 At[4][2], B0[2][2], B1[2][2];
    unsigned voffA[2], voffB[2];
    PG8_VOFF(cur.lda, cur.ldb);
    PG8_STAGE(PG8_SB(0, 0), cur.b, voffB); PG8_STAGE(PG8_SB(0, 1), PG8_H1(cur.b, cur.ldb), voffB); PG8_STAGE(PG8_SA(0, 0), cur.a, voffA); PG8_STAGE(PG8_SA(0, 1), PG8_H1(cur.a, cur.lda), voffA);
    if (wr == 1) PG8_BAR;
    PG8_WAIT_V(2); PG8_BAR;
    PG8_STAGE(PG8_SB(1, 0), cur.b + kstep, voffB); PG8_STAGE(PG8_SA(1, 0), cur.a + kstep, voffA); PG8_STAGE(PG8_SB(1, 1), PG8_H1(cur.b, cur.ldb) + kstep, voffB);
    PG8_WAIT_V(6); PG8_BAR;
    for (;;) {
        const bool has_next = S.next(ui + 1, nxt);
        if (!has_next) nxt = cur;
        const int nt = cur.nt;
        for (int t = 0; t < nt; t += 2) {
            const bool last = (t == nt - 2);
            PG8_LDB(B0, 0, 0); PG8_LDB(B1, 0, 1); PG8_SCHED; PG8_LDA(At, 0, 0); PG8_STAGE(PG8_SA(1, 1), PG8_H1(cur.a, cur.lda) + (size_t)(t + 1) * kstep, voffA);
            if (last) PG8_VOFF(nxt.lda, nxt.ldb);
            const char* a2 = last ? nxt.a : cur.a + (size_t)(t + 2) * kstep; const char* b2 = last ? nxt.b : cur.b + (size_t)(t + 2) * kstep;
            const int lda2 = last ? nxt.lda : cur.lda, ldb2 = last ? nxt.ldb : cur.ldb;
            PG8_WAIT_V(8); PG8_WAIT_L(0); PG8_BAR; PG8_MMA(0, 0, At, B0); PG8_MMA(0, 1, At, B1); PG8_BAR; PG8_SCHED;
            PG8_LDA(At, 0, 1); PG8_STAGE(PG8_SB(0, 0), b2, voffB); PG8_STAGE(PG8_SB(0, 1), PG8_H1(b2, ldb2), voffB); PG8_STAGE(PG8_SA(0, 0), a2, voffA);
            PG8_WAIT_V(8); PG8_WAIT_L(0); PG8_BAR; PG8_MMA(1, 0, At, B0); PG8_MMA(1, 1, At, B1); PG8_BAR; PG8_SCHED;
            PG8_LDB(B0, 1, 0); PG8_LDB(B1, 1, 1); PG8_SCHED; PG8_LDA(At, 1, 0); PG8_STAGE(PG8_SA(0, 1), PG8_H1(a2, lda2), voffA);
            PG8_WAIT_V(8); PG8_WAIT_L(0); PG8_BAR; PG8_MMA(0, 0, At, B0); PG8_MMA(0, 1, At, B1); PG8_BAR; PG8_SCHED;
            PG8_LDA(At, 1, 1); PG8_STAGE(PG8_SB(1, 0), b2 + kstep, voffB); PG8_STAGE(PG8_SB(1, 1), PG8_H1(b2, ldb2) + kstep, voffB); PG8_STAGE(PG8_SA(1, 0), a2 + kstep, voffA);
            PG8_WAIT_V(8); PG8_WAIT_L(0); PG8_BAR; PG8_MMA(1, 0, At, B0); PG8_MMA(1, 1, At, B1); PG8_BAR; PG8_SCHED;
        }
        if constexpr (ALIGN_EPI) { if (wr == 0) PG8_BAR; }
        E(acc, cur, wr, wc, fr, fq);
        if (!has_next) break;
#pragma unroll
        for (int a = 0; a < 2; ++a)
#pragma unroll
            for (int b = 0; b < 2; ++b)
#pragma unroll
                for (int m = 0; m < 4; ++m)
#pragma unroll
                    for (int n = 0; n < 2; ++n) acc[a][b][m][n] = (f32x4){0.f, 0.f, 0.f, 0.f};
        cur = nxt; ++ui;
        if constexpr (ALIGN_EPI) { if (wr == 1) PG8_BAR; }
    }
    PG8_WAIT_V(0);
    if constexpr (!ALIGN_EPI) { if (wr == 0) PG8_BAR; }
    PG8_BAR;
#undef PG8_VOFF
#undef PG8_H1
#undef PG8_SA
#undef PG8_SB
#undef PG8_STAGE
#undef PG8_LDA
#undef PG8_LDB
#undef PG8_MMA
#undef PG8_WAIT_V
#undef PG8_WAIT_L
#undef PG8_BAR
#undef PG8_SCHED
}
struct SchedPlain {
    const char* A; const char* B; int nM, nN, lda, ldb, nt, G, c;
    __device__ __forceinline__ bool next(int i, Unit& u) const {
        int pm, pn; if (!static_tile(i, G, c, nM, nN, pm, pn)) return false;
        u.pm = pm; u.pn = pn; u.aux = 0; u.nt = nt; u.lda = lda; u.ldb = ldb; u.a = A + (size_t)pm * BM * lda * 2; u.b = B + (size_t)pn * BM * ldb * 2; return true; }
};
struct SchedMerge {
    const char* XB; const char* WG; const char* Y; const char* WB; int G, c;
    __device__ __forceinline__ bool next(int i, Unit& u) const {
        const int ti = i / 6, sub = i - ti * 6, br = sub >> 1; int pm, pn; if (!static_tile(ti, G, c, 256, 4, pm, pn)) return false;
        u.pm = pm; u.pn = pn; u.aux = sub;
        if ((sub & 1) == 0) { u.nt = 16; u.lda = 1024; u.ldb = 1024; u.a = XB + (size_t)pm * BM * 1024 * 2; u.b = WG + (size_t)(br * 1024 + pn * BM) * 1024 * 2; }
        else { u.nt = 8; u.lda = 1536; u.ldb = 512; u.a = Y + ((size_t)pm * BM * 1536 + br * 512) * 2; u.b = WB + (size_t)(br * 1024 + pn * BM) * 512 * 2; }
        return true; }
};
struct SchedExp {
    const char* A; const char* B; int lda, ldb, nt, total, G, c; size_t bexp; const PG8_LAS int* tab;
    __device__ __forceinline__ bool next(int i, Unit& u) const {
        const long L = (long)i * G + c; if (L >= total) return false;
        int id = (int)L; { const int q = total / NXCD, r = total % NXCD, xcd = id % NXCD, off = id / NXCD; id = (xcd < r ? xcd * (q + 1) : r * (q + 1) + (xcd - r) * q) + off; }
        const int rt = id >> 2, pn = id & 3; const int e = __builtin_amdgcn_readfirstlane(tab[rt]);
        u.pm = rt; u.pn = pn; u.aux = e; u.nt = nt; u.lda = lda; u.ldb = ldb; u.a = A + (size_t)rt * BM * lda * 2; u.b = B + (size_t)e * bexp + (size_t)pn * BM * ldb * 2; return true; }
};
struct EpiBf16 {
    static constexpr bool PERM = true; bf16_t* O; int ldc;
    __device__ __forceinline__ void operator()(const f32x4 (&acc)[2][2][4][2], const Unit& u, int wr, int wc, int fr, int fq) const {
        bf16_t* base = O + (size_t)(u.pm * BM + wr * 64 + fr) * ldc + u.pn * BM + wc * 32 + 8 * fq;
#pragma unroll
        for (int ai = 0; ai < 2; ++ai)
#pragma unroll
            for (int m = 0; m < 4; ++m) { bf16_t* rowp = base + (size_t)(ai * HALF + m * 16) * ldc;
#pragma unroll
                for (int bj = 0; bj < 2; ++bj) { const f32x4 v0 = acc[ai][bj][m][0], v1 = acc[ai][bj][m][1];
                    u32x4 w; w.x = cvt_pk_bf16(v0[0], v0[1]); w.y = cvt_pk_bf16(v0[2], v0[3]); w.z = cvt_pk_bf16(v1[0], v1[1]); w.w = cvt_pk_bf16(v1[2], v1[3]);
                    *(u32x4*)(rowp + bj * HALF) = w; } }
    }
};
struct EpiProj {
    static constexpr bool PERM = true; bf16_t *HG, *DQK, *DV, *MQ; const float* rope;
    __device__ __forceinline__ void operator()(const f32x4 (&acc)[2][2][4][2], const Unit& u, int wr, int wc, int fr, int fq) const {
        const int pn = u.pn; bf16_t* dst; int ld, mode;
        if (pn < 8) { dst = HG + pn * 256; ld = 2048; mode = (pn < 2 || pn >= 6) ? 1 : 0; }
        else if (pn < 12) { dst = DQK + (pn - 8) * 256; ld = 1024; mode = pn < 10 ? 2 : 3; }
        else if (pn < 14) { dst = DV + (pn - 12) * 256; ld = 512; mode = 0; }
        else { dst = MQ + (pn - 14) * 256; ld = 512; mode = 0; }
        const int row0 = u.pm * BM + wr * 64 + fr; const bool rot = (mode >= 2) && ((wc & 1) == 0);
#pragma unroll
        for (int ai = 0; ai < 2; ++ai)
#pragma unroll
            for (int m = 0; m < 4; ++m) { const int row = row0 + ai * HALF + m * 16; bf16_t* rowp = dst + (size_t)row * ld + wc * 32 + 8 * fq;
                f32x4 r0 = {1.f, 0.f, 1.f, 0.f}, r1 = r0, r2 = r0, r3 = r0;
                if (rot) { const f32x4* rp = (const f32x4*)(rope + (size_t)row * 16); r0 = rp[0]; r1 = rp[1]; r2 = rp[2]; r3 = rp[3]; }
#pragma unroll
                for (int bj = 0; bj < 2; ++bj) { f32x4 v0 = acc[ai][bj][m][0], v1 = acc[ai][bj][m][1];
                    if (mode == 1) {
#pragma unroll
                        for (int e = 0; e < 4; ++e) { v0[e] = siluf_(v0[e]); v1[e] = siluf_(v1[e]); } }
                    if (rot) {
                        f32x4 p0, p1;
#pragma unroll
                        for (int e = 0; e < 4; ++e) { p0[e] = __shfl_xor(v0[e], 16); p1[e] = __shfl_xor(v1[e], 16); }
                        const float sg = (fq == 0) ? -1.f : 1.f;
                        if (fq < 2) {
                            v0[0] = v0[0] * r0[0] + sg * p0[0] * r0[1]; v0[1] = v0[1] * r0[2] + sg * p0[1] * r0[3]; v0[2] = v0[2] * r1[0] + sg * p0[2] * r1[1]; v0[3] = v0[3] * r1[2] + sg * p0[3] * r1[3];
                            v1[0] = v1[0] * r2[0] + sg * p1[0] * r2[1]; v1[1] = v1[1] * r2[2] + sg * p1[1] * r2[3]; v1[2] = v1[2] * r3[0] + sg * p1[2] * r3[1]; v1[3] = v1[3] * r3[2] + sg * p1[3] * r3[3]; } }
                    if (mode == 2) { v0 = v0 * QSCALE_DF; v1 = v1 * QSCALE_DF; }
                    u32x4 w; w.x = cvt_pk_bf16(v0[0], v0[1]); w.y = cvt_pk_bf16(v0[2], v0[3]); w.z = cvt_pk_bf16(v1[0], v1[1]); w.w = cvt_pk_bf16(v1[2], v1[3]);
                    *(u32x4*)(rowp + bj * HALF) = w; }
                asm volatile("" ::: "memory"); }
    }
};
__device__ __forceinline__ u32x4 ld16_sc1(const unsigned char* p) {
    const unsigned long long a = __hip_atomic_load((const unsigned long long*)p, __ATOMIC_RELAXED, __HIP_MEMORY_SCOPE_AGENT), b = __hip_atomic_load((const unsigned long long*)p + 1, __ATOMIC_RELAXED, __HIP_MEMORY_SCOPE_AGENT);
    u32x4 r; r.x = (unsigned)a; r.y = (unsigned)(a >> 32); r.z = (unsigned)b; r.w = (unsigned)(b >> 32); return r; }
__device__ __forceinline__ void unpack8(const u32x4 w, float (&o)[8]) {
    o[0] = __uint_as_float(w.x << 16); o[1] = __uint_as_float(w.x & 0xffff0000u); o[2] = __uint_as_float(w.y << 16); o[3] = __uint_as_float(w.y & 0xffff0000u);
    o[4] = __uint_as_float(w.z << 16); o[5] = __uint_as_float(w.z & 0xffff0000u); o[6] = __uint_as_float(w.w << 16); o[7] = __uint_as_float(w.w & 0xffff0000u); }
struct EpiMerge {
    static constexpr bool PERM = true; bf16_t* MG; unsigned char* scrG; unsigned char* scrS;
    static __device__ __forceinline__ void unpack8_(const u32x4 w, float (&o)[8]) {
        o[0] = __uint_as_float(w.x << 16); o[1] = __uint_as_float(w.x & 0xffff0000u); o[2] = __uint_as_float(w.y << 16); o[3] = __uint_as_float(w.y & 0xffff0000u);
        o[4] = __uint_as_float(w.z << 16); o[5] = __uint_as_float(w.z & 0xffff0000u); o[6] = __uint_as_float(w.w << 16); o[7] = __uint_as_float(w.w & 0xffff0000u); }
    __device__ __forceinline__ void operator()(const f32x4 (&acc)[2][2][4][2], const Unit& u, int wr, int wc, int fr, int fq) const {
        const int sub = u.aux, br = sub >> 1; const int wid = wr * 4 + wc, lane = fq * 16 + fr;
        unsigned lo = ((unsigned)wid * 16u * 64u + (unsigned)lane) * 16u; asm volatile("" : "+v"(lo));
        if ((sub & 1) == 0) {
#pragma unroll
            for (int ai = 0; ai < 2; ++ai)
#pragma unroll
                for (int bj = 0; bj < 2; ++bj)
#pragma unroll
                    for (int m = 0; m < 4; ++m) { const int g = (ai * 2 + bj) * 4 + m; const f32x4 v0 = acc[ai][bj][m][0], v1 = acc[ai][bj][m][1];
                        u32x4 w; w.x = cvt_pk_bf16(sigmoidf_(v0[0]), sigmoidf_(v0[1])); w.y = cvt_pk_bf16(sigmoidf_(v0[2]), sigmoidf_(v0[3]));
                        w.z = cvt_pk_bf16(sigmoidf_(v1[0]), sigmoidf_(v1[1])); w.w = cvt_pk_bf16(sigmoidf_(v1[2]), sigmoidf_(v1[3]));
                        *(u32x4*)(scrG + (lo + (unsigned)g * 1024u)) = w; asm volatile("" ::: "memory"); }
        } else {
            bf16_t* base = MG + (size_t)(u.pm * BM + wr * 64 + fr) * 1024 + u.pn * BM + wc * 32 + 8 * fq;
#pragma unroll
            for (int ai = 0; ai < 2; ++ai)
#pragma unroll
                for (int bj = 0; bj < 2; ++bj)
#pragma unroll
                    for (int m = 0; m < 4; ++m) { const int g = (ai * 2 + bj) * 4 + m; const f32x4 v0 = acc[ai][bj][m][0], v1 = acc[ai][bj][m][1];
                        float gt[8], o[8]; unpack8(*(const u32x4*)(scrG + (lo + (unsigned)g * 1024u)), gt);
                        o[0] = gt[0] * v0[0]; o[1] = gt[1] * v0[1]; o[2] = gt[2] * v0[2]; o[3] = gt[3] * v0[3]; o[4] = gt[4] * v1[0]; o[5] = gt[5] * v1[1]; o[6] = gt[6] * v1[2]; o[7] = gt[7] * v1[3];
                        if (br > 0) { float pv[8]; unpack8(*(const u32x4*)(scrS + (lo + (unsigned)g * 1024u)), pv);
#pragma unroll
                            for (int e = 0; e < 8; ++e) o[e] += pv[e]; }
                        u32x4 w; w.x = cvt_pk_bf16(o[0], o[1]); w.y = cvt_pk_bf16(o[2], o[3]); w.z = cvt_pk_bf16(o[4], o[5]); w.w = cvt_pk_bf16(o[6], o[7]);
                        if (br < 2) *(u32x4*)(scrS + (lo + (unsigned)g * 1024u)) = w; else *(u32x4*)(base + (size_t)(ai * HALF + m * 16) * 1024 + bj * HALF) = w;
                        asm volatile("" ::: "memory"); }
        }
    }
};
struct EpiWout {
    static constexpr bool PERM = false; const float* x; float* out;
    __device__ __forceinline__ void operator()(const f32x4 (&acc)[2][2][4][2], const Unit& u, int wr, int wc, int fr, int fq) const {
        const size_t off0 = (size_t)(u.pm * BM + wr * 64 + fr) * 1024 + u.pn * BM + wc * 32 + 4 * fq;
#pragma unroll
        for (int ai = 0; ai < 2; ++ai)
#pragma unroll
            for (int m = 0; m < 4; ++m) { const size_t off = off0 + (size_t)(ai * HALF + m * 16) * 1024;
#pragma unroll
                for (int bj = 0; bj < 2; ++bj)
#pragma unroll
                    for (int n = 0; n < 2; ++n) { const f32x4 xv = *(const f32x4*)(x + off + bj * HALF + n * 16); *(f32x4*)(out + off + bj * HALF + n * 16) = xv * ALPHA + acc[ai][bj][m][n]; }
                if (m & 1) asm volatile("" ::: "memory"); }
    }
};
struct EpiSwiglu {
    static constexpr bool PERM = true; bf16_t* H;
    __device__ __forceinline__ void operator()(const f32x4 (&acc)[2][2][4][2], const Unit& u, int wr, int wc, int fr, int fq) const {
        bf16_t* base = H + (size_t)(u.pm * BM + wr * 64 + fr) * 512 + u.pn * HALF + wc * 32 + 8 * fq;
#pragma unroll
        for (int ai = 0; ai < 2; ++ai)
#pragma unroll
            for (int m = 0; m < 4; ++m) { const f32x4 g0 = acc[ai][0][m][0], g1 = acc[ai][0][m][1], u0 = acc[ai][1][m][0], u1 = acc[ai][1][m][1];
                u32x4 w; w.x = cvt_pk_bf16(siluf_(g0[0]) * u0[0], siluf_(g0[1]) * u0[1]); w.y = cvt_pk_bf16(siluf_(g0[2]) * u0[2], siluf_(g0[3]) * u0[3]);
                w.z = cvt_pk_bf16(siluf_(g1[0]) * u1[0], siluf_(g1[1]) * u1[1]); w.w = cvt_pk_bf16(siluf_(g1[2]) * u1[2], siluf_(g1[3]) * u1[3]);
                *(u32x4*)(base + (size_t)(ai * HALF + m * 16) * 512) = w; }
    }
};
}

#define LASP(p) ((__attribute__((address_space(3))) unsigned char*)(p))
__device__ __forceinline__ void phase_proj_pg8(const Params& p, unsigned char* lds) {
    unsigned char* ws = p.ws;
    { pg8::SchedPlain S{(const char*)(ws + WS_XB), (const char*)(ws + WS_WT_IN), 256, 16, 1024, 1024, 16, (int)gridDim.x, (int)blockIdx.x};
      pg8::EpiProj E{(bf16_t*)(ws + WS_HG), (bf16_t*)(ws + WS_DQK), (bf16_t*)(ws + WS_DV), (bf16_t*)(ws + WS_MQ), (const float*)(ws + WS_ROPE)};
      pg8::gemm_phase<pg8::EpiProj, pg8::SchedPlain, true>(LASP(lds), S, E); }
    { pg8::SchedPlain S{(const char*)(ws + WS_MEMB), (const char*)(ws + WS_WT_MKV), 16, 4, 1024, 1024, 16, (int)gridDim.x, (int)blockIdx.x};
      pg8::EpiBf16 E{(bf16_t*)(ws + WS_MKV), 1024};
      pg8::gemm_phase<pg8::EpiBf16, pg8::SchedPlain, true>(LASP(lds), S, E); }
}
constexpr size_t WS_SCR = WS_DQK;
__device__ __forceinline__ void phase_merge_pg8(const Params& p, unsigned char* lds) {
    unsigned char* ws = p.ws;
    pg8::SchedMerge S{(const char*)(ws + WS_XB), (const char*)(ws + WS_WT_G), (const char*)(ws + WS_Y), (const char*)(ws + WS_WT_B), (int)gridDim.x, (int)blockIdx.x};
    pg8::EpiMerge E{(bf16_t*)(ws + WS_MERGED), ws + WS_SCR + (size_t)blockIdx.x * 262144, ws + WS_SCR + (size_t)blockIdx.x * 262144 + 131072};
    pg8::gemm_phase<pg8::EpiMerge, pg8::SchedMerge, true>(LASP(lds), S, E);
}
__device__ __forceinline__ void phase_wout_pg8(const Params& p, unsigned char* lds) {
    unsigned char* ws = p.ws;
    pg8::SchedPlain S{(const char*)(ws + WS_MERGED), (const char*)(ws + WS_WT_OUT), 256, 4, 1024, 1024, 16, (int)gridDim.x, (int)blockIdx.x};
    pg8::EpiWout E{(const float*)p.in[0], p.out};
    pg8::gemm_phase<pg8::EpiWout, pg8::SchedPlain, true>(LASP(lds), S, E);
}
constexpr int LDS_TAB = 131072;
__device__ __forceinline__ int exp_table(const Params& p, unsigned char* lds) {
    const int lane = threadIdx.x & 63; int tiles, endi; const int nt256 = expert_layout((const int*)(p.ws + WS_CTL), lane, tiles, endi);
    int* tab = (int*)(lds + LDS_TAB);
    for (int rt = threadIdx.x >> 6; rt < nt256; rt += 8) { const int e = expert_of_tile(rt, lane, endi); if (lane == 0) tab[rt] = e; }
    __syncthreads(); return nt256;
}
__device__ __forceinline__ void phase_exp_gu_pg8(const Params& p, unsigned char* lds) {
    unsigned char* ws = p.ws; const int nt256 = exp_table(p, lds);
    pg8::SchedExp S{(const char*)(ws + WS_XS), (const char*)(ws + WS_WT_GU), 1024, 1024, 16, nt256 * 4, (int)gridDim.x, (int)blockIdx.x, (size_t)1024 * 1024 * 2, (const __attribute__((address_space(3))) int*)LASP(lds + LDS_TAB)};
    pg8::EpiSwiglu E{(bf16_t*)(ws + WS_H)};
    pg8::gemm_phase<pg8::EpiSwiglu, pg8::SchedExp, true>(LASP(lds), S, E);
}
__device__ __forceinline__ void phase_exp_dn_pg8(const Params& p, unsigned char* lds) {
    unsigned char* ws = p.ws; const int nt256 = exp_table(p, lds);
    pg8::SchedExp S{(const char*)(ws + WS_H), (const char*)(ws + WS_WT_DN), 512, 512, 8, nt256 * 4, (int)gridDim.x, (int)blockIdx.x, (size_t)1024 * 512 * 2, (const __attribute__((address_space(3))) int*)LASP(lds + LDS_TAB)};
    pg8::EpiBf16 E{(bf16_t*)(ws + WS_YB), 1024};
    pg8::gemm_phase<pg8::EpiBf16, pg8::SchedExp, true>(LASP(lds), S, E);
}

#include <hip/hip_bf16.h>
namespace attn64 {
using bf16=__hip_bfloat16;
using bf16x8=__attribute__((ext_vector_type(8)))short;
using s16x4=__attribute__((ext_vector_type(4)))short;
using f32x16=__attribute__((ext_vector_type(16)))float;
using u32x4=__attribute__((ext_vector_type(4)))unsigned;
constexpr int SEQ=4096,D=64;
constexpr int NW=8,QBLK=32,QB=QBLK*NW,KVBLK=64,NQB=SEQ/QB;
constexpr int ATTN_UNIT_ROWS=QB;
__device__ __forceinline__ int crow(int r,int hi){return (r&3)+8*(r>>2)+4*hi;}
#define SBAR() __builtin_amdgcn_sched_barrier(0)
__device__ __forceinline__ void cmask(f32x16&p0,f32x16&p1,int jb,int qrel,int hi){
  const float NEG=-INFINITY; const int dq=qrel-64*jb-4*hi;
  #pragma unroll
  for(int r=0;r<16;++r){const int c=(r&3)+8*(r>>2); if(c>dq)p0[r]=NEG; if(c+32>dq)p1[r]=NEG;}
}

constexpr int NSLOT=3, SLOTB=8192;
constexpr int LDS_K=0, LDS_V=NSLOT*SLOTB, LDS_WS=2*NSLOT*SLOTB, LDS_OST=LDS_WS+NW*64*4, LDS_BYTES=LDS_OST+NW*4096;
constexpr float C2=0.125f*1.4426950408889634f;
__device__ __forceinline__ void glds16(const void*gsrc,unsigned lds_dst){unsigned keep;
  asm volatile("s_mov_b32 %0, m0\n\ts_mov_b32 m0, %2\n\ts_nop 0\n\tglobal_load_lds_dwordx4 %1, off\n\ts_mov_b32 m0, %0":"=&s"(keep):"v"(gsrc),"s"(lds_dst):"memory");}
__device__ __forceinline__ float max3f(float a,float b,float c){float r;asm("v_max3_f32 %0, %1, %2, %3":"=v"(r):"v"(a),"v"(b),"v"(c));return r;}
__device__ __forceinline__ float max2f(float a,float b){float r;asm("v_max_f32_e32 %0, %1, %2":"=v"(r):"v"(a),"v"(b));return r;}
__device__ __forceinline__ float fadd_s(float a,float b){float r;asm("v_add_f32_e32 %0, %1, %2":"=v"(r):"v"(a),"v"(b));return r;}
__device__ __forceinline__ float fsub_s(float a,float b){float r;asm("v_sub_f32_e32 %0, %1, %2":"=v"(r):"v"(a),"v"(b));return r;}
typedef float f32x2_t __attribute__((ext_vector_type(2))); typedef __bf16 bf16x2_t __attribute__((ext_vector_type(2)));
__device__ __forceinline__ unsigned cvtpk_s(float lo,float hi){f32x2_t v={lo,hi};bf16x2_t b=__builtin_convertvector(v,bf16x2_t);return __builtin_bit_cast(unsigned,b);}
#define WAIT_BAR(N) asm volatile("s_waitcnt vmcnt(" #N ") lgkmcnt(0)\n\ts_barrier":::"memory")

__device__ __forceinline__ void qkt(f32x16&p0,f32x16&p1,const char*Kslot,const bf16x8*qr,const f32x16&negm,int r32,int hi){
  const char*kb=Kslot+hi*1024+r32*16;
  #pragma unroll
  for(int d0=0;d0<4;++d0){
    const bf16x8 b0=*reinterpret_cast<const bf16x8*>(kb+d0*2048);
    const bf16x8 b1=*reinterpret_cast<const bf16x8*>(kb+d0*2048+512);
    if(d0==0){p0=__builtin_amdgcn_mfma_f32_32x32x16_bf16(b0,qr[0],negm,0,0,0);p1=__builtin_amdgcn_mfma_f32_32x32x16_bf16(b1,qr[0],negm,0,0,0);}
    else{p0=__builtin_amdgcn_mfma_f32_32x32x16_bf16(b0,qr[d0],p0,0,0,0);p1=__builtin_amdgcn_mfma_f32_32x32x16_bf16(b1,qr[d0],p1,0,0,0);}}
}
typedef __attribute__((address_space(3))) const char* lds_cptr;
typedef short v4i16_t __attribute__((ext_vector_type(4)));
__device__ __forceinline__ void kload8(bf16x8*kf,lds_cptr kp){
  kf[0]=*(const __attribute__((address_space(3))) bf16x8*)(kp);      kf[1]=*(const __attribute__((address_space(3))) bf16x8*)(kp+512);
  kf[2]=*(const __attribute__((address_space(3))) bf16x8*)(kp+2048); kf[3]=*(const __attribute__((address_space(3))) bf16x8*)(kp+2560);
  kf[4]=*(const __attribute__((address_space(3))) bf16x8*)(kp+4096); kf[5]=*(const __attribute__((address_space(3))) bf16x8*)(kp+4608);
  kf[6]=*(const __attribute__((address_space(3))) bf16x8*)(kp+6144); kf[7]=*(const __attribute__((address_space(3))) bf16x8*)(kp+6656);
}
__device__ __forceinline__ void kload2(bf16x8*kf,lds_cptr kp,int j){ kf[2*j]=*(const __attribute__((address_space(3))) bf16x8*)(kp+j*2048); kf[2*j+1]=*(const __attribute__((address_space(3))) bf16x8*)(kp+j*2048+512); }
__device__ __forceinline__ s16x4 vtr(lds_cptr p){ return __builtin_bit_cast(s16x4,__builtin_amdgcn_ds_read_tr16_b64_v4i16((__attribute__((address_space(3))) v4i16_t*)p)); }
__device__ __forceinline__ float rowmax(const f32x16&p0,const f32x16&p1){
  float a=max3f(p0[0],p0[1],p1[0]),b=max3f(p0[2],p0[3],p1[1]);a=max3f(a,p1[2],p1[3]);
  #pragma unroll
  for(int r=4;r<16;r+=4){a=max3f(a,p0[r],p0[r+1]);b=max3f(b,p0[r+2],p0[r+3]);a=max3f(a,p1[r],p1[r+1]);b=max3f(b,p1[r+2],p1[r+3]);}
  const float m=max2f(a,b);
  auto rr=__builtin_amdgcn_permlane32_swap(__float_as_uint(m),__float_as_uint(m),false,false);
  return max2f(__uint_as_float(rr[0]),__uint_as_float(rr[1]));
}
__device__ __forceinline__ void pv(f32x16*o,int vb,bf16x8 pa0,bf16x8 pa1,bf16x8 pa2,bf16x8 pa3){
  #pragma unroll
  for(int d0=0;d0<2;++d0){s16x4 lo[4],hi[4];
    #pragma unroll
    for(int ks=0;ks<4;++ks){
      asm volatile("ds_read_b64_tr_b16 %0,%1 offset:%c2":"=&v"(lo[ks]):"v"(vb),"i"(d0*4096+ks*1024):"memory");
      asm volatile("ds_read_b64_tr_b16 %0,%1 offset:%c2":"=&v"(hi[ks]):"v"(vb),"i"(d0*4096+ks*1024+512):"memory");}
    asm volatile("s_waitcnt lgkmcnt(0)":::"memory");SBAR();
    #define PK(k) (bf16x8){lo[k][0],lo[k][1],lo[k][2],lo[k][3],hi[k][0],hi[k][1],hi[k][2],hi[k][3]}
    o[d0]=__builtin_amdgcn_mfma_f32_32x32x16_bf16(pa0,PK(0),o[d0],0,0,0);
    o[d0]=__builtin_amdgcn_mfma_f32_32x32x16_bf16(pa1,PK(1),o[d0],0,0,0);
    o[d0]=__builtin_amdgcn_mfma_f32_32x32x16_bf16(pa2,PK(2),o[d0],0,0,0);
    o[d0]=__builtin_amdgcn_mfma_f32_32x32x16_bf16(pa3,PK(3),o[d0],0,0,0);
    #undef PK
  }
}

#ifndef ATTN_STORE16
#define ATTN_STORE16(p,v) (*(u32x4*)(p)=(v))
#endif
template<int THRL,int PQ,int PK,int PV,int PO> __device__ __forceinline__ void attn_unit(int qb,const bf16*Qs,const bf16*__restrict__ Ks,const bf16*__restrict__ Vs,bf16*Os,char*shm){
  const int tid=threadIdx.x,lane=tid&63,r32=lane&31,hi=lane>>5; const int wid=__builtin_amdgcn_readfirstlane(tid>>6);
  const int q0=qb*QB;
  const bf16*Qw=Qs+(long)(q0+wid*QBLK)*PQ;
  const bf16*Kh=Ks,*Vh=Vs;
  const unsigned lds0=(unsigned)(uintptr_t)shm;
  float*wsf=(float*)(shm+LDS_WS)+wid*64;
  const bf16*ksrc=Kh+(long)lane*PK+wid*8;
  const bf16*vsrc=Vh+(long)(16*(wid&3)+(lane>>2))*PV+(wid>>2)*32+(lane&3)*8;
  const unsigned kdst=lds0+LDS_K+wid*1024, vdst=lds0+LDS_V+wid*1024;
  #define DMA_K(t,slot) glds16(ksrc+(long)(t)*KVBLK*PK,(unsigned)__builtin_amdgcn_readfirstlane(kdst+(slot)))
  #define DMA_V(t,slot) glds16(vsrc+(long)(t)*KVBLK*PV,(unsigned)__builtin_amdgcn_readfirstlane(vdst+(slot)))
  const int vb0=(int)(lds0+LDS_V)+((lane>>4)&1)*32+(lane&3)*8+(4*hi+((lane&15)>>2))*64;
  const char*Kbase=shm+LDS_K; bf16x8 kf[8];
  const lds_cptr shm3=(lds_cptr)shm; const lds_cptr kp0=shm3+LDS_K+hi*1024+r32*16; const lds_cptr vp0=shm3+LDS_V+((lane>>4)&1)*32+(lane&3)*8+(4*hi+((lane&15)>>2))*64;
  const int NT=(q0+QB)/KVBLK;
  DMA_K(0,0);DMA_V(0,0);DMA_K(1,SLOTB);
  bf16x8 qr[4];
  #pragma unroll
  for(int d0=0;d0<4;++d0)qr[d0]=*reinterpret_cast<const bf16x8*>(&Qw[(long)r32*PQ+d0*16+hi*8]);
  float mhat=0.f,l_reg=0.f;f32x16 o[2];f32x16 negm;{float z_=0.f;asm volatile("":"+v"(z_));
  _Pragma("unroll") for(int r=0;r<16;++r){o[0][r]=z_;o[1][r]=z_;negm[r]=z_;}}asm volatile("":"+v"(negm));
  const int qrel=wid*QBLK+r32;
  #define CMASK(P0,P1,t) do{int jb_=(t)-(NT-4); if(jb_>=0)cmask(P0,P1,jb_,qrel,hi);}while(0)
  bool resc=false;
  #define START(P0,P1) do{ const float rm=rowmax(P0,P1); resc=false; \
    { const float dl=rm; mhat=fadd_s(mhat,dl); \
      _Pragma("unroll") for(int r=0;r<16;++r){P0[r]=fsub_s(P0[r],dl);P1[r]=fsub_s(P1[r],dl);} \
      _Pragma("unroll") for(int r=0;r<16;++r)negm[r]=-mhat; asm volatile("":"+v"(negm)); } \
    _Pragma("unroll") for(int r=0;r<16;++r)P0[r]=__builtin_amdgcn_exp2f(P0[r]); }while(0)
  #define RESC() do{ if(resc){ asm volatile("s_waitcnt lgkmcnt(0)":::"memory"); \
      _Pragma("unroll") for(int d_=0;d_<2;++d_) _Pragma("unroll") for(int r=0;r<16;++r)o[d_][r]*=wsf[crow(r,hi)]; } }while(0)
  f32x16 pA0,pA1,pB0,pB1;
  int sl_prev=0,sl_cur=0,sl_next=SLOTB;
  #define ROT() do{sl_prev=sl_cur;sl_cur=sl_next;sl_next=(sl_next==(NSLOT-1)*SLOTB)?0:sl_next+SLOTB;}while(0)
  DMA_K(2,2*SLOTB);
  WAIT_BAR(3);
  qkt(pA0,pA1,Kbase,qr,negm,r32,hi);asm volatile("s_nop 15\n\ts_nop 7":"+v"(pA0),"+v"(pA1));CMASK(pA0,pA1,0);
  START(pA0,pA1);
  _Pragma("unroll") for(int r=0;r<16;++r)pA1[r]=__builtin_amdgcn_exp2f(pA1[r]);
  WAIT_BAR(0);
  DMA_K(3,0);DMA_V(1,SLOTB);
  ROT();
  kload8(kf,kp0+sl_cur);
  WAIT_BAR(2);
  s16x4 vlo[8],vhi[8]; u32x4 pw0,pw1,pw2,pw3;
  #define PKW(P,B) cvtpk_s(P[B],P[B+1])
  #define PAF(k) __builtin_bit_cast(bf16x8,pw##k)
  #define VFR(i) (bf16x8){vlo[i][0],vlo[i][1],vlo[i][2],vlo[i][3],vhi[i][0],vhi[i][1],vhi[i][2],vhi[i][3]}
  #define PIN(x) asm volatile("":"+v"(x))
  #define MX3(a,b,c) __builtin_fmaxf(__builtin_fmaxf((a),(b)),(c))
  #define GAPA(MF,A0,A1,A2,A3,W0,W1,PW) do{ MF; sacc+=A0; sacc+=A1; sacc+=A2; sacc+=A3; PIN(sacc); W0; W1; PIN(PW); SBAR(); }while(0)
  #define EX(v) __builtin_amdgcn_exp2f(v)
  #define GAPB(MF,X,B) do{ MF; X[B]=EX(X[B]); X[B+1]=EX(X[B+1]); X[B+2]=EX(X[B+2]); X[B+3]=EX(X[B+3]); PIN(X); SBAR(); }while(0)
  #define VRD(i) do{ vlo[i]=vtr(vp_+(((i)>>2)*4096+((i)&3)*1024)); vhi[i]=vtr(vp_+(((i)>>2)*4096+((i)&3)*1024+512)); }while(0)
  #define KRD(G,j) do{ if(G){ kload2(kf,kp0+sl_next,j); SBAR(); } }while(0)
  #define STEP(C0,C1,P0,P1,t,GK,GV,GL) do{ SBAR(); \
    const lds_cptr vp_=vp0+sl_prev; \
    VRD(0); SBAR(); float sacc=(P0[0]+P0[1]); \
    GAPA(C0=__builtin_amdgcn_mfma_f32_32x32x16_bf16(kf[0],qr[0],negm,0,0,0), P0[2],P0[3],P0[4],P0[5],     pw0[0]=PKW(P0,0), pw0[1]=PKW(P0,2), pw0); \
    VRD(4); SBAR(); GAPA(C1=__builtin_amdgcn_mfma_f32_32x32x16_bf16(kf[1],qr[0],negm,0,0,0), P0[6],P0[7],P0[8],P0[9],     pw0[2]=PKW(P0,4), pw0[3]=PKW(P0,6), pw0); \
    VRD(1); SBAR(); GAPA(C0=__builtin_amdgcn_mfma_f32_32x32x16_bf16(kf[2],qr[1],C0,0,0,0),   P0[10],P0[11],P0[12],P0[13], pw1[0]=PKW(P0,8), pw1[1]=PKW(P0,10), pw1); \
    VRD(5); SBAR(); GAPA(C1=__builtin_amdgcn_mfma_f32_32x32x16_bf16(kf[3],qr[1],C1,0,0,0),   P0[14],P0[15],P1[0],P1[1],   pw1[2]=PKW(P0,12),pw1[3]=PKW(P0,14), pw1); \
    VRD(2); SBAR(); GAPA(C0=__builtin_amdgcn_mfma_f32_32x32x16_bf16(kf[4],qr[2],C0,0,0,0),   P1[2],P1[3],P1[4],P1[5],     pw2[0]=PKW(P1,0), pw2[1]=PKW(P1,2), pw2); \
    VRD(6); SBAR(); GAPA(C1=__builtin_amdgcn_mfma_f32_32x32x16_bf16(kf[5],qr[2],C1,0,0,0),   P1[6],P1[7],P1[8],P1[9],     pw2[2]=PKW(P1,4), pw2[3]=PKW(P1,6), pw2); \
    VRD(3); SBAR(); GAPA(C0=__builtin_amdgcn_mfma_f32_32x32x16_bf16(kf[6],qr[3],C0,0,0,0),   P1[10],P1[11],P1[12],P1[13], pw3[0]=PKW(P1,8), pw3[1]=PKW(P1,10), pw3); \
    VRD(7); SBAR(); GAPA(C1=__builtin_amdgcn_mfma_f32_32x32x16_bf16(kf[7],qr[3],C1,0,0,0),   P1[14],P1[15],0.f,0.f,       pw3[2]=PKW(P1,12),pw3[3]=PKW(P1,14), pw3); \
    l_reg+=sacc; \
    if(GK){DMA_K((t)+3,sl_cur);} if(GV){DMA_V((t)+1,sl_next);} \
    CMASK(C0,C1,t); \
    { float a=MX3(C0[0],C0[1],C1[0]),b=MX3(C0[2],C0[3],C1[1]); a=MX3(a,C1[2],C1[3]); \
      _Pragma("unroll") for(int r=4;r<16;r+=4){a=MX3(a,C0[r],C0[r+1]);b=MX3(b,C0[r+2],C0[r+3]);a=MX3(a,C1[r],C1[r+1]);b=MX3(b,C1[r+2],C1[r+3]);} \
      float rm=__builtin_fmaxf(a,b); { auto rr=__builtin_amdgcn_permlane32_swap(__float_as_uint(rm),__float_as_uint(rm),false,false); rm=__builtin_fmaxf(__uint_as_float(rr[0]),__uint_as_float(rr[1])); } \
      resc=false; \
      if(__builtin_expect(__any(rm>(float)THRL),0)){ const float dl=__builtin_fmaxf(rm,0.f); mhat+=dl; \
        _Pragma("unroll") for(int r=0;r<16;++r){C0[r]-=dl;C1[r]-=dl;} \
        _Pragma("unroll") for(int r=0;r<16;++r)negm[r]=-mhat; asm volatile("":"+v"(negm)); \
        const float f=__builtin_amdgcn_exp2f(-dl); l_reg*=f; if(hi==0)wsf[r32]=f; resc=true; } } \
    SBAR(); \
    GAPB(o[0]=__builtin_amdgcn_mfma_f32_32x32x16_bf16(PAF(0),VFR(0),o[0],0,0,0), C0,0); \
    GAPB(o[1]=__builtin_amdgcn_mfma_f32_32x32x16_bf16(PAF(0),VFR(4),o[1],0,0,0), C0,4); \
    KRD(GL,0); GAPB(o[0]=__builtin_amdgcn_mfma_f32_32x32x16_bf16(PAF(1),VFR(1),o[0],0,0,0), C0,8); \
    KRD(GL,1); GAPB(o[1]=__builtin_amdgcn_mfma_f32_32x32x16_bf16(PAF(1),VFR(5),o[1],0,0,0), C0,12); \
    KRD(GL,2); GAPB(o[0]=__builtin_amdgcn_mfma_f32_32x32x16_bf16(PAF(2),VFR(2),o[0],0,0,0), C1,0); \
    KRD(GL,3); GAPB(o[1]=__builtin_amdgcn_mfma_f32_32x32x16_bf16(PAF(2),VFR(6),o[1],0,0,0), C1,4); \
    GAPB(o[0]=__builtin_amdgcn_mfma_f32_32x32x16_bf16(PAF(3),VFR(3),o[0],0,0,0), C1,8); \
    GAPB(o[1]=__builtin_amdgcn_mfma_f32_32x32x16_bf16(PAF(3),VFR(7),o[1],0,0,0), C1,12); \
    }while(0)
  int t=1;
  #undef CMASK
  #define CMASK(P0,P1,t) do{}while(0)
  for(;t+5<NT;t+=2){
    STEP(pB0,pB1,pA0,pA1,t,true,true,true);     WAIT_BAR(2); RESC(); ROT();
    STEP(pA0,pA1,pB0,pB1,t+1,true,true,true);   WAIT_BAR(2); RESC(); ROT();
  }
  #undef CMASK
  #define CMASK(P0,P1,t) do{int jb_=(t)-(NT-4); if(jb_>=0)cmask(P0,P1,jb_,qrel,hi);}while(0)
  #define ENDW(tt) do{ if((tt)+3<NT){WAIT_BAR(2);} else if((tt)+2<NT){WAIT_BAR(1);} else {WAIT_BAR(0);} }while(0)
  for(;t+1<NT;t+=2){
    STEP(pB0,pB1,pA0,pA1,t,(t+3<NT),(t+1<NT),(t+1<NT));       ENDW(t);   RESC(); ROT();
    STEP(pA0,pA1,pB0,pB1,t+1,(t+4<NT),(t+2<NT),(t+2<NT));     ENDW(t+1); RESC(); ROT();
  }
  STEP(pB0,pB1,pA0,pA1,NT-1,false,false,false); RESC();
  { float sacc=pB0[0]+pB0[1]; _Pragma("unroll") for(int r=2;r<16;++r)sacc+=pB0[r]; _Pragma("unroll") for(int r=0;r<16;++r)sacc+=pB1[r]; l_reg+=sacc;
    pw0=(u32x4){PKW(pB0,0),PKW(pB0,2),PKW(pB0,4),PKW(pB0,6)};pw1=(u32x4){PKW(pB0,8),PKW(pB0,10),PKW(pB0,12),PKW(pB0,14)};pw2=(u32x4){PKW(pB1,0),PKW(pB1,2),PKW(pB1,4),PKW(pB1,6)};pw3=(u32x4){PKW(pB1,8),PKW(pB1,10),PKW(pB1,12),PKW(pB1,14)};
    SBAR(); pv(o,vb0+sl_cur,PAF(0),PAF(1),PAF(2),PAF(3)); }
  #undef PKW
  #undef PAF
  #undef VFR
  #undef PIN
  #undef MX3
  #undef GAPA
  #undef GAPB
  #undef EX
  #undef VRD
  #undef KRD
  #undef STEP
  #undef ENDW
  {auto rr=__builtin_amdgcn_permlane32_swap(__float_as_uint(l_reg),__float_as_uint(l_reg),false,false);l_reg=__uint_as_float(rr[0])+__uint_as_float(rr[1]);}
  if(hi==0)wsf[32+r32]=l_reg;asm volatile("s_waitcnt lgkmcnt(0)":::"memory");
  float rli[16];
  #pragma unroll
  for(int r=0;r<16;++r)rli[r]=__builtin_amdgcn_rcpf(wsf[32+crow(r,hi)]);
  bf16*Ow=Os+(long)(q0+wid*QBLK)*PO;
  { bf16*stg=(bf16*)(shm+LDS_OST)+wid*2048;
    #pragma unroll
    for(int r=0;r<16;++r){const int orow=crow(r,hi);
      #pragma unroll
      for(int d0=0;d0<2;++d0)stg[orow*64+d0*32+r32]=__float2bfloat16(o[d0][r]*rli[r]);}
    asm volatile("s_waitcnt lgkmcnt(0)":::"memory");
    #pragma unroll
    for(int i=0;i<4;++i){const int row=i*8+(lane>>3),ch=lane&7; const u32x4 v=*(const u32x4*)(stg+row*64+ch*8); ATTN_STORE16(Ow+(long)row*PO+ch*8,v);} }
  asm volatile("s_waitcnt lgkmcnt(0)\n\ts_barrier":::"memory");
  #undef DMA_K
  #undef DMA_V
  #undef CMASK
  #undef START
  #undef RESC
  #undef ROT
}
constexpr int ATTN_LDS_BYTES=LDS_BYTES;
#undef SBAR
#undef WAIT_BAR
}

__device__ __forceinline__ void phase_diffattn(const Params& p, unsigned char* lds) {
    using attn64::bf16; unsigned char* ws = p.ws;
    const bf16* DQK = (const bf16*)(ws + WS_DQK); const bf16* DV = (const bf16*)(ws + WS_DV); bf16* O12 = (bf16*)p.out + (size_t)NTOK * 1024;
    const int G = gridDim.x, bx = blockIdx.x; const int vcu = (G % 8 == 0) ? (bx % 8) * (G / 8) + bx / 8 : bx;
    for (int vh = vcu; vh < 256; vh += G) {
        const int bh = vh >> 2, run = vh & 3, b = bh >> 2, h = bh & 3; const size_t row0 = (size_t)b * SEQ;
        const bf16* Qs = DQK + row0 * 1024 + (run >> 1) * 256 + h * 64; const bf16* Ks = DQK + row0 * 1024 + 512 + (run >> 1) * 256 + h * 64;
        const bf16* Vs = DV + row0 * 512 + h * 128 + (run & 1) * 64; bf16* Os = O12 + row0 * 1024 + h * 256 + run * 64;
        for (int qb = 15; qb >= 0; --qb) attn64::attn_unit<8, 1024, 1024, 512, 1024>(qb, Qs, Ks, Vs, Os, (char*)lds);
    }
}
__device__ __forceinline__ void phase_diffcombine(const Params& p, unsigned char* lds) {
    unsigned char* ws = p.ws; const bf16_t* O12 = (const bf16_t*)p.out + (size_t)NTOK * 1024; bf16_t* Y = (bf16_t*)(ws + WS_Y);
    const float lam = ((const float*)(ws + WS_SCAL))[512]; const float* sub_gain = (const float*)p.in[11];
    const int lane = threadIdx.x & 63, wave = threadIdx.x >> 6; const int gw = blockIdx.x * 8 + wave, ngw = gridDim.x * 8;
    const int h = lane >> 4, d0 = (lane & 15) * 8;
    float gn[8];
#pragma unroll
    for (int e = 0; e < 8; ++e) gn[e] = sub_gain[d0 + e] * (1.f - LAM_INIT);
    for (int t = gw; t < NTOK; t += ngw) {
        const u32x4 a = *(const u32x4*)(O12 + (size_t)t * 1024 + h * 256 + d0), b = *(const u32x4*)(O12 + (size_t)t * 1024 + h * 256 + 128 + d0);
        float o1[8], o2[8], o[8]; pg8::unpack8(a, o1); pg8::unpack8(b, o2); float sq = 0.f;
#pragma unroll
        for (int e = 0; e < 8; ++e) { o[e] = o1[e] - lam * o2[e]; sq += o[e] * o[e]; }
        sq += __shfl_xor(sq, 1); sq += __shfl_xor(sq, 2); sq += __shfl_xor(sq, 4); sq += __shfl_xor(sq, 8);
        const float rs = rsqrtf(sq * (1.f / 128.f) + RMS_EPS);
        u32x4 w; w.x = pk2(o[0] * rs * gn[0], o[1] * rs * gn[1]); w.y = pk2(o[2] * rs * gn[2], o[3] * rs * gn[3]); w.z = pk2(o[4] * rs * gn[4], o[5] * rs * gn[5]); w.w = pk2(o[6] * rs * gn[6], o[7] * rs * gn[7]);
        *(u32x4*)(Y + (size_t)t * 1536 + 512 + h * 128 + d0) = w;
    }
}

namespace attnd {
using bf16 = __hip_bfloat16;
constexpr int D = 128, NW = 8, QBLK = 32, KVBLK = 64;
constexpr float SCALE = 0.088388347648318440f;
constexpr float THR = 8.f;
constexpr int SDEPTH = 2;
constexpr int LDQ = 512, LDK = 1024, LDO = 1536;
constexpr size_t SHM_V = KVBLK * D * 2, SHM_K = KVBLK * D * 2, SHM_ATTN = 2 * SHM_V + 2 * SHM_K + NW * 64 * 4;
using bf16x8 = __attribute__((ext_vector_type(8))) short;
using s16x4  = __attribute__((ext_vector_type(4))) short;
using f32x16 = __attribute__((ext_vector_type(16))) float;
using f32x8  = __attribute__((ext_vector_type(8))) float;
using u32x4  = __attribute__((ext_vector_type(4))) unsigned;
#define KSWZ_D(row, colB) ((row) * 256 + ((colB) ^ (((row) & 7) << 4)))
#define SBAR_D() __builtin_amdgcn_sched_barrier(0)
__device__ __forceinline__ int crow(int r, int hi) { return (r & 3) + 8 * (r >> 2) + 4 * hi; }
__device__ __forceinline__ unsigned cvtpk(float lo, float hi) { return pg8::cvt_pk_bf16(lo, hi); }
template <typename TIn> struct Stage;
template <> struct Stage<bf16>  { using T = bf16x8;
  __device__ static __forceinline__ T ld8(const bf16* p) { return *reinterpret_cast<const bf16x8*>(p); }
  __device__ static __forceinline__ bf16x8 tobf(T x) { return x; } };
template <> struct Stage<float> { using T = f32x8;
  __device__ static __forceinline__ T ld8(const float* p) { return *reinterpret_cast<const f32x8*>(p); }
  __device__ static __forceinline__ bf16x8 tobf(T x) {
    u32x4 w = {cvtpk(x[0], x[1]), cvtpk(x[2], x[3]), cvtpk(x[4], x[5]), cvtpk(x[6], x[7])}; return *reinterpret_cast<bf16x8*>(&w); } };

__device__ __forceinline__ void partialSM(f32x16& p0, f32x16& p1, float& m_reg, float& mn, float& alpha) {
  constexpr float C = SCALE * 1.4426950408889634f;
  float pmax = p0[0]; for (int r = 1; r < 16; ++r) pmax = fmaxf(pmax, p0[r]); for (int r = 0; r < 16; ++r) pmax = fmaxf(pmax, p1[r]);
  { auto rr = __builtin_amdgcn_permlane32_swap(__float_as_uint(pmax), __float_as_uint(pmax), false, false);
    pmax = fmaxf(__uint_as_float(rr[0]), __uint_as_float(rr[1])); }
  if (__builtin_expect(__all(pmax - m_reg <= THR / SCALE), 1)) { mn = m_reg; alpha = 1.f; }
  else { mn = fmaxf(m_reg, pmax); alpha = __builtin_amdgcn_exp2f((m_reg - mn) * C); m_reg = mn; }
  float mnC = -mn * C;
  for (int r = 0; r < 16; ++r) p0[r] = fmaf(p0[r], C, mnC); for (int r = 0; r < 16; ++r) p1[r] = fmaf(p1[r], C, mnC);
  for (int r = 0; r < 16; ++r) p0[r] = __builtin_amdgcn_exp2f(p0[r]);
}
__device__ __forceinline__ void finishSM(f32x16& p0, f32x16& p1, float alpha, float& l_reg, bf16x8& pa0, bf16x8& pa1, bf16x8& pa2, bf16x8& pa3) {
  for (int r = 0; r < 16; ++r) p1[r] = __builtin_amdgcn_exp2f(p1[r]);
  float ps = 0; for (int r = 0; r < 16; ++r) ps += p0[r]; for (int r = 0; r < 16; ++r) ps += p1[r];
  { auto rr = __builtin_amdgcn_permlane32_swap(__float_as_uint(ps), __float_as_uint(ps), false, false);
    ps = __uint_as_float(rr[0]) + __uint_as_float(rr[1]); }
  l_reg = l_reg * alpha + ps;
#define PK4(P, BASE, OUT) do { unsigned a0 = cvtpk(P[BASE + 0], P[BASE + 1]), a1 = cvtpk(P[BASE + 2], P[BASE + 3]);   \
    unsigned b0 = cvtpk(P[BASE + 4], P[BASE + 5]), b1 = cvtpk(P[BASE + 6], P[BASE + 7]);                              \
    auto r0 = __builtin_amdgcn_permlane32_swap(a0, b0, false, false); auto r1 = __builtin_amdgcn_permlane32_swap(a1, b1, false, false); \
    u32x4 w = {r0[0], r1[0], r0[1], r1[1]}; OUT = *reinterpret_cast<bf16x8*>(&w); } while (0)
  PK4(p0, 0, pa0); PK4(p0, 8, pa1); PK4(p1, 0, pa2); PK4(p1, 8, pa3);
#undef PK4
}
__device__ __forceinline__ void qkt(f32x16& p0, f32x16& p1, const bf16* Ks, const bf16x8* qr, int r32, int hi) {
  p0 = f32x16{}; p1 = f32x16{};
  for (int d0 = 0; d0 < 8; ++d0) { int cb = (d0 * 16 + hi * 8) * 2;
    bf16x8 b0 = *reinterpret_cast<const bf16x8*>((const char*)Ks + KSWZ_D(r32, cb));
    bf16x8 b1 = *reinterpret_cast<const bf16x8*>((const char*)Ks + KSWZ_D(32 + r32, cb));
    p0 = __builtin_amdgcn_mfma_f32_32x32x16_bf16(b0, qr[d0], p0, 0, 0, 0);
    p1 = __builtin_amdgcn_mfma_f32_32x32x16_bf16(b1, qr[d0], p1, 0, 0, 0); }
}
__device__ __forceinline__ int v_st(int k, int c) { const int kk = (k & ~0xC) | ((k & 4) << 1) | ((k & 8) >> 1); return ((kk >> 3) * 4 + (c >> 5)) * 512 + ((kk & 7) * 32 + (c & 31)) * 2; }
__device__ __forceinline__ int v_rd_base(int lane) { return ((lane & 3) << 3) | (((lane >> 2) & 3) << 6) | (((lane >> 4) & 1) << 5) | (((lane >> 5) & 1) << 8); }
constexpr int v_rd_off(int d0, int ks, int half) { return d0 * 512 + ks * 4096 + half * 2048; }
template <int OFF> __device__ __forceinline__ s16x4 tr_read(int vb) {
  s16x4 r; asm volatile("ds_read_b64_tr_b16 %0, %1 offset:%2" : "=&v"(r) : "v"(vb), "i"(OFF) : "memory"); return r;
}
template <int D0> __device__ __forceinline__ void pv_one(f32x16& od, int vb, bf16x8 pa0, bf16x8 pa1, bf16x8 pa2, bf16x8 pa3) {
  const s16x4 l0 = tr_read<v_rd_off(D0, 0, 0)>(vb), h0 = tr_read<v_rd_off(D0, 0, 1)>(vb), l1 = tr_read<v_rd_off(D0, 1, 0)>(vb), h1 = tr_read<v_rd_off(D0, 1, 1)>(vb);
  const s16x4 l2 = tr_read<v_rd_off(D0, 2, 0)>(vb), h2 = tr_read<v_rd_off(D0, 2, 1)>(vb), l3 = tr_read<v_rd_off(D0, 3, 0)>(vb), h3 = tr_read<v_rd_off(D0, 3, 1)>(vb);
  asm volatile("s_waitcnt lgkmcnt(0)" ::: "memory"); SBAR_D();
#define PK(L, H) (bf16x8){L[0], L[1], L[2], L[3], H[0], H[1], H[2], H[3]}
  od = __builtin_amdgcn_mfma_f32_32x32x16_bf16(pa0, PK(l0, h0), od, 0, 0, 0);
  od = __builtin_amdgcn_mfma_f32_32x32x16_bf16(pa1, PK(l1, h1), od, 0, 0, 0);
  od = __builtin_amdgcn_mfma_f32_32x32x16_bf16(pa2, PK(l2, h2), od, 0, 0, 0);
  od = __builtin_amdgcn_mfma_f32_32x32x16_bf16(pa3, PK(l3, h3), od, 0, 0, 0);
#undef PK
}
__device__ __forceinline__ void pv_d0(f32x16* o, int vb, bf16x8 pa0, bf16x8 pa1, bf16x8 pa2, bf16x8 pa3) {
  pv_one<0>(o[0], vb, pa0, pa1, pa2, pa3); pv_one<1>(o[1], vb, pa0, pa1, pa2, pa3); pv_one<2>(o[2], vb, pa0, pa1, pa2, pa3); pv_one<3>(o[3], vb, pa0, pa1, pa2, pa3);
}

template <typename TQ>
__device__ __forceinline__ void attn_dense_body(const TQ* __restrict__ Qb, const bf16* __restrict__ Kh, const bf16* __restrict__ Vh,
                                                bf16* __restrict__ Ob, int seq, char* lds) {
  using St = Stage<bf16>; using SQ = Stage<TQ>;
  const int tid = threadIdx.x, wid = tid >> 6, lane = tid & 63, r32 = lane & 31, hi = lane >> 5;
  bf16* V_lds = (bf16*)lds; bf16* K_lds = (bf16*)(lds + 2 * SHM_V);
  float* ws = (float*)(lds + 2 * SHM_V + 2 * SHM_K) + wid * 64; float* li_l = ws; float* al_l = ws + 32;
  float m_reg = -1e30f, l_reg = 0; f32x16 o[4] = {}; bf16x8 qr[8];
  const TQ* Qw = Qb + (long)(wid * QBLK + r32) * LDQ + hi * 8;
#pragma unroll
  for (int d0 = 0; d0 < 8; ++d0) qr[d0] = SQ::tobf(SQ::ld8(Qw + d0 * 16));
  const int sr = tid >> 4, sc = (tid & 15) * 8, vst0 = v_st(sr, sc), vst1 = v_st(32 + sr, sc);
  const int vb0 = (int)(uintptr_t)V_lds + v_rd_base(lane);
  struct { typename St::T vs0, vs1, ks0, ks1; } sr_[SDEPTH];
#define SLOAD(i, k0) do { sr_[i].vs0 = St::ld8(&Vh[(long)((k0) + sr) * LDK + sc]); sr_[i].vs1 = St::ld8(&Vh[(long)((k0) + 32 + sr) * LDK + sc]); \
    sr_[i].ks0 = St::ld8(&Kh[(long)((k0) + sr) * LDK + sc]); sr_[i].ks1 = St::ld8(&Kh[(long)((k0) + 32 + sr) * LDK + sc]); } while (0)
#define SWRITE(b, i) do { *(bf16x8*)((char*)V_lds + (b) * SHM_V + vst0) = St::tobf(sr_[i].vs0);          \
    *(bf16x8*)((char*)V_lds + (b) * SHM_V + vst1) = St::tobf(sr_[i].vs1); int kc = sc * 2;               \
    *(bf16x8*)((char*)K_lds + (b) * SHM_K + KSWZ_D(sr, kc)) = St::tobf(sr_[i].ks0);                       \
    *(bf16x8*)((char*)K_lds + (b) * SHM_K + KSWZ_D(32 + sr, kc)) = St::tobf(sr_[i].ks1); } while (0)
#define SWAIT() do { if constexpr (SDEPTH == 2) asm volatile("s_waitcnt vmcnt(4)" ::: "memory"); else asm volatile("s_waitcnt vmcnt(0)" ::: "memory"); } while (0)
#define RESC(a) do { if (__any((a) < 1.f)) { if (hi == 0) al_l[r32] = (a); asm volatile("s_waitcnt lgkmcnt(0)" ::: "memory"); \
    for (int d = 0; d < 4; ++d) for (int r = 0; r < 16; ++r) o[d][r] *= al_l[crow(r, hi)]; } } while (0)
  f32x16 pA0, pA1, pB0, pB1; float mnA, mnB, alA, alB; bf16x8 pa0, pa1, pa2, pa3; const int NT = seq / KVBLK;
  constexpr int SE = 0, SO = SDEPTH - 1;
  SLOAD(SE, 0); asm volatile("s_waitcnt vmcnt(0)" ::: "memory"); SWRITE(0, SE); __syncthreads();
  qkt(pA0, pA1, K_lds, qr, r32, hi); partialSM(pA0, pA1, m_reg, mnA, alA);
  SLOAD(SO, KVBLK); if constexpr (SDEPTH == 2) { if (2 < NT) SLOAD(SE, 2 * KVBLK); }
  SWAIT(); SWRITE(1, SO); __syncthreads();
  for (int j = 1; j + 1 < NT; j += 2) {
    SBAR_D(); qkt(pB0, pB1, (bf16*)((char*)K_lds + SHM_K), qr, r32, hi);
    finishSM(pA0, pA1, alA, l_reg, pa0, pa1, pa2, pa3); SBAR_D();
    SLOAD(SO, (j + SDEPTH) * KVBLK); SBAR_D();
    pv_d0(o, vb0, pa0, pa1, pa2, pa3); partialSM(pB0, pB1, m_reg, mnB, alB);
    __syncthreads(); SWAIT(); SWRITE(0, SE);
    RESC(alB); __syncthreads();
    SBAR_D(); qkt(pA0, pA1, K_lds, qr, r32, hi);
    finishSM(pB0, pB1, alB, l_reg, pa0, pa1, pa2, pa3); SBAR_D();
    if (SDEPTH == 1 || j + 3 < NT) SLOAD(SE, (j + 1 + SDEPTH) * KVBLK); SBAR_D();
    pv_d0(o, vb0 + (int)SHM_V, pa0, pa1, pa2, pa3); partialSM(pA0, pA1, m_reg, mnA, alA);
    __syncthreads(); SWAIT(); SWRITE(1, SO);
    RESC(alA); __syncthreads();
  }
  SBAR_D(); qkt(pB0, pB1, (bf16*)((char*)K_lds + SHM_K), qr, r32, hi);
  finishSM(pA0, pA1, alA, l_reg, pa0, pa1, pa2, pa3); SBAR_D();
  pv_d0(o, vb0, pa0, pa1, pa2, pa3); partialSM(pB0, pB1, m_reg, mnB, alB);
  __syncthreads(); RESC(alB);
  finishSM(pB0, pB1, alB, l_reg, pa0, pa1, pa2, pa3); SBAR_D();
  pv_d0(o, vb0 + (int)SHM_V, pa0, pa1, pa2, pa3);
  if (hi == 0) li_l[r32] = l_reg; asm volatile("s_waitcnt lgkmcnt(0)" ::: "memory");
  float rli[16];
#pragma unroll
  for (int r = 0; r < 16; ++r) rli[r] = __builtin_amdgcn_rcpf(li_l[crow(r, hi)]);
  bf16* Ow = Ob + (long)(wid * QBLK) * LDO;
#pragma unroll
  for (int r = 0; r < 16; ++r) { int orow = crow(r, hi);
    for (int d0 = 0; d0 < 4; ++d0) Ow[(long)orow * LDO + d0 * 32 + r32] = __float2bfloat16(o[d0][r] * rli[r]); }
#undef SLOAD
#undef SWRITE
#undef SWAIT
#undef RESC
}

}
__device__ __forceinline__ void phase_memattn(const Params& p, unsigned char* lds) {
    using attnd::bf16; unsigned char* ws = p.ws; const bf16* MQ = (const bf16*)(ws + WS_MQ); const bf16* MKV = (const bf16*)(ws + WS_MKV); bf16* Y = (bf16*)(ws + WS_Y);
    const int G = gridDim.x, bx = blockIdx.x; const int vcu = (G % 8 == 0) ? (bx % 8) * (G / 8) + bx / 8 : bx;
    for (int u = vcu; u < NBATCH * 4 * 16; u += G) {
        const int qb = u & 15, bh = u >> 4, b = bh >> 2, h = bh & 3; const size_t m0 = (size_t)b * SEQ + qb * 256;
        attnd::attn_dense_body<bf16>(MQ + m0 * 512 + h * 128, MKV + (size_t)b * NMEM * 1024 + h * 128, MKV + (size_t)b * NMEM * 1024 + 512 + h * 128, Y + m0 * 1536 + 1024 + h * 128, NMEM, (char*)lds);
        __syncthreads();
    }
}

namespace hg {
constexpr int ROWQ = 272, ROWT = 144;
constexpr int L_QR = 0, L_FR = 17408, L_VR = 34816, L_VT = 52224, L_KT = 70656, L_TOT = 89088, L_SSQ = 91136;
__device__ __forceinline__ void load_tile(unsigned char* dst, const bf16_t* src, int tid) {
    const int r = tid >> 3, c = tid & 7;
    const u32x4 a = *(const u32x4*)(src + (size_t)r * 2048 + c * 8), b = *(const u32x4*)(src + (size_t)r * 2048 + 64 + c * 8);
    *(u32x4*)(dst + r * ROWQ + c * 16) = a; *(u32x4*)(dst + r * ROWQ + 128 + c * 16) = b;
}
__device__ __forceinline__ u32x4 pack8(const float* v) { u32x4 w; w.x = pk2(v[0], v[1]); w.y = pk2(v[2], v[3]); w.z = pk2(v[4], v[5]); w.w = pk2(v[6], v[7]); return w; }
__device__ __forceinline__ void gate_scan(unsigned char* lds, int k, int seg, float lbv, float (&kk)[16], float (&cs)[16], float& offset, float& total) {
    float run = 0.f;
#pragma unroll
    for (int i = 0; i < 16; ++i) { const float fp = bf2f(*(const bf16_t*)(lds + L_FR + (16 * seg + i) * ROWQ + k * 2)); const float sg = sigmoidf_(fp);
        const float f = lbv + (1.f - lbv) * sg; kk[i] = (1.f - lbv) * (1.f - sg); run += __logf(f); cs[i] = run; }
    float* tot = (float*)(lds + L_TOT); tot[seg * 128 + k] = run;
    __syncthreads();
    const float t0 = tot[k], t1 = tot[128 + k], t2 = tot[256 + k], t3 = tot[384 + k];
    offset = (seg > 0 ? t0 : 0.f) + (seg > 1 ? t1 : 0.f) + (seg > 2 ? t2 : 0.f); total = (t0 + t1) + (t2 + t3);
}
__device__ __forceinline__ void write_vt(unsigned char* lds, int k, int seg) {
    float v[16];
#pragma unroll
    for (int i = 0; i < 16; ++i) v[i] = bf2f(*(const bf16_t*)(lds + L_VR + (16 * seg + i) * ROWQ + k * 2));
    *(u32x4*)(lds + L_VT + k * ROWT + seg * 32) = pack8(v); *(u32x4*)(lds + L_VT + k * ROWT + seg * 32 + 16) = pack8(v + 8);
}
}
__device__ __forceinline__ void phase_hgrn_A(const Params& p, unsigned char* lds) {
    using namespace hg; unsigned char* ws = p.ws; const bf16_t* HG = (const bf16_t*)(ws + WS_HG); const float* lower0 = (const float*)(ws + WS_SCAL);
    bf16_t* US = (bf16_t*)p.out; float* DEC = (float*)(ws + WS_DEC);
    const int tid = threadIdx.x, lane = tid & 63, w = tid >> 6, fr = lane & 15, fq = lane >> 4, k = tid & 127, seg = tid >> 7;
    for (int item = blockIdx.x; item < 4096; item += gridDim.x) {
        const int bh = item >> 6, c = item & 63, b = bh >> 2, h = bh & 3; const bf16_t* row0 = HG + ((size_t)b * SEQ + c * 64) * 2048 + h * 128;
        load_tile(lds + L_FR, row0 + 512, tid); load_tile(lds + L_VR, row0 + 1024, tid);
        __syncthreads();
        float kk[16], cs[16], offset, total; const float lbv = lower0[h * 128 + k];
        write_vt(lds, k, seg);
        gate_scan(lds, k, seg, lbv, kk, cs, offset, total);
        { float ke[16];
#pragma unroll
          for (int i = 0; i < 16; ++i) ke[i] = kk[i] * __expf(total - (offset + cs[i]));
          *(u32x4*)(lds + L_KT + k * ROWT + seg * 32) = pack8(ke); *(u32x4*)(lds + L_KT + k * ROWT + seg * 32 + 16) = pack8(ke + 8);
          if (seg == 0) DEC[(size_t)item * 128 + k] = __expf(total); }
        __syncthreads();
        const bf16x8 a0 = *(const bf16x8*)(lds + L_KT + (16 * w + fr) * ROWT + fq * 16), a1 = *(const bf16x8*)(lds + L_KT + (16 * w + fr) * ROWT + 64 + fq * 16);
        unsigned char* uT = lds + L_FR;
#pragma unroll
        for (int j = 0; j < 8; ++j) {
            const bf16x8 b0 = *(const bf16x8*)(lds + L_VT + (16 * j + fr) * ROWT + fq * 16), b1 = *(const bf16x8*)(lds + L_VT + (16 * j + fr) * ROWT + 64 + fq * 16);
            f32x4 acc = {0.f, 0.f, 0.f, 0.f};
            acc = __builtin_amdgcn_mfma_f32_16x16x32_bf16(a0, b0, acc, 0, 0, 0); acc = __builtin_amdgcn_mfma_f32_16x16x32_bf16(a1, b1, acc, 0, 0, 0);
            u32x2 o; o.x = pk2(acc[0], acc[1]); o.y = pk2(acc[2], acc[3]);
            *(u32x2*)(uT + (16 * j + fr) * ROWQ + (16 * w + 4 * fq) * 2) = o; }
        __syncthreads();
        bf16_t* dst = US + (size_t)item * 16384;
#pragma unroll
        for (int i = 0; i < 4; ++i) { const int ch = tid + 512 * i, v = ch >> 4, kc = ch & 15; *(u32x4*)(dst + v * 128 + kc * 8) = *(const u32x4*)(uT + v * ROWQ + kc * 16); }
        __syncthreads();
    }
}
__device__ __forceinline__ void phase_hgrn_B(const Params& p, unsigned char* lds) {
    unsigned char* ws = p.ws; bf16_t* US = (bf16_t*)p.out; const float* DEC = (const float*)(ws + WS_DEC);
    const size_t gt = (size_t)blockIdx.x * 512 + threadIdx.x, ngt = (size_t)gridDim.x * 512;
    for (size_t e = gt; e < (size_t)64 * 128 * 16; e += ngt) {
        const int kc = (int)(e & 15), v = (int)((e >> 4) & 127), bh = (int)(e >> 11);
        bf16_t* pu = US + (size_t)bh * 64 * 16384 + v * 128 + kc * 8; const float* pd = DEC + (size_t)bh * 64 * 128 + kc * 8;
        float S[8];
#pragma unroll
        for (int i = 0; i < 8; ++i) S[i] = 0.f;
#pragma unroll 4
        for (int c = 0; c < 64; ++c) {
            const u32x4 uw = *(const u32x4*)(pu + (size_t)c * 16384); const f32x4 d0 = *(const f32x4*)(pd + c * 128), d1 = *(const f32x4*)(pd + c * 128 + 4);
            float u[8]; pg8::unpack8(uw, u);
            *(u32x4*)(pu + (size_t)c * 16384) = hg::pack8(S);
            S[0] = d0[0] * S[0] + u[0]; S[1] = d0[1] * S[1] + u[1]; S[2] = d0[2] * S[2] + u[2]; S[3] = d0[3] * S[3] + u[3];
            S[4] = d1[0] * S[4] + u[4]; S[5] = d1[1] * S[5] + u[5]; S[6] = d1[2] * S[6] + u[6]; S[7] = d1[3] * S[7] + u[7];
        }
    }
}
__device__ __forceinline__ void phase_hgrn_C(const Params& p, unsigned char* lds) {
    using namespace hg; unsigned char* ws = p.ws; const bf16_t* HG = (const bf16_t*)(ws + WS_HG); const float* lower0 = (const float*)(ws + WS_SCAL);
    const bf16_t* US = (const bf16_t*)p.out; bf16_t* Y = (bf16_t*)(ws + WS_Y); const float* gain = (const float*)p.in[6];
    const int tid = threadIdx.x, lane = tid & 63, w = tid >> 6, fr = lane & 15, fq = lane >> 4, k = tid & 127, seg = tid >> 7;
    for (int item = blockIdx.x; item < 4096; item += gridDim.x) {
        const int bh = item >> 6, c = item & 63, b = bh >> 2, h = bh & 3; const size_t m0 = (size_t)b * SEQ + c * 64; const bf16_t* row0 = HG + m0 * 2048 + h * 128;
        bf16x8 bS[4];
        { const bf16_t* sp = US + (size_t)item * 16384 + (16 * w + fr) * 128 + fq * 8;
#pragma unroll
          for (int ks = 0; ks < 4; ++ks) bS[ks] = *(const bf16x8*)(sp + ks * 32); }
        load_tile(lds + L_QR, row0, tid); load_tile(lds + L_FR, row0 + 512, tid); load_tile(lds + L_VR, row0 + 1024, tid);
        __syncthreads();
        float kk[16], cs[16], offset, total; const float lbv = lower0[h * 128 + k];
        write_vt(lds, k, seg);
        gate_scan(lds, k, seg, lbv, kk, cs, offset, total);
#pragma unroll
        for (int i = 0; i < 16; ++i) { const float cum = offset + cs[i]; bf16_t* pq = (bf16_t*)(lds + L_QR + (16 * seg + i) * ROWQ + k * 2); bf16_t* pf = (bf16_t*)(lds + L_FR + (16 * seg + i) * ROWQ + k * 2);
            *pq = f2bf(bf2f(*pq) * __expf(cum)); *pf = f2bf(kk[i] * __expf(-cum)); }
        __syncthreads();
        { const int si = w >> 1; bf16x8 a[4];
#pragma unroll
          for (int ks = 0; ks < 4; ++ks) a[ks] = *(const bf16x8*)(lds + L_FR + (16 * si + fr) * ROWQ + ks * 64 + fq * 16);
#pragma unroll
          for (int jj = 0; jj < 2; ++jj) { const int tj = 2 * (w & 1) + jj; f32x4 acc = {0.f, 0.f, 0.f, 0.f};
#pragma unroll
              for (int ks = 0; ks < 4; ++ks) { const bf16x8 bq = *(const bf16x8*)(lds + L_QR + (16 * tj + fr) * ROWQ + ks * 64 + fq * 16); acc = __builtin_amdgcn_mfma_f32_16x16x32_bf16(a[ks], bq, acc, 0, 0, 0); }
              const int t = 16 * tj + fr, s0 = 16 * si + 4 * fq;
              u32x2 o; o.x = pk2(s0 <= t ? acc[0] : 0.f, s0 + 1 <= t ? acc[1] : 0.f); o.y = pk2(s0 + 2 <= t ? acc[2] : 0.f, s0 + 3 <= t ? acc[3] : 0.f);
              *(u32x2*)(lds + L_KT + t * ROWT + s0 * 2) = o; } }
        __syncthreads();
        f32x4 acc[4];
        { const bf16x8 bV0 = *(const bf16x8*)(lds + L_VT + (16 * w + fr) * ROWT + fq * 16), bV1 = *(const bf16x8*)(lds + L_VT + (16 * w + fr) * ROWT + 64 + fq * 16);
#pragma unroll
          for (int tj = 0; tj < 4; ++tj) { f32x4 ac = {0.f, 0.f, 0.f, 0.f};
#pragma unroll
              for (int ks = 0; ks < 4; ++ks) { const bf16x8 aq = *(const bf16x8*)(lds + L_QR + (16 * tj + fr) * ROWQ + ks * 64 + fq * 16); ac = __builtin_amdgcn_mfma_f32_16x16x32_bf16(aq, bS[ks], ac, 0, 0, 0); }
              const bf16x8 ap0 = *(const bf16x8*)(lds + L_KT + (16 * tj + fr) * ROWT + fq * 16), ap1 = *(const bf16x8*)(lds + L_KT + (16 * tj + fr) * ROWT + 64 + fq * 16);
              ac = __builtin_amdgcn_mfma_f32_16x16x32_bf16(ap0, bV0, ac, 0, 0, 0); ac = __builtin_amdgcn_mfma_f32_16x16x32_bf16(ap1, bV1, ac, 0, 0, 0);
              acc[tj] = ac; } }
        float* ssq = (float*)(lds + L_SSQ);
#pragma unroll
        for (int tj = 0; tj < 4; ++tj)
#pragma unroll
            for (int r = 0; r < 4; ++r) { float sq = acc[tj][r] * acc[tj][r]; sq += __shfl_xor(sq, 1); sq += __shfl_xor(sq, 2); sq += __shfl_xor(sq, 4); sq += __shfl_xor(sq, 8);
                if (fr == 0) ssq[w * 64 + 16 * tj + 4 * fq + r] = sq; }
        __syncthreads();
        const float gn = gain[h * 128 + 16 * w + fr];
#pragma unroll
        for (int tj = 0; tj < 4; ++tj)
#pragma unroll
            for (int r = 0; r < 4; ++r) { const int t = 16 * tj + 4 * fq + r; float tot = 0.f;
#pragma unroll
                for (int ww = 0; ww < 8; ++ww) tot += ssq[ww * 64 + t];
                const float gate = bf2f(row0[(size_t)t * 2048 + 1536 + 16 * w + fr]);
                Y[(m0 + t) * 1536 + h * 128 + 16 * w + fr] = f2bf(acc[tj][r] * rsqrtf(tot * (1.f / 128.f) + RMS_EPS) * gn * gate); }
        __syncthreads();
    }
}

template <bool COOP> __device__ __forceinline__ void cg_or_nothing() { if (COOP) cg::this_grid().sync(); }
template <bool COOP>
__global__ void __launch_bounds__(512, 2) k_fwd(Params p) {
    extern __shared__ __attribute__((aligned(16))) unsigned char lds[];
    const int lo = p.ph_lo, hi = p.ph_hi;
#define RUN_PHASE(k, call) do { if (((PHASE_MASK >> (k)) & 1) && lo <= (k) && (k) < hi) { call; if (COOP && (k) + 1 < hi) { cg::this_grid().sync(); } } } while (0)
    RUN_PHASE(0, phase_prologue(p, lds));
    RUN_PHASE(1, ((USE_PG8 & 1) ? phase_proj_pg8(p, lds) : (phase_proj(p, lds), cg_or_nothing<COOP>(), phase_rope(p, lds))));
    RUN_PHASE(2, (((USE_OPT & 2) ? phase_hgrn_A(p, lds) : phase_hgrn_naive(p, lds)), __syncthreads(), (USE_OPT & 1) ? phase_diffattn(p, lds) : phase_attn_naive<true>(p, lds), __syncthreads(), (USE_OPT & 4) ? phase_memattn(p, lds) : phase_attn_naive<false>(p, lds)));
    RUN_PHASE(3, (((USE_OPT & 2) ? phase_hgrn_B(p, lds) : (void)0), __syncthreads(), (USE_OPT & 1) ? phase_diffcombine(p, lds) : (void)0));
    RUN_PHASE(4, ((USE_OPT & 2) ? phase_hgrn_C(p, lds) : (void)0));
    RUN_PHASE(5, ((USE_PG8 & 2) ? phase_merge_pg8(p, lds) : phase_merge(p, lds)));
    RUN_PHASE(6, ((USE_PG8 & 4) ? phase_wout_pg8(p, lds) : phase_wout(p, lds)));
    RUN_PHASE(7, phase_ln1_route(p, lds));
    RUN_PHASE(8, phase_dispatch(p, lds));
    RUN_PHASE(9, ((USE_PG8 & 8) ? phase_exp_gu_pg8(p, lds) : phase_exp_gu(p, lds)));
    RUN_PHASE(10, ((USE_PG8 & 16) ? phase_exp_dn_pg8(p, lds) : phase_exp_dn(p, lds)));
    RUN_PHASE(11, phase_final(p, lds));
#undef RUN_PHASE
}

extern "C" void kernel_launch(void* const* d_in, const int* in_sizes, int n_in, void* d_out, int out_size, void* d_ws, size_t ws_size, hipStream_t stream) {
    static int grid = 0;
    if (grid == 0) {
        if (n_in != 26 || in_sizes[0] != NTOK * DM || out_size != NTOK * DM || ws_size < WS_END) {
            fprintf(stderr, "kernel_launch: unexpected shapes: n_in %d in0 %d out %d ws %zu (need >= %zu)\n", n_in, n_in > 0 ? in_sizes[0] : -1, out_size, ws_size, (size_t)WS_END); grid = -1; return; }
        int dev = 0, cus = 0, per_cu = 0;
        hipGetDevice(&dev); hipDeviceGetAttribute(&cus, hipDeviceAttributeMultiprocessorCount, dev);
        if (MK_ONE_LAUNCH) {
            hipFuncSetAttribute((const void*)k_fwd<true>, hipFuncAttributeMaxDynamicSharedMemorySize, LDS_BYTES);
            hipOccupancyMaxActiveBlocksPerMultiprocessor(&per_cu, (const void*)k_fwd<true>, 512, LDS_BYTES);
            if (per_cu < 1) { fprintf(stderr, "kernel_launch: occupancy query says %d blocks/CU\n", per_cu); per_cu = 1; }
            grid = cus * 1;
        } else {
            hipFuncSetAttribute((const void*)k_fwd<false>, hipFuncAttributeMaxDynamicSharedMemorySize, LDS_BYTES);
            grid = cus;
        }
        (void)hipGetLastError();
    }
    if (grid < 0) return;
    Params p{};
    for (int i = 0; i < 26; ++i) p.in[i] = d_in[i];
    p.out = (float*)d_out; p.ws = (unsigned char*)d_ws;
    if (MK_ONE_LAUNCH) {
        p.ph_lo = 0; p.ph_hi = NPHASE;
        void* args[] = {&p};
        hipError_t e = hipLaunchCooperativeKernel((const void*)k_fwd<true>, dim3(grid), dim3(512), args, LDS_BYTES, stream);
        if (e != hipSuccess) fprintf(stderr, "cooperative launch failed: %s (grid %d)\n", hipGetErrorString(e), grid);
    } else {
        for (int ph = 0; ph < NPHASE; ++ph) { p.ph_lo = ph; p.ph_hi = ph + 1; hipLaunchKernelGGL(k_fwd<false>, dim3(grid), dim3(512), LDS_BYTES, stream, p); }
    }
}
```

```cpp
#include <hip/hip_runtime.h>
#include <hip/hip_cooperative_groups.h>
#include <cstdio>
#include <cstdint>
namespace cg = cooperative_groups;

#ifndef PHASE_MASK
#define PHASE_MASK 0xffff
#endif
#ifndef USE_PG8
#define USE_PG8 0x1f
#endif
#ifndef USE_OPT
#define USE_OPT 0xf
#endif
#ifndef MK_ONE_LAUNCH
#define MK_ONE_LAUNCH 1
#endif

typedef unsigned short bf16_t;
typedef short bf16x8 __attribute__((ext_vector_type(8)));
typedef float f32x4 __attribute__((ext_vector_type(4)));
typedef unsigned u32x4 __attribute__((ext_vector_type(4)));
typedef unsigned u32x2 __attribute__((ext_vector_type(2)));

constexpr int NTOK = 65536, DM = 1024, SEQ = 4096, NBATCH = 16, NMEM = 256, NEXP = 32;
constexpr int NSLOT = 2 * NTOK + NEXP * 256;
constexpr float ALPHA = 1.189207115002721f;
constexpr float LN_EPS = 1e-5f, RMS_EPS = 1e-6f;
constexpr float LOG2E = 1.4426950408889634f;
constexpr float QSCALE_DF = 0.125f * LOG2E;
constexpr float QSCALE_MEM = 0.08838834764831845f * LOG2E;
constexpr float LAM_INIT = 0.2f;
constexpr int NPHASE = 12;

constexpr size_t MiB = (size_t)1 << 20;
constexpr size_t WS_CTL = 0;
constexpr size_t WS_SCAL = 1 * MiB;
constexpr size_t WS_ROPE = 2 * MiB;
constexpr size_t WS_RECI = 6 * MiB;
constexpr size_t WS_RECW = 7 * MiB;
constexpr size_t WS_WT_IN = 8 * MiB;
constexpr size_t WS_WT_G = 16 * MiB;
constexpr size_t WS_WT_MKV = 22 * MiB;
constexpr size_t WS_WT_B = 24 * MiB;
constexpr size_t WS_WT_OUT = 27 * MiB;
constexpr size_t WS_WT_R = 29 * MiB;
constexpr size_t WS_WT_GU = 30 * MiB;
constexpr size_t WS_WT_DN = 94 * MiB;
constexpr size_t WS_MEMB = 126 * MiB;
constexpr size_t WS_MKV = 134 * MiB;
constexpr size_t WS_DEC = 142 * MiB;
constexpr size_t WS_LOGITS = 144 * MiB;
constexpr size_t WS_HG = 176 * MiB;
constexpr size_t WS_DQK = 432 * MiB;
constexpr size_t WS_DV = 560 * MiB;
constexpr size_t WS_MQ = 624 * MiB;
constexpr size_t WS_XB = 688 * MiB;
constexpr size_t WS_Y = 816 * MiB;
constexpr size_t WS_END = 1008 * MiB;
constexpr size_t WS_MERGED = WS_HG;
constexpr size_t WS_X1B = WS_DV;
constexpr size_t WS_XS = WS_HG;
constexpr size_t WS_H = 448 * MiB;
constexpr size_t WS_YB = 584 * MiB;
constexpr int LDS_BYTES = 147456;

struct Params { const void* in[26]; float* out; unsigned char* ws; int ph_lo, ph_hi; };

__device__ __forceinline__ float bf2f(bf16_t v) { return __uint_as_float(((unsigned)v) << 16); }
__device__ __forceinline__ bf16_t f2bf(float f) { unsigned u = __float_as_uint(f); u += 0x7fffu + ((u >> 16) & 1u); return (bf16_t)(u >> 16); }
__device__ __forceinline__ unsigned pk2(float lo, float hi) { return (unsigned)f2bf(lo) | ((unsigned)f2bf(hi) << 16); }
__device__ __forceinline__ float sigmoidf_(float x) { return __builtin_amdgcn_rcpf(1.f + __expf(-x)); }
__device__ __forceinline__ float siluf_(float x) { return x * __builtin_amdgcn_rcpf(1.f + __expf(-x)); }
__device__ __forceinline__ float wave_sum(float v) {
#pragma unroll
    for (int o = 1; o < 64; o <<= 1) v += __shfl_xor(v, o);
    return v;
}
__device__ __forceinline__ float wave_max(float v) {
#pragma unroll
    for (int o = 1; o < 64; o <<= 1) v = fmaxf(v, __shfl_xor(v, o));
    return v;
}
#define LDS_WAIT() asm volatile("s_waitcnt lgkmcnt(0)" ::: "memory")

__device__ __forceinline__ void tr_item(const float* W, int K, int N, bf16_t* WT, int dst_row0, float* scr, int k0, int n0, int lane) {
#pragma unroll 8
    for (int i = 0; i < 32; ++i) { const int kk = 2 * i + (lane >> 5); scr[kk * 33 + (lane & 31)] = W[(size_t)(k0 + kk) * N + n0 + (lane & 31)]; }
    LDS_WAIT();
    const int c = lane & 7;
#pragma unroll
    for (int j = 0; j < 4; ++j) { const int n = (lane >> 3) + 8 * j; const float* s = scr + (8 * c) * 33 + n;
        u32x4 o; o.x = pk2(s[0 * 33], s[1 * 33]); o.y = pk2(s[2 * 33], s[3 * 33]); o.z = pk2(s[4 * 33], s[5 * 33]); o.w = pk2(s[6 * 33], s[7 * 33]);
        *(u32x4*)(WT + (size_t)(dst_row0 + n) * K + k0 + 8 * c) = o; }
    LDS_WAIT();
}
__device__ __forceinline__ void tr_job(const float* W, int K, int N, int ne, bf16_t* WT, int erow, int blk, int blkstride, int base, float* scr, int gw, int ngw, int lane) {
    const int nkb = K / 64, nnb = N / 32, per = nkb * nnb, total = per * ne;
    for (int it = gw; it < total; it += ngw) {
        const int e = it / per, r = it % per, kb = r / nnb, nb = r % nnb, n0 = nb * 32;
        tr_item(W + (size_t)e * K * N, K, N, WT, base + e * erow + (n0 / blk) * blkstride + (n0 % blk), scr, kb * 64, n0, lane);
    }
}
__device__ __forceinline__ void sincos_acc(float ang, float& c, float& s) {
    const double a = (double)ang;
    const double q = rint(a * 0.63661977236758134308);
    const double r = fma(-q, 1.57079632679489661923, a) - q * 6.12323399573676603587e-17;
    const double r2 = r * r;
    double sp = 1.0 / 6227020800.0; sp = fma(sp, r2, -1.0 / 39916800.0); sp = fma(sp, r2, 1.0 / 362880.0); sp = fma(sp, r2, -1.0 / 5040.0);
    sp = fma(sp, r2, 1.0 / 120.0); sp = fma(sp, r2, -1.0 / 6.0); sp = fma(sp, r2, 1.0); const double sr = sp * r;
    double cp = 1.0 / 479001600.0; cp = fma(cp, r2, -1.0 / 3628800.0); cp = fma(cp, r2, 1.0 / 40320.0); cp = fma(cp, r2, -1.0 / 720.0);
    cp = fma(cp, r2, 1.0 / 24.0); cp = fma(cp, r2, -0.5); const double cr = fma(cp, r2, 1.0);
    const int qi = ((int)q) & 3;
    const double cc = (qi == 0) ? cr : (qi == 1) ? -sr : (qi == 2) ? -cr : sr;
    const double ss = (qi == 0) ? sr : (qi == 1) ? cr : (qi == 2) ? -sr : -cr;
    c = (float)cc; s = (float)ss;
}
__device__ __forceinline__ void phase_prologue(const Params& p, unsigned char* lds) {
    const int tid = threadIdx.x, lane = tid & 63, wave = tid >> 6;
    const int gw = blockIdx.x * 8 + wave, ngw = gridDim.x * 8;
    const size_t gt = (size_t)blockIdx.x * 512 + tid, ngt = (size_t)gridDim.x * 512;
    unsigned char* ws = p.ws;
    float* scr = (float*)lds + wave * (64 * 33);
    tr_job((const float*)p.in[3], 1024, 4096, 1, (bf16_t*)(ws + WS_WT_IN), 0, 4096, 0, 0, scr, gw, ngw, lane);
    tr_job((const float*)p.in[4], 1024, 3072, 1, (bf16_t*)(ws + WS_WT_G), 0, 3072, 0, 0, scr, gw, ngw, lane);
    tr_job((const float*)p.in[12], 1024, 1024, 1, (bf16_t*)(ws + WS_WT_MKV), 0, 1024, 0, 0, scr, gw, ngw, lane);
    tr_job((const float*)p.in[13], 512, 1024, 1, (bf16_t*)(ws + WS_WT_B), 0, 1024, 0, 0, scr, gw, ngw, lane);
    tr_job((const float*)p.in[14], 512, 1024, 1, (bf16_t*)(ws + WS_WT_B), 0, 1024, 0, 1024, scr, gw, ngw, lane);
    tr_job((const float*)p.in[15], 512, 1024, 1, (bf16_t*)(ws + WS_WT_B), 0, 1024, 0, 2048, scr, gw, ngw, lane);
    tr_job((const float*)p.in[16], 1024, 1024, 1, (bf16_t*)(ws + WS_WT_OUT), 0, 1024, 0, 0, scr, gw, ngw, lane);
    tr_job((const float*)p.in[21], 1024, 512, 32, (bf16_t*)(ws + WS_WT_GU), 1024, 128, 256, 0, scr, gw, ngw, lane);
    tr_job((const float*)p.in[22], 1024, 512, 32, (bf16_t*)(ws + WS_WT_GU), 1024, 128, 256, 128, scr, gw, ngw, lane);
    tr_job((const float*)p.in[23], 512, 1024, 32, (bf16_t*)(ws + WS_WT_DN), 1024, 1024, 0, 0, scr, gw, ngw, lane);
    { const float* wg = (const float*)p.in[19]; const float* we = (const float*)p.in[20]; bf16_t* wr = (bf16_t*)(ws + WS_WT_R);
      for (size_t i = gt; i < 48 * 1024; i += ngt) { const int r = (int)(i >> 10), k = (int)(i & 1023);
          const float v = r < 4 ? wg[k * 4 + r] : (r < 36 ? we[k * 32 + (r - 4)] : 0.f); const bf16_t hb = f2bf(v); wr[i] = hb; wr[48 * 1024 + i] = f2bf(v - bf2f(hb)); } }
    { const float* x = (const float*)p.in[0]; bf16_t* xb = (bf16_t*)(ws + WS_XB);
      for (size_t i = gt; i < (size_t)NTOK * DM / 8; i += ngt) { const f32x4 a = *(const f32x4*)(x + i * 8), b = *(const f32x4*)(x + i * 8 + 4);
          u32x4 o; o.x = pk2(a.x, a.y); o.y = pk2(a.z, a.w); o.z = pk2(b.x, b.y); o.w = pk2(b.z, b.w); *(u32x4*)(xb + i * 8) = o; }
      const float* mm = (const float*)p.in[1]; bf16_t* mb = (bf16_t*)(ws + WS_MEMB);
      for (size_t i = gt; i < (size_t)NBATCH * NMEM * DM / 8; i += ngt) { const f32x4 a = *(const f32x4*)(mm + i * 8), b = *(const f32x4*)(mm + i * 8 + 4);
          u32x4 o; o.x = pk2(a.x, a.y); o.y = pk2(a.z, a.w); o.z = pk2(b.x, b.y); o.w = pk2(b.z, b.w); *(u32x4*)(mb + i * 8) = o; } }
    { const int* pos = (const int*)p.in[2]; float* rope = (float*)(ws + WS_ROPE);
      for (size_t i = gt; i < (size_t)NTOK * 8; i += ngt) { const int tk = (int)(i >> 3), fi = (int)(i & 7);
          const float invf = fi == 0 ? 1.0f : fi == 1 ? 0.1939227432012558f : fi == 2 ? 0.03760603070259094f : fi == 3 ? 0.007292664609849453f : fi == 4 ? 0.0014142135623842478f
                           : fi == 5 ? 0.00027424818836152554f : fi == 6 ? 5.3182957344688475e-05f : 1.0313385246263351e-05f;
          const float ang = (float)pos[tk] * invf; float c, s; sincos_acc(ang, c, s); rope[i * 2] = c; rope[i * 2 + 1] = s; } }
    if (blockIdx.x == 0) {
        float* sc = (float*)(ws + WS_SCAL); const float* lbs = (const float*)p.in[5];
        { const float a = lbs[tid], b = lbs[512 + tid]; sc[tid] = 1.f / (1.f + expf(b - a)); }
        if (wave == 0) {
            const float* q1 = (const float*)p.in[7]; const float* k1 = (const float*)p.in[8]; const float* q2 = (const float*)p.in[9]; const float* k2 = (const float*)p.in[10];
            const float s1 = wave_sum(q1[lane] * k1[lane]), s2 = wave_sum(q2[lane] * k2[lane]);
            if (lane == 0) sc[512] = expf(s1) - expf(s2) + LAM_INIT;
        }
        if (tid < 64) ((int*)(ws + WS_CTL))[tid] = 0;
    }
}

struct SgCtx { int t, wr, wc, fr, fq; unsigned char* sA; unsigned char* sB; };
__device__ __forceinline__ SgCtx sg_ctx(unsigned char* lds) {
    SgCtx c; const int tid = threadIdx.x; c.t = tid & 255; const int team = tid >> 8; const int wid = c.t >> 6, lane = c.t & 63;
    c.wr = wid >> 1; c.wc = wid & 1; c.fr = lane & 15; c.fq = lane >> 4; c.sA = lds + team * 16384; c.sB = c.sA + 8192; return c;
}
__device__ __forceinline__ void sg_zero(f32x4 (&acc)[4][2]) {
#pragma unroll
    for (int m = 0; m < 4; ++m)
#pragma unroll
        for (int n = 0; n < 2; ++n) acc[m][n] = (f32x4){0.f, 0.f, 0.f, 0.f};
}
__device__ __forceinline__ void sg_tile(f32x4 (&acc)[4][2], const bf16_t* a0, const bf16_t* a1, const bf16_t* b0, int K, const SgCtx& c) {
    const int bo = c.t * 16;
#pragma unroll 1
    for (int kt = 0; kt < K; kt += 32) {
        const bf16x8 va0 = *(const bf16x8*)(a0 + kt), va1 = *(const bf16x8*)(a1 + kt), vb0 = *(const bf16x8*)(b0 + kt);
        *(bf16x8*)(c.sA + bo) = va0; *(bf16x8*)(c.sA + bo + 4096) = va1; *(bf16x8*)(c.sB + bo) = vb0;
        __syncthreads();
        bf16x8 At[4], Bt[2];
#pragma unroll
        for (int m = 0; m < 4; ++m) At[m] = *(const bf16x8*)(c.sA + (c.wr * 64 + m * 16 + c.fr) * 64 + c.fq * 16);
#pragma unroll
        for (int n = 0; n < 2; ++n) Bt[n] = *(const bf16x8*)(c.sB + (c.wc * 32 + n * 16 + c.fr) * 64 + c.fq * 16);
#pragma unroll
        for (int m = 0; m < 4; ++m)
#pragma unroll
            for (int n = 0; n < 2; ++n) acc[m][n] = __builtin_amdgcn_mfma_f32_16x16x32_bf16(At[m], Bt[n], acc[m][n], 0, 0, 0);
        __syncthreads();
    }
}
#define SG_R0(c) ((c).t >> 2)
#define SG_C0(c) (((c).t & 3) * 8)
template <class F> __device__ __forceinline__ void sg_store_bf16(const f32x4 (&acc)[4][2], bf16_t* dst, size_t ld, const SgCtx& c, F f) {
    bf16_t* base = dst + (size_t)(c.wr * 64 + c.fq * 4) * ld + c.wc * 32 + c.fr;
#pragma unroll
    for (int m = 0; m < 4; ++m)
#pragma unroll
        for (int j = 0; j < 4; ++j) { bf16_t* pr = base + (size_t)(m * 16 + j) * ld;
#pragma unroll
            for (int n = 0; n < 2; ++n) pr[n * 16] = f2bf(f(acc[m][n][j], c.wc * 32 + n * 16));
            asm volatile("" ::: "memory"); }
}
struct FIdent { __device__ __forceinline__ float operator()(float v, int) const { return v; } };
struct FSilu { __device__ __forceinline__ float operator()(float v, int) const { return siluf_(v); } };
struct FQScale { __device__ __forceinline__ float operator()(float v, int d0) const { return d0 >= 16 ? v * QSCALE_DF : v; } };

__device__ __forceinline__ void phase_proj(const Params& p, unsigned char* lds) {
    const SgCtx c = sg_ctx(lds); const int team = threadIdx.x >> 8; unsigned char* ws = p.ws;
    const bf16_t* XB = (const bf16_t*)(ws + WS_XB); const bf16_t* WT = (const bf16_t*)(ws + WS_WT_IN);
    bf16_t* HG = (bf16_t*)(ws + WS_HG); bf16_t* DQK = (bf16_t*)(ws + WS_DQK); bf16_t* DV = (bf16_t*)(ws + WS_DV); bf16_t* MQ = (bf16_t*)(ws + WS_MQ);
    const int r0 = SG_R0(c), c0 = SG_C0(c);
    { const int ntiles = 512 * 64;
      for (int tb = 2 * blockIdx.x; tb < ntiles; tb += 2 * gridDim.x) {
        const int tile = tb + team; const int tm = tile >> 6, tn = tile & 63;
        f32x4 acc[4][2]; sg_zero(acc);
        sg_tile(acc, XB + (size_t)(tm * 128 + r0) * 1024 + c0, XB + (size_t)(tm * 128 + r0 + 64) * 1024 + c0, WT + (size_t)(tn * 64 + r0) * 1024 + c0, 1024, c);
        const size_t mrow = (size_t)tm * 128; const int n0 = tn * 64;
        if (n0 < 2048) { const int g = n0 >> 9; bf16_t* d = HG + mrow * 2048 + n0; if (g == 0 || g == 3) sg_store_bf16(acc, d, 2048, c, FSilu()); else sg_store_bf16(acc, d, 2048, c, FIdent()); }
        else if (n0 < 3072) { bf16_t* d = DQK + mrow * 1024 + (n0 - 2048); if (n0 < 2560) sg_store_bf16(acc, d, 1024, c, FQScale()); else sg_store_bf16(acc, d, 1024, c, FIdent()); }
        else if (n0 < 3584) sg_store_bf16(acc, DV + mrow * 512 + (n0 - 3072), 512, c, FIdent());
        else sg_store_bf16(acc, MQ + mrow * 512 + (n0 - 3584), 512, c, FIdent());
      } }
    { const bf16_t* MB = (const bf16_t*)(ws + WS_MEMB); const bf16_t* WK = (const bf16_t*)(ws + WS_WT_MKV); bf16_t* MKV = (bf16_t*)(ws + WS_MKV);
      const int ntiles = 32 * 16;
      for (int tb = 2 * blockIdx.x; tb < ntiles; tb += 2 * gridDim.x) {
        const int tile = tb + team; const int tm = tile >> 4, tn = tile & 15;
        f32x4 acc[4][2]; sg_zero(acc);
        sg_tile(acc, MB + (size_t)(tm * 128 + r0) * 1024 + c0, MB + (size_t)(tm * 128 + r0 + 64) * 1024 + c0, WK + (size_t)(tn * 64 + r0) * 1024 + c0, 1024, c);
        sg_store_bf16(acc, MKV + (size_t)tm * 128 * 1024 + tn * 64, 1024, c, FIdent());
      } }
}
__device__ __forceinline__ void phase_rope(const Params& p, unsigned char* lds) {
    unsigned char* ws = p.ws; bf16_t* DQK = (bf16_t*)(ws + WS_DQK); const float* rope = (const float*)(ws + WS_ROPE);
    const size_t gt = (size_t)blockIdx.x * 512 + threadIdx.x, ngt = (size_t)gridDim.x * 512;
    for (size_t i = gt; i < (size_t)NTOK * 128; i += ngt) {
        const size_t m = i >> 7; const int rem = (int)(i & 127), gh = rem >> 3, fi = rem & 7;
        bf16_t* q = DQK + m * 1024 + gh * 64;
        const float t1 = bf2f(q[fi]), t2 = bf2f(q[8 + fi]); const float cs = rope[(m * 8 + fi) * 2], sn = rope[(m * 8 + fi) * 2 + 1];
        float o1 = t1 * cs - t2 * sn, o2 = t2 * cs + t1 * sn;
        if (gh < 8) { o1 *= QSCALE_DF; o2 *= QSCALE_DF; }
        q[fi] = f2bf(o1); q[8 + fi] = f2bf(o2);
    }
}
__device__ __forceinline__ void phase_hgrn_naive(const Params& p, unsigned char* lds) {
    unsigned char* ws = p.ws; const bf16_t* HG = (const bf16_t*)(ws + WS_HG); bf16_t* Y = (bf16_t*)(ws + WS_Y);
    const float* lower0 = (const float*)(ws + WS_SCAL); const float* gain = (const float*)p.in[6];
    float* fs = (float*)lds; float* ks = fs + 128; float* qs = ks + 128; float* part = qs + 128; float* red = part + 512;
    const int tid = threadIdx.x, v = tid & 127, kq = tid >> 7, lane = tid & 63, wave = tid >> 6;
    for (int bh = blockIdx.x; bh < 64; bh += gridDim.x) {
        const int b = bh >> 2, h = bh & 3;
        float S[32];
#pragma unroll
        for (int i = 0; i < 32; ++i) S[i] = 0.f;
        const float lbv = lower0[h * 128 + v], gn = gain[h * 128 + v];
        for (int t = 0; t < SEQ; ++t) {
            const size_t m = (size_t)b * SEQ + t; const bf16_t* row = HG + m * 2048 + h * 128;
            if (tid < 128) { const float fp = bf2f(row[512 + v]); const float f = lbv + (1.f - lbv) * sigmoidf_(fp); fs[v] = f; ks[v] = 1.f - f; qs[v] = bf2f(row[v]); }
            const float vv = bf2f(row[1024 + v]);
            __syncthreads();
            float o = 0.f;
#pragma unroll
            for (int i = 0; i < 32; ++i) { const int k = kq * 32 + i; S[i] = fs[k] * S[i] + ks[k] * vv; o += qs[k] * S[i]; }
            part[kq * 128 + v] = o;
            __syncthreads();
            float ot = 0.f;
            if (tid < 128) { ot = part[v] + part[128 + v] + part[256 + v] + part[384 + v]; const float sq = wave_sum(ot * ot); if (lane == 0) red[wave] = sq; }
            __syncthreads();
            if (tid < 128) { const float ms = (red[0] + red[1]) * (1.f / 128.f); const float y = ot * rsqrtf(ms + RMS_EPS) * gn * bf2f(row[1536 + v]); Y[m * 1536 + h * 128 + v] = f2bf(y); }
        }
        __syncthreads();
    }
}
template <bool DIFF>
__device__ __forceinline__ void phase_attn_naive(const Params& p, unsigned char* lds) {
    constexpr int DQ = DIFF ? 64 : 128, NMAP = DIFF ? 2 : 1;
    unsigned char* ws = p.ws; const int tid = threadIdx.x, lane = tid & 63, wave = tid >> 6;
    float* wbuf = (float*)lds + wave * 4096; float* qbuf = (float*)(lds + 131072) + wave * 128;
    const bf16_t* DQK = (const bf16_t*)(ws + WS_DQK); const bf16_t* DV = (const bf16_t*)(ws + WS_DV); const bf16_t* MQ = (const bf16_t*)(ws + WS_MQ); const bf16_t* MKV = (const bf16_t*)(ws + WS_MKV);
    bf16_t* Y = (bf16_t*)(ws + WS_Y); const float lam = ((const float*)(ws + WS_SCAL))[512]; const float* sub_gain = (const float*)p.in[11];
    const int gw = blockIdx.x * 8 + wave, ngw = gridDim.x * 8; const int nrows = NTOK * 4;
    for (int r = gw; r < nrows; r += ngw) {
        int b, h, nk; size_t m; const bf16_t *Q, *K, *V; int kp, vp;
        if (DIFF) { const int bh = r >> 12, i = r & 4095; b = bh >> 2; h = bh & 3; m = (size_t)b * SEQ + i; nk = i + 1;
            Q = DQK + m * 1024 + h * 64; K = DQK + (size_t)b * SEQ * 1024 + 512 + h * 64; kp = 1024; V = DV + (size_t)b * SEQ * 512 + h * 128; vp = 512; }
        else { m = (size_t)(r >> 2); h = r & 3; b = (int)(m >> 12); nk = NMEM;
            Q = MQ + m * 512 + h * 128; K = MKV + (size_t)b * NMEM * 1024 + h * 128; kp = 1024; V = MKV + (size_t)b * NMEM * 1024 + 512 + h * 128; vp = 1024; }
        if (DIFF) { qbuf[lane] = bf2f(Q[lane]); qbuf[64 + lane] = bf2f(Q[256 + lane]); }
        else { qbuf[lane] = bf2f(Q[lane]) * QSCALE_MEM; qbuf[64 + lane] = bf2f(Q[64 + lane]) * QSCALE_MEM; }
        LDS_WAIT();
        float mx[NMAP], ls[NMAP];
#pragma unroll
        for (int a = 0; a < NMAP; ++a) { mx[a] = -1e30f; ls[a] = 0.f; }
        for (int j = lane; j < nk; j += 64) {
#pragma unroll
            for (int a = 0; a < NMAP; ++a) {
                const bf16_t* kr = K + (size_t)j * kp + a * 256; float s = 0.f;
#pragma unroll 2
                for (int cc = 0; cc < DQ / 8; ++cc) { const bf16x8 kv = *(const bf16x8*)(kr + cc * 8);
#pragma unroll
                    for (int e = 0; e < 8; ++e) s += qbuf[a * 64 + cc * 8 + e] * bf2f((bf16_t)kv[e]); }
                if (s > mx[a]) { ls[a] = ls[a] * exp2f(mx[a] - s) + 1.f; mx[a] = s; } else ls[a] += exp2f(s - mx[a]);
            }
        }
        float M[NMAP], Linv[NMAP];
#pragma unroll
        for (int a = 0; a < NMAP; ++a) { M[a] = wave_max(mx[a]); const float l = wave_sum(ls[a] * exp2f(mx[a] - M[a])); Linv[a] = 1.f / l; }
        for (int j = lane; j < nk; j += 64) {
            float w = 0.f;
#pragma unroll
            for (int a = 0; a < NMAP; ++a) {
                const bf16_t* kr = K + (size_t)j * kp + a * 256; float s = 0.f;
#pragma unroll 2
                for (int cc = 0; cc < DQ / 8; ++cc) { const bf16x8 kv = *(const bf16x8*)(kr + cc * 8);
#pragma unroll
                    for (int e = 0; e < 8; ++e) s += qbuf[a * 64 + cc * 8 + e] * bf2f((bf16_t)kv[e]); }
                const float pj = exp2f(s - M[a]) * Linv[a]; w = (a == 0) ? pj : w - lam * pj;
            }
            wbuf[j] = w;
        }
        LDS_WAIT();
        float a0 = 0.f, a1 = 0.f; const bf16_t* vb = V + 2 * lane;
        for (int j = 0; j < nk; ++j) { const float w = wbuf[j]; const unsigned u = *(const unsigned*)(vb + (size_t)j * vp); a0 += w * __uint_as_float(u << 16); a1 += w * __uint_as_float(u & 0xffff0000u); }
        if (DIFF) { const float ms = wave_sum(a0 * a0 + a1 * a1) * (1.f / 128.f); const float rs = rsqrtf(ms + RMS_EPS) * (1.f - LAM_INIT);
            *(unsigned*)(Y + m * 1536 + 512 + h * 128 + 2 * lane) = pk2(a0 * rs * sub_gain[2 * lane], a1 * rs * sub_gain[2 * lane + 1]); }
        else *(unsigned*)(Y + m * 1536 + 1024 + h * 128 + 2 * lane) = pk2(a0, a1);
        LDS_WAIT();
    }
}
__device__ __forceinline__ void phase_merge(const Params& p, unsigned char* lds) {
    const SgCtx c = sg_ctx(lds); const int team = threadIdx.x >> 8; unsigned char* ws = p.ws;
    const bf16_t* XB = (const bf16_t*)(ws + WS_XB); const bf16_t* WG = (const bf16_t*)(ws + WS_WT_G); const bf16_t* Y = (const bf16_t*)(ws + WS_Y); const bf16_t* WB = (const bf16_t*)(ws + WS_WT_B);
    bf16_t* MG = (bf16_t*)(ws + WS_MERGED); const int r0 = SG_R0(c), c0 = SG_C0(c);
    const int ntiles = 512 * 16;
    for (int tb = 2 * blockIdx.x; tb < ntiles; tb += 2 * gridDim.x) {
        const int tile = tb + team; const int tm = tile >> 4, tn = tile & 15;
        f32x4 sum[4][2]; sg_zero(sum);
#pragma unroll 1
        for (int br = 0; br < 3; ++br) {
            f32x4 ag[4][2]; sg_zero(ag);
            sg_tile(ag, XB + (size_t)(tm * 128 + r0) * 1024 + c0, XB + (size_t)(tm * 128 + r0 + 64) * 1024 + c0, WG + (size_t)(br * 1024 + tn * 64 + r0) * 1024 + c0, 1024, c);
            f32x4 ay[4][2]; sg_zero(ay);
            sg_tile(ay, Y + (size_t)(tm * 128 + r0) * 1536 + br * 512 + c0, Y + (size_t)(tm * 128 + r0 + 64) * 1536 + br * 512 + c0, WB + (size_t)(br * 1024 + tn * 64 + r0) * 512 + c0, 512, c);
#pragma unroll
            for (int m = 0; m < 4; ++m)
#pragma unroll
                for (int n = 0; n < 2; ++n)
#pragma unroll
                    for (int j = 0; j < 4; ++j) sum[m][n][j] += sigmoidf_(ag[m][n][j]) * ay[m][n][j];
        }
        sg_store_bf16(sum, MG + (size_t)tm * 128 * 1024 + tn * 64, 1024, c, FIdent());
    }
}
__device__ __forceinline__ void phase_wout(const Params& p, unsigned char* lds) {
    const SgCtx c = sg_ctx(lds); const int team = threadIdx.x >> 8; unsigned char* ws = p.ws;
    const bf16_t* MG = (const bf16_t*)(ws + WS_MERGED); const bf16_t* WO = (const bf16_t*)(ws + WS_WT_OUT); const float* x = (const float*)p.in[0]; float* pre = p.out;
    const int r0 = SG_R0(c), c0 = SG_C0(c); const int ntiles = 512 * 16;
    for (int tb = 2 * blockIdx.x; tb < ntiles; tb += 2 * gridDim.x) {
        const int tile = tb + team; const int tm = tile >> 4, tn = tile & 15;
        f32x4 acc[4][2]; sg_zero(acc);
        sg_tile(acc, MG + (size_t)(tm * 128 + r0) * 1024 + c0, MG + (size_t)(tm * 128 + r0 + 64) * 1024 + c0, WO + (size_t)(tn * 64 + r0) * 1024 + c0, 1024, c);
        { const size_t off = ((size_t)tm * 128 + c.wr * 64 + c.fq * 4) * 1024 + tn * 64 + c.wc * 32 + c.fr;
#pragma unroll
          for (int m = 0; m < 4; ++m)
#pragma unroll
              for (int j = 0; j < 4; ++j) { const size_t o2 = off + (size_t)(m * 16 + j) * 1024;
#pragma unroll
                  for (int n = 0; n < 2; ++n) pre[o2 + n * 16] = ALPHA * x[o2 + n * 16] + acc[m][n][j];
                  asm volatile("" ::: "memory"); } }
    }
}
__device__ __forceinline__ void phase_ln1_route(const Params& p, unsigned char* lds) {
    unsigned char* ws = p.ws; const int tid = threadIdx.x, lane = tid & 63, wave = tid >> 6;
    float* x1f = p.out; bf16_t* x1b = (bf16_t*)(ws + WS_X1B); const float* g1 = (const float*)p.in[17]; const float* b1 = (const float*)p.in[18];
    const float* wg = (const float*)p.in[19]; const float* we = (const float*)p.in[20];
    int* cnt = (int*)(ws + WS_CTL); int* reci = (int*)(ws + WS_RECI); float* recw = (float*)(ws + WS_RECW);
    const int gw = blockIdx.x * 8 + wave, ngw = gridDim.x * 8;
    for (int t = gw; t < NTOK; t += ngw) {
        float* row = x1f + (size_t)t * 1024; f32x4 v[4]; float s = 0.f;
#pragma unroll
        for (int j = 0; j < 4; ++j) { v[j] = *(const f32x4*)(row + 256 * j + 4 * lane); s += (v[j].x + v[j].y) + (v[j].z + v[j].w); }
        const float mean = wave_sum(s) * (1.f / 1024.f); float s2 = 0.f;
#pragma unroll
        for (int j = 0; j < 4; ++j) { v[j] = v[j] - mean; s2 += (v[j].x * v[j].x + v[j].y * v[j].y) + (v[j].z * v[j].z + v[j].w * v[j].w); }
        const float rstd = rsqrtf(wave_sum(s2) * (1.f / 1024.f) + LN_EPS);
#pragma unroll
        for (int j = 0; j < 4; ++j) { const f32x4 gg = *(const f32x4*)(g1 + 256 * j + 4 * lane), bb = *(const f32x4*)(b1 + 256 * j + 4 * lane);
            v[j] = v[j] * rstd * gg + bb; *(f32x4*)(row + 256 * j + 4 * lane) = v[j];
            u32x2 o; o.x = pk2(v[j].x, v[j].y); o.y = pk2(v[j].z, v[j].w); *(u32x2*)(x1b + (size_t)t * 1024 + 256 * j + 4 * lane) = o; }
        float lg[36];
#pragma unroll
        for (int i = 0; i < 36; ++i) lg[i] = 0.f;
#pragma unroll
        for (int j = 0; j < 4; ++j)
#pragma unroll
            for (int e = 0; e < 4; ++e) { const int k = 256 * j + 4 * lane + e; const float xv = v[j][e];
                const f32x4 g4 = *(const f32x4*)(wg + k * 4);
#pragma unroll
                for (int q = 0; q < 4; ++q) lg[q] += xv * g4[q];
#pragma unroll
                for (int q8 = 0; q8 < 8; ++q8) { const f32x4 e4 = *(const f32x4*)(we + k * 32 + q8 * 4);
#pragma unroll
                    for (int q = 0; q < 4; ++q) lg[4 + q8 * 4 + q] += xv * e4[q]; } }
#pragma unroll
        for (int i = 0; i < 36; ++i) lg[i] = wave_sum(lg[i]);
        int gi = 0; float gm = lg[0];
#pragma unroll
        for (int q = 1; q < 4; ++q) if (lg[q] > gm) { gm = lg[q]; gi = q; }
        float gs = 0.f;
#pragma unroll
        for (int q = 0; q < 4; ++q) gs += expf(lg[q] - gm);
        const float group_w = 1.f / gs;
        float ig[8];
#pragma unroll
        for (int i = 0; i < 8; ++i) ig[i] = gi == 0 ? lg[4 + i] : gi == 1 ? lg[12 + i] : gi == 2 ? lg[20 + i] : lg[28 + i];
        int i1 = 0; float l1 = ig[0];
#pragma unroll
        for (int i = 1; i < 8; ++i) if (ig[i] > l1) { l1 = ig[i]; i1 = i; }
        int i2 = -1; float l2 = -3.0e38f;
#pragma unroll
        for (int i = 0; i < 8; ++i) if (i != i1 && ig[i] > l2) { l2 = ig[i]; i2 = i; }
        const float e2 = expf(l2 - l1); const float w1 = group_w / (1.f + e2), w2 = group_w * e2 / (1.f + e2);
        if (lane == 0) { const int ea = gi * 8 + i1, eb = gi * 8 + i2; const int pa = atomicAdd(cnt + ea, 1), pb = atomicAdd(cnt + eb, 1);
            reci[t * 4 + 0] = ea; reci[t * 4 + 1] = eb; reci[t * 4 + 2] = pa; reci[t * 4 + 3] = pb; recw[t * 2] = w1; recw[t * 2 + 1] = w2; }
    }
}
__device__ __forceinline__ void phase_ln1_route2(const Params& p, unsigned char* lds) {
    unsigned char* ws = p.ws; const int tid = threadIdx.x, lane = tid & 63, wave = tid >> 6, fr = lane & 15, fq = lane >> 4;
    float* x1f = p.out; bf16_t* x1b = (bf16_t*)(ws + WS_X1B); const float* g1 = (const float*)p.in[17]; const float* b1 = (const float*)p.in[18];
    const bf16_t* WRH = (const bf16_t*)(ws + WS_WT_R); const bf16_t* WRL = WRH + 48 * 1024;
    int* cnt = (int*)(ws + WS_CTL); int* reci = (int*)(ws + WS_RECI); float* recw = (float*)(ws + WS_RECW);
    float* lgs = (float*)lds + wave * (16 * 48);
    const int gw = blockIdx.x * 8 + wave, ngw = gridDim.x * 8;
    f32x4 gg[4], bb[4];
#pragma unroll
    for (int j = 0; j < 4; ++j) { gg[j] = *(const f32x4*)(g1 + 256 * j + 4 * lane); bb[j] = *(const f32x4*)(b1 + 256 * j + 4 * lane); }
    for (int g = gw; g < NTOK / 16; g += ngw) {
#pragma unroll 2
        for (int rr = 0; rr < 16; ++rr) {
            const int t = g * 16 + rr; float* row = x1f + (size_t)t * 1024; f32x4 v[4]; float s = 0.f;
#pragma unroll
            for (int j = 0; j < 4; ++j) { v[j] = *(const f32x4*)(row + 256 * j + 4 * lane); s += (v[j].x + v[j].y) + (v[j].z + v[j].w); }
            const float mean = wave_sum(s) * (1.f / 1024.f); float s2 = 0.f;
#pragma unroll
            for (int j = 0; j < 4; ++j) { v[j] = v[j] - mean; s2 += (v[j].x * v[j].x + v[j].y * v[j].y) + (v[j].z * v[j].z + v[j].w * v[j].w); }
            const float rstd = rsqrtf(wave_sum(s2) * (1.f / 1024.f) + LN_EPS);
#pragma unroll
            for (int j = 0; j < 4; ++j) { v[j] = v[j] * rstd * gg[j] + bb[j]; *(f32x4*)(row + 256 * j + 4 * lane) = v[j];
                u32x2 o; o.x = pk2(v[j].x, v[j].y); o.y = pk2(v[j].z, v[j].w); *(u32x2*)(x1b + (size_t)t * 1024 + 256 * j + 4 * lane) = o; }
        }
        asm volatile("s_waitcnt vmcnt(0)" ::: "memory");
        f32x4 acc[3];
#pragma unroll
        for (int j = 0; j < 3; ++j) acc[j] = (f32x4){0.f, 0.f, 0.f, 0.f};
        const float* arow = x1f + (size_t)(g * 16 + fr) * 1024 + fq * 8; const bf16_t* bh = WRH + fr * 1024 + fq * 8; const bf16_t* bl = WRL + fr * 1024 + fq * 8;
#pragma unroll 4
        for (int ks = 0; ks < 32; ++ks) {
            const f32x4 xa = *(const f32x4*)(arow + ks * 32), xb = *(const f32x4*)(arow + ks * 32 + 4);
            const float xs[8] = {xa.x, xa.y, xa.z, xa.w, xb.x, xb.y, xb.z, xb.w}; bf16x8 ah, al;
#pragma unroll
            for (int e = 0; e < 8; ++e) { const bf16_t hb = f2bf(xs[e]); ah[e] = (short)hb; al[e] = (short)f2bf(xs[e] - bf2f(hb)); }
#pragma unroll
            for (int j = 0; j < 3; ++j) { const bf16x8 wh = *(const bf16x8*)(bh + j * 16 * 1024 + ks * 32), wl = *(const bf16x8*)(bl + j * 16 * 1024 + ks * 32);
                acc[j] = __builtin_amdgcn_mfma_f32_16x16x32_bf16(ah, wh, acc[j], 0, 0, 0); acc[j] = __builtin_amdgcn_mfma_f32_16x16x32_bf16(al, wh, acc[j], 0, 0, 0);
                acc[j] = __builtin_amdgcn_mfma_f32_16x16x32_bf16(ah, wl, acc[j], 0, 0, 0); }
        }
#pragma unroll
        for (int j = 0; j < 3; ++j)
#pragma unroll
            for (int r = 0; r < 4; ++r) lgs[(4 * fq + r) * 48 + j * 16 + fr] = acc[j][r];
        LDS_WAIT();
        if (lane < 16) {
            const int t = g * 16 + lane; float lg[36];
#pragma unroll
            for (int i = 0; i < 36; ++i) lg[i] = lgs[lane * 48 + i];
            int gi = 0; float gm = lg[0];
#pragma unroll
            for (int q = 1; q < 4; ++q) if (lg[q] > gm) { gm = lg[q]; gi = q; }
            float gs = 0.f;
#pragma unroll
            for (int q = 0; q < 4; ++q) gs += expf(lg[q] - gm);
            const float group_w = 1.f / gs;
            float ig[8];
#pragma unroll
            for (int i = 0; i < 8; ++i) ig[i] = gi == 0 ? lg[4 + i] : gi == 1 ? lg[12 + i] : gi == 2 ? lg[20 + i] : lg[28 + i];
            int i1 = 0; float l1 = ig[0];
#pragma unroll
            for (int i = 1; i < 8; ++i) if (ig[i] > l1) { l1 = ig[i]; i1 = i; }
            int i2 = -1; float l2 = -3.0e38f;
#pragma unroll
            for (int i = 0; i < 8; ++i) if (i != i1 && ig[i] > l2) { l2 = ig[i]; i2 = i; }
            const float e2 = expf(l2 - l1); const float w1 = group_w / (1.f + e2), w2 = group_w * e2 / (1.f + e2);
            const int ea = gi * 8 + i1, eb = gi * 8 + i2; const int pa = atomicAdd(cnt + ea, 1), pb = atomicAdd(cnt + eb, 1);
            reci[t * 4 + 0] = ea; reci[t * 4 + 1] = eb; reci[t * 4 + 2] = pa; reci[t * 4 + 3] = pb; recw[t * 2] = w1; recw[t * 2 + 1] = w2;
        }
        LDS_WAIT();
    }
}
__device__ __forceinline__ int expert_layout(const int* cnt, int lane, int& tiles, int& endi) {
    tiles = (lane < 32) ? ((cnt[lane] + 255) >> 8) : 0; int x = tiles;
#pragma unroll
    for (int o = 1; o < 32; o <<= 1) { const int y = __shfl_up(x, o); if (lane >= o) x += y; }
    endi = x; return __shfl(x, 31);
}
__device__ __forceinline__ int expert_of_tile(int rt, int lane, int endi) { return __popcll(__ballot(lane < 32 && endi <= rt)); }
__device__ __forceinline__ void phase_dispatch(const Params& p, unsigned char* lds) {
    unsigned char* ws = p.ws; const int tid = threadIdx.x, lane = tid & 63, wave = tid >> 6;
    const int* cnt = (const int*)(ws + WS_CTL); int* reci = (int*)(ws + WS_RECI); const bf16_t* x1b = (const bf16_t*)(ws + WS_X1B); bf16_t* xs = (bf16_t*)(ws + WS_XS);
    int tiles, endi; expert_layout(cnt, lane, tiles, endi); const int base = endi - tiles;
    const int gw = blockIdx.x * 8 + wave, ngw = gridDim.x * 8;
    for (int t = gw; t < NTOK; t += ngw) {
        const int ea = reci[t * 4], eb = reci[t * 4 + 1], pa = reci[t * 4 + 2], pb = reci[t * 4 + 3];
        const int sa = __shfl(base, ea) * 256 + pa, sb = __shfl(base, eb) * 256 + pb;
        const u32x4 a = *(const u32x4*)(x1b + (size_t)t * 1024 + lane * 8), b = *(const u32x4*)(x1b + (size_t)t * 1024 + 512 + lane * 8);
        *(u32x4*)(xs + (size_t)sa * 1024 + lane * 8) = a; *(u32x4*)(xs + (size_t)sa * 1024 + 512 + lane * 8) = b;
        *(u32x4*)(xs + (size_t)sb * 1024 + lane * 8) = a; *(u32x4*)(xs + (size_t)sb * 1024 + 512 + lane * 8) = b;
        if (lane == 0) { reci[t * 4 + 2] = sa; reci[t * 4 + 3] = sb; }
    }
}
__device__ __forceinline__ void phase_exp_gu(const Params& p, unsigned char* lds) {
    const SgCtx c = sg_ctx(lds); const int team = threadIdx.x >> 8, lane = threadIdx.x & 63; unsigned char* ws = p.ws;
    const int* cnt = (const int*)(ws + WS_CTL); const bf16_t* XS = (const bf16_t*)(ws + WS_XS); const bf16_t* WGU = (const bf16_t*)(ws + WS_WT_GU); bf16_t* H = (bf16_t*)(ws + WS_H);
    int tiles, endi; const int nt256 = expert_layout(cnt, lane, tiles, endi);
    const int r0 = SG_R0(c), c0 = SG_C0(c); const int ntiles = nt256 * 2 * 8;
    for (int tb = 2 * blockIdx.x; tb < ntiles; tb += 2 * gridDim.x) {
        int tile = tb + team; const bool valid = tile < ntiles; if (!valid) tile = ntiles - 1;
        const int rt = tile >> 3, tn = tile & 7; const int e = expert_of_tile(rt >> 1, lane, endi);
        const bf16_t* a0 = XS + (size_t)(rt * 128 + r0) * 1024 + c0; const bf16_t* a1 = a0 + (size_t)64 * 1024;
        const bf16_t* bg = WGU + (size_t)(e * 1024 + (tn >> 1) * 256 + (tn & 1) * 64 + r0) * 1024 + c0;
        f32x4 ag[4][2]; sg_zero(ag); sg_tile(ag, a0, a1, bg, 1024, c);
        f32x4 au[4][2]; sg_zero(au); sg_tile(au, a0, a1, bg + (size_t)128 * 1024, 1024, c);
#pragma unroll
        for (int m = 0; m < 4; ++m)
#pragma unroll
            for (int n = 0; n < 2; ++n)
#pragma unroll
                for (int j = 0; j < 4; ++j) ag[m][n][j] = siluf_(ag[m][n][j]) * au[m][n][j];
        if (valid) sg_store_bf16(ag, H + (size_t)rt * 128 * 512 + tn * 64, 512, c, FIdent());
    }
}
__device__ __forceinline__ void phase_exp_dn(const Params& p, unsigned char* lds) {
    const SgCtx c = sg_ctx(lds); const int team = threadIdx.x >> 8, lane = threadIdx.x & 63; unsigned char* ws = p.ws;
    const int* cnt = (const int*)(ws + WS_CTL); const bf16_t* H = (const bf16_t*)(ws + WS_H); const bf16_t* WDN = (const bf16_t*)(ws + WS_WT_DN); bf16_t* YB = (bf16_t*)(ws + WS_YB);
    int tiles, endi; const int nt256 = expert_layout(cnt, lane, tiles, endi);
    const int r0 = SG_R0(c), c0 = SG_C0(c); const int ntiles = nt256 * 2 * 16;
    for (int tb = 2 * blockIdx.x; tb < ntiles; tb += 2 * gridDim.x) {
        int tile = tb + team; const bool valid = tile < ntiles; if (!valid) tile = ntiles - 1;
        const int rt = tile >> 4, tn = tile & 15; const int e = expert_of_tile(rt >> 1, lane, endi);
        const bf16_t* a0 = H + (size_t)(rt * 128 + r0) * 512 + c0; const bf16_t* b0 = WDN + (size_t)(e * 1024 + tn * 64 + r0) * 512 + c0;
        f32x4 acc[4][2]; sg_zero(acc); sg_tile(acc, a0, a0 + (size_t)64 * 512, b0, 512, c);
        if (valid) sg_store_bf16(acc, YB + (size_t)rt * 128 * 1024 + tn * 64, 1024, c, FIdent());
    }
}
__device__ __forceinline__ void phase_final(const Params& p, unsigned char* lds) {
    unsigned char* ws = p.ws; const int tid = threadIdx.x, lane = tid & 63, wave = tid >> 6;
    float* out = p.out; const bf16_t* YB = (const bf16_t*)(ws + WS_YB); const int* reci = (const int*)(ws + WS_RECI); const float* recw = (const float*)(ws + WS_RECW);
    const float* g2 = (const float*)p.in[24]; const float* b2 = (const float*)p.in[25];
    const int gw = blockIdx.x * 8 + wave, ngw = gridDim.x * 8;
    for (int t = gw; t < NTOK; t += ngw) {
        float* row = out + (size_t)t * 1024; const int sa = reci[t * 4 + 2], sb = reci[t * 4 + 3]; const float wa = recw[t * 2], wb = recw[t * 2 + 1];
        f32x4 v[4]; float s = 0.f;
#pragma unroll
        for (int j = 0; j < 4; ++j) { const f32x4 xv = *(const f32x4*)(row + 256 * j + 4 * lane);
            const u32x2 ya = *(const u32x2*)(YB + (size_t)sa * 1024 + 256 * j + 4 * lane), yb = *(const u32x2*)(YB + (size_t)sb * 1024 + 256 * j + 4 * lane);
            f32x4 fa, fb; fa.x = __uint_as_float(ya.x << 16); fa.y = __uint_as_float(ya.x & 0xffff0000u); fa.z = __uint_as_float(ya.y << 16); fa.w = __uint_as_float(ya.y & 0xffff0000u);
            fb.x = __uint_as_float(yb.x << 16); fb.y = __uint_as_float(yb.x & 0xffff0000u); fb.z = __uint_as_float(yb.y << 16); fb.w = __uint_as_float(yb.y & 0xffff0000u);
            v[j] = xv * ALPHA + fa * wa + fb * wb; s += (v[j].x + v[j].y) + (v[j].z + v[j].w); }
        const float mean = wave_sum(s) * (1.f / 1024.f); float s2 = 0.f;
#pragma unroll
        for (int j = 0; j < 4; ++j) { v[j] = v[j] - mean; s2 += (v[j].x * v[j].x + v[j].y * v[j].y) + (v[j].z * v[j].z + v[j].w * v[j].w); }
        const float rstd = rsqrtf(wave_sum(s2) * (1.f / 1024.f) + LN_EPS);
#pragma unroll
        for (int j = 0; j < 4; ++j) { const f32x4 gg = *(const f32x4*)(g2 + 256 * j + 4 * lane), bb = *(const f32x4*)(b2 + 256 * j + 4 * lane);
            *(f32x4*)(row + 256 * j + 4 * lane) = v[j] * rstd * gg + bb; }
    }
}

namespace pg8 {
#define PG8_LAS __attribute__((address_space(3)))
constexpr int BM = 256, BK = 64, HALF = 128, HTB = HALF * BK * 2, STAGE_BYTES = 8 * HTB, NXCD = 8, WGM = 8;
__host__ __device__ __forceinline__ int lds_byte(int r, int c) { const int st = (r >> 4) * 2 + (c >> 5), rr = r & 15, cc = c & 31, ob = rr * 64 + cc * 2; return st * 1024 + (ob ^ (((ob >> 9) & 1) << 5)); }
__host__ __device__ __forceinline__ void stage_rc(int b, int& R, int& C) { const int st = b / 1024, sb = b % 1024, swz = sb ^ (((sb >> 9) & 1) << 5); R = (st >> 1) * 16 + swz / 64; C = (st & 1) * 32 + (swz % 64) / 2; }
__host__ __device__ __forceinline__ int perm32(int rho) { const int n = rho >> 4, i = rho & 15; return 8 * (i >> 2) + 4 * n + (i & 3); }
struct Unit { int pm, pn, aux, nt, lda, ldb; const char* a; const char* b; };
typedef float f32x2_t __attribute__((ext_vector_type(2))); typedef __bf16 bf16x2_t __attribute__((ext_vector_type(2)));
__device__ __forceinline__ unsigned cvt_pk_bf16(float lo, float hi) { f32x2_t v = {lo, hi}; bf16x2_t b = __builtin_convertvector(v, bf16x2_t); return __builtin_bit_cast(unsigned, b); }
__device__ __forceinline__ bool static_tile(int i, int G, int c, int nM, int nN, int& pm, int& pn) {
    const int nwg = nM * nN; const long L = (long)i * G + c; if (L >= nwg) return false;
    int wgid = (int)L; { const int q = nwg / NXCD, r = nwg % NXCD, xcd = wgid % NXCD, off = wgid / NXCD; wgid = (xcd < r ? xcd * (q + 1) : r * (q + 1) + (xcd - r) * q) + off; }
    const int nig = WGM * nN, gid = wgid / nig, fm = gid * WGM, gsz = (nM - fm) < WGM ? (nM - fm) : WGM;
    pm = fm + ((wgid % nig) % gsz); pn = (wgid % nig) / gsz; return true;
}
template <class Epi, class Sched, bool ALIGN_EPI>
__device__ __forceinline__ void gemm_phase(PG8_LAS unsigned char* lds, const Sched& S, const Epi& E) {
    const int tid = threadIdx.x, wid = __builtin_amdgcn_readfirstlane(tid >> 6), lane = tid & 63, wr = wid >> 2, wc = wid & 3, fr = lane & 15, fq = lane >> 4;
    const size_t kstep = (size_t)(BK * 2);
    const unsigned ldsw = (unsigned)wid * 1024u;
    const int aoff = lds_byte(wr * 64 + fr, fq * 8), boff = lds_byte(wc * 32 + fr, fq * 8);
#define PG8_VOFF(LDA, LDB) do { int t_ = threadIdx.x; asm volatile("" : "+v"(t_)); _Pragma("unroll") for (int i_ = 0; i_ < 2; ++i_) { int R_, C_; stage_rc(t_ * 16 + i_ * 8192, R_, C_); \
        const int Rb_ = Epi::PERM ? ((R_ & ~31) + perm32(R_ & 31)) : R_; voffA[i_] = (unsigned)(R_ * (LDA) + C_) * 2u; voffB[i_] = (unsigned)(Rb_ * (LDB) + C_) * 2u; } } while (0)
#define PG8_SA(b, h) (((b) * 2 + (h)) * HTB)
#define PG8_SB(b, h) ((4 + (b) * 2 + (h)) * HTB)
#define PG8_STAGE(bufoff, gbase, voff) do { _Pragma("unroll") for (int _i = 0; _i < 2; ++_i) \
        __builtin_amdgcn_global_load_lds((const unsigned*)((const char*)(gbase) + (voff)[_i]), (PG8_LAS unsigned*)(lds + (bufoff) + ldsw + _i * 8192), 16, 0, 0); } while (0)
#define PG8_LDA(dst, b, h) do { _Pragma("unroll") for (int m = 0; m < 4; ++m) _Pragma("unroll") for (int k = 0; k < 2; ++k) dst[m][k] = *(const PG8_LAS bf16x8*)(lds + PG8_SA(b, h) + aoff + m * 2048 + k * 1024); } while (0)
#define PG8_LDB(dst, b, h) do { _Pragma("unroll") for (int n = 0; n < 2; ++n) _Pragma("unroll") for (int k = 0; k < 2; ++k) dst[n][k] = *(const PG8_LAS bf16x8*)(lds + PG8_SB(b, h) + boff + n * 2048 + k * 1024); } while (0)
#define PG8_MMA(ai, bj, At, Bt) do { __builtin_amdgcn_s_setprio(1); _Pragma("unroll") for (int m = 0; m < 4; ++m) _Pragma("unroll") for (int n = 0; n < 2; ++n) _Pragma("unroll") for (int k = 0; k < 2; ++k) \
        acc[ai][bj][m][n] = __builtin_amdgcn_mfma_f32_16x16x32_bf16(Bt[n][k], At[m][k], acc[ai][bj][m][n], 0, 0, 0); __builtin_amdgcn_s_setprio(0); } while (0)
#define PG8_WAIT_V(n) asm volatile("s_waitcnt vmcnt(" #n ")" ::: "memory")
#define PG8_WAIT_L(n) asm volatile("s_waitcnt lgkmcnt(" #n ")" ::: "memory")
#define PG8_BAR __builtin_amdgcn_s_barrier()
#define PG8_SCHED __builtin_amdgcn_sched_barrier(0)
#define PG8_H1(p, ld) ((p) + (size_t)HALF * (ld) * 2)
    Unit cur, nxt; int ui = 0;
    if (!S.next(0, cur)) return;
    f32x4 acc[2][2][4][2];
#pragma unroll
    for (int a = 0; a < 2; ++a)
#pragma unroll
        for (int b = 0; b < 2; ++b)
#pragma unroll
            for (int m = 0; m < 4; ++m)
#pragma unroll
                for (int n = 0; n < 2; ++n) acc[a][b][m][n] = (f32x4){0.f, 0.f, 0.f, 0.f};
    bf16x8 At[4][2], B0[2][2], B1[2][2];
    unsigned voffA[2], voffB[2];
    PG8_VOFF(cur.lda, cur.ldb);
    PG8_STAGE(PG8_SB(0, 0), cur.b, voffB); PG8_STAGE(PG8_SB(0, 1), PG8_H1(cur.b, cur.ldb), voffB); PG8_STAGE(PG8_SA(0, 0), cur.a, voffA); PG8_STAGE(PG8_SA(0, 1), PG8_H1(cur.a, cur.lda), voffA);
    if (wr == 1) PG8_BAR;
    PG8_WAIT_V(2); PG8_BAR;
    PG8_STAGE(PG8_SB(1, 0), cur.b + kstep, voffB); PG8_STAGE(PG8_SA(1, 0), cur.a + kstep, voffA); PG8_STAGE(PG8_SB(1, 1), PG8_H1(cur.b, cur.ldb) + kstep, voffB);
    PG8_WAIT_V(6); PG8_BAR;
    for (;;) {
        const bool has_next = S.next(ui + 1, nxt);
        if (!has_next) nxt = cur;
        const int nt = cur.nt;
        for (int t = 0; t < nt; t += 2) {
            const bool last = (t == nt - 2);
            PG8_LDB(B0, 0, 0); PG8_LDB(B1, 0, 1); PG8_SCHED; PG8_LDA(At, 0, 0); PG8_STAGE(PG8_SA(1, 1), PG8_H1(cur.a, cur.lda) + (size_t)(t + 1) * kstep, voffA);
            if (last) PG8_VOFF(nxt.lda, nxt.ldb);
            const char* a2 = last ? nxt.a : cur.a + (size_t)(t + 2) * kstep; const char* b2 = last ? nxt.b : cur.b + (size_t)(t + 2) * kstep;
            const int lda2 = last ? nxt.lda : cur.lda, ldb2 = last ? nxt.ldb : cur.ldb;
            PG8_WAIT_V(8); PG8_WAIT_L(0); PG8_BAR; PG8_MMA(0, 0, At, B0); PG8_MMA(0, 1, At, B1); PG8_BAR; PG8_SCHED;
            PG8_LDA(At, 0, 1); PG8_STAGE(PG8_SB(0, 0), b2, voffB); PG8_STAGE(PG8_SB(0, 1), PG8_H1(b2, ldb2), voffB); PG8_STAGE(PG8_SA(0, 0), a2, voffA);
            PG8_WAIT_V(8); PG8_WAIT_L(0); PG8_BAR; PG8_MMA(1, 0, At, B0); PG8_MMA(1, 1, At, B1); PG8_BAR; PG8_SCHED;
            PG8_LDB(B0, 1, 0); PG8_LDB(B1, 1, 1); PG8_SCHED; PG8_LDA(At, 1, 0); PG8_STAGE(PG8_SA(0, 1), PG8_H1(a2, lda2), voffA);
            PG8_WAIT_V(8); PG8_WAIT_L(0); PG8_BAR; PG8_MMA(0, 0, At, B0); PG8_MMA(0, 1, At, B1); PG8_BAR; PG8_SCHED;
            PG8_LDA(At, 1, 1); PG8_STAGE(PG8_SB(1, 0), b2 + kstep, voffB); PG8_STAGE(PG8_SB(1, 1), PG8_H1(b2, ldb2) + kstep, voffB); PG8_STAGE(PG8_SA(1, 0), a2 + kstep, voffA);
            PG8_WAIT_V(8); PG8_WAIT_L(0); PG8_BAR; PG8_MMA(1, 0, At, B0); PG8_MMA(1, 1, At, B1); PG8_BAR; PG8_SCHED;
        }
        if constexpr (ALIGN_EPI) { if (wr == 0) PG8_BAR; }
        E(acc, cur, wr, wc, fr, fq);
        if (!has_next) break;
#pragma unroll
        for (int a = 0; a < 2; ++a)
#pragma unroll
            for (int b = 0; b < 2; ++b)
#pragma unroll
                for (int m = 0; m < 4; ++m)
#pragma unroll
                    for (int n = 0; n < 2; ++n) acc[a][b][m][n] = (f32x4){0.f, 0.f, 0.f, 0.f};
        cur = nxt; ++ui;
        if constexpr (ALIGN_EPI) { if (wr == 1) PG8_BAR; }
    }
    PG8_WAIT_V(0);
    if constexpr (!ALIGN_EPI) { if (wr == 0) PG8_BAR; }
    PG8_BAR;
#undef PG8_VOFF
#undef PG8_H1
#undef PG8_SA
#undef PG8_SB
#undef PG8_STAGE
#undef PG8_LDA
#undef PG8_LDB
#undef PG8_MMA
#undef PG8_WAIT_V
#undef PG8_WAIT_L
#undef PG8_BAR
#undef PG8_SCHED
}
struct SchedPlain {
    const char* A; const char* B; int nM, nN, lda, ldb, nt, G, c;
    __device__ __forceinline__ bool next(int i, Unit& u) const {
        int pm, pn; if (!static_tile(i, G, c, nM, nN, pm, pn)) return false;
        u.pm = pm; u.pn = pn; u.aux = 0; u.nt = nt; u.lda = lda; u.ldb = ldb; u.a = A + (size_t)pm * BM * lda * 2; u.b = B + (size_t)pn * BM * ldb * 2; return true; }
};
struct SchedMerge {
    const char* XB; const char* WG; const char* Y; const char* WB; int G, c;
    __device__ __forceinline__ bool next(int i, Unit& u) const {
        const int ti = i / 6, sub = i - ti * 6, br = sub >> 1; int pm, pn; if (!static_tile(ti, G, c, 256, 4, pm, pn)) return false;
        u.pm = pm; u.pn = pn; u.aux = sub;
        if ((sub & 1) == 0) { u.nt = 16; u.lda = 1024; u.ldb = 1024; u.a = XB + (size_t)pm * BM * 1024 * 2; u.b = WG + (size_t)(br * 1024 + pn * BM) * 1024 * 2; }
        else { u.nt = 8; u.lda = 1536; u.ldb = 512; u.a = Y + ((size_t)pm * BM * 1536 + br * 512) * 2; u.b = WB + (size_t)(br * 1024 + pn * BM) * 512 * 2; }
        return true; }
};
struct SchedExp {
    const char* A; const char* B; int lda, ldb, nt, total, G, c; size_t bexp; const PG8_LAS int* tab;
    __device__ __forceinline__ bool next(int i, Unit& u) const {
        const long L = (long)i * G + c; if (L >= total) return false;
        int id = (int)L; { const int q = total / NXCD, r = total % NXCD, xcd = id % NXCD, off = id / NXCD; id = (xcd < r ? xcd * (q + 1) : r * (q + 1) + (xcd - r) * q) + off; }
        const int rt = id >> 2, pn = id & 3; const int e = __builtin_amdgcn_readfirstlane(tab[rt]);
        u.pm = rt; u.pn = pn; u.aux = e; u.nt = nt; u.lda = lda; u.ldb = ldb; u.a = A + (size_t)rt * BM * lda * 2; u.b = B + (size_t)e * bexp + (size_t)pn * BM * ldb * 2; return true; }
};
struct EpiBf16 {
    static constexpr bool PERM = true; bf16_t* O; int ldc;
    __device__ __forceinline__ void operator()(const f32x4 (&acc)[2][2][4][2], const Unit& u, int wr, int wc, int fr, int fq) const {
        bf16_t* base = O + (size_t)(u.pm * BM + wr * 64 + fr) * ldc + u.pn * BM + wc * 32 + 8 * fq;
#pragma unroll
        for (int ai = 0; ai < 2; ++ai)
#pragma unroll
            for (int m = 0; m < 4; ++m) { bf16_t* rowp = base + (size_t)(ai * HALF + m * 16) * ldc;
#pragma unroll
                for (int bj = 0; bj < 2; ++bj) { const f32x4 v0 = acc[ai][bj][m][0], v1 = acc[ai][bj][m][1];
                    u32x4 w; w.x = cvt_pk_bf16(v0[0], v0[1]); w.y = cvt_pk_bf16(v0[2], v0[3]); w.z = cvt_pk_bf16(v1[0], v1[1]); w.w = cvt_pk_bf16(v1[2], v1[3]);
                    *(u32x4*)(rowp + bj * HALF) = w; } }
    }
};
struct EpiProj {
    static constexpr bool PERM = true; bf16_t *HG, *DQK, *DV, *MQ; const float* rope;
    __device__ __forceinline__ void operator()(const f32x4 (&acc)[2][2][4][2], const Unit& u, int wr, int wc, int fr, int fq) const {
        const int pn = u.pn; bf16_t* dst; int ld, mode;
        if (pn < 8) { dst = HG + pn * 256; ld = 2048; mode = (pn < 2 || pn >= 6) ? 1 : 0; }
        else if (pn < 12) { dst = DQK + (pn - 8) * 256; ld = 1024; mode = pn < 10 ? 2 : 3; }
        else if (pn < 14) { dst = DV + (pn - 12) * 256; ld = 512; mode = 0; }
        else { dst = MQ + (pn - 14) * 256; ld = 512; mode = 0; }
        const int row0 = u.pm * BM + wr * 64 + fr; const bool rot = (mode >= 2) && ((wc & 1) == 0);
#pragma unroll
        for (int ai = 0; ai < 2; ++ai)
#pragma unroll
            for (int m = 0; m < 4; ++m) { const int row = row0 + ai * HALF + m * 16; bf16_t* rowp = dst + (size_t)row * ld + wc * 32 + 8 * fq;
                f32x4 r0 = {1.f, 0.f, 1.f, 0.f}, r1 = r0, r2 = r0, r3 = r0;
                if (rot) { const f32x4* rp = (const f32x4*)(rope + (size_t)row * 16); r0 = rp[0]; r1 = rp[1]; r2 = rp[2]; r3 = rp[3]; }
#pragma unroll
                for (int bj = 0; bj < 2; ++bj) { f32x4 v0 = acc[ai][bj][m][0], v1 = acc[ai][bj][m][1];
                    if (mode == 1) {
#pragma unroll
                        for (int e = 0; e < 4; ++e) { v0[e] = siluf_(v0[e]); v1[e] = siluf_(v1[e]); } }
                    if (rot) {
                        f32x4 p0, p1;
#pragma unroll
                        for (int e = 0; e < 4; ++e) { p0[e] = __shfl_xor(v0[e], 16); p1[e] = __shfl_xor(v1[e], 16); }
                        const float sg = (fq == 0) ? -1.f : 1.f;
                        if (fq < 2) {
                            v0[0] = v0[0] * r0[0] + sg * p0[0] * r0[1]; v0[1] = v0[1] * r0[2] + sg * p0[1] * r0[3]; v0[2] = v0[2] * r1[0] + sg * p0[2] * r1[1]; v0[3] = v0[3] * r1[2] + sg * p0[3] * r1[3];
                            v1[0] = v1[0] * r2[0] + sg * p1[0] * r2[1]; v1[1] = v1[1] * r2[2] + sg * p1[1] * r2[3]; v1[2] = v1[2] * r3[0] + sg * p1[2] * r3[1]; v1[3] = v1[3] * r3[2] + sg * p1[3] * r3[3]; } }
                    if (mode == 2) { v0 = v0 * QSCALE_DF; v1 = v1 * QSCALE_DF; }
                    u32x4 w; w.x = cvt_pk_bf16(v0[0], v0[1]); w.y = cvt_pk_bf16(v0[2], v0[3]); w.z = cvt_pk_bf16(v1[0], v1[1]); w.w = cvt_pk_bf16(v1[2], v1[3]);
                    *(u32x4*)(rowp + bj * HALF) = w; }
                asm volatile("" ::: "memory"); }
    }
};
__device__ __forceinline__ u32x4 ld16_sc1(const unsigned char* p) {
    const unsigned long long a = __hip_atomic_load((const unsigned long long*)p, __ATOMIC_RELAXED, __HIP_MEMORY_SCOPE_AGENT), b = __hip_atomic_load((const unsigned long long*)p + 1, __ATOMIC_RELAXED, __HIP_MEMORY_SCOPE_AGENT);
    u32x4 r; r.x = (unsigned)a; r.y = (unsigned)(a >> 32); r.z = (unsigned)b; r.w = (unsigned)(b >> 32); return r; }
__device__ __forceinline__ void unpack8(const u32x4 w, float (&o)[8]) {
    o[0] = __uint_as_float(w.x << 16); o[1] = __uint_as_float(w.x & 0xffff0000u); o[2] = __uint_as_float(w.y << 16); o[3] = __uint_as_float(w.y & 0xffff0000u);
    o[4] = __uint_as_float(w.z << 16); o[5] = __uint_as_float(w.z & 0xffff0000u); o[6] = __uint_as_float(w.w << 16); o[7] = __uint_as_float(w.w & 0xffff0000u); }
struct EpiMerge {
    static constexpr bool PERM = true; bf16_t* MG; unsigned char* scrG; unsigned char* scrS;
    static __device__ __forceinline__ void unpack8_(const u32x4 w, float (&o)[8]) {
        o[0] = __uint_as_float(w.x << 16); o[1] = __uint_as_float(w.x & 0xffff0000u); o[2] = __uint_as_float(w.y << 16); o[3] = __uint_as_float(w.y & 0xffff0000u);
        o[4] = __uint_as_float(w.z << 16); o[5] = __uint_as_float(w.z & 0xffff0000u); o[6] = __uint_as_float(w.w << 16); o[7] = __uint_as_float(w.w & 0xffff0000u); }
    __device__ __forceinline__ void operator()(const f32x4 (&acc)[2][2][4][2], const Unit& u, int wr, int wc, int fr, int fq) const {
        const int sub = u.aux, br = sub >> 1; const int wid = wr * 4 + wc, lane = fq * 16 + fr;
        unsigned lo = ((unsigned)wid * 16u * 64u + (unsigned)lane) * 16u; asm volatile("" : "+v"(lo));
        if ((sub & 1) == 0) {
#pragma unroll
            for (int ai = 0; ai < 2; ++ai)
#pragma unroll
                for (int bj = 0; bj < 2; ++bj)
#pragma unroll
                    for (int m = 0; m < 4; ++m) { const int g = (ai * 2 + bj) * 4 + m; const f32x4 v0 = acc[ai][bj][m][0], v1 = acc[ai][bj][m][1];
                        u32x4 w; w.x = cvt_pk_bf16(sigmoidf_(v0[0]), sigmoidf_(v0[1])); w.y = cvt_pk_bf16(sigmoidf_(v0[2]), sigmoidf_(v0[3]));
                        w.z = cvt_pk_bf16(sigmoidf_(v1[0]), sigmoidf_(v1[1])); w.w = cvt_pk_bf16(sigmoidf_(v1[2]), sigmoidf_(v1[3]));
                        *(u32x4*)(scrG + (lo + (unsigned)g * 1024u)) = w; asm volatile("" ::: "memory"); }
        } else {
            bf16_t* base = MG + (size_t)(u.pm * BM + wr * 64 + fr) * 1024 + u.pn * BM + wc * 32 + 8 * fq;
#pragma unroll
            for (int ai = 0; ai < 2; ++ai)
#pragma unroll
                for (int bj = 0; bj < 2; ++bj)
#pragma unroll
                    for (int m = 0; m < 4; ++m) { const int g = (ai * 2 + bj) * 4 + m; const f32x4 v0 = acc[ai][bj][m][0], v1 = acc[ai][bj][m][1];
                        float gt[8], o[8]; unpack8(*(const u32x4*)(scrG + (lo + (unsigned)g * 1024u)), gt);
                        o[0] = gt[0] * v0[0]; o[1] = gt[1] * v0[1]; o[2] = gt[2] * v0[2]; o[3] = gt[3] * v0[3]; o[4] = gt[4] * v1[0]; o[5] = gt[5] * v1[1]; o[6] = gt[6] * v1[2]; o[7] = gt[7] * v1[3];
                        if (br > 0) { float pv[8]; unpack8(*(const u32x4*)(scrS + (lo + (unsigned)g * 1024u)), pv);
#pragma unroll
                            for (int e = 0; e < 8; ++e) o[e] += pv[e]; }
                        u32x4 w; w.x = cvt_pk_bf16(o[0], o[1]); w.y = cvt_pk_bf16(o[2], o[3]); w.z = cvt_pk_bf16(o[4], o[5]); w.w = cvt_pk_bf16(o[6], o[7]);
                        if (br < 2) *(u32x4*)(scrS + (lo + (unsigned)g * 1024u)) = w; else *(u32x4*)(base + (size_t)(ai * HALF + m * 16) * 1024 + bj * HALF) = w;
                        asm volatile("" ::: "memory"); }
        }
    }
};
struct EpiWout {
    static constexpr bool PERM = false; const float* x; float* out;
    __device__ __forceinline__ void operator()(const f32x4 (&acc)[2][2][4][2], const Unit& u, int wr, int wc, int fr, int fq) const {
        const size_t off0 = (size_t)(u.pm * BM + wr * 64 + fr) * 1024 + u.pn * BM + wc * 32 + 4 * fq;
#pragma unroll
        for (int ai = 0; ai < 2; ++ai)
#pragma unroll
            for (int m = 0; m < 4; ++m) { const size_t off = off0 + (size_t)(ai * HALF + m * 16) * 1024;
#pragma unroll
                for (int bj = 0; bj < 2; ++bj)
#pragma unroll
                    for (int n = 0; n < 2; ++n) { const f32x4 xv = *(const f32x4*)(x + off + bj * HALF + n * 16); *(f32x4*)(out + off + bj * HALF + n * 16) = xv * ALPHA + acc[ai][bj][m][n]; }
                if (m & 1) asm volatile("" ::: "memory"); }
    }
};
struct EpiSwiglu {
    static constexpr bool PERM = true; bf16_t* H;
    __device__ __forceinline__ void operator()(const f32x4 (&acc)[2][2][4][2], const Unit& u, int wr, int wc, int fr, int fq) const {
        bf16_t* base = H + (size_t)(u.pm * BM + wr * 64 + fr) * 512 + u.pn * HALF + wc * 32 + 8 * fq;
#pragma unroll
        for (int ai = 0; ai < 2; ++ai)
#pragma unroll
            for (int m = 0; m < 4; ++m) { const f32x4 g0 = acc[ai][0][m][0], g1 = acc[ai][0][m][1], u0 = acc[ai][1][m][0], u1 = acc[ai][1][m][1];
                u32x4 w; w.x = cvt_pk_bf16(siluf_(g0[0]) * u0[0], siluf_(g0[1]) * u0[1]); w.y = cvt_pk_bf16(siluf_(g0[2]) * u0[2], siluf_(g0[3]) * u0[3]);
                w.z = cvt_pk_bf16(siluf_(g1[0]) * u1[0], siluf_(g1[1]) * u1[1]); w.w = cvt_pk_bf16(siluf_(g1[2]) * u1[2], siluf_(g1[3]) * u1[3]);
                *(u32x4*)(base + (size_t)(ai * HALF + m * 16) * 512) = w; }
    }
};
}

#define LASP(p) ((__attribute__((address_space(3))) unsigned char*)(p))
__device__ __forceinline__ void phase_proj_pg8(const Params& p, unsigned char* lds) {
    unsigned char* ws = p.ws;
    { pg8::SchedPlain S{(const char*)(ws + WS_XB), (const char*)(ws + WS_WT_IN), 256, 16, 1024, 1024, 16, (int)gridDim.x, (int)blockIdx.x};
      pg8::EpiProj E{(bf16_t*)(ws + WS_HG), (bf16_t*)(ws + WS_DQK), (bf16_t*)(ws + WS_DV), (bf16_t*)(ws + WS_MQ), (const float*)(ws + WS_ROPE)};
      pg8::gemm_phase<pg8::EpiProj, pg8::SchedPlain, true>(LASP(lds), S, E); }
    { pg8::SchedPlain S{(const char*)(ws + WS_MEMB), (const char*)(ws + WS_WT_MKV), 16, 4, 1024, 1024, 16, (int)gridDim.x, (int)blockIdx.x};
      pg8::EpiBf16 E{(bf16_t*)(ws + WS_MKV), 1024};
      pg8::gemm_phase<pg8::EpiBf16, pg8::SchedPlain, true>(LASP(lds), S, E); }
}
constexpr size_t WS_SCR = WS_DQK;
__device__ __forceinline__ void phase_merge_pg8(const Params& p, unsigned char* lds) {
    unsigned char* ws = p.ws;
    pg8::SchedMerge S{(const char*)(ws + WS_XB), (const char*)(ws + WS_WT_G), (const char*)(ws + WS_Y), (const char*)(ws + WS_WT_B), (int)gridDim.x, (int)blockIdx.x};
    pg8::EpiMerge E{(bf16_t*)(ws + WS_MERGED), ws + WS_SCR + (size_t)blockIdx.x * 262144, ws + WS_SCR + (size_t)blockIdx.x * 262144 + 131072};
    pg8::gemm_phase<pg8::EpiMerge, pg8::SchedMerge, true>(LASP(lds), S, E);
}
__device__ __forceinline__ void phase_wout_pg8(const Params& p, unsigned char* lds) {
    unsigned char* ws = p.ws;
    pg8::SchedPlain S{(const char*)(ws + WS_MERGED), (const char*)(ws + WS_WT_OUT), 256, 4, 1024, 1024, 16, (int)gridDim.x, (int)blockIdx.x};
    pg8::EpiWout E{(const float*)p.in[0], p.out};
    pg8::gemm_phase<pg8::EpiWout, pg8::SchedPlain, true>(LASP(lds), S, E);
}
constexpr int LDS_TAB = 131072;
__device__ __forceinline__ int exp_table(const Params& p, unsigned char* lds) {
    const int lane = threadIdx.x & 63; int tiles, endi; const int nt256 = expert_layout((const int*)(p.ws + WS_CTL), lane, tiles, endi);
    int* tab = (int*)(lds + LDS_TAB);
    for (int rt = threadIdx.x >> 6; rt < nt256; rt += 8) { const int e = expert_of_tile(rt, lane, endi); if (lane == 0) tab[rt] = e; }
    __syncthreads(); return nt256;
}
__device__ __forceinline__ void phase_exp_gu_pg8(const Params& p, unsigned char* lds) {
    unsigned char* ws = p.ws; const int nt256 = exp_table(p, lds);
    pg8::SchedExp S{(const char*)(ws + WS_XS), (const char*)(ws + WS_WT_GU), 1024, 1024, 16, nt256 * 4, (int)gridDim.x, (int)blockIdx.x, (size_t)1024 * 1024 * 2, (const __attribute__((address_space(3))) int*)LASP(lds + LDS_TAB)};
    pg8::EpiSwiglu E{(bf16_t*)(ws + WS_H)};
    pg8::gemm_phase<pg8::EpiSwiglu, pg8::SchedExp, true>(LASP(lds), S, E);
}
__device__ __forceinline__ void phase_exp_dn_pg8(const Params& p, unsigned char* lds) {
    unsigned char* ws = p.ws; const int nt256 = exp_table(p, lds);
    pg8::SchedExp S{(const char*)(ws + WS_H), (const char*)(ws + WS_WT_DN), 512, 512, 8, nt256 * 4, (int)gridDim.x, (int)blockIdx.x, (size_t)1024 * 512 * 2, (const __attribute__((address_space(3))) int*)LASP(lds + LDS_TAB)};
    pg8::EpiBf16 E{(bf16_t*)(ws + WS_YB), 1024};
    pg8::gemm_phase<pg8::EpiBf16, pg8::SchedExp, true>(LASP(lds), S, E);
}

#include <hip/hip_bf16.h>
namespace attn64 {
using bf16=__hip_bfloat16;
using bf16x8=__attribute__((ext_vector_type(8)))short;
using s16x4=__attribute__((ext_vector_type(4)))short;
using f32x16=__attribute__((ext_vector_type(16)))float;
using u32x4=__attribute__((ext_vector_type(4)))unsigned;
constexpr int SEQ=4096,D=64;
constexpr int NW=8,QBLK=32,QB=QBLK*NW,KVBLK=64,NQB=SEQ/QB;
constexpr int ATTN_UNIT_ROWS=QB;
__device__ __forceinline__ int crow(int r,int hi){return (r&3)+8*(r>>2)+4*hi;}
#define SBAR() __builtin_amdgcn_sched_barrier(0)
__device__ __forceinline__ void cmask(f32x16&p0,f32x16&p1,int jb,int qrel,int hi){
  const float NEG=-INFINITY; const int dq=qrel-64*jb-4*hi;
  #pragma unroll
  for(int r=0;r<16;++r){const int c=(r&3)+8*(r>>2); if(c>dq)p0[r]=NEG; if(c+32>dq)p1[r]=NEG;}
}

constexpr int NSLOT=3, SLOTB=8192;
constexpr int LDS_K=0, LDS_V=NSLOT*SLOTB, LDS_WS=2*NSLOT*SLOTB, LDS_OST=LDS_WS+NW*64*4, LDS_BYTES=LDS_OST+NW*4096;
constexpr float C2=0.125f*1.4426950408889634f;
__device__ __forceinline__ void glds16(const void*gsrc,unsigned lds_dst){unsigned keep;
  asm volatile("s_mov_b32 %0, m0\n\ts_mov_b32 m0, %2\n\ts_nop 0\n\tglobal_load_lds_dwordx4 %1, off\n\ts_mov_b32 m0, %0":"=&s"(keep):"v"(gsrc),"s"(lds_dst):"memory");}
__device__ __forceinline__ float max3f(float a,float b,float c){float r;asm("v_max3_f32 %0, %1, %2, %3":"=v"(r):"v"(a),"v"(b),"v"(c));return r;}
__device__ __forceinline__ float max2f(float a,float b){float r;asm("v_max_f32_e32 %0, %1, %2":"=v"(r):"v"(a),"v"(b));return r;}
__device__ __forceinline__ float fadd_s(float a,float b){float r;asm("v_add_f32_e32 %0, %1, %2":"=v"(r):"v"(a),"v"(b));return r;}
__device__ __forceinline__ float fsub_s(float a,float b){float r;asm("v_sub_f32_e32 %0, %1, %2":"=v"(r):"v"(a),"v"(b));return r;}
typedef float f32x2_t __attribute__((ext_vector_type(2))); typedef __bf16 bf16x2_t __attribute__((ext_vector_type(2)));
__device__ __forceinline__ unsigned cvtpk_s(float lo,float hi){f32x2_t v={lo,hi};bf16x2_t b=__builtin_convertvector(v,bf16x2_t);return __builtin_bit_cast(unsigned,b);}
#define WAIT_BAR(N) asm volatile("s_waitcnt vmcnt(" #N ") lgkmcnt(0)\n\ts_barrier":::"memory")

__device__ __forceinline__ void qkt(f32x16&p0,f32x16&p1,const char*Kslot,const bf16x8*qr,const f32x16&negm,int r32,int hi){
  const char*kb=Kslot+hi*1024+r32*16;
  #pragma unroll
  for(int d0=0;d0<4;++d0){
    const bf16x8 b0=*reinterpret_cast<const bf16x8*>(kb+d0*2048);
    const bf16x8 b1=*reinterpret_cast<const bf16x8*>(kb+d0*2048+512);
    if(d0==0){p0=__builtin_amdgcn_mfma_f32_32x32x16_bf16(b0,qr[0],negm,0,0,0);p1=__builtin_amdgcn_mfma_f32_32x32x16_bf16(b1,qr[0],negm,0,0,0);}
    else{p0=__builtin_amdgcn_mfma_f32_32x32x16_bf16(b0,qr[d0],p0,0,0,0);p1=__builtin_amdgcn_mfma_f32_32x32x16_bf16(b1,qr[d0],p1,0,0,0);}}
}
typedef __attribute__((address_space(3))) const char* lds_cptr;
typedef short v4i16_t __attribute__((ext_vector_type(4)));
__device__ __forceinline__ void kload8(bf16x8*kf,lds_cptr kp){
  kf[0]=*(const __attribute__((address_space(3))) bf16x8*)(kp);      kf[1]=*(const __attribute__((address_space(3))) bf16x8*)(kp+512);
  kf[2]=*(const __attribute__((address_space(3))) bf16x8*)(kp+2048); kf[3]=*(const __attribute__((address_space(3))) bf16x8*)(kp+2560);
  kf[4]=*(const __attribute__((address_space(3))) bf16x8*)(kp+4096); kf[5]=*(const __attribute__((address_space(3))) bf16x8*)(kp+4608);
  kf[6]=*(const __attribute__((address_space(3))) bf16x8*)(kp+6144); kf[7]=*(const __attribute__((address_space(3))) bf16x8*)(kp+6656);
}
__device__ __forceinline__ void kload2(bf16x8*kf,lds_cptr kp,int j){ kf[2*j]=*(const __attribute__((address_space(3))) bf16x8*)(kp+j*2048); kf[2*j+1]=*(const __attribute__((address_space(3))) bf16x8*)(kp+j*2048+512); }
__device__ __forceinline__ s16x4 vtr(lds_cptr p){ return __builtin_bit_cast(s16x4,__builtin_amdgcn_ds_read_tr16_b64_v4i16((__attribute__((address_space(3))) v4i16_t*)p)); }
__device__ __forceinline__ float rowmax(const f32x16&p0,const f32x16&p1){
  float a=max3f(p0[0],p0[1],p1[0]),b=max3f(p0[2],p0[3],p1[1]);a=max3f(a,p1[2],p1[3]);
  #pragma unroll
  for(int r=4;r<16;r+=4){a=max3f(a,p0[r],p0[r+1]);b=max3f(b,p0[r+2],p0[r+3]);a=max3f(a,p1[r],p1[r+1]);b=max3f(b,p1[r+2],p1[r+3]);}
  const float m=max2f(a,b);
  auto rr=__builtin_amdgcn_permlane32_swap(__float_as_uint(m),__float_as_uint(m),false,false);
  return max2f(__uint_as_float(rr[0]),__uint_as_float(rr[1]));
}
__device__ __forceinline__ void pv(f32x16*o,int vb,bf16x8 pa0,bf16x8 pa1,bf16x8 pa2,bf16x8 pa3){
  #pragma unroll
  for(int d0=0;d0<2;++d0){s16x4 lo[4],hi[4];
    #pragma unroll
    for(int ks=0;ks<4;++ks){
      asm volatile("ds_read_b64_tr_b16 %0,%1 offset:%c2":"=&v"(lo[ks]):"v"(vb),"i"(d0*4096+ks*1024):"memory");
      asm volatile("ds_read_b64_tr_b16 %0,%1 offset:%c2":"=&v"(hi[ks]):"v"(vb),"i"(d0*4096+ks*1024+512):"memory");}
    asm volatile("s_waitcnt lgkmcnt(0)":::"memory");SBAR();
    #define PK(k) (bf16x8){lo[k][0],lo[k][1],lo[k][2],lo[k][3],hi[k][0],hi[k][1],hi[k][2],hi[k][3]}
    o[d0]=__builtin_amdgcn_mfma_f32_32x32x16_bf16(pa0,PK(0),o[d0],0,0,0);
    o[d0]=__builtin_amdgcn_mfma_f32_32x32x16_bf16(pa1,PK(1),o[d0],0,0,0);
    o[d0]=__builtin_amdgcn_mfma_f32_32x32x16_bf16(pa2,PK(2),o[d0],0,0,0);
    o[d0]=__builtin_amdgcn_mfma_f32_32x32x16_bf16(pa3,PK(3),o[d0],0,0,0);
    #undef PK
  }
}

#ifndef ATTN_STORE16
#define ATTN_STORE16(p,v) (*(u32x4*)(p)=(v))
#endif
template<int THRL,int PQ,int PK,int PV,int PO> __device__ __forceinline__ void attn_unit(int qb,const bf16*Qs,const bf16*__restrict__ Ks,const bf16*__restrict__ Vs,bf16*Os,char*shm){
  const int tid=threadIdx.x,lane=tid&63,r32=lane&31,hi=lane>>5; const int wid=__builtin_amdgcn_readfirstlane(tid>>6);
  const int q0=qb*QB;
  const bf16*Qw=Qs+(long)(q0+wid*QBLK)*PQ;
  const bf16*Kh=Ks,*Vh=Vs;
  const unsigned lds0=(unsigned)(uintptr_t)shm;
  float*wsf=(float*)(shm+LDS_WS)+wid*64;
  const bf16*ksrc=Kh+(long)lane*PK+wid*8;
  const bf16*vsrc=Vh+(long)(16*(wid&3)+(lane>>2))*PV+(wid>>2)*32+(lane&3)*8;
  const unsigned kdst=lds0+LDS_K+wid*1024, vdst=lds0+LDS_V+wid*1024;
  #define DMA_K(t,slot) glds16(ksrc+(long)(t)*KVBLK*PK,(unsigned)__builtin_amdgcn_readfirstlane(kdst+(slot)))
  #define DMA_V(t,slot) glds16(vsrc+(long)(t)*KVBLK*PV,(unsigned)__builtin_amdgcn_readfirstlane(vdst+(slot)))
  const int vb0=(int)(lds0+LDS_V)+((lane>>4)&1)*32+(lane&3)*8+(4*hi+((lane&15)>>2))*64;
  const char*Kbase=shm+LDS_K; bf16x8 kf[8];
  const lds_cptr shm3=(lds_cptr)shm; const lds_cptr kp0=shm3+LDS_K+hi*1024+r32*16; const lds_cptr vp0=shm3+LDS_V+((lane>>4)&1)*32+(lane&3)*8+(4*hi+((lane&15)>>2))*64;
  const int NT=(q0+QB)/KVBLK;
  DMA_K(0,0);DMA_V(0,0);DMA_K(1,SLOTB);
  bf16x8 qr[4];
  #pragma unroll
  for(int d0=0;d0<4;++d0)qr[d0]=*reinterpret_cast<const bf16x8*>(&Qw[(long)r32*PQ+d0*16+hi*8]);
  float mhat=0.f,l_reg=0.f;f32x16 o[2];f32x16 negm;{float z_=0.f;asm volatile("":"+v"(z_));
  _Pragma("unroll") for(int r=0;r<16;++r){o[0][r]=z_;o[1][r]=z_;negm[r]=z_;}}asm volatile("":"+v"(negm));
  const int qrel=wid*QBLK+r32;
  #define CMASK(P0,P1,t) do{int jb_=(t)-(NT-4); if(jb_>=0)cmask(P0,P1,jb_,qrel,hi);}while(0)
  bool resc=false;
  #define START(P0,P1) do{ const float rm=rowmax(P0,P1); resc=false; \
    { const float dl=rm; mhat=fadd_s(mhat,dl); \
      _Pragma("unroll") for(int r=0;r<16;++r){P0[r]=fsub_s(P0[r],dl);P1[r]=fsub_s(P1[r],dl);} \
      _Pragma("unroll") for(int r=0;r<16;++r)negm[r]=-mhat; asm volatile("":"+v"(negm)); } \
    _Pragma("unroll") for(int r=0;r<16;++r)P0[r]=__builtin_amdgcn_exp2f(P0[r]); }while(0)
  #define RESC() do{ if(resc){ asm volatile("s_waitcnt lgkmcnt(0)":::"memory"); \
      _Pragma("unroll") for(int d_=0;d_<2;++d_) _Pragma("unroll") for(int r=0;r<16;++r)o[d_][r]*=wsf[crow(r,hi)]; } }while(0)
  f32x16 pA0,pA1,pB0,pB1;
  int sl_prev=0,sl_cur=0,sl_next=SLOTB;
  #define ROT() do{sl_prev=sl_cur;sl_cur=sl_next;sl_next=(sl_next==(NSLOT-1)*SLOTB)?0:sl_next+SLOTB;}while(0)
  DMA_K(2,2*SLOTB);
  WAIT_BAR(3);
  qkt(pA0,pA1,Kbase,qr,negm,r32,hi);asm volatile("s_nop 15\n\ts_nop 7":"+v"(pA0),"+v"(pA1));CMASK(pA0,pA1,0);
  START(pA0,pA1);
  _Pragma("unroll") for(int r=0;r<16;++r)pA1[r]=__builtin_amdgcn_exp2f(pA1[r]);
  WAIT_BAR(0);
  DMA_K(3,0);DMA_V(1,SLOTB);
  ROT();
  kload8(kf,kp0+sl_cur);
  WAIT_BAR(2);
  s16x4 vlo[8],vhi[8]; u32x4 pw0,pw1,pw2,pw3;
  #define PKW(P,B) cvtpk_s(P[B],P[B+1])
  #define PAF(k) __builtin_bit_cast(bf16x8,pw##k)
  #define VFR(i) (bf16x8){vlo[i][0],vlo[i][1],vlo[i][2],vlo[i][3],vhi[i][0],vhi[i][1],vhi[i][2],vhi[i][3]}
  #define PIN(x) asm volatile("":"+v"(x))
  #define MX3(a,b,c) __builtin_fmaxf(__builtin_fmaxf((a),(b)),(c))
  #define GAPA(MF,A0,A1,A2,A3,W0,W1,PW) do{ MF; sacc+=A0; sacc+=A1; sacc+=A2; sacc+=A3; PIN(sacc); W0; W1; PIN(PW); SBAR(); }while(0)
  #define EX(v) __builtin_amdgcn_exp2f(v)
  #define GAPB(MF,X,B) do{ MF; X[B]=EX(X[B]); X[B+1]=EX(X[B+1]); X[B+2]=EX(X[B+2]); X[B+3]=EX(X[B+3]); PIN(X); SBAR(); }while(0)
  #define VRD(i) do{ vlo[i]=vtr(vp_+(((i)>>2)*4096+((i)&3)*1024)); vhi[i]=vtr(vp_+(((i)>>2)*4096+((i)&3)*1024+512)); }while(0)
  #define KRD(G,j) do{ if(G){ kload2(kf,kp0+sl_next,j); SBAR(); } }while(0)
  #define STEP(C0,C1,P0,P1,t,GK,GV,GL) do{ SBAR(); \
    const lds_cptr vp_=vp0+sl_prev; \
    VRD(0); SBAR(); float sacc=(P0[0]+P0[1]); \
    GAPA(C0=__builtin_amdgcn_mfma_f32_32x32x16_bf16(kf[0],qr[0],negm,0,0,0), P0[2],P0[3],P0[4],P0[5],     pw0[0]=PKW(P0,0), pw0[1]=PKW(P0,2), pw0); \
    VRD(4); SBAR(); GAPA(C1=__builtin_amdgcn_mfma_f32_32x32x16_bf16(kf[1],qr[0],negm,0,0,0), P0[6],P0[7],P0[8],P0[9],     pw0[2]=PKW(P0,4), pw0[3]=PKW(P0,6), pw0); \
    VRD(1); SBAR(); GAPA(C0=__builtin_amdgcn_mfma_f32_32x32x16_bf16(kf[2],qr[1],C0,0,0,0),   P0[10],P0[11],P0[12],P0[13], pw1[0]=PKW(P0,8), pw1[1]=PKW(P0,10), pw1); \
    VRD(5); SBAR(); GAPA(C1=__builtin_amdgcn_mfma_f32_32x32x16_bf16(kf[3],qr[1],C1,0,0,0),   P0[14],P0[15],P1[0],P1[1],   pw1[2]=PKW(P0,12),pw1[3]=PKW(P0,14), pw1); \
    VRD(2); SBAR(); GAPA(C0=__builtin_amdgcn_mfma_f32_32x32x16_bf16(kf[4],qr[2],C0,0,0,0),   P1[2],P1[3],P1[4],P1[5],     pw2[0]=PKW(P1,0), pw2[1]=PKW(P1,2), pw2); \
    VRD(6); SBAR(); GAPA(C1=__builtin_amdgcn_mfma_f32_32x32x16_bf16(kf[5],qr[2],C1,0,0,0),   P1[6],P1[7],P1[8],P1[9],     pw2[2]=PKW(P1,4), pw2[3]=PKW(P1,6), pw2); \
    VRD(3); SBAR(); GAPA(C0=__builtin_amdgcn_mfma_f32_32x32x16_bf16(kf[6],qr[3],C0,0,0,0),   P1[10],P1[11],P1[12],P1[13], pw3[0]=PKW(P1,8), pw3[1]=PKW(P1,10), pw3); \
    VRD(7); SBAR(); GAPA(C1=__builtin_amdgcn_mfma_f32_32x32x16_bf16(kf[7],qr[3],C1,0,0,0),   P1[14],P1[15],0.f,0.f,       pw3[2]=PKW(P1,12),pw3[3]=PKW(P1,14), pw3); \
    l_reg+=sacc; \
    if(GK){DMA_K((t)+3,sl_cur);} if(GV){DMA_V((t)+1,sl_next);} \
    CMASK(C0,C1,t); \
    { float a=MX3(C0[0],C0[1],C1[0]),b=MX3(C0[2],C0[3],C1[1]); a=MX3(a,C1[2],C1[3]); \
      _Pragma("unroll") for(int r=4;r<16;r+=4){a=MX3(a,C0[r],C0[r+1]);b=MX3(b,C0[r+2],C0[r+3]);a=MX3(a,C1[r],C1[r+1]);b=MX3(b,C1[r+2],C1[r+3]);} \
      float rm=__builtin_fmaxf(a,b); { auto rr=__builtin_amdgcn_permlane32_swap(__float_as_uint(rm),__float_as_uint(rm),false,false); rm=__builtin_fmaxf(__uint_as_float(rr[0]),__uint_as_float(rr[1])); } \
      resc=false; \
      if(__builtin_expect(__any(rm>(float)THRL),0)){ const float dl=__builtin_fmaxf(rm,0.f); mhat+=dl; \
        _Pragma("unroll") for(int r=0;r<16;++r){C0[r]-=dl;C1[r]-=dl;} \
        _Pragma("unroll") for(int r=0;r<16;++r)negm[r]=-mhat; asm volatile("":"+v"(negm)); \
        const float f=__builtin_amdgcn_exp2f(-dl); l_reg*=f; if(hi==0)wsf[r32]=f; resc=true; } } \
    SBAR(); \
    GAPB(o[0]=__builtin_amdgcn_mfma_f32_32x32x16_bf16(PAF(0),VFR(0),o[0],0,0,0), C0,0); \
    GAPB(o[1]=__builtin_amdgcn_mfma_f32_32x32x16_bf16(PAF(0),VFR(4),o[1],0,0,0), C0,4); \
    KRD(GL,0); GAPB(o[0]=__builtin_amdgcn_mfma_f32_32x32x16_bf16(PAF(1),VFR(1),o[0],0,0,0), C0,8); \
    KRD(GL,1); GAPB(o[1]=__builtin_amdgcn_mfma_f32_32x32x16_bf16(PAF(1),VFR(5),o[1],0,0,0), C0,12); \
    KRD(GL,2); GAPB(o[0]=__builtin_amdgcn_mfma_f32_32x32x16_bf16(PAF(2),VFR(2),o[0],0,0,0), C1,0); \
    KRD(GL,3); GAPB(o[1]=__builtin_amdgcn_mfma_f32_32x32x16_bf16(PAF(2),VFR(6),o[1],0,0,0), C1,4); \
    GAPB(o[0]=__builtin_amdgcn_mfma_f32_32x32x16_bf16(PAF(3),VFR(3),o[0],0,0,0), C1,8); \
    GAPB(o[1]=__builtin_amdgcn_mfma_f32_32x32x16_bf16(PAF(3),VFR(7),o[1],0,0,0), C1,12); \
    }while(0)
  int t=1;
  #undef CMASK
  #define CMASK(P0,P1,t) do{}while(0)
  for(;t+5<NT;t+=2){
    STEP(pB0,pB1,pA0,pA1,t,true,true,true);     WAIT_BAR(2); RESC(); ROT();
    STEP(pA0,pA1,pB0,pB1,t+1,true,true,true);   WAIT_BAR(2); RESC(); ROT();
  }
  #undef CMASK
  #define CMASK(P0,P1,t) do{int jb_=(t)-(NT-4); if(jb_>=0)cmask(P0,P1,jb_,qrel,hi);}while(0)
  #define ENDW(tt) do{ if((tt)+3<NT){WAIT_BAR(2);} else if((tt)+2<NT){WAIT_BAR(1);} else {WAIT_BAR(0);} }while(0)
  for(;t+1<NT;t+=2){
    STEP(pB0,pB1,pA0,pA1,t,(t+3<NT),(t+1<NT),(t+1<NT));       ENDW(t);   RESC(); ROT();
    STEP(pA0,pA1,pB0,pB1,t+1,(t+4<NT),(t+2<NT),(t+2<NT));     ENDW(t+1); RESC(); ROT();
  }
  STEP(pB0,pB1,pA0,pA1,NT-1,false,false,false); RESC();
  { float sacc=pB0[0]+pB0[1]; _Pragma("unroll") for(int r=2;r<16;++r)sacc+=pB0[r]; _Pragma("unroll") for(int r=0;r<16;++r)sacc+=pB1[r]; l_reg+=sacc;
    pw0=(u32x4){PKW(pB0,0),PKW(pB0,2),PKW(pB0,4),PKW(pB0,6)};pw1=(u32x4){PKW(pB0,8),PKW(pB0,10),PKW(pB0,12),PKW(pB0,14)};pw2=(u32x4){PKW(pB1,0),PKW(pB1,2),PKW(pB1,4),PKW(pB1,6)};pw3=(u32x4){PKW(pB1,8),PKW(pB1,10),PKW(pB1,12),PKW(pB1,14)};
    SBAR(); pv(o,vb0+sl_cur,PAF(0),PAF(1),PAF(2),PAF(3)); }
  #undef PKW
  #undef PAF
  #undef VFR
  #undef PIN
  #undef MX3
  #undef GAPA
  #undef GAPB
  #undef EX
  #undef VRD
  #undef KRD
  #undef STEP
  #undef ENDW
  {auto rr=__builtin_amdgcn_permlane32_swap(__float_as_uint(l_reg),__float_as_uint(l_reg),false,false);l_reg=__uint_as_float(rr[0])+__uint_as_float(rr[1]);}
  if(hi==0)wsf[32+r32]=l_reg;asm volatile("s_waitcnt lgkmcnt(0)":::"memory");
  float rli[16];
  #pragma unroll
  for(int r=0;r<16;++r)rli[r]=__builtin_amdgcn_rcpf(wsf[32+crow(r,hi)]);
  bf16*Ow=Os+(long)(q0+wid*QBLK)*PO;
  { bf16*stg=(bf16*)(shm+LDS_OST)+wid*2048;
    #pragma unroll
    for(int r=0;r<16;++r){const int orow=crow(r,hi);
      #pragma unroll
      for(int d0=0;d0<2;++d0)stg[orow*64+d0*32+r32]=__float2bfloat16(o[d0][r]*rli[r]);}
    asm volatile("s_waitcnt lgkmcnt(0)":::"memory");
    #pragma unroll
    for(int i=0;i<4;++i){const int row=i*8+(lane>>3),ch=lane&7; const u32x4 v=*(const u32x4*)(stg+row*64+ch*8); ATTN_STORE16(Ow+(long)row*PO+ch*8,v);} }
  asm volatile("s_waitcnt lgkmcnt(0)\n\ts_barrier":::"memory");
  #undef DMA_K
  #undef DMA_V
  #undef CMASK
  #undef START
  #undef RESC
  #undef ROT
}
constexpr int ATTN_LDS_BYTES=LDS_BYTES;
#undef SBAR
#undef WAIT_BAR
}

__device__ __forceinline__ void phase_diffattn(const Params& p, unsigned char* lds) {
    using attn64::bf16; unsigned char* ws = p.ws;
    const bf16* DQK = (const bf16*)(ws + WS_DQK); const bf16* DV = (const bf16*)(ws + WS_DV); bf16* O12 = (bf16*)p.out + (size_t)NTOK * 1024;
    const int G = gridDim.x, bx = blockIdx.x; const int vcu = (G % 8 == 0) ? (bx % 8) * (G / 8) + bx / 8 : bx;
    for (int vh = vcu; vh < 256; vh += G) {
        const int bh = vh >> 2, run = vh & 3, b = bh >> 2, h = bh & 3; const size_t row0 = (size_t)b * SEQ;
        const bf16* Qs = DQK + row0 * 1024 + (run >> 1) * 256 + h * 64; const bf16* Ks = DQK + row0 * 1024 + 512 + (run >> 1) * 256 + h * 64;
        const bf16* Vs = DV + row0 * 512 + h * 128 + (run & 1) * 64; bf16* Os = O12 + row0 * 1024 + h * 256 + run * 64;
        for (int qb = 15; qb >= 0; --qb) attn64::attn_unit<8, 1024, 1024, 512, 1024>(qb, Qs, Ks, Vs, Os, (char*)lds);
    }
}
__device__ __forceinline__ void phase_diffcombine(const Params& p, unsigned char* lds) {
    unsigned char* ws = p.ws; const bf16_t* O12 = (const bf16_t*)p.out + (size_t)NTOK * 1024; bf16_t* Y = (bf16_t*)(ws + WS_Y);
    const float lam = ((const float*)(ws + WS_SCAL))[512]; const float* sub_gain = (const float*)p.in[11];
    const int lane = threadIdx.x & 63, wave = threadIdx.x >> 6; const int gw = blockIdx.x * 8 + wave, ngw = gridDim.x * 8;
    const int h = lane >> 4, d0 = (lane & 15) * 8;
    float gn[8];
#pragma unroll
    for (int e = 0; e < 8; ++e) gn[e] = sub_gain[d0 + e] * (1.f - LAM_INIT);
    for (int t = gw; t < NTOK; t += ngw) {
        const u32x4 a = *(const u32x4*)(O12 + (size_t)t * 1024 + h * 256 + d0), b = *(const u32x4*)(O12 + (size_t)t * 1024 + h * 256 + 128 + d0);
        float o1[8], o2[8], o[8]; pg8::unpack8(a, o1); pg8::unpack8(b, o2); float sq = 0.f;
#pragma unroll
        for (int e = 0; e < 8; ++e) { o[e] = o1[e] - lam * o2[e]; sq += o[e] * o[e]; }
        sq += __shfl_xor(sq, 1); sq += __shfl_xor(sq, 2); sq += __shfl_xor(sq, 4); sq += __shfl_xor(sq, 8);
        const float rs = rsqrtf(sq * (1.f / 128.f) + RMS_EPS);
        u32x4 w; w.x = pk2(o[0] * rs * gn[0], o[1] * rs * gn[1]); w.y = pk2(o[2] * rs * gn[2], o[3] * rs * gn[3]); w.z = pk2(o[4] * rs * gn[4], o[5] * rs * gn[5]); w.w = pk2(o[6] * rs * gn[6], o[7] * rs * gn[7]);
        *(u32x4*)(Y + (size_t)t * 1536 + 512 + h * 128 + d0) = w;
    }
}

namespace attnd {
using bf16 = __hip_bfloat16;
constexpr int D = 128, NW = 8, QBLK = 32, KVBLK = 64;
constexpr float SCALE = 0.088388347648318440f;
constexpr float THR = 8.f;
constexpr int SDEPTH = 2;
constexpr int LDQ = 512, LDK = 1024, LDO = 1536;
constexpr size_t SHM_V = KVBLK * D * 2, SHM_K = KVBLK * D * 2, SHM_ATTN = 2 * SHM_V + 2 * SHM_K + NW * 64 * 4;
using bf16x8 = __attribute__((ext_vector_type(8))) short;
using s16x4  = __attribute__((ext_vector_type(4))) short;
using f32x16 = __attribute__((ext_vector_type(16))) float;
using f32x8  = __attribute__((ext_vector_type(8))) float;
using u32x4  = __attribute__((ext_vector_type(4))) unsigned;
#define KSWZ_D(row, colB) ((row) * 256 + ((colB) ^ (((row) & 7) << 4)))
#define SBAR_D() __builtin_amdgcn_sched_barrier(0)
__device__ __forceinline__ int crow(int r, int hi) { return (r & 3) + 8 * (r >> 2) + 4 * hi; }
__device__ __forceinline__ unsigned cvtpk(float lo, float hi) { return pg8::cvt_pk_bf16(lo, hi); }
template <typename TIn> struct Stage;
template <> struct Stage<bf16>  { using T = bf16x8;
  __device__ static __forceinline__ T ld8(const bf16* p) { return *reinterpret_cast<const bf16x8*>(p); }
  __device__ static __forceinline__ bf16x8 tobf(T x) { return x; } };
template <> struct Stage<float> { using T = f32x8;
  __device__ static __forceinline__ T ld8(const float* p) { return *reinterpret_cast<const f32x8*>(p); }
  __device__ static __forceinline__ bf16x8 tobf(T x) {
    u32x4 w = {cvtpk(x[0], x[1]), cvtpk(x[2], x[3]), cvtpk(x[4], x[5]), cvtpk(x[6], x[7])}; return *reinterpret_cast<bf16x8*>(&w); } };

__device__ __forceinline__ void partialSM(f32x16& p0, f32x16& p1, float& m_reg, float& mn, float& alpha) {
  constexpr float C = SCALE * 1.4426950408889634f;
  float pmax = p0[0]; for (int r = 1; r < 16; ++r) pmax = fmaxf(pmax, p0[r]); for (int r = 0; r < 16; ++r) pmax = fmaxf(pmax, p1[r]);
  { auto rr = __builtin_amdgcn_permlane32_swap(__float_as_uint(pmax), __float_as_uint(pmax), false, false);
    pmax = fmaxf(__uint_as_float(rr[0]), __uint_as_float(rr[1])); }
  if (__builtin_expect(__all(pmax - m_reg <= THR / SCALE), 1)) { mn = m_reg; alpha = 1.f; }
  else { mn = fmaxf(m_reg, pmax); alpha = __builtin_amdgcn_exp2f((m_reg - mn) * C); m_reg = mn; }
  float mnC = -mn * C;
  for (int r = 0; r < 16; ++r) p0[r] = fmaf(p0[r], C, mnC); for (int r = 0; r < 16; ++r) p1[r] = fmaf(p1[r], C, mnC);
  for (int r = 0; r < 16; ++r) p0[r] = __builtin_amdgcn_exp2f(p0[r]);
}
__device__ __forceinline__ void finishSM(f32x16& p0, f32x16& p1, float alpha, float& l_reg, bf16x8& pa0, bf16x8& pa1, bf16x8& pa2, bf16x8& pa3) {
  for (int r = 0; r < 16; ++r) p1[r] = __builtin_amdgcn_exp2f(p1[r]);
  float ps = 0; for (int r = 0; r < 16; ++r) ps += p0[r]; for (int r = 0; r < 16; ++r) ps += p1[r];
  { auto rr = __builtin_amdgcn_permlane32_swap(__float_as_uint(ps), __float_as_uint(ps), false, false);
    ps = __uint_as_float(rr[0]) + __uint_as_float(rr[1]); }
  l_reg = l_reg * alpha + ps;
#define PK4(P, BASE, OUT) do { unsigned a0 = cvtpk(P[BASE + 0], P[BASE + 1]), a1 = cvtpk(P[BASE + 2], P[BASE + 3]);   \
    unsigned b0 = cvtpk(P[BASE + 4], P[BASE + 5]), b1 = cvtpk(P[BASE + 6], P[BASE + 7]);                              \
    auto r0 = __builtin_amdgcn_permlane32_swap(a0, b0, false, false); auto r1 = __builtin_amdgcn_permlane32_swap(a1, b1, false, false); \
    u32x4 w = {r0[0], r1[0], r0[1], r1[1]}; OUT = *reinterpret_cast<bf16x8*>(&w); } while (0)
  PK4(p0, 0, pa0); PK4(p0, 8, pa1); PK4(p1, 0, pa2); PK4(p1, 8, pa3);
#undef PK4
}
__device__ __forceinline__ void qkt(f32x16& p0, f32x16& p1, const bf16* Ks, const bf16x8* qr, int r32, int hi) {
  p0 = f32x16{}; p1 = f32x16{};
  for (int d0 = 0; d0 < 8; ++d0) { int cb = (d0 * 16 + hi * 8) * 2;
    bf16x8 b0 = *reinterpret_cast<const bf16x8*>((const char*)Ks + KSWZ_D(r32, cb));
    bf16x8 b1 = *reinterpret_cast<const bf16x8*>((const char*)Ks + KSWZ_D(32 + r32, cb));
    p0 = __builtin_amdgcn_mfma_f32_32x32x16_bf16(b0, qr[d0], p0, 0, 0, 0);
    p1 = __builtin_amdgcn_mfma_f32_32x32x16_bf16(b1, qr[d0], p1, 0, 0, 0); }
}
__device__ __forceinline__ int v_st(int k, int c) { const int kk = (k & ~0xC) | ((k & 4) << 1) | ((k & 8) >> 1); return ((kk >> 3) * 4 + (c >> 5)) * 512 + ((kk & 7) * 32 + (c & 31)) * 2; }
__device__ __forceinline__ int v_rd_base(int lane) { return ((lane & 3) << 3) | (((lane >> 2) & 3) << 6) | (((lane >> 4) & 1) << 5) | (((lane >> 5) & 1) << 8); }
constexpr int v_rd_off(int d0, int ks, int half) { return d0 * 512 + ks * 4096 + half * 2048; }
template <int OFF> __device__ __forceinline__ s16x4 tr_read(int vb) {
  s16x4 r; asm volatile("ds_read_b64_tr_b16 %0, %1 offset:%2" : "=&v"(r) : "v"(vb), "i"(OFF) : "memory"); return r;
}
template <int D0> __device__ __forceinline__ void pv_one(f32x16& od, int vb, bf16x8 pa0, bf16x8 pa1, bf16x8 pa2, bf16x8 pa3) {
  const s16x4 l0 = tr_read<v_rd_off(D0, 0, 0)>(vb), h0 = tr_read<v_rd_off(D0, 0, 1)>(vb), l1 = tr_read<v_rd_off(D0, 1, 0)>(vb), h1 = tr_read<v_rd_off(D0, 1, 1)>(vb);
  const s16x4 l2 = tr_read<v_rd_off(D0, 2, 0)>(vb), h2 = tr_read<v_rd_off(D0, 2, 1)>(vb), l3 = tr_read<v_rd_off(D0, 3, 0)>(vb), h3 = tr_read<v_rd_off(D0, 3, 1)>(vb);
  asm volatile("s_waitcnt lgkmcnt(0)" ::: "memory"); SBAR_D();
#define PK(L, H) (bf16x8){L[0], L[1], L[2], L[3], H[0], H[1], H[2], H[3]}
  od = __builtin_amdgcn_mfma_f32_32x32x16_bf16(pa0, PK(l0, h0), od, 0, 0, 0);
  od = __builtin_amdgcn_mfma_f32_32x32x16_bf16(pa1, PK(l1, h1), od, 0, 0, 0);
  od = __builtin_amdgcn_mfma_f32_32x32x16_bf16(pa2, PK(l2, h2), od, 0, 0, 0);
  od = __builtin_amdgcn_mfma_f32_32x32x16_bf16(pa3, PK(l3, h3), od, 0, 0, 0);
#undef PK
}
__device__ __forceinline__ void pv_d0(f32x16* o, int vb, bf16x8 pa0, bf16x8 pa1, bf16x8 pa2, bf16x8 pa3) {
  pv_one<0>(o[0], vb, pa0, pa1, pa2, pa3); pv_one<1>(o[1], vb, pa0, pa1, pa2, pa3); pv_one<2>(o[2], vb, pa0, pa1, pa2, pa3); pv_one<3>(o[3], vb, pa0, pa1, pa2, pa3);
}

template <typename TQ>
__device__ __forceinline__ void attn_dense_body(const TQ* __restrict__ Qb, const bf16* __restrict__ Kh, const bf16* __restrict__ Vh,
                                                bf16* __restrict__ Ob, int seq, char* lds) {
  using St = Stage<bf16>; using SQ = Stage<TQ>;
  const int tid = threadIdx.x, wid = tid >> 6, lane = tid & 63, r32 = lane & 31, hi = lane >> 5;
  bf16* V_lds = (bf16*)lds; bf16* K_lds = (bf16*)(lds + 2 * SHM_V);
  float* ws = (float*)(lds + 2 * SHM_V + 2 * SHM_K) + wid * 64; float* li_l = ws; float* al_l = ws + 32;
  float m_reg = -1e30f, l_reg = 0; f32x16 o[4] = {}; bf16x8 qr[8];
  const TQ* Qw = Qb + (long)(wid * QBLK + r32) * LDQ + hi * 8;
#pragma unroll
  for (int d0 = 0; d0 < 8; ++d0) qr[d0] = SQ::tobf(SQ::ld8(Qw + d0 * 16));
  const int sr = tid >> 4, sc = (tid & 15) * 8, vst0 = v_st(sr, sc), vst1 = v_st(32 + sr, sc);
  const int vb0 = (int)(uintptr_t)V_lds + v_rd_base(lane);
  struct { typename St::T vs0, vs1, ks0, ks1; } sr_[SDEPTH];
#define SLOAD(i, k0) do { sr_[i].vs0 = St::ld8(&Vh[(long)((k0) + sr) * LDK + sc]); sr_[i].vs1 = St::ld8(&Vh[(long)((k0) + 32 + sr) * LDK + sc]); \
    sr_[i].ks0 = St::ld8(&Kh[(long)((k0) + sr) * LDK + sc]); sr_[i].ks1 = St::ld8(&Kh[(long)((k0) + 32 + sr) * LDK + sc]); } while (0)
#define SWRITE(b, i) do { *(bf16x8*)((char*)V_lds + (b) * SHM_V + vst0) = St::tobf(sr_[i].vs0);          \
    *(bf16x8*)((char*)V_lds + (b) * SHM_V + vst1) = St::tobf(sr_[i].vs1); int kc = sc * 2;               \
    *(bf16x8*)((char*)K_lds + (b) * SHM_K + KSWZ_D(sr, kc)) = St::tobf(sr_[i].ks0);                       \
    *(bf16x8*)((char*)K_lds + (b) * SHM_K + KSWZ_D(32 + sr, kc)) = St::tobf(sr_[i].ks1); } while (0)
#define SWAIT() do { if constexpr (SDEPTH == 2) asm volatile("s_waitcnt vmcnt(4)" ::: "memory"); else asm volatile("s_waitcnt vmcnt(0)" ::: "memory"); } while (0)
#define RESC(a) do { if (__any((a) < 1.f)) { if (hi == 0) al_l[r32] = (a); asm volatile("s_waitcnt lgkmcnt(0)" ::: "memory"); \
    for (int d = 0; d < 4; ++d) for (int r = 0; r < 16; ++r) o[d][r] *= al_l[crow(r, hi)]; } } while (0)
  f32x16 pA0, pA1, pB0, pB1; float mnA, mnB, alA, alB; bf16x8 pa0, pa1, pa2, pa3; const int NT = seq / KVBLK;
  constexpr int SE = 0, SO = SDEPTH - 1;
  SLOAD(SE, 0); asm volatile("s_waitcnt vmcnt(0)" ::: "memory"); SWRITE(0, SE); __syncthreads();
  qkt(pA0, pA1, K_lds, qr, r32, hi); partialSM(pA0, pA1, m_reg, mnA, alA);
  SLOAD(SO, KVBLK); if constexpr (SDEPTH == 2) { if (2 < NT) SLOAD(SE, 2 * KVBLK); }
  SWAIT(); SWRITE(1, SO); __syncthreads();
  for (int j = 1; j + 1 < NT; j += 2) {
    SBAR_D(); qkt(pB0, pB1, (bf16*)((char*)K_lds + SHM_K), qr, r32, hi);
    finishSM(pA0, pA1, alA, l_reg, pa0, pa1, pa2, pa3); SBAR_D();
    SLOAD(SO, (j + SDEPTH) * KVBLK); SBAR_D();
    pv_d0(o, vb0, pa0, pa1, pa2, pa3); partialSM(pB0, pB1, m_reg, mnB, alB);
    __syncthreads(); SWAIT(); SWRITE(0, SE);
    RESC(alB); __syncthreads();
    SBAR_D(); qkt(pA0, pA1, K_lds, qr, r32, hi);
    finishSM(pB0, pB1, alB, l_reg, pa0, pa1, pa2, pa3); SBAR_D();
    if (SDEPTH == 1 || j + 3 < NT) SLOAD(SE, (j + 1 + SDEPTH) * KVBLK); SBAR_D();
    pv_d0(o, vb0 + (int)SHM_V, pa0, pa1, pa2, pa3); partialSM(pA0, pA1, m_reg, mnA, alA);
    __syncthreads(); SWAIT(); SWRITE(1, SO);
    RESC(alA); __syncthreads();
  }
  SBAR_D(); qkt(pB0, pB1, (bf16*)((char*)K_lds + SHM_K), qr, r32, hi);
  finishSM(pA0, pA1, alA, l_reg, pa0, pa1, pa2, pa3); SBAR_D();
  pv_d0(o, vb0, pa0, pa1, pa2, pa3); partialSM(pB0, pB1, m_reg, mnB, alB);
  __syncthreads(); RESC(alB);
  finishSM(pB0, pB1, alB, l_reg, pa0, pa1, pa2, pa3); SBAR_D();
  pv_d0(o, vb0 + (int)SHM_V, pa0, pa1, pa2, pa3);
  if (hi == 0) li_l[r32] = l_reg; asm volatile("s_waitcnt lgkmcnt(0)" ::: "memory");
  float rli[16];
#pragma unroll
  for (int r = 0; r < 16; ++r) rli[r] = __builtin_amdgcn_rcpf(li_l[crow(r, hi)]);
  bf16* Ow = Ob + (long)(wid * QBLK) * LDO;
#pragma unroll
  for (int r = 0; r < 16; ++r) { int orow = crow(r, hi);
    for (int d0 = 0; d0 < 4; ++d0) Ow[(long)orow * LDO + d0 * 32 + r32] = __float2bfloat16(o[d0][r] * rli[r]); }
#undef SLOAD
#undef SWRITE
#undef SWAIT
#undef RESC
}

}
__device__ __forceinline__ void phase_memattn(const Params& p, unsigned char* lds) {
    using attnd::bf16; unsigned char* ws = p.ws; const bf16* MQ = (const bf16*)(ws + WS_MQ); const bf16* MKV = (const bf16*)(ws + WS_MKV); bf16* Y = (bf16*)(ws + WS_Y);
    const int G = gridDim.x, bx = blockIdx.x; const int vcu = (G % 8 == 0) ? (bx % 8) * (G / 8) + bx / 8 : bx;
    for (int u = vcu; u < NBATCH * 4 * 16; u += G) {
        const int qb = u & 15, bh = u >> 4, b = bh >> 2, h = bh & 3; const size_t m0 = (size_t)b * SEQ + qb * 256;
        attnd::attn_dense_body<bf16>(MQ + m0 * 512 + h * 128, MKV + (size_t)b * NMEM * 1024 + h * 128, MKV + (size_t)b * NMEM * 1024 + 512 + h * 128, Y + m0 * 1536 + 1024 + h * 128, NMEM, (char*)lds);
        __syncthreads();
    }
}

namespace hg {
constexpr int ROWQ = 272, ROWT = 144;
constexpr int L_QR = 0, L_FR = 17408, L_VR = 34816, L_VT = 52224, L_KT = 70656, L_TOT = 89088, L_SSQ = 91136;
__device__ __forceinline__ void load_tile(unsigned char* dst, const bf16_t* src, int tid) {
    const int r = tid >> 3, c = tid & 7;
    const u32x4 a = *(const u32x4*)(src + (size_t)r * 2048 + c * 8), b = *(const u32x4*)(src + (size_t)r * 2048 + 64 + c * 8);
    *(u32x4*)(dst + r * ROWQ + c * 16) = a; *(u32x4*)(dst + r * ROWQ + 128 + c * 16) = b;
}
__device__ __forceinline__ u32x4 pack8(const float* v) { u32x4 w; w.x = pk2(v[0], v[1]); w.y = pk2(v[2], v[3]); w.z = pk2(v[4], v[5]); w.w = pk2(v[6], v[7]); return w; }
__device__ __forceinline__ void gate_scan(unsigned char* lds, int k, int seg, float lbv, float (&kk)[16], float (&cs)[16], float& offset, float& total) {
    float run = 0.f;
#pragma unroll
    for (int i = 0; i < 16; ++i) { const float fp = bf2f(*(const bf16_t*)(lds + L_FR + (16 * seg + i) * ROWQ + k * 2)); const float sg = sigmoidf_(fp);
        const float f = lbv + (1.f - lbv) * sg; kk[i] = (1.f - lbv) * (1.f - sg); run += __logf(f); cs[i] = run; }
    float* tot = (float*)(lds + L_TOT); tot[seg * 128 + k] = run;
    __syncthreads();
    const float t0 = tot[k], t1 = tot[128 + k], t2 = tot[256 + k], t3 = tot[384 + k];
    offset = (seg > 0 ? t0 : 0.f) + (seg > 1 ? t1 : 0.f) + (seg > 2 ? t2 : 0.f); total = (t0 + t1) + (t2 + t3);
}
__device__ __forceinline__ void write_vt(unsigned char* lds, int k, int seg) {
    float v[16];
#pragma unroll
    for (int i = 0; i < 16; ++i) v[i] = bf2f(*(const bf16_t*)(lds + L_VR + (16 * seg + i) * ROWQ + k * 2));
    *(u32x4*)(lds + L_VT + k * ROWT + seg * 32) = pack8(v); *(u32x4*)(lds + L_VT + k * ROWT + seg * 32 + 16) = pack8(v + 8);
}
}
__device__ __forceinline__ void phase_hgrn_A(const Params& p, unsigned char* lds) {
    using namespace hg; unsigned char* ws = p.ws; const bf16_t* HG = (const bf16_t*)(ws + WS_HG); const float* lower0 = (const float*)(ws + WS_SCAL);
    bf16_t* US = (bf16_t*)p.out; float* DEC = (float*)(ws + WS_DEC);
    const int tid = threadIdx.x, lane = tid & 63, w = tid >> 6, fr = lane & 15, fq = lane >> 4, k = tid & 127, seg = tid >> 7;
    for (int item = blockIdx.x; item < 4096; item += gridDim.x) {
        const int bh = item >> 6, c = item & 63, b = bh >> 2, h = bh & 3; const bf16_t* row0 = HG + ((size_t)b * SEQ + c * 64) * 2048 + h * 128;
        load_tile(lds + L_FR, row0 + 512, tid); load_tile(lds + L_VR, row0 + 1024, tid);
        __syncthreads();
        float kk[16], cs[16], offset, total; const float lbv = lower0[h * 128 + k];
        write_vt(lds, k, seg);
        gate_scan(lds, k, seg, lbv, kk, cs, offset, total);
        { float ke[16];
#pragma unroll
          for (int i = 0; i < 16; ++i) ke[i] = kk[i] * __expf(total - (offset + cs[i]));
          *(u32x4*)(lds + L_KT + k * ROWT + seg * 32) = pack8(ke); *(u32x4*)(lds + L_KT + k * ROWT + seg * 32 + 16) = pack8(ke + 8);
          if (seg == 0) DEC[(size_t)item * 128 + k] = __expf(total); }
        __syncthreads();
        const bf16x8 a0 = *(const bf16x8*)(lds + L_KT + (16 * w + fr) * ROWT + fq * 16), a1 = *(const bf16x8*)(lds + L_KT + (16 * w + fr) * ROWT + 64 + fq * 16);
        unsigned char* uT = lds + L_FR;
#pragma unroll
        for (int j = 0; j < 8; ++j) {
            const bf16x8 b0 = *(const bf16x8*)(lds + L_VT + (16 * j + fr) * ROWT + fq * 16), b1 = *(const bf16x8*)(lds + L_VT + (16 * j + fr) * ROWT + 64 + fq * 16);
            f32x4 acc = {0.f, 0.f, 0.f, 0.f};
            acc = __builtin_amdgcn_mfma_f32_16x16x32_bf16(a0, b0, acc, 0, 0, 0); acc = __builtin_amdgcn_mfma_f32_16x16x32_bf16(a1, b1, acc, 0, 0, 0);
            u32x2 o; o.x = pk2(acc[0], acc[1]); o.y = pk2(acc[2], acc[3]);
            *(u32x2*)(uT + (16 * j + fr) * ROWQ + (16 * w + 4 * fq) * 2) = o; }
        __syncthreads();
        bf16_t* dst = US + (size_t)item * 16384;
#pragma unroll
        for (int i = 0; i < 4; ++i) { const int ch = tid + 512 * i, v = ch >> 4, kc = ch & 15; *(u32x4*)(dst + v * 128 + kc * 8) = *(const u32x4*)(uT + v * ROWQ + kc * 16); }
        __syncthreads();
    }
}
__device__ __forceinline__ void phase_hgrn_B(const Params& p, unsigned char* lds) {
    unsigned char* ws = p.ws; bf16_t* US = (bf16_t*)p.out; const float* DEC = (const float*)(ws + WS_DEC);
    const size_t gt = (size_t)blockIdx.x * 512 + threadIdx.x, ngt = (size_t)gridDim.x * 512;
    for (size_t e = gt; e < (size_t)64 * 128 * 16; e += ngt) {
        const int kc = (int)(e & 15), v = (int)((e >> 4) & 127), bh = (int)(e >> 11);
        bf16_t* pu = US + (size_t)bh * 64 * 16384 + v * 128 + kc * 8; const float* pd = DEC + (size_t)bh * 64 * 128 + kc * 8;
        float S[8];
#pragma unroll
        for (int i = 0; i < 8; ++i) S[i] = 0.f;
#pragma unroll 4
        for (int c = 0; c < 64; ++c) {
            const u32x4 uw = *(const u32x4*)(pu + (size_t)c * 16384); const f32x4 d0 = *(const f32x4*)(pd + c * 128), d1 = *(const f32x4*)(pd + c * 128 + 4);
            float u[8]; pg8::unpack8(uw, u);
            *(u32x4*)(pu + (size_t)c * 16384) = hg::pack8(S);
            S[0] = d0[0] * S[0] + u[0]; S[1] = d0[1] * S[1] + u[1]; S[2] = d0[2] * S[2] + u[2]; S[3] = d0[3] * S[3] + u[3];
            S[4] = d1[0] * S[4] + u[4]; S[5] = d1[1] * S[5] + u[5]; S[6] = d1[2] * S[6] + u[6]; S[7] = d1[3] * S[7] + u[7];
        }
    }
}
__device__ __forceinline__ void phase_hgrn_C(const Params& p, unsigned char* lds) {
    using namespace hg; unsigned char* ws = p.ws; const bf16_t* HG = (const bf16_t*)(ws + WS_HG); const float* lower0 = (const float*)(ws + WS_SCAL);
    const bf16_t* US = (const bf16_t*)p.out; bf16_t* Y = (bf16_t*)(ws + WS_Y); const float* gain = (const float*)p.in[6];
    const int tid = threadIdx.x, lane = tid & 63, w = tid >> 6, fr = lane & 15, fq = lane >> 4, k = tid & 127, seg = tid >> 7;
    for (int item = blockIdx.x; item < 4096; item += gridDim.x) {
        const int bh = item >> 6, c = item & 63, b = bh >> 2, h = bh & 3; const size_t m0 = (size_t)b * SEQ + c * 64; const bf16_t* row0 = HG + m0 * 2048 + h * 128;
        bf16x8 bS[4];
        { const bf16_t* sp = US + (size_t)item * 16384 + (16 * w + fr) * 128 + fq * 8;
#pragma unroll
          for (int ks = 0; ks < 4; ++ks) bS[ks] = *(const bf16x8*)(sp + ks * 32); }
        load_tile(lds + L_QR, row0, tid); load_tile(lds + L_FR, row0 + 512, tid); load_tile(lds + L_VR, row0 + 1024, tid);
        __syncthreads();
        float kk[16], cs[16], offset, total; const float lbv = lower0[h * 128 + k];
        write_vt(lds, k, seg);
        gate_scan(lds, k, seg, lbv, kk, cs, offset, total);
#pragma unroll
        for (int i = 0; i < 16; ++i) { const float cum = offset + cs[i]; bf16_t* pq = (bf16_t*)(lds + L_QR + (16 * seg + i) * ROWQ + k * 2); bf16_t* pf = (bf16_t*)(lds + L_FR + (16 * seg + i) * ROWQ + k * 2);
            *pq = f2bf(bf2f(*pq) * __expf(cum)); *pf = f2bf(kk[i] * __expf(-cum)); }
        __syncthreads();
        { const int si = w >> 1; bf16x8 a[4];
#pragma unroll
          for (int ks = 0; ks < 4; ++ks) a[ks] = *(const bf16x8*)(lds + L_FR + (16 * si + fr) * ROWQ + ks * 64 + fq * 16);
#pragma unroll
          for (int jj = 0; jj < 2; ++jj) { const int tj = 2 * (w & 1) + jj; f32x4 acc = {0.f, 0.f, 0.f, 0.f};
#pragma unroll
              for (int ks = 0; ks < 4; ++ks) { const bf16x8 bq = *(const bf16x8*)(lds + L_QR + (16 * tj + fr) * ROWQ + ks * 64 + fq * 16); acc = __builtin_amdgcn_mfma_f32_16x16x32_bf16(a[ks], bq, acc, 0, 0, 0); }
              const int t = 16 * tj + fr, s0 = 16 * si + 4 * fq;
              u32x2 o; o.x = pk2(s0 <= t ? acc[0] : 0.f, s0 + 1 <= t ? acc[1] : 0.f); o.y = pk2(s0 + 2 <= t ? acc[2] : 0.f, s0 + 3 <= t ? acc[3] : 0.f);
              *(u32x2*)(lds + L_KT + t * ROWT + s0 * 2) = o; } }
        __syncthreads();
        f32x4 acc[4];
        { const bf16x8 bV0 = *(const bf16x8*)(lds + L_VT + (16 * w + fr) * ROWT + fq * 16), bV1 = *(const bf16x8*)(lds + L_VT + (16 * w + fr) * ROWT + 64 + fq * 16);
#pragma unroll
          for (int tj = 0; tj < 4; ++tj) { f32x4 ac = {0.f, 0.f, 0.f, 0.f};
#pragma unroll
              for (int ks = 0; ks < 4; ++ks) { const bf16x8 aq = *(const bf16x8*)(lds + L_QR + (16 * tj + fr) * ROWQ + ks * 64 + fq * 16); ac = __builtin_amdgcn_mfma_f32_16x16x32_bf16(aq, bS[ks], ac, 0, 0, 0); }
              const bf16x8 ap0 = *(const bf16x8*)(lds + L_KT + (16 * tj + fr) * ROWT + fq * 16), ap1 = *(const bf16x8*)(lds + L_KT + (16 * tj + fr) * ROWT + 64 + fq * 16);
              ac = __builtin_amdgcn_mfma_f32_16x16x32_bf16(ap0, bV0, ac, 0, 0, 0); ac = __builtin_amdgcn_mfma_f32_16x16x32_bf16(ap1, bV1, ac, 0, 0, 0);
              acc[tj] = ac; } }
        float* ssq = (float*)(lds + L_SSQ);
#pragma unroll
        for (int tj = 0; tj < 4; ++tj)
#pragma unroll
            for (int r = 0; r < 4; ++r) { float sq = acc[tj][r] * acc[tj][r]; sq += __shfl_xor(sq, 1); sq += __shfl_xor(sq, 2); sq += __shfl_xor(sq, 4); sq += __shfl_xor(sq, 8);
                if (fr == 0) ssq[w * 64 + 16 * tj + 4 * fq + r] = sq; }
        __syncthreads();
        const float gn = gain[h * 128 + 16 * w + fr];
#pragma unroll
        for (int tj = 0; tj < 4; ++tj)
#pragma unroll
            for (int r = 0; r < 4; ++r) { const int t = 16 * tj + 4 * fq + r; float tot = 0.f;
#pragma unroll
                for (int ww = 0; ww < 8; ++ww) tot += ssq[ww * 64 + t];
                const float gate = bf2f(row0[(size_t)t * 2048 + 1536 + 16 * w + fr]);
                Y[(m0 + t) * 1536 + h * 128 + 16 * w + fr] = f2bf(acc[tj][r] * rsqrtf(tot * (1.f / 128.f) + RMS_EPS) * gn * gate); }
        __syncthreads();
    }
}

template <bool COOP> __device__ __forceinline__ void cg_or_nothing() { if (COOP) cg::this_grid().sync(); }
template <bool COOP>
__global__ void __launch_bounds__(512, 2) k_fwd(Params p) {
    extern __shared__ __attribute__((aligned(16))) unsigned char lds[];
    const int lo = p.ph_lo, hi = p.ph_hi;
#define RUN_PHASE(k, call) do { if (((PHASE_MASK >> (k)) & 1) && lo <= (k) && (k) < hi) { call; if (COOP && (k) + 1 < hi) { cg::this_grid().sync(); } } } while (0)
    RUN_PHASE(0, phase_prologue(p, lds));
    RUN_PHASE(1, ((USE_PG8 & 1) ? phase_proj_pg8(p, lds) : (phase_proj(p, lds), cg_or_nothing<COOP>(), phase_rope(p, lds))));
    RUN_PHASE(2, (((USE_OPT & 2) ? phase_hgrn_A(p, lds) : phase_hgrn_naive(p, lds)), __syncthreads(), (USE_OPT & 1) ? phase_diffattn(p, lds) : phase_attn_naive<true>(p, lds), __syncthreads(), (USE_OPT & 4) ? phase_memattn(p, lds) : phase_attn_naive<false>(p, lds)));
    RUN_PHASE(3, (((USE_OPT & 2) ? phase_hgrn_B(p, lds) : (void)0), __syncthreads(), (USE_OPT & 1) ? phase_diffcombine(p, lds) : (void)0));
    RUN_PHASE(4, ((USE_OPT & 2) ? phase_hgrn_C(p, lds) : (void)0));
    RUN_PHASE(5, ((USE_PG8 & 2) ? phase_merge_pg8(p, lds) : phase_merge(p, lds)));
    RUN_PHASE(6, ((USE_PG8 & 4) ? phase_wout_pg8(p, lds) : phase_wout(p, lds)));
    RUN_PHASE(7, ((USE_OPT & 8) ? phase_ln1_route2(p, lds) : phase_ln1_route(p, lds)));
    RUN_PHASE(8, phase_dispatch(p, lds));
    RUN_PHASE(9, ((USE_PG8 & 8) ? phase_exp_gu_pg8(p, lds) : phase_exp_gu(p, lds)));
    RUN_PHASE(10, ((USE_PG8 & 16) ? phase_exp_dn_pg8(p, lds) : phase_exp_dn(p, lds)));
    RUN_PHASE(11, phase_final(p, lds));
#undef RUN_PHASE
}

extern "C" void kernel_launch(void* const* d_in, const int* in_sizes, int n_in, void* d_out, int out_size, void* d_ws, size_t ws_size, hipStream_t stream) {
    static int grid = 0;
    if (grid == 0) {
        if (n_in != 26 || in_sizes[0] != NTOK * DM || out_size != NTOK * DM || ws_size < WS_END) {
            fprintf(stderr, "kernel_launch: unexpected shapes: n_in %d in0 %d out %d ws %zu (need >= %zu)\n", n_in, n_in > 0 ? in_sizes[0] : -1, out_size, ws_size, (size_t)WS_END); grid = -1; return; }
        int dev = 0, cus = 0, per_cu = 0;
        hipGetDevice(&dev); hipDeviceGetAttribute(&cus, hipDeviceAttributeMultiprocessorCount, dev);
        if (MK_ONE_LAUNCH) {
            hipFuncSetAttribute((const void*)k_fwd<true>, hipFuncAttributeMaxDynamicSharedMemorySize, LDS_BYTES);
            hipOccupancyMaxActiveBlocksPerMultiprocessor(&per_cu, (const void*)k_fwd<true>, 512, LDS_BYTES);
            if (per_cu < 1) { fprintf(stderr, "kernel_launch: occupancy query says %d blocks/CU\n", per_cu); per_cu = 1; }
            grid = cus * 1;
        } else {
            hipFuncSetAttribute((const void*)k_fwd<false>, hipFuncAttributeMaxDynamicSharedMemorySize, LDS_BYTES);
            grid = cus;
        }
        (void)hipGetLastError();
    }
    if (grid < 0) return;
    Params p{};
    for (int i = 0; i < 26; ++i) p.in[i] = d_in[i];
    p.out = (float*)d_out; p.ws = (unsigned char*)d_ws;
    if (MK_ONE_LAUNCH) {
        p.ph_lo = 0; p.ph_hi = NPHASE;
        void* args[] = {&p};
        hipError_t e = hipLaunchCooperativeKernel((const void*)k_fwd<true>, dim3(grid), dim3(512), args, LDS_BYTES, stream);
        if (e != hipSuccess) fprintf(stderr, "cooperative launch failed: %s (grid %d)\n", hipGetErrorString(e), grid);
    } else {
        for (int ph = 0; ph < NPHASE; ++ph) { p.ph_lo = ph; p.ph_hi = ph + 1; hipLaunchKernelGGL(k_fwd<false>, dim3(grid), dim3(512), LDS_BYTES, stream, p); }
    }
}
```

```cpp
#include <hip/hip_runtime.h>
#include <hip/hip_cooperative_groups.h>
#include <cstdio>
#include <cstdint>
namespace cg = cooperative_groups;

#ifndef PHASE_MASK
#define PHASE_MASK 0xffff
#endif
#ifndef USE_PG8
#define USE_PG8 0x1f
#endif
#ifndef USE_OPT
#define USE_OPT 0xf
#endif
#ifndef MK_ONE_LAUNCH
#define MK_ONE_LAUNCH 1
#endif

typedef unsigned short bf16_t;
typedef short bf16x8 __attribute__((ext_vector_type(8)));
typedef float f32x4 __attribute__((ext_vector_type(4)));
typedef unsigned u32x4 __attribute__((ext_vector_type(4)));
typedef unsigned u32x2 __attribute__((ext_vector_type(2)));

constexpr int NTOK = 65536, DM = 1024, SEQ = 4096, NBATCH = 16, NMEM = 256, NEXP = 32;
constexpr int NSLOT = 2 * NTOK + NEXP * 256;
constexpr float ALPHA = 1.189207115002721f;
constexpr float LN_EPS = 1e-5f, RMS_EPS = 1e-6f;
constexpr float LOG2E = 1.4426950408889634f;
constexpr float QSCALE_DF = 0.125f * LOG2E;
constexpr float QSCALE_MEM = 0.08838834764831845f * LOG2E;
constexpr float LAM_INIT = 0.2f;
constexpr int NPHASE = 12;

constexpr size_t MiB = (size_t)1 << 20;
constexpr size_t WS_CTL = 0;
constexpr size_t WS_SCAL = 1 * MiB;
constexpr size_t WS_ROPE = 2 * MiB;
constexpr size_t WS_RECI = 6 * MiB;
constexpr size_t WS_RECW = 7 * MiB;
constexpr size_t WS_WT_IN = 8 * MiB;
constexpr size_t WS_WT_G = 16 * MiB;
constexpr size_t WS_WT_MKV = 22 * MiB;
constexpr size_t WS_WT_B = 24 * MiB;
constexpr size_t WS_WT_OUT = 27 * MiB;
constexpr size_t WS_WT_R = 29 * MiB;
constexpr size_t WS_WT_GU = 30 * MiB;
constexpr size_t WS_WT_DN = 94 * MiB;
constexpr size_t WS_MEMB = 126 * MiB;
constexpr size_t WS_MKV = 134 * MiB;
constexpr size_t WS_DEC = 142 * MiB;
constexpr size_t WS_LOGITS = 144 * MiB;
constexpr size_t WS_HG = 176 * MiB;
constexpr size_t WS_DQK = 432 * MiB;
constexpr size_t WS_DV = 560 * MiB;
constexpr size_t WS_MQ = 624 * MiB;
constexpr size_t WS_XB = 688 * MiB;
constexpr size_t WS_Y = 816 * MiB;
constexpr size_t WS_END = 1008 * MiB;
constexpr size_t WS_MERGED = WS_HG;
constexpr size_t WS_X1B = WS_DV;
constexpr size_t WS_XS = WS_HG;
constexpr size_t WS_H = 448 * MiB;
constexpr size_t WS_YB = 584 * MiB;
constexpr int LDS_BYTES = 147456, LDS_BAR = 147456 - 64;
constexpr size_t WS_BAR = 65536;

struct Params { const void* in[26]; float* out; unsigned char* ws; int ph_lo, ph_hi; };

__device__ __forceinline__ float bf2f(bf16_t v) { return __uint_as_float(((unsigned)v) << 16); }
__device__ __forceinline__ bf16_t f2bf(float f) { unsigned u = __float_as_uint(f); u += 0x7fffu + ((u >> 16) & 1u); return (bf16_t)(u >> 16); }
__device__ __forceinline__ unsigned pk2(float lo, float hi) { return (unsigned)f2bf(lo) | ((unsigned)f2bf(hi) << 16); }
__device__ __forceinline__ float sigmoidf_(float x) { return __builtin_amdgcn_rcpf(1.f + __expf(-x)); }
__device__ __forceinline__ float siluf_(float x) { return x * __builtin_amdgcn_rcpf(1.f + __expf(-x)); }
__device__ __forceinline__ float wave_sum(float v) {
#pragma unroll
    for (int o = 1; o < 64; o <<= 1) v += __shfl_xor(v, o);
    return v;
}
__device__ __forceinline__ float wave_max(float v) {
#pragma unroll
    for (int o = 1; o < 64; o <<= 1) v = fmaxf(v, __shfl_xor(v, o));
    return v;
}
#define LDS_WAIT() asm volatile("s_waitcnt lgkmcnt(0)" ::: "memory")

__device__ __forceinline__ void tr_item(const float* W, int K, int N, bf16_t* WT, int dst_row0, float* scr, int k0, int n0, int lane) {
#pragma unroll 8
    for (int i = 0; i < 32; ++i) { const int kk = 2 * i + (lane >> 5); scr[kk * 33 + (lane & 31)] = W[(size_t)(k0 + kk) * N + n0 + (lane & 31)]; }
    LDS_WAIT();
    const int c = lane & 7;
#pragma unroll
    for (int j = 0; j < 4; ++j) { const int n = (lane >> 3) + 8 * j; const float* s = scr + (8 * c) * 33 + n;
        u32x4 o; o.x = pk2(s[0 * 33], s[1 * 33]); o.y = pk2(s[2 * 33], s[3 * 33]); o.z = pk2(s[4 * 33], s[5 * 33]); o.w = pk2(s[6 * 33], s[7 * 33]);
        *(u32x4*)(WT + (size_t)(dst_row0 + n) * K + k0 + 8 * c) = o; }
    LDS_WAIT();
}
__device__ __forceinline__ void tr_job(const float* W, int K, int N, int ne, bf16_t* WT, int erow, int blk, int blkstride, int base, float* scr, int gw, int ngw, int lane) {
    const int nkb = K / 64, nnb = N / 32, per = nkb * nnb, total = per * ne;
    for (int it = gw; it < total; it += ngw) {
        const int e = it / per, r = it % per, kb = r / nnb, nb = r % nnb, n0 = nb * 32;
        tr_item(W + (size_t)e * K * N, K, N, WT, base + e * erow + (n0 / blk) * blkstride + (n0 % blk), scr, kb * 64, n0, lane);
    }
}
__device__ __forceinline__ void sincos_acc(float ang, float& c, float& s) {
    const double a = (double)ang;
    const double q = rint(a * 0.63661977236758134308);
    const double r = fma(-q, 1.57079632679489661923, a) - q * 6.12323399573676603587e-17;
    const double r2 = r * r;
    double sp = 1.0 / 6227020800.0; sp = fma(sp, r2, -1.0 / 39916800.0); sp = fma(sp, r2, 1.0 / 362880.0); sp = fma(sp, r2, -1.0 / 5040.0);
    sp = fma(sp, r2, 1.0 / 120.0); sp = fma(sp, r2, -1.0 / 6.0); sp = fma(sp, r2, 1.0); const double sr = sp * r;
    double cp = 1.0 / 479001600.0; cp = fma(cp, r2, -1.0 / 3628800.0); cp = fma(cp, r2, 1.0 / 40320.0); cp = fma(cp, r2, -1.0 / 720.0);
    cp = fma(cp, r2, 1.0 / 24.0); cp = fma(cp, r2, -0.5); const double cr = fma(cp, r2, 1.0);
    const int qi = ((int)q) & 3;
    const double cc = (qi == 0) ? cr : (qi == 1) ? -sr : (qi == 2) ? -cr : sr;
    const double ss = (qi == 0) ? sr : (qi == 1) ? cr : (qi == 2) ? -sr : -cr;
    c = (float)cc; s = (float)ss;
}
__device__ __forceinline__ void phase_prologue(const Params& p, unsigned char* lds) {
    const int tid = threadIdx.x, lane = tid & 63, wave = tid >> 6;
    const int gw = blockIdx.x * 8 + wave, ngw = gridDim.x * 8;
    const size_t gt = (size_t)blockIdx.x * 512 + tid, ngt = (size_t)gridDim.x * 512;
    unsigned char* ws = p.ws;
    float* scr = (float*)lds + wave * (64 * 33);
    tr_job((const float*)p.in[3], 1024, 4096, 1, (bf16_t*)(ws + WS_WT_IN), 0, 4096, 0, 0, scr, gw, ngw, lane);
    tr_job((const float*)p.in[4], 1024, 3072, 1, (bf16_t*)(ws + WS_WT_G), 0, 3072, 0, 0, scr, gw, ngw, lane);
    tr_job((const float*)p.in[12], 1024, 1024, 1, (bf16_t*)(ws + WS_WT_MKV), 0, 1024, 0, 0, scr, gw, ngw, lane);
    tr_job((const float*)p.in[13], 512, 1024, 1, (bf16_t*)(ws + WS_WT_B), 0, 1024, 0, 0, scr, gw, ngw, lane);
    tr_job((const float*)p.in[14], 512, 1024, 1, (bf16_t*)(ws + WS_WT_B), 0, 1024, 0, 1024, scr, gw, ngw, lane);
    tr_job((const float*)p.in[15], 512, 1024, 1, (bf16_t*)(ws + WS_WT_B), 0, 1024, 0, 2048, scr, gw, ngw, lane);
    tr_job((const float*)p.in[16], 1024, 1024, 1, (bf16_t*)(ws + WS_WT_OUT), 0, 1024, 0, 0, scr, gw, ngw, lane);
    tr_job((const float*)p.in[21], 1024, 512, 32, (bf16_t*)(ws + WS_WT_GU), 1024, 128, 256, 0, scr, gw, ngw, lane);
    tr_job((const float*)p.in[22], 1024, 512, 32, (bf16_t*)(ws + WS_WT_GU), 1024, 128, 256, 128, scr, gw, ngw, lane);
    tr_job((const float*)p.in[23], 512, 1024, 32, (bf16_t*)(ws + WS_WT_DN), 1024, 1024, 0, 0, scr, gw, ngw, lane);
    { const float* wg = (const float*)p.in[19]; const float* we = (const float*)p.in[20]; bf16_t* wr = (bf16_t*)(ws + WS_WT_R);
      for (size_t i = gt; i < 48 * 1024; i += ngt) { const int r = (int)(i >> 10), k = (int)(i & 1023);
          const float v = r < 4 ? wg[k * 4 + r] : (r < 36 ? we[k * 32 + (r - 4)] : 0.f); const bf16_t hb = f2bf(v); wr[i] = hb; wr[48 * 1024 + i] = f2bf(v - bf2f(hb)); } }
    { const float* x = (const float*)p.in[0]; bf16_t* xb = (bf16_t*)(ws + WS_XB);
      for (size_t i = gt; i < (size_t)NTOK * DM / 8; i += ngt) { const f32x4 a = *(const f32x4*)(x + i * 8), b = *(const f32x4*)(x + i * 8 + 4);
          u32x4 o; o.x = pk2(a.x, a.y); o.y = pk2(a.z, a.w); o.z = pk2(b.x, b.y); o.w = pk2(b.z, b.w); *(u32x4*)(xb + i * 8) = o; }
      const float* mm = (const float*)p.in[1]; bf16_t* mb = (bf16_t*)(ws + WS_MEMB);
      for (size_t i = gt; i < (size_t)NBATCH * NMEM * DM / 8; i += ngt) { const f32x4 a = *(const f32x4*)(mm + i * 8), b = *(const f32x4*)(mm + i * 8 + 4);
          u32x4 o; o.x = pk2(a.x, a.y); o.y = pk2(a.z, a.w); o.z = pk2(b.x, b.y); o.w = pk2(b.z, b.w); *(u32x4*)(mb + i * 8) = o; } }
    { const int* pos = (const int*)p.in[2]; float* rope = (float*)(ws + WS_ROPE);
      for (size_t i = gt; i < (size_t)NTOK * 8; i += ngt) { const int tk = (int)(i >> 3), fi = (int)(i & 7);
          const float invf = fi == 0 ? 1.0f : fi == 1 ? 0.1939227432012558f : fi == 2 ? 0.03760603070259094f : fi == 3 ? 0.007292664609849453f : fi == 4 ? 0.0014142135623842478f
                           : fi == 5 ? 0.00027424818836152554f : fi == 6 ? 5.3182957344688475e-05f : 1.0313385246263351e-05f;
          const float ang = (float)pos[tk] * invf; float c, s; sincos_acc(ang, c, s); rope[i * 2] = c; rope[i * 2 + 1] = s; } }
    if (blockIdx.x == 0) {
        float* sc = (float*)(ws + WS_SCAL); const float* lbs = (const float*)p.in[5];
        { const float a = lbs[tid], b = lbs[512 + tid]; sc[tid] = 1.f / (1.f + expf(b - a)); }
        if (wave == 0) {
            const float* q1 = (const float*)p.in[7]; const float* k1 = (const float*)p.in[8]; const float* q2 = (const float*)p.in[9]; const float* k2 = (const float*)p.in[10];
            const float s1 = wave_sum(q1[lane] * k1[lane]), s2 = wave_sum(q2[lane] * k2[lane]);
            if (lane == 0) sc[512] = expf(s1) - expf(s2) + LAM_INIT;
        }
        if (tid < 64) ((int*)(ws + WS_CTL))[tid] = 0;
    }
}

struct SgCtx { int t, wr, wc, fr, fq; unsigned char* sA; unsigned char* sB; };
__device__ __forceinline__ SgCtx sg_ctx(unsigned char* lds) {
    SgCtx c; const int tid = threadIdx.x; c.t = tid & 255; const int team = tid >> 8; const int wid = c.t >> 6, lane = c.t & 63;
    c.wr = wid >> 1; c.wc = wid & 1; c.fr = lane & 15; c.fq = lane >> 4; c.sA = lds + team * 16384; c.sB = c.sA + 8192; return c;
}
__device__ __forceinline__ void sg_zero(f32x4 (&acc)[4][2]) {
#pragma unroll
    for (int m = 0; m < 4; ++m)
#pragma unroll
        for (int n = 0; n < 2; ++n) acc[m][n] = (f32x4){0.f, 0.f, 0.f, 0.f};
}
__device__ __forceinline__ void sg_tile(f32x4 (&acc)[4][2], const bf16_t* a0, const bf16_t* a1, const bf16_t* b0, int K, const SgCtx& c) {
    const int bo = c.t * 16;
#pragma unroll 1
    for (int kt = 0; kt < K; kt += 32) {
        const bf16x8 va0 = *(const bf16x8*)(a0 + kt), va1 = *(const bf16x8*)(a1 + kt), vb0 = *(const bf16x8*)(b0 + kt);
        *(bf16x8*)(c.sA + bo) = va0; *(bf16x8*)(c.sA + bo + 4096) = va1; *(bf16x8*)(c.sB + bo) = vb0;
        __syncthreads();
        bf16x8 At[4], Bt[2];
#pragma unroll
        for (int m = 0; m < 4; ++m) At[m] = *(const bf16x8*)(c.sA + (c.wr * 64 + m * 16 + c.fr) * 64 + c.fq * 16);
#pragma unroll
        for (int n = 0; n < 2; ++n) Bt[n] = *(const bf16x8*)(c.sB + (c.wc * 32 + n * 16 + c.fr) * 64 + c.fq * 16);
#pragma unroll
        for (int m = 0; m < 4; ++m)
#pragma unroll
            for (int n = 0; n < 2; ++n) acc[m][n] = __builtin_amdgcn_mfma_f32_16x16x32_bf16(At[m], Bt[n], acc[m][n], 0, 0, 0);
        __syncthreads();
    }
}
#define SG_R0(c) ((c).t >> 2)
#define SG_C0(c) (((c).t & 3) * 8)
template <class F> __device__ __forceinline__ void sg_store_bf16(const f32x4 (&acc)[4][2], bf16_t* dst, size_t ld, const SgCtx& c, F f) {
    bf16_t* base = dst + (size_t)(c.wr * 64 + c.fq * 4) * ld + c.wc * 32 + c.fr;
#pragma unroll
    for (int m = 0; m < 4; ++m)
#pragma unroll
        for (int j = 0; j < 4; ++j) { bf16_t* pr = base + (size_t)(m * 16 + j) * ld;
#pragma unroll
            for (int n = 0; n < 2; ++n) pr[n * 16] = f2bf(f(acc[m][n][j], c.wc * 32 + n * 16));
            asm volatile("" ::: "memory"); }
}
struct FIdent { __device__ __forceinline__ float operator()(float v, int) const { return v; } };
struct FSilu { __device__ __forceinline__ float operator()(float v, int) const { return siluf_(v); } };
struct FQScale { __device__ __forceinline__ float operator()(float v, int d0) const { return d0 >= 16 ? v * QSCALE_DF : v; } };

__device__ __forceinline__ void phase_proj(const Params& p, unsigned char* lds) {
    const SgCtx c = sg_ctx(lds); const int team = threadIdx.x >> 8; unsigned char* ws = p.ws;
    const bf16_t* XB = (const bf16_t*)(ws + WS_XB); const bf16_t* WT = (const bf16_t*)(ws + WS_WT_IN);
    bf16_t* HG = (bf16_t*)(ws + WS_HG); bf16_t* DQK = (bf16_t*)(ws + WS_DQK); bf16_t* DV = (bf16_t*)(ws + WS_DV); bf16_t* MQ = (bf16_t*)(ws + WS_MQ);
    const int r0 = SG_R0(c), c0 = SG_C0(c);
    { const int ntiles = 512 * 64;
      for (int tb = 2 * blockIdx.x; tb < ntiles; tb += 2 * gridDim.x) {
        const int tile = tb + team; const int tm = tile >> 6, tn = tile & 63;
        f32x4 acc[4][2]; sg_zero(acc);
        sg_tile(acc, XB + (size_t)(tm * 128 + r0) * 1024 + c0, XB + (size_t)(tm * 128 + r0 + 64) * 1024 + c0, WT + (size_t)(tn * 64 + r0) * 1024 + c0, 1024, c);
        const size_t mrow = (size_t)tm * 128; const int n0 = tn * 64;
        if (n0 < 2048) { const int g = n0 >> 9; bf16_t* d = HG + mrow * 2048 + n0; if (g == 0 || g == 3) sg_store_bf16(acc, d, 2048, c, FSilu()); else sg_store_bf16(acc, d, 2048, c, FIdent()); }
        else if (n0 < 3072) { bf16_t* d = DQK + mrow * 1024 + (n0 - 2048); if (n0 < 2560) sg_store_bf16(acc, d, 1024, c, FQScale()); else sg_store_bf16(acc, d, 1024, c, FIdent()); }
        else if (n0 < 3584) sg_store_bf16(acc, DV + mrow * 512 + (n0 - 3072), 512, c, FIdent());
        else sg_store_bf16(acc, MQ + mrow * 512 + (n0 - 3584), 512, c, FIdent());
      } }
    { const bf16_t* MB = (const bf16_t*)(ws + WS_MEMB); const bf16_t* WK = (const bf16_t*)(ws + WS_WT_MKV); bf16_t* MKV = (bf16_t*)(ws + WS_MKV);
      const int ntiles = 32 * 16;
      for (int tb = 2 * blockIdx.x; tb < ntiles; tb += 2 * gridDim.x) {
        const int tile = tb + team; const int tm = tile >> 4, tn = tile & 15;
        f32x4 acc[4][2]; sg_zero(acc);
        sg_tile(acc, MB + (size_t)(tm * 128 + r0) * 1024 + c0, MB + (size_t)(tm * 128 + r0 + 64) * 1024 + c0, WK + (size_t)(tn * 64 + r0) * 1024 + c0, 1024, c);
        sg_store_bf16(acc, MKV + (size_t)tm * 128 * 1024 + tn * 64, 1024, c, FIdent());
      } }
}
__device__ __forceinline__ void phase_rope(const Params& p, unsigned char* lds) {
    unsigned char* ws = p.ws; bf16_t* DQK = (bf16_t*)(ws + WS_DQK); const float* rope = (const float*)(ws + WS_ROPE);
    const size_t gt = (size_t)blockIdx.x * 512 + threadIdx.x, ngt = (size_t)gridDim.x * 512;
    for (size_t i = gt; i < (size_t)NTOK * 128; i += ngt) {
        const size_t m = i >> 7; const int rem = (int)(i & 127), gh = rem >> 3, fi = rem & 7;
        bf16_t* q = DQK + m * 1024 + gh * 64;
        const float t1 = bf2f(q[fi]), t2 = bf2f(q[8 + fi]); const float cs = rope[(m * 8 + fi) * 2], sn = rope[(m * 8 + fi) * 2 + 1];
        float o1 = t1 * cs - t2 * sn, o2 = t2 * cs + t1 * sn;
        if (gh < 8) { o1 *= QSCALE_DF; o2 *= QSCALE_DF; }
        q[fi] = f2bf(o1); q[8 + fi] = f2bf(o2);
    }
}
__device__ __forceinline__ void phase_hgrn_naive(const Params& p, unsigned char* lds) {
    unsigned char* ws = p.ws; const bf16_t* HG = (const bf16_t*)(ws + WS_HG); bf16_t* Y = (bf16_t*)(ws + WS_Y);
    const float* lower0 = (const float*)(ws + WS_SCAL); const float* gain = (const float*)p.in[6];
    float* fs = (float*)lds; float* ks = fs + 128; float* qs = ks + 128; float* part = qs + 128; float* red = part + 512;
    const int tid = threadIdx.x, v = tid & 127, kq = tid >> 7, lane = tid & 63, wave = tid >> 6;
    for (int bh = blockIdx.x; bh < 64; bh += gridDim.x) {
        const int b = bh >> 2, h = bh & 3;
        float S[32];
#pragma unroll
        for (int i = 0; i < 32; ++i) S[i] = 0.f;
        const float lbv = lower0[h * 128 + v], gn = gain[h * 128 + v];
        for (int t = 0; t < SEQ; ++t) {
            const size_t m = (size_t)b * SEQ + t; const bf16_t* row = HG + m * 2048 + h * 128;
            if (tid < 128) { const float fp = bf2f(row[512 + v]); const float f = lbv + (1.f - lbv) * sigmoidf_(fp); fs[v] = f; ks[v] = 1.f - f; qs[v] = bf2f(row[v]); }
            const float vv = bf2f(row[1024 + v]);
            __syncthreads();
            float o = 0.f;
#pragma unroll
            for (int i = 0; i < 32; ++i) { const int k = kq * 32 + i; S[i] = fs[k] * S[i] + ks[k] * vv; o += qs[k] * S[i]; }
            part[kq * 128 + v] = o;
            __syncthreads();
            float ot = 0.f;
            if (tid < 128) { ot = part[v] + part[128 + v] + part[256 + v] + part[384 + v]; const float sq = wave_sum(ot * ot); if (lane == 0) red[wave] = sq; }
            __syncthreads();
            if (tid < 128) { const float ms = (red[0] + red[1]) * (1.f / 128.f); const float y = ot * rsqrtf(ms + RMS_EPS) * gn * bf2f(row[1536 + v]); Y[m * 1536 + h * 128 + v] = f2bf(y); }
        }
        __syncthreads();
    }
}
template <bool DIFF>
__device__ __forceinline__ void phase_attn_naive(const Params& p, unsigned char* lds) {
    constexpr int DQ = DIFF ? 64 : 128, NMAP = DIFF ? 2 : 1;
    unsigned char* ws = p.ws; const int tid = threadIdx.x, lane = tid & 63, wave = tid >> 6;
    float* wbuf = (float*)lds + wave * 4096; float* qbuf = (float*)(lds + 131072) + wave * 128;
    const bf16_t* DQK = (const bf16_t*)(ws + WS_DQK); const bf16_t* DV = (const bf16_t*)(ws + WS_DV); const bf16_t* MQ = (const bf16_t*)(ws + WS_MQ); const bf16_t* MKV = (const bf16_t*)(ws + WS_MKV);
    bf16_t* Y = (bf16_t*)(ws + WS_Y); const float lam = ((const float*)(ws + WS_SCAL))[512]; const float* sub_gain = (const float*)p.in[11];
    const int gw = blockIdx.x * 8 + wave, ngw = gridDim.x * 8; const int nrows = NTOK * 4;
    for (int r = gw; r < nrows; r += ngw) {
        int b, h, nk; size_t m; const bf16_t *Q, *K, *V; int kp, vp;
        if (DIFF) { const int bh = r >> 12, i = r & 4095; b = bh >> 2; h = bh & 3; m = (size_t)b * SEQ + i; nk = i + 1;
            Q = DQK + m * 1024 + h * 64; K = DQK + (size_t)b * SEQ * 1024 + 512 + h * 64; kp = 1024; V = DV + (size_t)b * SEQ * 512 + h * 128; vp = 512; }
        else { m = (size_t)(r >> 2); h = r & 3; b = (int)(m >> 12); nk = NMEM;
            Q = MQ + m * 512 + h * 128; K = MKV + (size_t)b * NMEM * 1024 + h * 128; kp = 1024; V = MKV + (size_t)b * NMEM * 1024 + 512 + h * 128; vp = 1024; }
        if (DIFF) { qbuf[lane] = bf2f(Q[lane]); qbuf[64 + lane] = bf2f(Q[256 + lane]); }
        else { qbuf[lane] = bf2f(Q[lane]) * QSCALE_MEM; qbuf[64 + lane] = bf2f(Q[64 + lane]) * QSCALE_MEM; }
        LDS_WAIT();
        float mx[NMAP], ls[NMAP];
#pragma unroll
        for (int a = 0; a < NMAP; ++a) { mx[a] = -1e30f; ls[a] = 0.f; }
        for (int j = lane; j < nk; j += 64) {
#pragma unroll
            for (int a = 0; a < NMAP; ++a) {
                const bf16_t* kr = K + (size_t)j * kp + a * 256; float s = 0.f;
#pragma unroll 2
                for (int cc = 0; cc < DQ / 8; ++cc) { const bf16x8 kv = *(const bf16x8*)(kr + cc * 8);
#pragma unroll
                    for (int e = 0; e < 8; ++e) s += qbuf[a * 64 + cc * 8 + e] * bf2f((bf16_t)kv[e]); }
                if (s > mx[a]) { ls[a] = ls[a] * exp2f(mx[a] - s) + 1.f; mx[a] = s; } else ls[a] += exp2f(s - mx[a]);
            }
        }
        float M[NMAP], Linv[NMAP];
#pragma unroll
        for (int a = 0; a < NMAP; ++a) { M[a] = wave_max(mx[a]); const float l = wave_sum(ls[a] * exp2f(mx[a] - M[a])); Linv[a] = 1.f / l; }
        for (int j = lane; j < nk; j += 64) {
            float w = 0.f;
#pragma unroll
            for (int a = 0; a < NMAP; ++a) {
                const bf16_t* kr = K + (size_t)j * kp + a * 256; float s = 0.f;
#pragma unroll 2
                for (int cc = 0; cc < DQ / 8; ++cc) { const bf16x8 kv = *(const bf16x8*)(kr + cc * 8);
#pragma unroll
                    for (int e = 0; e < 8; ++e) s += qbuf[a * 64 + cc * 8 + e] * bf2f((bf16_t)kv[e]); }
                const float pj = exp2f(s - M[a]) * Linv[a]; w = (a == 0) ? pj : w - lam * pj;
            }
            wbuf[j] = w;
        }
        LDS_WAIT();
        float a0 = 0.f, a1 = 0.f; const bf16_t* vb = V + 2 * lane;
        for (int j = 0; j < nk; ++j) { const float w = wbuf[j]; const unsigned u = *(const unsigned*)(vb + (size_t)j * vp); a0 += w * __uint_as_float(u << 16); a1 += w * __uint_as_float(u & 0xffff0000u); }
        if (DIFF) { const float ms = wave_sum(a0 * a0 + a1 * a1) * (1.f / 128.f); const float rs = rsqrtf(ms + RMS_EPS) * (1.f - LAM_INIT);
            *(unsigned*)(Y + m * 1536 + 512 + h * 128 + 2 * lane) = pk2(a0 * rs * sub_gain[2 * lane], a1 * rs * sub_gain[2 * lane + 1]); }
        else *(unsigned*)(Y + m * 1536 + 1024 + h * 128 + 2 * lane) = pk2(a0, a1);
        LDS_WAIT();
    }
}
__device__ __forceinline__ void phase_merge(const Params& p, unsigned char* lds) {
    const SgCtx c = sg_ctx(lds); const int team = threadIdx.x >> 8; unsigned char* ws = p.ws;
    const bf16_t* XB = (const bf16_t*)(ws + WS_XB); const bf16_t* WG = (const bf16_t*)(ws + WS_WT_G); const bf16_t* Y = (const bf16_t*)(ws + WS_Y); const bf16_t* WB = (const bf16_t*)(ws + WS_WT_B);
    bf16_t* MG = (bf16_t*)(ws + WS_MERGED); const int r0 = SG_R0(c), c0 = SG_C0(c);
    const int ntiles = 512 * 16;
    for (int tb = 2 * blockIdx.x; tb < ntiles; tb += 2 * gridDim.x) {
        const int tile = tb + team; const int tm = tile >> 4, tn = tile & 15;
        f32x4 sum[4][2]; sg_zero(sum);
#pragma unroll 1
        for (int br = 0; br < 3; ++br) {
            f32x4 ag[4][2]; sg_zero(ag);
            sg_tile(ag, XB + (size_t)(tm * 128 + r0) * 1024 + c0, XB + (size_t)(tm * 128 + r0 + 64) * 1024 + c0, WG + (size_t)(br * 1024 + tn * 64 + r0) * 1024 + c0, 1024, c);
            f32x4 ay[4][2]; sg_zero(ay);
            sg_tile(ay, Y + (size_t)(tm * 128 + r0) * 1536 + br * 512 + c0, Y + (size_t)(tm * 128 + r0 + 64) * 1536 + br * 512 + c0, WB + (size_t)(br * 1024 + tn * 64 + r0) * 512 + c0, 512, c);
#pragma unroll
            for (int m = 0; m < 4; ++m)
#pragma unroll
                for (int n = 0; n < 2; ++n)
#pragma unroll
                    for (int j = 0; j < 4; ++j) sum[m][n][j] += sigmoidf_(ag[m][n][j]) * ay[m][n][j];
        }
        sg_store_bf16(sum, MG + (size_t)tm * 128 * 1024 + tn * 64, 1024, c, FIdent());
    }
}
__device__ __forceinline__ void phase_wout(const Params& p, unsigned char* lds) {
    const SgCtx c = sg_ctx(lds); const int team = threadIdx.x >> 8; unsigned char* ws = p.ws;
    const bf16_t* MG = (const bf16_t*)(ws + WS_MERGED); const bf16_t* WO = (const bf16_t*)(ws + WS_WT_OUT); const float* x = (const float*)p.in[0]; float* pre = p.out;
    const int r0 = SG_R0(c), c0 = SG_C0(c); const int ntiles = 512 * 16;
    for (int tb = 2 * blockIdx.x; tb < ntiles; tb += 2 * gridDim.x) {
        const int tile = tb + team; const int tm = tile >> 4, tn = tile & 15;
        f32x4 acc[4][2]; sg_zero(acc);
        sg_tile(acc, MG + (size_t)(tm * 128 + r0) * 1024 + c0, MG + (size_t)(tm * 128 + r0 + 64) * 1024 + c0, WO + (size_t)(tn * 64 + r0) * 1024 + c0, 1024, c);
        { const size_t off = ((size_t)tm * 128 + c.wr * 64 + c.fq * 4) * 1024 + tn * 64 + c.wc * 32 + c.fr;
#pragma unroll
          for (int m = 0; m < 4; ++m)
#pragma unroll
              for (int j = 0; j < 4; ++j) { const size_t o2 = off + (size_t)(m * 16 + j) * 1024;
#pragma unroll
                  for (int n = 0; n < 2; ++n) pre[o2 + n * 16] = ALPHA * x[o2 + n * 16] + acc[m][n][j];
                  asm volatile("" ::: "memory"); } }
    }
}
__device__ __forceinline__ void phase_ln1_route(const Params& p, unsigned char* lds) {
    unsigned char* ws = p.ws; const int tid = threadIdx.x, lane = tid & 63, wave = tid >> 6;
    float* x1f = p.out; bf16_t* x1b = (bf16_t*)(ws + WS_X1B); const float* g1 = (const float*)p.in[17]; const float* b1 = (const float*)p.in[18];
    const float* wg = (const float*)p.in[19]; const float* we = (const float*)p.in[20];
    int* cnt = (int*)(ws + WS_CTL); int* reci = (int*)(ws + WS_RECI); float* recw = (float*)(ws + WS_RECW);
    const int gw = blockIdx.x * 8 + wave, ngw = gridDim.x * 8;
    for (int t = gw; t < NTOK; t += ngw) {
        float* row = x1f + (size_t)t * 1024; f32x4 v[4]; float s = 0.f;
#pragma unroll
        for (int j = 0; j < 4; ++j) { v[j] = *(const f32x4*)(row + 256 * j + 4 * lane); s += (v[j].x + v[j].y) + (v[j].z + v[j].w); }
        const float mean = wave_sum(s) * (1.f / 1024.f); float s2 = 0.f;
#pragma unroll
        for (int j = 0; j < 4; ++j) { v[j] = v[j] - mean; s2 += (v[j].x * v[j].x + v[j].y * v[j].y) + (v[j].z * v[j].z + v[j].w * v[j].w); }
        const float rstd = rsqrtf(wave_sum(s2) * (1.f / 1024.f) + LN_EPS);
#pragma unroll
        for (int j = 0; j < 4; ++j) { const f32x4 gg = *(const f32x4*)(g1 + 256 * j + 4 * lane), bb = *(const f32x4*)(b1 + 256 * j + 4 * lane);
            v[j] = v[j] * rstd * gg + bb; *(f32x4*)(row + 256 * j + 4 * lane) = v[j];
            u32x2 o; o.x = pk2(v[j].x, v[j].y); o.y = pk2(v[j].z, v[j].w); *(u32x2*)(x1b + (size_t)t * 1024 + 256 * j + 4 * lane) = o; }
        float lg[36];
#pragma unroll
        for (int i = 0; i < 36; ++i) lg[i] = 0.f;
#pragma unroll
        for (int j = 0; j < 4; ++j)
#pragma unroll
            for (int e = 0; e < 4; ++e) { const int k = 256 * j + 4 * lane + e; const float xv = v[j][e];
                const f32x4 g4 = *(const f32x4*)(wg + k * 4);
#pragma unroll
                for (int q = 0; q < 4; ++q) lg[q] += xv * g4[q];
#pragma unroll
                for (int q8 = 0; q8 < 8; ++q8) { const f32x4 e4 = *(const f32x4*)(we + k * 32 + q8 * 4);
#pragma unroll
                    for (int q = 0; q < 4; ++q) lg[4 + q8 * 4 + q] += xv * e4[q]; } }
#pragma unroll
        for (int i = 0; i < 36; ++i) lg[i] = wave_sum(lg[i]);
        int gi = 0; float gm = lg[0];
#pragma unroll
        for (int q = 1; q < 4; ++q) if (lg[q] > gm) { gm = lg[q]; gi = q; }
        float gs = 0.f;
#pragma unroll
        for (int q = 0; q < 4; ++q) gs += expf(lg[q] - gm);
        const float group_w = 1.f / gs;
        float ig[8];
#pragma unroll
        for (int i = 0; i < 8; ++i) ig[i] = gi == 0 ? lg[4 + i] : gi == 1 ? lg[12 + i] : gi == 2 ? lg[20 + i] : lg[28 + i];
        int i1 = 0; float l1 = ig[0];
#pragma unroll
        for (int i = 1; i < 8; ++i) if (ig[i] > l1) { l1 = ig[i]; i1 = i; }
        int i2 = -1; float l2 = -3.0e38f;
#pragma unroll
        for (int i = 0; i < 8; ++i) if (i != i1 && ig[i] > l2) { l2 = ig[i]; i2 = i; }
        const float e2 = expf(l2 - l1); const float w1 = group_w / (1.f + e2), w2 = group_w * e2 / (1.f + e2);
        if (lane == 0) { const int ea = gi * 8 + i1, eb = gi * 8 + i2; const int pa = atomicAdd(cnt + ea, 1), pb = atomicAdd(cnt + eb, 1);
            reci[t * 4 + 0] = ea; reci[t * 4 + 1] = eb; reci[t * 4 + 2] = pa; reci[t * 4 + 3] = pb; recw[t * 2] = w1; recw[t * 2 + 1] = w2; }
    }
}
__device__ __forceinline__ void phase_ln1_route2(const Params& p, unsigned char* lds) {
    unsigned char* ws = p.ws; const int tid = threadIdx.x, lane = tid & 63, wave = tid >> 6, fr = lane & 15, fq = lane >> 4;
    float* x1f = p.out; bf16_t* x1b = (bf16_t*)(ws + WS_X1B); const float* g1 = (const float*)p.in[17]; const float* b1 = (const float*)p.in[18];
    const bf16_t* WRH = (const bf16_t*)(ws + WS_WT_R); const bf16_t* WRL = WRH + 48 * 1024;
    int* cnt = (int*)(ws + WS_CTL); int* reci = (int*)(ws + WS_RECI); float* recw = (float*)(ws + WS_RECW);
    float* lgs = (float*)lds + wave * (16 * 48);
    const int gw = blockIdx.x * 8 + wave, ngw = gridDim.x * 8;
    f32x4 gg[4], bb[4];
#pragma unroll
    for (int j = 0; j < 4; ++j) { gg[j] = *(const f32x4*)(g1 + 256 * j + 4 * lane); bb[j] = *(const f32x4*)(b1 + 256 * j + 4 * lane); }
    for (int g = gw; g < NTOK / 16; g += ngw) {
#pragma unroll 2
        for (int rr = 0; rr < 16; ++rr) {
            const int t = g * 16 + rr; float* row = x1f + (size_t)t * 1024; f32x4 v[4]; float s = 0.f;
#pragma unroll
            for (int j = 0; j < 4; ++j) { v[j] = *(const f32x4*)(row + 256 * j + 4 * lane); s += (v[j].x + v[j].y) + (v[j].z + v[j].w); }
            const float mean = wave_sum(s) * (1.f / 1024.f); float s2 = 0.f;
#pragma unroll
            for (int j = 0; j < 4; ++j) { v[j] = v[j] - mean; s2 += (v[j].x * v[j].x + v[j].y * v[j].y) + (v[j].z * v[j].z + v[j].w * v[j].w); }
            const float rstd = rsqrtf(wave_sum(s2) * (1.f / 1024.f) + LN_EPS);
#pragma unroll
            for (int j = 0; j < 4; ++j) { v[j] = v[j] * rstd * gg[j] + bb[j]; *(f32x4*)(row + 256 * j + 4 * lane) = v[j];
                u32x2 o; o.x = pk2(v[j].x, v[j].y); o.y = pk2(v[j].z, v[j].w); *(u32x2*)(x1b + (size_t)t * 1024 + 256 * j + 4 * lane) = o; }
        }
        asm volatile("s_waitcnt vmcnt(0)" ::: "memory");
        f32x4 acc[3];
#pragma unroll
        for (int j = 0; j < 3; ++j) acc[j] = (f32x4){0.f, 0.f, 0.f, 0.f};
        const float* arow = x1f + (size_t)(g * 16 + fr) * 1024 + fq * 8; const bf16_t* bh = WRH + fr * 1024 + fq * 8; const bf16_t* bl = WRL + fr * 1024 + fq * 8;
#pragma unroll 4
        for (int ks = 0; ks < 32; ++ks) {
            const f32x4 xa = *(const f32x4*)(arow + ks * 32), xb = *(const f32x4*)(arow + ks * 32 + 4);
            const float xs[8] = {xa.x, xa.y, xa.z, xa.w, xb.x, xb.y, xb.z, xb.w}; bf16x8 ah, al;
#pragma unroll
            for (int e = 0; e < 8; ++e) { const bf16_t hb = f2bf(xs[e]); ah[e] = (short)hb; al[e] = (short)f2bf(xs[e] - bf2f(hb)); }
#pragma unroll
            for (int j = 0; j < 3; ++j) { const bf16x8 wh = *(const bf16x8*)(bh + j * 16 * 1024 + ks * 32), wl = *(const bf16x8*)(bl + j * 16 * 1024 + ks * 32);
                acc[j] = __builtin_amdgcn_mfma_f32_16x16x32_bf16(ah, wh, acc[j], 0, 0, 0); acc[j] = __builtin_amdgcn_mfma_f32_16x16x32_bf16(al, wh, acc[j], 0, 0, 0);
                acc[j] = __builtin_amdgcn_mfma_f32_16x16x32_bf16(ah, wl, acc[j], 0, 0, 0); }
        }
#pragma unroll
        for (int j = 0; j < 3; ++j)
#pragma unroll
            for (int r = 0; r < 4; ++r) lgs[(4 * fq + r) * 48 + j * 16 + fr] = acc[j][r];
        LDS_WAIT();
        if (lane < 16) {
            const int t = g * 16 + lane; float lg[36];
#pragma unroll
            for (int i = 0; i < 36; ++i) lg[i] = lgs[lane * 48 + i];
            int gi = 0; float gm = lg[0];
#pragma unroll
            for (int q = 1; q < 4; ++q) if (lg[q] > gm) { gm = lg[q]; gi = q; }
            float gs = 0.f;
#pragma unroll
            for (int q = 0; q < 4; ++q) gs += expf(lg[q] - gm);
            const float group_w = 1.f / gs;
            float ig[8];
#pragma unroll
            for (int i = 0; i < 8; ++i) ig[i] = gi == 0 ? lg[4 + i] : gi == 1 ? lg[12 + i] : gi == 2 ? lg[20 + i] : lg[28 + i];
            int i1 = 0; float l1 = ig[0];
#pragma unroll
            for (int i = 1; i < 8; ++i) if (ig[i] > l1) { l1 = ig[i]; i1 = i; }
            int i2 = -1; float l2 = -3.0e38f;
#pragma unroll
            for (int i = 0; i < 8; ++i) if (i != i1 && ig[i] > l2) { l2 = ig[i]; i2 = i; }
            const float e2 = expf(l2 - l1); const float w1 = group_w / (1.f + e2), w2 = group_w * e2 / (1.f + e2);
            const int ea = gi * 8 + i1, eb = gi * 8 + i2; const int pa = atomicAdd(cnt + ea, 1), pb = atomicAdd(cnt + eb, 1);
            reci[t * 4 + 0] = ea; reci[t * 4 + 1] = eb; reci[t * 4 + 2] = pa; reci[t * 4 + 3] = pb; recw[t * 2] = w1; recw[t * 2 + 1] = w2;
        }
        LDS_WAIT();
    }
}
__device__ __forceinline__ int expert_layout(const int* cnt, int lane, int& tiles, int& endi) {
    tiles = (lane < 32) ? ((cnt[lane] + 255) >> 8) : 0; int x = tiles;
#pragma unroll
    for (int o = 1; o < 32; o <<= 1) { const int y = __shfl_up(x, o); if (lane >= o) x += y; }
    endi = x; return __shfl(x, 31);
}
__device__ __forceinline__ int expert_of_tile(int rt, int lane, int endi) { return __popcll(__ballot(lane < 32 && endi <= rt)); }
__device__ __forceinline__ void phase_dispatch(const Params& p, unsigned char* lds) {
    unsigned char* ws = p.ws; const int tid = threadIdx.x, lane = tid & 63, wave = tid >> 6;
    const int* cnt = (const int*)(ws + WS_CTL); int* reci = (int*)(ws + WS_RECI); const bf16_t* x1b = (const bf16_t*)(ws + WS_X1B); bf16_t* xs = (bf16_t*)(ws + WS_XS);
    int tiles, endi; expert_layout(cnt, lane, tiles, endi); const int base = endi - tiles;
    const int gw = blockIdx.x * 8 + wave, ngw = gridDim.x * 8;
    for (int t = gw; t < NTOK; t += ngw) {
        const int ea = reci[t * 4], eb = reci[t * 4 + 1], pa = reci[t * 4 + 2], pb = reci[t * 4 + 3];
        const int sa = __shfl(base, ea) * 256 + pa, sb = __shfl(base, eb) * 256 + pb;
        const u32x4 a = *(const u32x4*)(x1b + (size_t)t * 1024 + lane * 8), b = *(const u32x4*)(x1b + (size_t)t * 1024 + 512 + lane * 8);
        *(u32x4*)(xs + (size_t)sa * 1024 + lane * 8) = a; *(u32x4*)(xs + (size_t)sa * 1024 + 512 + lane * 8) = b;
        *(u32x4*)(xs + (size_t)sb * 1024 + lane * 8) = a; *(u32x4*)(xs + (size_t)sb * 1024 + 512 + lane * 8) = b;
        if (lane == 0) { reci[t * 4 + 2] = sa; reci[t * 4 + 3] = sb; }
    }
}
__device__ __forceinline__ void phase_exp_gu(const Params& p, unsigned char* lds) {
    const SgCtx c = sg_ctx(lds); const int team = threadIdx.x >> 8, lane = threadIdx.x & 63; unsigned char* ws = p.ws;
    const int* cnt = (const int*)(ws + WS_CTL); const bf16_t* XS = (const bf16_t*)(ws + WS_XS); const bf16_t* WGU = (const bf16_t*)(ws + WS_WT_GU); bf16_t* H = (bf16_t*)(ws + WS_H);
    int tiles, endi; const int nt256 = expert_layout(cnt, lane, tiles, endi);
    const int r0 = SG_R0(c), c0 = SG_C0(c); const int ntiles = nt256 * 2 * 8;
    for (int tb = 2 * blockIdx.x; tb < ntiles; tb += 2 * gridDim.x) {
        int tile = tb + team; const bool valid = tile < ntiles; if (!valid) tile = ntiles - 1;
        const int rt = tile >> 3, tn = tile & 7; const int e = expert_of_tile(rt >> 1, lane, endi);
        const bf16_t* a0 = XS + (size_t)(rt * 128 + r0) * 1024 + c0; const bf16_t* a1 = a0 + (size_t)64 * 1024;
        const bf16_t* bg = WGU + (size_t)(e * 1024 + (tn >> 1) * 256 + (tn & 1) * 64 + r0) * 1024 + c0;
        f32x4 ag[4][2]; sg_zero(ag); sg_tile(ag, a0, a1, bg, 1024, c);
        f32x4 au[4][2]; sg_zero(au); sg_tile(au, a0, a1, bg + (size_t)128 * 1024, 1024, c);
#pragma unroll
        for (int m = 0; m < 4; ++m)
#pragma unroll
            for (int n = 0; n < 2; ++n)
#pragma unroll
                for (int j = 0; j < 4; ++j) ag[m][n][j] = siluf_(ag[m][n][j]) * au[m][n][j];
        if (valid) sg_store_bf16(ag, H + (size_t)rt * 128 * 512 + tn * 64, 512, c, FIdent());
    }
}
__device__ __forceinline__ void phase_exp_dn(const Params& p, unsigned char* lds) {
    const SgCtx c = sg_ctx(lds); const int team = threadIdx.x >> 8, lane = threadIdx.x & 63; unsigned char* ws = p.ws;
    const int* cnt = (const int*)(ws + WS_CTL); const bf16_t* H = (const bf16_t*)(ws + WS_H); const bf16_t* WDN = (const bf16_t*)(ws + WS_WT_DN); bf16_t* YB = (bf16_t*)(ws + WS_YB);
    int tiles, endi; const int nt256 = expert_layout(cnt, lane, tiles, endi);
    const int r0 = SG_R0(c), c0 = SG_C0(c); const int ntiles = nt256 * 2 * 16;
    for (int tb = 2 * blockIdx.x; tb < ntiles; tb += 2 * gridDim.x) {
        int tile = tb + team; const bool valid = tile < ntiles; if (!valid) tile = ntiles - 1;
        const int rt = tile >> 4, tn = tile & 15; const int e = expert_of_tile(rt >> 1, lane, endi);
        const bf16_t* a0 = H + (size_t)(rt * 128 + r0) * 512 + c0; const bf16_t* b0 = WDN + (size_t)(e * 1024 + tn * 64 + r0) * 512 + c0;
        f32x4 acc[4][2]; sg_zero(acc); sg_tile(acc, a0, a0 + (size_t)64 * 512, b0, 512, c);
        if (valid) sg_store_bf16(acc, YB + (size_t)rt * 128 * 1024 + tn * 64, 1024, c, FIdent());
    }
}
__device__ __forceinline__ void phase_final(const Params& p, unsigned char* lds) {
    unsigned char* ws = p.ws; const int tid = threadIdx.x, lane = tid & 63, wave = tid >> 6;
    float* out = p.out; const bf16_t* YB = (const bf16_t*)(ws + WS_YB); const int* reci = (const int*)(ws + WS_RECI); const float* recw = (const float*)(ws + WS_RECW);
    const float* g2 = (const float*)p.in[24]; const float* b2 = (const float*)p.in[25];
    const int gw = blockIdx.x * 8 + wave, ngw = gridDim.x * 8;
    for (int t = gw; t < NTOK; t += ngw) {
        float* row = out + (size_t)t * 1024; const int sa = reci[t * 4 + 2], sb = reci[t * 4 + 3]; const float wa = recw[t * 2], wb = recw[t * 2 + 1];
        f32x4 v[4]; float s = 0.f;
#pragma unroll
        for (int j = 0; j < 4; ++j) { const f32x4 xv = *(const f32x4*)(row + 256 * j + 4 * lane);
            const u32x2 ya = *(const u32x2*)(YB + (size_t)sa * 1024 + 256 * j + 4 * lane), yb = *(const u32x2*)(YB + (size_t)sb * 1024 + 256 * j + 4 * lane);
            f32x4 fa, fb; fa.x = __uint_as_float(ya.x << 16); fa.y = __uint_as_float(ya.x & 0xffff0000u); fa.z = __uint_as_float(ya.y << 16); fa.w = __uint_as_float(ya.y & 0xffff0000u);
            fb.x = __uint_as_float(yb.x << 16); fb.y = __uint_as_float(yb.x & 0xffff0000u); fb.z = __uint_as_float(yb.y << 16); fb.w = __uint_as_float(yb.y & 0xffff0000u);
            v[j] = xv * ALPHA + fa * wa + fb * wb; s += (v[j].x + v[j].y) + (v[j].z + v[j].w); }
        const float mean = wave_sum(s) * (1.f / 1024.f); float s2 = 0.f;
#pragma unroll
        for (int j = 0; j < 4; ++j) { v[j] = v[j] - mean; s2 += (v[j].x * v[j].x + v[j].y * v[j].y) + (v[j].z * v[j].z + v[j].w * v[j].w); }
        const float rstd = rsqrtf(wave_sum(s2) * (1.f / 1024.f) + LN_EPS);
#pragma unroll
        for (int j = 0; j < 4; ++j) { const f32x4 gg = *(const f32x4*)(g2 + 256 * j + 4 * lane), bb = *(const f32x4*)(b2 + 256 * j + 4 * lane);
            *(f32x4*)(row + 256 * j + 4 * lane) = v[j] * rstd * gg + bb; }
    }
}

namespace pg8 {
#define PG8_LAS __attribute__((address_space(3)))
constexpr int BM = 256, BK = 64, HALF = 128, HTB = HALF * BK * 2, STAGE_BYTES = 8 * HTB, NXCD = 8, WGM = 8;
__host__ __device__ __forceinline__ int lds_byte(int r, int c) { const int st = (r >> 4) * 2 + (c >> 5), rr = r & 15, cc = c & 31, ob = rr * 64 + cc * 2; return st * 1024 + (ob ^ (((ob >> 9) & 1) << 5)); }
__host__ __device__ __forceinline__ void stage_rc(int b, int& R, int& C) { const int st = b / 1024, sb = b % 1024, swz = sb ^ (((sb >> 9) & 1) << 5); R = (st >> 1) * 16 + swz / 64; C = (st & 1) * 32 + (swz % 64) / 2; }
__host__ __device__ __forceinline__ int perm32(int rho) { const int n = rho >> 4, i = rho & 15; return 8 * (i >> 2) + 4 * n + (i & 3); }
struct Unit { int pm, pn, aux, nt, lda, ldb; const char* a; const char* b; };
typedef float f32x2_t __attribute__((ext_vector_type(2))); typedef __bf16 bf16x2_t __attribute__((ext_vector_type(2)));
__device__ __forceinline__ unsigned cvt_pk_bf16(float lo, float hi) { f32x2_t v = {lo, hi}; bf16x2_t b = __builtin_convertvector(v, bf16x2_t); return __builtin_bit_cast(unsigned, b); }
__device__ __forceinline__ bool static_tile(int i, int G, int c, int nM, int nN, int& pm, int& pn) {
    const int nwg = nM * nN; const long L = (long)i * G + c; if (L >= nwg) return false;
    int wgid = (int)L; { const int q = nwg / NXCD, r = nwg % NXCD, xcd = wgid % NXCD, off = wgid / NXCD; wgid = (xcd < r ? xcd * (q + 1) : r * (q + 1) + (xcd - r) * q) + off; }
    const int nig = WGM * nN, gid = wgid / nig, fm = gid * WGM, gsz = (nM - fm) < WGM ? (nM - fm) : WGM;
    pm = fm + ((wgid % nig) % gsz); pn = (wgid % nig) / gsz; return true;
}
template <class Epi, class Sched, bool ALIGN_EPI>
__device__ __forceinline__ void gemm_phase(PG8_LAS unsigned char* lds, const Sched& S, const Epi& E) {
    const int tid = threadIdx.x, wid = __builtin_amdgcn_readfirstlane(tid >> 6), lane = tid & 63, wr = wid >> 2, wc = wid & 3, fr = lane & 15, fq = lane >> 4;
    const size_t kstep = (size_t)(BK * 2);
    const unsigned ldsw = (unsigned)wid * 1024u;
    const int aoff = lds_byte(wr * 64 + fr, fq * 8), boff = lds_byte(wc * 32 + fr, fq * 8);
#define PG8_VOFF(LDA, LDB) do { int t_ = threadIdx.x; asm volatile("" : "+v"(t_)); _Pragma("unroll") for (int i_ = 0; i_ < 2; ++i_) { int R_, C_; stage_rc(t_ * 16 + i_ * 8192, R_, C_); \
        const int Rb_ = Epi::PERM ? ((R_ & ~31) + perm32(R_ & 31)) : R_; voffA[i_] = (unsigned)(R_ * (LDA) + C_) * 2u; voffB[i_] = (unsigned)(Rb_ * (LDB) + C_) * 2u; } } while (0)
#define PG8_SA(b, h) (((b) * 2 + (h)) * HTB)
#define PG8_SB(b, h) ((4 + (b) * 2 + (h)) * HTB)
#define PG8_STAGE(bufoff, gbase, voff) do { _Pragma("unroll") for (int _i = 0; _i < 2; ++_i) \
        __builtin_amdgcn_global_load_lds((const unsigned*)((const char*)(gbase) + (voff)[_i]), (PG8_LAS unsigned*)(lds + (bufoff) + ldsw + _i * 8192), 16, 0, 0); } while (0)
#define PG8_LDA(dst, b, h) do { _Pragma("unroll") for (int m = 0; m < 4; ++m) _Pragma("unroll") for (int k = 0; k < 2; ++k) dst[m][k] = *(const PG8_LAS bf16x8*)(lds + PG8_SA(b, h) + aoff + m * 2048 + k * 1024); } while (0)
#define PG8_LDB(dst, b, h) do { _Pragma("unroll") for (int n = 0; n < 2; ++n) _Pragma("unroll") for (int k = 0; k < 2; ++k) dst[n][k] = *(const PG8_LAS bf16x8*)(lds + PG8_SB(b, h) + boff + n * 2048 + k * 1024); } while (0)
#define PG8_MMA(ai, bj, At, Bt) do { __builtin_amdgcn_s_setprio(1); _Pragma("unroll") for (int m = 0; m < 4; ++m) _Pragma("unroll") for (int n = 0; n < 2; ++n) _Pragma("unroll") for (int k = 0; k < 2; ++k) \
        acc[ai][bj][m][n] = __builtin_amdgcn_mfma_f32_16x16x32_bf16(Bt[n][k], At[m][k], acc[ai][bj][m][n], 0, 0, 0); __builtin_amdgcn_s_setprio(0); } while (0)
#define PG8_WAIT_V(n) asm volatile("s_waitcnt vmcnt(" #n ")" ::: "memory")
#define PG8_WAIT_L(n) asm volatile("s_waitcnt lgkmcnt(" #n ")" ::: "memory")
#define PG8_BAR __builtin_amdgcn_s_barrier()
#define PG8_SCHED __builtin_amdgcn_sched_barrier(0)
#define PG8_H1(p, ld) ((p) + (size_t)HALF * (ld) * 2)
    Unit cur, nxt; int ui = 0;
    if (!S.next(0, cur)) return;
    f32x4 acc[2][2][4][2];
#pragma unroll
    for (int a = 0; a < 2; ++a)
#pragma unroll
        for (int b = 0; b < 2; ++b)
#pragma unroll
            for (int m = 0; m < 4; ++m)
#pragma unroll
                for (int n = 0; n < 2; ++n) acc[a][b][m][n] = (f32x4){0.f, 0.f, 0.f, 0.f};
    bf16x8 At[4][2], B0[2][2], B1[2][2];
    unsigned voffA[2], voffB[2];
    PG8_VOFF(cur.lda, cur.ldb);
    PG8_STAGE(PG8_SB(0, 0), cur.b, voffB); PG8_STAGE(PG8_SB(0, 1), PG8_H1(cur.b, cur.ldb), voffB); PG8_STAGE(PG8_SA(0, 0), cur.a, voffA); PG8_STAGE(PG8_SA(0, 1), PG8_H1(cur.a, cur.lda), voffA);
    if (wr == 1) PG8_BAR;
    PG8_WAIT_V(2); PG8_BAR;
    PG8_STAGE(PG8_SB(1, 0), cur.b + kstep, voffB); PG8_STAGE(PG8_SA(1, 0), cur.a + kstep, voffA); PG8_STAGE(PG8_SB(1, 1), PG8_H1(cur.b, cur.ldb) + kstep, voffB);
    PG8_WAIT_V(6); PG8_BAR;
    for (;;) {
        const bool has_next = S.next(ui + 1, nxt);
        if (!has_next) nxt = cur;
        const int nt = cur.nt;
        for (int t = 0; t < nt; t += 2) {
            const bool last = (t == nt - 2);
            PG8_LDB(B0, 0, 0); PG8_LDB(B1, 0, 1); PG8_SCHED; PG8_LDA(At, 0, 0); PG8_STAGE(PG8_SA(1, 1), PG8_H1(cur.a, cur.lda) + (size_t)(t + 1) * kstep, voffA);
            if (last) PG8_VOFF(nxt.lda, nxt.ldb);
            const char* a2 = last ? nxt.a : cur.a + (size_t)(t + 2) * kstep; const char* b2 = last ? nxt.b : cur.b + (size_t)(t + 2) * kstep;
            const int lda2 = last ? nxt.lda : cur.lda, ldb2 = last ? nxt.ldb : cur.ldb;
            PG8_WAIT_V(8); PG8_WAIT_L(0); PG8_BAR; PG8_MMA(0, 0, At, B0); PG8_MMA(0, 1, At, B1); PG8_BAR; PG8_SCHED;
            PG8_LDA(At, 0, 1); PG8_STAGE(PG8_SB(0, 0), b2, voffB); PG8_STAGE(PG8_SB(0, 1), PG8_H1(b2, ldb2), voffB); PG8_STAGE(PG8_SA(0, 0), a2, voffA);
            PG8_WAIT_V(8); PG8_WAIT_L(0); PG8_BAR; PG8_MMA(1, 0, At, B0); PG8_MMA(1, 1, At, B1); PG8_BAR; PG8_SCHED;
            PG8_LDB(B0, 1, 0); PG8_LDB(B1, 1, 1); PG8_SCHED; PG8_LDA(At, 1, 0); PG8_STAGE(PG8_SA(0, 1), PG8_H1(a2, lda2), voffA);
            PG8_WAIT_V(8); PG8_WAIT_L(0); PG8_BAR; PG8_MMA(0, 0, At, B0); PG8_MMA(0, 1, At, B1); PG8_BAR; PG8_SCHED;
            PG8_LDA(At, 1, 1); PG8_STAGE(PG8_SB(1, 0), b2 + kstep, voffB); PG8_STAGE(PG8_SB(1, 1), PG8_H1(b2, ldb2) + kstep, voffB); PG8_STAGE(PG8_SA(1, 0), a2 + kstep, voffA);
            PG8_WAIT_V(8); PG8_WAIT_L(0); PG8_BAR; PG8_MMA(1, 0, At, B0); PG8_MMA(1, 1, At, B1); PG8_BAR; PG8_SCHED;
        }
        if constexpr (ALIGN_EPI) { if (wr == 0) PG8_BAR; }
        E(acc, cur, wr, wc, fr, fq);
        if (!has_next) break;
#pragma unroll
        for (int a = 0; a < 2; ++a)
#pragma unroll
            for (int b = 0; b < 2; ++b)
#pragma unroll
                for (int m = 0; m < 4; ++m)
#pragma unroll
                    for (int n = 0; n < 2; ++n) acc[a][b][m][n] = (f32x4){0.f, 0.f, 0.f, 0.f};
        cur = nxt; ++ui;
        if constexpr (ALIGN_EPI) { if (wr == 1) PG8_BAR; }
    }
    PG8_WAIT_V(0);
    if constexpr (!ALIGN_EPI) { if (wr == 0) PG8_BAR; }
    PG8_BAR;
#undef PG8_VOFF
#undef PG8_H1
#undef PG8_SA
#undef PG8_SB
#undef PG8_STAGE
#undef PG8_LDA
#undef PG8_LDB
#undef PG8_MMA
#undef PG8_WAIT_V
#undef PG8_WAIT_L
#undef PG8_BAR
#undef PG8_SCHED
}
struct SchedPlain {
    const char* A; const char* B; int nM, nN, lda, ldb, nt, G, c;
    __device__ __forceinline__ bool next(int i, Unit& u) const {
        int pm, pn; if (!static_tile(i, G, c, nM, nN, pm, pn)) return false;
        u.pm = pm; u.pn = pn; u.aux = 0; u.nt = nt; u.lda = lda; u.ldb = ldb; u.a = A + (size_t)pm * BM * lda * 2; u.b = B + (size_t)pn * BM * ldb * 2; return true; }
};
struct SchedMerge {
    const char* XB; const char* WG; const char* Y; const char* WB; int G, c;
    __device__ __forceinline__ bool next(int i, Unit& u) const {
        const int ti = i / 6, sub = i - ti * 6, br = sub >> 1; int pm, pn; if (!static_tile(ti, G, c, 256, 4, pm, pn)) return false;
        u.pm = pm; u.pn = pn; u.aux = sub;
        if ((sub & 1) == 0) { u.nt = 16; u.lda = 1024; u.ldb = 1024; u.a = XB + (size_t)pm * BM * 1024 * 2; u.b = WG + (size_t)(br * 1024 + pn * BM) * 1024 * 2; }
        else { u.nt = 8; u.lda = 1536; u.ldb = 512; u.a = Y + ((size_t)pm * BM * 1536 + br * 512) * 2; u.b = WB + (size_t)(br * 1024 + pn * BM) * 512 * 2; }
        return true; }
};
struct SchedExp {
    const char* A; const char* B; int lda, ldb, nt, total, G, c; size_t bexp; const PG8_LAS int* tab;
    __device__ __forceinline__ bool next(int i, Unit& u) const {
        const long L = (long)i * G + c; if (L >= total) return false;
        int id = (int)L; { const int q = total / NXCD, r = total % NXCD, xcd = id % NXCD, off = id / NXCD; id = (xcd < r ? xcd * (q + 1) : r * (q + 1) + (xcd - r) * q) + off; }
        const int rt = id >> 2, pn = id & 3; const int e = __builtin_amdgcn_readfirstlane(tab[rt]);
        u.pm = rt; u.pn = pn; u.aux = e; u.nt = nt; u.lda = lda; u.ldb = ldb; u.a = A + (size_t)rt * BM * lda * 2; u.b = B + (size_t)e * bexp + (size_t)pn * BM * ldb * 2; return true; }
};
struct EpiBf16 {
    static constexpr bool PERM = true; bf16_t* O; int ldc;
    __device__ __forceinline__ void operator()(const f32x4 (&acc)[2][2][4][2], const Unit& u, int wr, int wc, int fr, int fq) const {
        bf16_t* base = O + (size_t)(u.pm * BM + wr * 64 + fr) * ldc + u.pn * BM + wc * 32 + 8 * fq;
#pragma unroll
        for (int ai = 0; ai < 2; ++ai)
#pragma unroll
            for (int m = 0; m < 4; ++m) { bf16_t* rowp = base + (size_t)(ai * HALF + m * 16) * ldc;
#pragma unroll
                for (int bj = 0; bj < 2; ++bj) { const f32x4 v0 = acc[ai][bj][m][0], v1 = acc[ai][bj][m][1];
                    u32x4 w; w.x = cvt_pk_bf16(v0[0], v0[1]); w.y = cvt_pk_bf16(v0[2], v0[3]); w.z = cvt_pk_bf16(v1[0], v1[1]); w.w = cvt_pk_bf16(v1[2], v1[3]);
                    *(u32x4*)(rowp + bj * HALF) = w; } }
    }
};
struct EpiProj {
    static constexpr bool PERM = true; bf16_t *HG, *DQK, *DV, *MQ; const float* rope;
    __device__ __forceinline__ void operator()(const f32x4 (&acc)[2][2][4][2], const Unit& u, int wr, int wc, int fr, int fq) const {
        const int pn = u.pn; bf16_t* dst; int ld, mode;
        if (pn < 8) { dst = HG + pn * 256; ld = 2048; mode = (pn < 2 || pn >= 6) ? 1 : 0; }
        else if (pn < 12) { dst = DQK + (pn - 8) * 256; ld = 1024; mode = pn < 10 ? 2 : 3; }
        else if (pn < 14) { dst = DV + (pn - 12) * 256; ld = 512; mode = 0; }
        else { dst = MQ + (pn - 14) * 256; ld = 512; mode = 0; }
        const int row0 = u.pm * BM + wr * 64 + fr; const bool rot = (mode >= 2) && ((wc & 1) == 0);
#pragma unroll
        for (int ai = 0; ai < 2; ++ai)
#pragma unroll
            for (int m = 0; m < 4; ++m) { const int row = row0 + ai * HALF + m * 16; bf16_t* rowp = dst + (size_t)row * ld + wc * 32 + 8 * fq;
                f32x4 r0 = {1.f, 0.f, 1.f, 0.f}, r1 = r0, r2 = r0, r3 = r0;
                if (rot) { const f32x4* rp = (const f32x4*)(rope + (size_t)row * 16); r0 = rp[0]; r1 = rp[1]; r2 = rp[2]; r3 = rp[3]; }
#pragma unroll
                for (int bj = 0; bj < 2; ++bj) { f32x4 v0 = acc[ai][bj][m][0], v1 = acc[ai][bj][m][1];
                    if (mode == 1) {
#pragma unroll
                        for (int e = 0; e < 4; ++e) { v0[e] = siluf_(v0[e]); v1[e] = siluf_(v1[e]); } }
                    if (rot) {
                        f32x4 p0, p1;
#pragma unroll
                        for (int e = 0; e < 4; ++e) { p0[e] = __shfl_xor(v0[e], 16); p1[e] = __shfl_xor(v1[e], 16); }
                        const float sg = (fq == 0) ? -1.f : 1.f;
                        if (fq < 2) {
                            v0[0] = v0[0] * r0[0] + sg * p0[0] * r0[1]; v0[1] = v0[1] * r0[2] + sg * p0[1] * r0[3]; v0[2] = v0[2] * r1[0] + sg * p0[2] * r1[1]; v0[3] = v0[3] * r1[2] + sg * p0[3] * r1[3];
                            v1[0] = v1[0] * r2[0] + sg * p1[0] * r2[1]; v1[1] = v1[1] * r2[2] + sg * p1[1] * r2[3]; v1[2] = v1[2] * r3[0] + sg * p1[2] * r3[1]; v1[3] = v1[3] * r3[2] + sg * p1[3] * r3[3]; } }
                    if (mode == 2) { v0 = v0 * QSCALE_DF; v1 = v1 * QSCALE_DF; }
                    u32x4 w; w.x = cvt_pk_bf16(v0[0], v0[1]); w.y = cvt_pk_bf16(v0[2], v0[3]); w.z = cvt_pk_bf16(v1[0], v1[1]); w.w = cvt_pk_bf16(v1[2], v1[3]);
                    *(u32x4*)(rowp + bj * HALF) = w; }
                asm volatile("" ::: "memory"); }
    }
};
__device__ __forceinline__ u32x4 ld16_sc1(const unsigned char* p) {
    const unsigned long long a = __hip_atomic_load((const unsigned long long*)p, __ATOMIC_RELAXED, __HIP_MEMORY_SCOPE_AGENT), b = __hip_atomic_load((const unsigned long long*)p + 1, __ATOMIC_RELAXED, __HIP_MEMORY_SCOPE_AGENT);
    u32x4 r; r.x = (unsigned)a; r.y = (unsigned)(a >> 32); r.z = (unsigned)b; r.w = (unsigned)(b >> 32); return r; }
__device__ __forceinline__ void unpack8(const u32x4 w, float (&o)[8]) {
    o[0] = __uint_as_float(w.x << 16); o[1] = __uint_as_float(w.x & 0xffff0000u); o[2] = __uint_as_float(w.y << 16); o[3] = __uint_as_float(w.y & 0xffff0000u);
    o[4] = __uint_as_float(w.z << 16); o[5] = __uint_as_float(w.z & 0xffff0000u); o[6] = __uint_as_float(w.w << 16); o[7] = __uint_as_float(w.w & 0xffff0000u); }
struct EpiMerge {
    static constexpr bool PERM = true; bf16_t* MG; unsigned char* scrG; unsigned char* scrS;
    static __device__ __forceinline__ void unpack8_(const u32x4 w, float (&o)[8]) {
        o[0] = __uint_as_float(w.x << 16); o[1] = __uint_as_float(w.x & 0xffff0000u); o[2] = __uint_as_float(w.y << 16); o[3] = __uint_as_float(w.y & 0xffff0000u);
        o[4] = __uint_as_float(w.z << 16); o[5] = __uint_as_float(w.z & 0xffff0000u); o[6] = __uint_as_float(w.w << 16); o[7] = __uint_as_float(w.w & 0xffff0000u); }
    __device__ __forceinline__ void operator()(const f32x4 (&acc)[2][2][4][2], const Unit& u, int wr, int wc, int fr, int fq) const {
        const int sub = u.aux, br = sub >> 1; const int wid = wr * 4 + wc, lane = fq * 16 + fr;
        unsigned lo = ((unsigned)wid * 16u * 64u + (unsigned)lane) * 16u; asm volatile("" : "+v"(lo));
        if ((sub & 1) == 0) {
#pragma unroll
            for (int ai = 0; ai < 2; ++ai)
#pragma unroll
                for (int bj = 0; bj < 2; ++bj)
#pragma unroll
                    for (int m = 0; m < 4; ++m) { const int g = (ai * 2 + bj) * 4 + m; const f32x4 v0 = acc[ai][bj][m][0], v1 = acc[ai][bj][m][1];
                        u32x4 w; w.x = cvt_pk_bf16(sigmoidf_(v0[0]), sigmoidf_(v0[1])); w.y = cvt_pk_bf16(sigmoidf_(v0[2]), sigmoidf_(v0[3]));
                        w.z = cvt_pk_bf16(sigmoidf_(v1[0]), sigmoidf_(v1[1])); w.w = cvt_pk_bf16(sigmoidf_(v1[2]), sigmoidf_(v1[3]));
                        *(u32x4*)(scrG + (lo + (unsigned)g * 1024u)) = w; asm volatile("" ::: "memory"); }
        } else {
            bf16_t* base = MG + (size_t)(u.pm * BM + wr * 64 + fr) * 1024 + u.pn * BM + wc * 32 + 8 * fq;
#pragma unroll
            for (int ai = 0; ai < 2; ++ai)
#pragma unroll
                for (int bj = 0; bj < 2; ++bj)
#pragma unroll
                    for (int m = 0; m < 4; ++m) { const int g = (ai * 2 + bj) * 4 + m; const f32x4 v0 = acc[ai][bj][m][0], v1 = acc[ai][bj][m][1];
                        float gt[8], o[8]; unpack8(*(const u32x4*)(scrG + (lo + (unsigned)g * 1024u)), gt);
                        o[0] = gt[0] * v0[0]; o[1] = gt[1] * v0[1]; o[2] = gt[2] * v0[2]; o[3] = gt[3] * v0[3]; o[4] = gt[4] * v1[0]; o[5] = gt[5] * v1[1]; o[6] = gt[6] * v1[2]; o[7] = gt[7] * v1[3];
                        if (br > 0) { float pv[8]; unpack8(*(const u32x4*)(scrS + (lo + (unsigned)g * 1024u)), pv);
#pragma unroll
                            for (int e = 0; e < 8; ++e) o[e] += pv[e]; }
                        u32x4 w; w.x = cvt_pk_bf16(o[0], o[1]); w.y = cvt_pk_bf16(o[2], o[3]); w.z = cvt_pk_bf16(o[4], o[5]); w.w = cvt_pk_bf16(o[6], o[7]);
                        if (br < 2) *(u32x4*)(scrS + (lo + (unsigned)g * 1024u)) = w; else *(u32x4*)(base + (size_t)(ai * HALF + m * 16) * 1024 + bj * HALF) = w;
                        asm volatile("" ::: "memory"); }
        }
    }
};
struct EpiWout {
    static constexpr bool PERM = false; const float* x; float* out;
    __device__ __forceinline__ void operator()(const f32x4 (&acc)[2][2][4][2], const Unit& u, int wr, int wc, int fr, int fq) const {
        const size_t off0 = (size_t)(u.pm * BM + wr * 64 + fr) * 1024 + u.pn * BM + wc * 32 + 4 * fq;
#pragma unroll
        for (int ai = 0; ai < 2; ++ai)
#pragma unroll
            for (int m = 0; m < 4; ++m) { const size_t off = off0 + (size_t)(ai * HALF + m * 16) * 1024;
#pragma unroll
                for (int bj = 0; bj < 2; ++bj)
#pragma unroll
                    for (int n = 0; n < 2; ++n) { const f32x4 xv = *(const f32x4*)(x + off + bj * HALF + n * 16); *(f32x4*)(out + off + bj * HALF + n * 16) = xv * ALPHA + acc[ai][bj][m][n]; }
                if (m & 1) asm volatile("" ::: "memory"); }
    }
};
struct EpiSwiglu {
    static constexpr bool PERM = true; bf16_t* H;
    __device__ __forceinline__ void operator()(const f32x4 (&acc)[2][2][4][2], const Unit& u, int wr, int wc, int fr, int fq) const {
        bf16_t* base = H + (size_t)(u.pm * BM + wr * 64 + fr) * 512 + u.pn * HALF + wc * 32 + 8 * fq;
#pragma unroll
        for (int ai = 0; ai < 2; ++ai)
#pragma unroll
            for (int m = 0; m < 4; ++m) { const f32x4 g0 = acc[ai][0][m][0], g1 = acc[ai][0][m][1], u0 = acc[ai][1][m][0], u1 = acc[ai][1][m][1];
                u32x4 w; w.x = cvt_pk_bf16(siluf_(g0[0]) * u0[0], siluf_(g0[1]) * u0[1]); w.y = cvt_pk_bf16(siluf_(g0[2]) * u0[2], siluf_(g0[3]) * u0[3]);
                w.z = cvt_pk_bf16(siluf_(g1[0]) * u1[0], siluf_(g1[1]) * u1[1]); w.w = cvt_pk_bf16(siluf_(g1[2]) * u1[2], siluf_(g1[3]) * u1[3]);
                *(u32x4*)(base + (size_t)(ai * HALF + m * 16) * 512) = w; }
    }
};
}

#define LASP(p) ((__attribute__((address_space(3))) unsigned char*)(p))
__device__ __forceinline__ void phase_proj_pg8(const Params& p, unsigned char* lds) {
    unsigned char* ws = p.ws;
    { pg8::SchedPlain S{(const char*)(ws + WS_XB), (const char*)(ws + WS_WT_IN), 256, 16, 1024, 1024, 16, (int)gridDim.x, (int)blockIdx.x};
      pg8::EpiProj E{(bf16_t*)(ws + WS_HG), (bf16_t*)(ws + WS_DQK), (bf16_t*)(ws + WS_DV), (bf16_t*)(ws + WS_MQ), (const float*)(ws + WS_ROPE)};
      pg8::gemm_phase<pg8::EpiProj, pg8::SchedPlain, true>(LASP(lds), S, E); }
    { pg8::SchedPlain S{(const char*)(ws + WS_MEMB), (const char*)(ws + WS_WT_MKV), 16, 4, 1024, 1024, 16, (int)gridDim.x, (int)blockIdx.x};
      pg8::EpiBf16 E{(bf16_t*)(ws + WS_MKV), 1024};
      pg8::gemm_phase<pg8::EpiBf16, pg8::SchedPlain, true>(LASP(lds), S, E); }
}
constexpr size_t WS_SCR = WS_DQK;
__device__ __forceinline__ void phase_merge_pg8(const Params& p, unsigned char* lds) {
    unsigned char* ws = p.ws;
    pg8::SchedMerge S{(const char*)(ws + WS_XB), (const char*)(ws + WS_WT_G), (const char*)(ws + WS_Y), (const char*)(ws + WS_WT_B), (int)gridDim.x, (int)blockIdx.x};
    pg8::EpiMerge E{(bf16_t*)(ws + WS_MERGED), ws + WS_SCR + (size_t)blockIdx.x * 262144, ws + WS_SCR + (size_t)blockIdx.x * 262144 + 131072};
    pg8::gemm_phase<pg8::EpiMerge, pg8::SchedMerge, true>(LASP(lds), S, E);
}
__device__ __forceinline__ void phase_wout_pg8(const Params& p, unsigned char* lds) {
    unsigned char* ws = p.ws;
    pg8::SchedPlain S{(const char*)(ws + WS_MERGED), (const char*)(ws + WS_WT_OUT), 256, 4, 1024, 1024, 16, (int)gridDim.x, (int)blockIdx.x};
    pg8::EpiWout E{(const float*)p.in[0], p.out};
    pg8::gemm_phase<pg8::EpiWout, pg8::SchedPlain, true>(LASP(lds), S, E);
}
constexpr int LDS_TAB = 131072;
__device__ __forceinline__ int exp_table(const Params& p, unsigned char* lds) {
    const int lane = threadIdx.x & 63; int tiles, endi; const int nt256 = expert_layout((const int*)(p.ws + WS_CTL), lane, tiles, endi);
    int* tab = (int*)(lds + LDS_TAB);
    for (int rt = threadIdx.x >> 6; rt < nt256; rt += 8) { const int e = expert_of_tile(rt, lane, endi); if (lane == 0) tab[rt] = e; }
    __syncthreads(); return nt256;
}
__device__ __forceinline__ void phase_exp_gu_pg8(const Params& p, unsigned char* lds) {
    unsigned char* ws = p.ws; const int nt256 = exp_table(p, lds);
    pg8::SchedExp S{(const char*)(ws + WS_XS), (const char*)(ws + WS_WT_GU), 1024, 1024, 16, nt256 * 4, (int)gridDim.x, (int)blockIdx.x, (size_t)1024 * 1024 * 2, (const __attribute__((address_space(3))) int*)LASP(lds + LDS_TAB)};
    pg8::EpiSwiglu E{(bf16_t*)(ws + WS_H)};
    pg8::gemm_phase<pg8::EpiSwiglu, pg8::SchedExp, true>(LASP(lds), S, E);
}
__device__ __forceinline__ void phase_exp_dn_pg8(const Params& p, unsigned char* lds) {
    unsigned char* ws = p.ws; const int nt256 = exp_table(p, lds);
    pg8::SchedExp S{(const char*)(ws + WS_H), (const char*)(ws + WS_WT_DN), 512, 512, 8, nt256 * 4, (int)gridDim.x, (int)blockIdx.x, (size_t)1024 * 512 * 2, (const __attribute__((address_space(3))) int*)LASP(lds + LDS_TAB)};
    pg8::EpiBf16 E{(bf16_t*)(ws + WS_YB), 1024};
    pg8::gemm_phase<pg8::EpiBf16, pg8::SchedExp, true>(LASP(lds), S, E);
}

#include <hip/hip_bf16.h>
namespace attn64 {
using bf16=__hip_bfloat16;
using bf16x8=__attribute__((ext_vector_type(8)))short;
using s16x4=__attribute__((ext_vector_type(4)))short;
using f32x16=__attribute__((ext_vector_type(16)))float;
using u32x4=__attribute__((ext_vector_type(4)))unsigned;
constexpr int SEQ=4096,D=64;
constexpr int NW=8,QBLK=32,QB=QBLK*NW,KVBLK=64,NQB=SEQ/QB;
constexpr int ATTN_UNIT_ROWS=QB;
__device__ __forceinline__ int crow(int r,int hi){return (r&3)+8*(r>>2)+4*hi;}
#define SBAR() __builtin_amdgcn_sched_barrier(0)
__device__ __forceinline__ void cmask(f32x16&p0,f32x16&p1,int jb,int qrel,int hi){
  const float NEG=-INFINITY; const int dq=qrel-64*jb-4*hi;
  #pragma unroll
  for(int r=0;r<16;++r){const int c=(r&3)+8*(r>>2); if(c>dq)p0[r]=NEG; if(c+32>dq)p1[r]=NEG;}
}

constexpr int NSLOT=3, SLOTB=8192;
constexpr int LDS_K=0, LDS_V=NSLOT*SLOTB, LDS_WS=2*NSLOT*SLOTB, LDS_OST=LDS_WS+NW*64*4, LDS_BYTES=LDS_OST+NW*4096;
constexpr float C2=0.125f*1.4426950408889634f;
__device__ __forceinline__ void glds16(const void*gsrc,unsigned lds_dst){unsigned keep;
  asm volatile("s_mov_b32 %0, m0\n\ts_mov_b32 m0, %2\n\ts_nop 0\n\tglobal_load_lds_dwordx4 %1, off\n\ts_mov_b32 m0, %0":"=&s"(keep):"v"(gsrc),"s"(lds_dst):"memory");}
__device__ __forceinline__ float max3f(float a,float b,float c){float r;asm("v_max3_f32 %0, %1, %2, %3":"=v"(r):"v"(a),"v"(b),"v"(c));return r;}
__device__ __forceinline__ float max2f(float a,float b){float r;asm("v_max_f32_e32 %0, %1, %2":"=v"(r):"v"(a),"v"(b));return r;}
__device__ __forceinline__ float fadd_s(float a,float b){float r;asm("v_add_f32_e32 %0, %1, %2":"=v"(r):"v"(a),"v"(b));return r;}
__device__ __forceinline__ float fsub_s(float a,float b){float r;asm("v_sub_f32_e32 %0, %1, %2":"=v"(r):"v"(a),"v"(b));return r;}
typedef float f32x2_t __attribute__((ext_vector_type(2))); typedef __bf16 bf16x2_t __attribute__((ext_vector_type(2)));
__device__ __forceinline__ unsigned cvtpk_s(float lo,float hi){f32x2_t v={lo,hi};bf16x2_t b=__builtin_convertvector(v,bf16x2_t);return __builtin_bit_cast(unsigned,b);}
#define WAIT_BAR(N) asm volatile("s_waitcnt vmcnt(" #N ") lgkmcnt(0)\n\ts_barrier":::"memory")

__device__ __forceinline__ void qkt(f32x16&p0,f32x16&p1,const char*Kslot,const bf16x8*qr,const f32x16&negm,int r32,int hi){
  const char*kb=Kslot+hi*1024+r32*16;
  #pragma unroll
  for(int d0=0;d0<4;++d0){
    const bf16x8 b0=*reinterpret_cast<const bf16x8*>(kb+d0*2048);
    const bf16x8 b1=*reinterpret_cast<const bf16x8*>(kb+d0*2048+512);
    if(d0==0){p0=__builtin_amdgcn_mfma_f32_32x32x16_bf16(b0,qr[0],negm,0,0,0);p1=__builtin_amdgcn_mfma_f32_32x32x16_bf16(b1,qr[0],negm,0,0,0);}
    else{p0=__builtin_amdgcn_mfma_f32_32x32x16_bf16(b0,qr[d0],p0,0,0,0);p1=__builtin_amdgcn_mfma_f32_32x32x16_bf16(b1,qr[d0],p1,0,0,0);}}
}
typedef __attribute__((address_space(3))) const char* lds_cptr;
typedef short v4i16_t __attribute__((ext_vector_type(4)));
__device__ __forceinline__ void kload8(bf16x8*kf,lds_cptr kp){
  kf[0]=*(const __attribute__((address_space(3))) bf16x8*)(kp);      kf[1]=*(const __attribute__((address_space(3))) bf16x8*)(kp+512);
  kf[2]=*(const __attribute__((address_space(3))) bf16x8*)(kp+2048); kf[3]=*(const __attribute__((address_space(3))) bf16x8*)(kp+2560);
  kf[4]=*(const __attribute__((address_space(3))) bf16x8*)(kp+4096); kf[5]=*(const __attribute__((address_space(3))) bf16x8*)(kp+4608);
  kf[6]=*(const __attribute__((address_space(3))) bf16x8*)(kp+6144); kf[7]=*(const __attribute__((address_space(3))) bf16x8*)(kp+6656);
}
__device__ __forceinline__ void kload2(bf16x8*kf,lds_cptr kp,int j){ kf[2*j]=*(const __attribute__((address_space(3))) bf16x8*)(kp+j*2048); kf[2*j+1]=*(const __attribute__((address_space(3))) bf16x8*)(kp+j*2048+512); }
__device__ __forceinline__ s16x4 vtr(lds_cptr p){ return __builtin_bit_cast(s16x4,__builtin_amdgcn_ds_read_tr16_b64_v4i16((__attribute__((address_space(3))) v4i16_t*)p)); }
__device__ __forceinline__ float rowmax(const f32x16&p0,const f32x16&p1){
  float a=max3f(p0[0],p0[1],p1[0]),b=max3f(p0[2],p0[3],p1[1]);a=max3f(a,p1[2],p1[3]);
  #pragma unroll
  for(int r=4;r<16;r+=4){a=max3f(a,p0[r],p0[r+1]);b=max3f(b,p0[r+2],p0[r+3]);a=max3f(a,p1[r],p1[r+1]);b=max3f(b,p1[r+2],p1[r+3]);}
  const float m=max2f(a,b);
  auto rr=__builtin_amdgcn_permlane32_swap(__float_as_uint(m),__float_as_uint(m),false,false);
  return max2f(__uint_as_float(rr[0]),__uint_as_float(rr[1]));
}
__device__ __forceinline__ void pv(f32x16*o,int vb,bf16x8 pa0,bf16x8 pa1,bf16x8 pa2,bf16x8 pa3){
  #pragma unroll
  for(int d0=0;d0<2;++d0){s16x4 lo[4],hi[4];
    #pragma unroll
    for(int ks=0;ks<4;++ks){
      asm volatile("ds_read_b64_tr_b16 %0,%1 offset:%c2":"=&v"(lo[ks]):"v"(vb),"i"(d0*4096+ks*1024):"memory");
      asm volatile("ds_read_b64_tr_b16 %0,%1 offset:%c2":"=&v"(hi[ks]):"v"(vb),"i"(d0*4096+ks*1024+512):"memory");}
    asm volatile("s_waitcnt lgkmcnt(0)":::"memory");SBAR();
    #define PK(k) (bf16x8){lo[k][0],lo[k][1],lo[k][2],lo[k][3],hi[k][0],hi[k][1],hi[k][2],hi[k][3]}
    o[d0]=__builtin_amdgcn_mfma_f32_32x32x16_bf16(pa0,PK(0),o[d0],0,0,0);
    o[d0]=__builtin_amdgcn_mfma_f32_32x32x16_bf16(pa1,PK(1),o[d0],0,0,0);
    o[d0]=__builtin_amdgcn_mfma_f32_32x32x16_bf16(pa2,PK(2),o[d0],0,0,0);
    o[d0]=__builtin_amdgcn_mfma_f32_32x32x16_bf16(pa3,PK(3),o[d0],0,0,0);
    #undef PK
  }
}

#ifndef ATTN_STORE16
#define ATTN_STORE16(p,v) (*(u32x4*)(p)=(v))
#endif
template<int THRL,int PQ,int PK,int PV,int PO> __device__ __forceinline__ void attn_unit(int qb,const bf16*Qs,const bf16*__restrict__ Ks,const bf16*__restrict__ Vs,bf16*Os,char*shm){
  const int tid=threadIdx.x,lane=tid&63,r32=lane&31,hi=lane>>5; const int wid=__builtin_amdgcn_readfirstlane(tid>>6);
  const int q0=qb*QB;
  const bf16*Qw=Qs+(long)(q0+wid*QBLK)*PQ;
  const bf16*Kh=Ks,*Vh=Vs;
  const unsigned lds0=(unsigned)(uintptr_t)shm;
  float*wsf=(float*)(shm+LDS_WS)+wid*64;
  const bf16*ksrc=Kh+(long)lane*PK+wid*8;
  const bf16*vsrc=Vh+(long)(16*(wid&3)+(lane>>2))*PV+(wid>>2)*32+(lane&3)*8;
  const unsigned kdst=lds0+LDS_K+wid*1024, vdst=lds0+LDS_V+wid*1024;
  #define DMA_K(t,slot) glds16(ksrc+(long)(t)*KVBLK*PK,(unsigned)__builtin_amdgcn_readfirstlane(kdst+(slot)))
  #define DMA_V(t,slot) glds16(vsrc+(long)(t)*KVBLK*PV,(unsigned)__builtin_amdgcn_readfirstlane(vdst+(slot)))
  const int vb0=(int)(lds0+LDS_V)+((lane>>4)&1)*32+(lane&3)*8+(4*hi+((lane&15)>>2))*64;
  const char*Kbase=shm+LDS_K; bf16x8 kf[8];
  const lds_cptr shm3=(lds_cptr)shm; const lds_cptr kp0=shm3+LDS_K+hi*1024+r32*16; const lds_cptr vp0=shm3+LDS_V+((lane>>4)&1)*32+(lane&3)*8+(4*hi+((lane&15)>>2))*64;
  const int NT=(q0+QB)/KVBLK;
  DMA_K(0,0);DMA_V(0,0);DMA_K(1,SLOTB);
  bf16x8 qr[4];
  #pragma unroll
  for(int d0=0;d0<4;++d0)qr[d0]=*reinterpret_cast<const bf16x8*>(&Qw[(long)r32*PQ+d0*16+hi*8]);
  float mhat=0.f,l_reg=0.f;f32x16 o[2];f32x16 negm;{float z_=0.f;asm volatile("":"+v"(z_));
  _Pragma("unroll") for(int r=0;r<16;++r){o[0][r]=z_;o[1][r]=z_;negm[r]=z_;}}asm volatile("":"+v"(negm));
  const int qrel=wid*QBLK+r32;
  #define CMASK(P0,P1,t) do{int jb_=(t)-(NT-4); if(jb_>=0)cmask(P0,P1,jb_,qrel,hi);}while(0)
  bool resc=false;
  #define START(P0,P1) do{ const float rm=rowmax(P0,P1); resc=false; \
    { const float dl=rm; mhat=fadd_s(mhat,dl); \
      _Pragma("unroll") for(int r=0;r<16;++r){P0[r]=fsub_s(P0[r],dl);P1[r]=fsub_s(P1[r],dl);} \
      _Pragma("unroll") for(int r=0;r<16;++r)negm[r]=-mhat; asm volatile("":"+v"(negm)); } \
    _Pragma("unroll") for(int r=0;r<16;++r)P0[r]=__builtin_amdgcn_exp2f(P0[r]); }while(0)
  #define RESC() do{ if(resc){ asm volatile("s_waitcnt lgkmcnt(0)":::"memory"); \
      _Pragma("unroll") for(int d_=0;d_<2;++d_) _Pragma("unroll") for(int r=0;r<16;++r)o[d_][r]*=wsf[crow(r,hi)]; } }while(0)
  f32x16 pA0,pA1,pB0,pB1;
  int sl_prev=0,sl_cur=0,sl_next=SLOTB;
  #define ROT() do{sl_prev=sl_cur;sl_cur=sl_next;sl_next=(sl_next==(NSLOT-1)*SLOTB)?0:sl_next+SLOTB;}while(0)
  DMA_K(2,2*SLOTB);
  WAIT_BAR(3);
  qkt(pA0,pA1,Kbase,qr,negm,r32,hi);asm volatile("s_nop 15\n\ts_nop 7":"+v"(pA0),"+v"(pA1));CMASK(pA0,pA1,0);
  START(pA0,pA1);
  _Pragma("unroll") for(int r=0;r<16;++r)pA1[r]=__builtin_amdgcn_exp2f(pA1[r]);
  WAIT_BAR(0);
  DMA_K(3,0);DMA_V(1,SLOTB);
  ROT();
  kload8(kf,kp0+sl_cur);
  WAIT_BAR(2);
  s16x4 vlo[8],vhi[8]; u32x4 pw0,pw1,pw2,pw3;
  #define PKW(P,B) cvtpk_s(P[B],P[B+1])
  #define PAF(k) __builtin_bit_cast(bf16x8,pw##k)
  #define VFR(i) (bf16x8){vlo[i][0],vlo[i][1],vlo[i][2],vlo[i][3],vhi[i][0],vhi[i][1],vhi[i][2],vhi[i][3]}
  #define PIN(x) asm volatile("":"+v"(x))
  #define MX3(a,b,c) __builtin_fmaxf(__builtin_fmaxf((a),(b)),(c))
  #define GAPA(MF,A0,A1,A2,A3,W0,W1,PW) do{ MF; sacc+=A0; sacc+=A1; sacc+=A2; sacc+=A3; PIN(sacc); W0; W1; PIN(PW); SBAR(); }while(0)
  #define EX(v) __builtin_amdgcn_exp2f(v)
  #define GAPB(MF,X,B) do{ MF; X[B]=EX(X[B]); X[B+1]=EX(X[B+1]); X[B+2]=EX(X[B+2]); X[B+3]=EX(X[B+3]); PIN(X); SBAR(); }while(0)
  #define VRD(i) do{ vlo[i]=vtr(vp_+(((i)>>2)*4096+((i)&3)*1024)); vhi[i]=vtr(vp_+(((i)>>2)*4096+((i)&3)*1024+512)); }while(0)
  #define KRD(G,j) do{ if(G){ kload2(kf,kp0+sl_next,j); SBAR(); } }while(0)
  #define STEP(C0,C1,P0,P1,t,GK,GV,GL) do{ SBAR(); \
    const lds_cptr vp_=vp0+sl_prev; \
    VRD(0); SBAR(); float sacc=(P0[0]+P0[1]); \
    GAPA(C0=__builtin_amdgcn_mfma_f32_32x32x16_bf16(kf[0],qr[0],negm,0,0,0), P0[2],P0[3],P0[4],P0[5],     pw0[0]=PKW(P0,0), pw0[1]=PKW(P0,2), pw0); \
    VRD(4); SBAR(); GAPA(C1=__builtin_amdgcn_mfma_f32_32x32x16_bf16(kf[1],qr[0],negm,0,0,0), P0[6],P0[7],P0[8],P0[9],     pw0[2]=PKW(P0,4), pw0[3]=PKW(P0,6), pw0); \
    VRD(1); SBAR(); GAPA(C0=__builtin_amdgcn_mfma_f32_32x32x16_bf16(kf[2],qr[1],C0,0,0,0),   P0[10],P0[11],P0[12],P0[13], pw1[0]=PKW(P0,8), pw1[1]=PKW(P0,10), pw1); \
    VRD(5); SBAR(); GAPA(C1=__builtin_amdgcn_mfma_f32_32x32x16_bf16(kf[3],qr[1],C1,0,0,0),   P0[14],P0[15],P1[0],P1[1],   pw1[2]=PKW(P0,12),pw1[3]=PKW(P0,14), pw1); \
    VRD(2); SBAR(); GAPA(C0=__builtin_amdgcn_mfma_f32_32x32x16_bf16(kf[4],qr[2],C0,0,0,0),   P1[2],P1[3],P1[4],P1[5],     pw2[0]=PKW(P1,0), pw2[1]=PKW(P1,2), pw2); \
    VRD(6); SBAR(); GAPA(C1=__builtin_amdgcn_mfma_f32_32x32x16_bf16(kf[5],qr[2],C1,0,0,0),   P1[6],P1[7],P1[8],P1[9],     pw2[2]=PKW(P1,4), pw2[3]=PKW(P1,6), pw2); \
    VRD(3); SBAR(); GAPA(C0=__builtin_amdgcn_mfma_f32_32x32x16_bf16(kf[6],qr[3],C0,0,0,0),   P1[10],P1[11],P1[12],P1[13], pw3[0]=PKW(P1,8), pw3[1]=PKW(P1,10), pw3); \
    VRD(7); SBAR(); GAPA(C1=__builtin_amdgcn_mfma_f32_32x32x16_bf16(kf[7],qr[3],C1,0,0,0),   P1[14],P1[15],0.f,0.f,       pw3[2]=PKW(P1,12),pw3[3]=PKW(P1,14), pw3); \
    l_reg+=sacc; \
    if(GK){DMA_K((t)+3,sl_cur);} if(GV){DMA_V((t)+1,sl_next);} \
    CMASK(C0,C1,t); \
    { float a=MX3(C0[0],C0[1],C1[0]),b=MX3(C0[2],C0[3],C1[1]); a=MX3(a,C1[2],C1[3]); \
      _Pragma("unroll") for(int r=4;r<16;r+=4){a=MX3(a,C0[r],C0[r+1]);b=MX3(b,C0[r+2],C0[r+3]);a=MX3(a,C1[r],C1[r+1]);b=MX3(b,C1[r+2],C1[r+3]);} \
      float rm=__builtin_fmaxf(a,b); { auto rr=__builtin_amdgcn_permlane32_swap(__float_as_uint(rm),__float_as_uint(rm),false,false); rm=__builtin_fmaxf(__uint_as_float(rr[0]),__uint_as_float(rr[1])); } \
      resc=false; \
      if(__builtin_expect(__any(rm>(float)THRL),0)){ const float dl=__builtin_fmaxf(rm,0.f); mhat+=dl; \
        _Pragma("unroll") for(int r=0;r<16;++r){C0[r]-=dl;C1[r]-=dl;} \
        _Pragma("unroll") for(int r=0;r<16;++r)negm[r]=-mhat; asm volatile("":"+v"(negm)); \
        const float f=__builtin_amdgcn_exp2f(-dl); l_reg*=f; if(hi==0)wsf[r32]=f; resc=true; } } \
    SBAR(); \
    GAPB(o[0]=__builtin_amdgcn_mfma_f32_32x32x16_bf16(PAF(0),VFR(0),o[0],0,0,0), C0,0); \
    GAPB(o[1]=__builtin_amdgcn_mfma_f32_32x32x16_bf16(PAF(0),VFR(4),o[1],0,0,0), C0,4); \
    KRD(GL,0); GAPB(o[0]=__builtin_amdgcn_mfma_f32_32x32x16_bf16(PAF(1),VFR(1),o[0],0,0,0), C0,8); \
    KRD(GL,1); GAPB(o[1]=__builtin_amdgcn_mfma_f32_32x32x16_bf16(PAF(1),VFR(5),o[1],0,0,0), C0,12); \
    KRD(GL,2); GAPB(o[0]=__builtin_amdgcn_mfma_f32_32x32x16_bf16(PAF(2),VFR(2),o[0],0,0,0), C1,0); \
    KRD(GL,3); GAPB(o[1]=__builtin_amdgcn_mfma_f32_32x32x16_bf16(PAF(2),VFR(6),o[1],0,0,0), C1,4); \
    GAPB(o[0]=__builtin_amdgcn_mfma_f32_32x32x16_bf16(PAF(3),VFR(3),o[0],0,0,0), C1,8); \
    GAPB(o[1]=__builtin_amdgcn_mfma_f32_32x32x16_bf16(PAF(3),VFR(7),o[1],0,0,0), C1,12); \
    }while(0)
  int t=1;
  #undef CMASK
  #define CMASK(P0,P1,t) do{}while(0)
  for(;t+5<NT;t+=2){
    STEP(pB0,pB1,pA0,pA1,t,true,true,true);     WAIT_BAR(2); RESC(); ROT();
    STEP(pA0,pA1,pB0,pB1,t+1,true,true,true);   WAIT_BAR(2); RESC(); ROT();
  }
  #undef CMASK
  #define CMASK(P0,P1,t) do{int jb_=(t)-(NT-4); if(jb_>=0)cmask(P0,P1,jb_,qrel,hi);}while(0)
  #define ENDW(tt) do{ if((tt)+3<NT){WAIT_BAR(2);} else if((tt)+2<NT){WAIT_BAR(1);} else {WAIT_BAR(0);} }while(0)
  for(;t+1<NT;t+=2){
    STEP(pB0,pB1,pA0,pA1,t,(t+3<NT),(t+1<NT),(t+1<NT));       ENDW(t);   RESC(); ROT();
    STEP(pA0,pA1,pB0,pB1,t+1,(t+4<NT),(t+2<NT),(t+2<NT));     ENDW(t+1); RESC(); ROT();
  }
  STEP(pB0,pB1,pA0,pA1,NT-1,false,false,false); RESC();
  { float sacc=pB0[0]+pB0[1]; _Pragma("unroll") for(int r=2;r<16;++r)sacc+=pB0[r]; _Pragma("unroll") for(int r=0;r<16;++r)sacc+=pB1[r]; l_reg+=sacc;
    pw0=(u32x4){PKW(pB0,0),PKW(pB0,2),PKW(pB0,4),PKW(pB0,6)};pw1=(u32x4){PKW(pB0,8),PKW(pB0,10),PKW(pB0,12),PKW(pB0,14)};pw2=(u32x4){PKW(pB1,0),PKW(pB1,2),PKW(pB1,4),PKW(pB1,6)};pw3=(u32x4){PKW(pB1,8),PKW(pB1,10),PKW(pB1,12),PKW(pB1,14)};
    SBAR(); pv(o,vb0+sl_cur,PAF(0),PAF(1),PAF(2),PAF(3)); }
  #undef PKW
  #undef PAF
  #undef VFR
  #undef PIN
  #undef MX3
  #undef GAPA
  #undef GAPB
  #undef EX
  #undef VRD
  #undef KRD
  #undef STEP
  #undef ENDW
  {auto rr=__builtin_amdgcn_permlane32_swap(__float_as_uint(l_reg),__float_as_uint(l_reg),false,false);l_reg=__uint_as_float(rr[0])+__uint_as_float(rr[1]);}
  if(hi==0)wsf[32+r32]=l_reg;asm volatile("s_waitcnt lgkmcnt(0)":::"memory");
  float rli[16];
  #pragma unroll
  for(int r=0;r<16;++r)rli[r]=__builtin_amdgcn_rcpf(wsf[32+crow(r,hi)]);
  bf16*Ow=Os+(long)(q0+wid*QBLK)*PO;
  { bf16*stg=(bf16*)(shm+LDS_OST)+wid*2048;
    #pragma unroll
    for(int r=0;r<16;++r){const int orow=crow(r,hi);
      #pragma unroll
      for(int d0=0;d0<2;++d0)stg[orow*64+d0*32+r32]=__float2bfloat16(o[d0][r]*rli[r]);}
    asm volatile("s_waitcnt lgkmcnt(0)":::"memory");
    #pragma unroll
    for(int i=0;i<4;++i){const int row=i*8+(lane>>3),ch=lane&7; const u32x4 v=*(const u32x4*)(stg+row*64+ch*8); ATTN_STORE16(Ow+(long)row*PO+ch*8,v);} }
  asm volatile("s_waitcnt lgkmcnt(0)\n\ts_barrier":::"memory");
  #undef DMA_K
  #undef DMA_V
  #undef CMASK
  #undef START
  #undef RESC
  #undef ROT
}
constexpr int ATTN_LDS_BYTES=LDS_BYTES;
#undef SBAR
#undef WAIT_BAR
}

__device__ __forceinline__ void phase_diffattn(const Params& p, unsigned char* lds) {
    using attn64::bf16; unsigned char* ws = p.ws;
    const bf16* DQK = (const bf16*)(ws + WS_DQK); const bf16* DV = (const bf16*)(ws + WS_DV); bf16* O12 = (bf16*)p.out + (size_t)NTOK * 1024;
    const int G = gridDim.x, bx = blockIdx.x; const int vcu = (G % 8 == 0) ? (bx % 8) * (G / 8) + bx / 8 : bx;
    for (int vh = vcu; vh < 256; vh += G) {
        const int bh = vh >> 2, run = vh & 3, b = bh >> 2, h = bh & 3; const size_t row0 = (size_t)b * SEQ;
        const bf16* Qs = DQK + row0 * 1024 + (run >> 1) * 256 + h * 64; const bf16* Ks = DQK + row0 * 1024 + 512 + (run >> 1) * 256 + h * 64;
        const bf16* Vs = DV + row0 * 512 + h * 128 + (run & 1) * 64; bf16* Os = O12 + row0 * 1024 + h * 256 + run * 64;
        for (int qb = 15; qb >= 0; --qb) attn64::attn_unit<8, 1024, 1024, 512, 1024>(qb, Qs, Ks, Vs, Os, (char*)lds);
    }
}
__device__ __forceinline__ void phase_diffcombine(const Params& p, unsigned char* lds) {
    unsigned char* ws = p.ws; const bf16_t* O12 = (const bf16_t*)p.out + (size_t)NTOK * 1024; bf16_t* Y = (bf16_t*)(ws + WS_Y);
    const float lam = ((const float*)(ws + WS_SCAL))[512]; const float* sub_gain = (const float*)p.in[11];
    const int lane = threadIdx.x & 63, wave = threadIdx.x >> 6; const int gw = blockIdx.x * 8 + wave, ngw = gridDim.x * 8;
    const int h = lane >> 4, d0 = (lane & 15) * 8;
    float gn[8];
#pragma unroll
    for (int e = 0; e < 8; ++e) gn[e] = sub_gain[d0 + e] * (1.f - LAM_INIT);
    for (int t = gw; t < NTOK; t += ngw) {
        const u32x4 a = *(const u32x4*)(O12 + (size_t)t * 1024 + h * 256 + d0), b = *(const u32x4*)(O12 + (size_t)t * 1024 + h * 256 + 128 + d0);
        float o1[8], o2[8], o[8]; pg8::unpack8(a, o1); pg8::unpack8(b, o2); float sq = 0.f;
#pragma unroll
        for (int e = 0; e < 8; ++e) { o[e] = o1[e] - lam * o2[e]; sq += o[e] * o[e]; }
        sq += __shfl_xor(sq, 1); sq += __shfl_xor(sq, 2); sq += __shfl_xor(sq, 4); sq += __shfl_xor(sq, 8);
        const float rs = rsqrtf(sq * (1.f / 128.f) + RMS_EPS);
        u32x4 w; w.x = pk2(o[0] * rs * gn[0], o[1] * rs * gn[1]); w.y = pk2(o[2] * rs * gn[2], o[3] * rs * gn[3]); w.z = pk2(o[4] * rs * gn[4], o[5] * rs * gn[5]); w.w = pk2(o[6] * rs * gn[6], o[7] * rs * gn[7]);
        *(u32x4*)(Y + (size_t)t * 1536 + 512 + h * 128 + d0) = w;
    }
}

namespace attnd {
using bf16 = __hip_bfloat16;
constexpr int D = 128, NW = 8, QBLK = 32, KVBLK = 64;
constexpr float SCALE = 0.088388347648318440f;
constexpr float THR = 8.f;
constexpr int SDEPTH = 2;
constexpr int LDQ = 512, LDK = 1024, LDO = 1536;
constexpr size_t SHM_V = KVBLK * D * 2, SHM_K = KVBLK * D * 2, SHM_ATTN = 2 * SHM_V + 2 * SHM_K + NW * 64 * 4;
using bf16x8 = __attribute__((ext_vector_type(8))) short;
using s16x4  = __attribute__((ext_vector_type(4))) short;
using f32x16 = __attribute__((ext_vector_type(16))) float;
using f32x8  = __attribute__((ext_vector_type(8))) float;
using u32x4  = __attribute__((ext_vector_type(4))) unsigned;
#define KSWZ_D(row, colB) ((row) * 256 + ((colB) ^ (((row) & 7) << 4)))
#define SBAR_D() __builtin_amdgcn_sched_barrier(0)
__device__ __forceinline__ int crow(int r, int hi) { return (r & 3) + 8 * (r >> 2) + 4 * hi; }
__device__ __forceinline__ unsigned cvtpk(float lo, float hi) { return pg8::cvt_pk_bf16(lo, hi); }
template <typename TIn> struct Stage;
template <> struct Stage<bf16>  { using T = bf16x8;
  __device__ static __forceinline__ T ld8(const bf16* p) { return *reinterpret_cast<const bf16x8*>(p); }
  __device__ static __forceinline__ bf16x8 tobf(T x) { return x; } };
template <> struct Stage<float> { using T = f32x8;
  __device__ static __forceinline__ T ld8(const float* p) { return *reinterpret_cast<const f32x8*>(p); }
  __device__ static __forceinline__ bf16x8 tobf(T x) {
    u32x4 w = {cvtpk(x[0], x[1]), cvtpk(x[2], x[3]), cvtpk(x[4], x[5]), cvtpk(x[6], x[7])}; return *reinterpret_cast<bf16x8*>(&w); } };

__device__ __forceinline__ void partialSM(f32x16& p0, f32x16& p1, float& m_reg, float& mn, float& alpha) {
  constexpr float C = SCALE * 1.4426950408889634f;
  float pmax = p0[0]; for (int r = 1; r < 16; ++r) pmax = fmaxf(pmax, p0[r]); for (int r = 0; r < 16; ++r) pmax = fmaxf(pmax, p1[r]);
  { auto rr = __builtin_amdgcn_permlane32_swap(__float_as_uint(pmax), __float_as_uint(pmax), false, false);
    pmax = fmaxf(__uint_as_float(rr[0]), __uint_as_float(rr[1])); }
  if (__builtin_expect(__all(pmax - m_reg <= THR / SCALE), 1)) { mn = m_reg; alpha = 1.f; }
  else { mn = fmaxf(m_reg, pmax); alpha = __builtin_amdgcn_exp2f((m_reg - mn) * C); m_reg = mn; }
  float mnC = -mn * C;
  for (int r = 0; r < 16; ++r) p0[r] = fmaf(p0[r], C, mnC); for (int r = 0; r < 16; ++r) p1[r] = fmaf(p1[r], C, mnC);
  for (int r = 0; r < 16; ++r) p0[r] = __builtin_amdgcn_exp2f(p0[r]);
}
__device__ __forceinline__ void finishSM(f32x16& p0, f32x16& p1, float alpha, float& l_reg, bf16x8& pa0, bf16x8& pa1, bf16x8& pa2, bf16x8& pa3) {
  for (int r = 0; r < 16; ++r) p1[r] = __builtin_amdgcn_exp2f(p1[r]);
  float ps = 0; for (int r = 0; r < 16; ++r) ps += p0[r]; for (int r = 0; r < 16; ++r) ps += p1[r];
  { auto rr = __builtin_amdgcn_permlane32_swap(__float_as_uint(ps), __float_as_uint(ps), false, false);
    ps = __uint_as_float(rr[0]) + __uint_as_float(rr[1]); }
  l_reg = l_reg * alpha + ps;
#define PK4(P, BASE, OUT) do { unsigned a0 = cvtpk(P[BASE + 0], P[BASE + 1]), a1 = cvtpk(P[BASE + 2], P[BASE + 3]);   \
    unsigned b0 = cvtpk(P[BASE + 4], P[BASE + 5]), b1 = cvtpk(P[BASE + 6], P[BASE + 7]);                              \
    auto r0 = __builtin_amdgcn_permlane32_swap(a0, b0, false, false); auto r1 = __builtin_amdgcn_permlane32_swap(a1, b1, false, false); \
    u32x4 w = {r0[0], r1[0], r0[1], r1[1]}; OUT = *reinterpret_cast<bf16x8*>(&w); } while (0)
  PK4(p0, 0, pa0); PK4(p0, 8, pa1); PK4(p1, 0, pa2); PK4(p1, 8, pa3);
#undef PK4
}
__device__ __forceinline__ void qkt(f32x16& p0, f32x16& p1, const bf16* Ks, const bf16x8* qr, int r32, int hi) {
  p0 = f32x16{}; p1 = f32x16{};
  for (int d0 = 0; d0 < 8; ++d0) { int cb = (d0 * 16 + hi * 8) * 2;
    bf16x8 b0 = *reinterpret_cast<const bf16x8*>((const char*)Ks + KSWZ_D(r32, cb));
    bf16x8 b1 = *reinterpret_cast<const bf16x8*>((const char*)Ks + KSWZ_D(32 + r32, cb));
    p0 = __builtin_amdgcn_mfma_f32_32x32x16_bf16(b0, qr[d0], p0, 0, 0, 0);
    p1 = __builtin_amdgcn_mfma_f32_32x32x16_bf16(b1, qr[d0], p1, 0, 0, 0); }
}
__device__ __forceinline__ int v_st(int k, int c) { const int kk = (k & ~0xC) | ((k & 4) << 1) | ((k & 8) >> 1); return ((kk >> 3) * 4 + (c >> 5)) * 512 + ((kk & 7) * 32 + (c & 31)) * 2; }
__device__ __forceinline__ int v_rd_base(int lane) { return ((lane & 3) << 3) | (((lane >> 2) & 3) << 6) | (((lane >> 4) & 1) << 5) | (((lane >> 5) & 1) << 8); }
constexpr int v_rd_off(int d0, int ks, int half) { return d0 * 512 + ks * 4096 + half * 2048; }
template <int OFF> __device__ __forceinline__ s16x4 tr_read(int vb) {
  s16x4 r; asm volatile("ds_read_b64_tr_b16 %0, %1 offset:%2" : "=&v"(r) : "v"(vb), "i"(OFF) : "memory"); return r;
}
template <int D0> __device__ __forceinline__ void pv_one(f32x16& od, int vb, bf16x8 pa0, bf16x8 pa1, bf16x8 pa2, bf16x8 pa3) {
  const s16x4 l0 = tr_read<v_rd_off(D0, 0, 0)>(vb), h0 = tr_read<v_rd_off(D0, 0, 1)>(vb), l1 = tr_read<v_rd_off(D0, 1, 0)>(vb), h1 = tr_read<v_rd_off(D0, 1, 1)>(vb);
  const s16x4 l2 = tr_read<v_rd_off(D0, 2, 0)>(vb), h2 = tr_read<v_rd_off(D0, 2, 1)>(vb), l3 = tr_read<v_rd_off(D0, 3, 0)>(vb), h3 = tr_read<v_rd_off(D0, 3, 1)>(vb);
  asm volatile("s_waitcnt lgkmcnt(0)" ::: "memory"); SBAR_D();
#define PK(L, H) (bf16x8){L[0], L[1], L[2], L[3], H[0], H[1], H[2], H[3]}
  od = __builtin_amdgcn_mfma_f32_32x32x16_bf16(pa0, PK(l0, h0), od, 0, 0, 0);
  od = __builtin_amdgcn_mfma_f32_32x32x16_bf16(pa1, PK(l1, h1), od, 0, 0, 0);
  od = __builtin_amdgcn_mfma_f32_32x32x16_bf16(pa2, PK(l2, h2), od, 0, 0, 0);
  od = __builtin_amdgcn_mfma_f32_32x32x16_bf16(pa3, PK(l3, h3), od, 0, 0, 0);
#undef PK
}
__device__ __forceinline__ void pv_d0(f32x16* o, int vb, bf16x8 pa0, bf16x8 pa1, bf16x8 pa2, bf16x8 pa3) {
  pv_one<0>(o[0], vb, pa0, pa1, pa2, pa3); pv_one<1>(o[1], vb, pa0, pa1, pa2, pa3); pv_one<2>(o[2], vb, pa0, pa1, pa2, pa3); pv_one<3>(o[3], vb, pa0, pa1, pa2, pa3);
}

template <typename TQ>
__device__ __forceinline__ void attn_dense_body(const TQ* __restrict__ Qb, const bf16* __restrict__ Kh, const bf16* __restrict__ Vh,
                                                bf16* __restrict__ Ob, int seq, char* lds) {
  using St = Stage<bf16>; using SQ = Stage<TQ>;
  const int tid = threadIdx.x, wid = tid >> 6, lane = tid & 63, r32 = lane & 31, hi = lane >> 5;
  bf16* V_lds = (bf16*)lds; bf16* K_lds = (bf16*)(lds + 2 * SHM_V);
  float* ws = (float*)(lds + 2 * SHM_V + 2 * SHM_K) + wid * 64; float* li_l = ws; float* al_l = ws + 32;
  float m_reg = -1e30f, l_reg = 0; f32x16 o[4] = {}; bf16x8 qr[8];
  const TQ* Qw = Qb + (long)(wid * QBLK + r32) * LDQ + hi * 8;
#pragma unroll
  for (int d0 = 0; d0 < 8; ++d0) qr[d0] = SQ::tobf(SQ::ld8(Qw + d0 * 16));
  const int sr = tid >> 4, sc = (tid & 15) * 8, vst0 = v_st(sr, sc), vst1 = v_st(32 + sr, sc);
  const int vb0 = (int)(uintptr_t)V_lds + v_rd_base(lane);
  struct { typename St::T vs0, vs1, ks0, ks1; } sr_[SDEPTH];
#define SLOAD(i, k0) do { sr_[i].vs0 = St::ld8(&Vh[(long)((k0) + sr) * LDK + sc]); sr_[i].vs1 = St::ld8(&Vh[(long)((k0) + 32 + sr) * LDK + sc]); \
    sr_[i].ks0 = St::ld8(&Kh[(long)((k0) + sr) * LDK + sc]); sr_[i].ks1 = St::ld8(&Kh[(long)((k0) + 32 + sr) * LDK + sc]); } while (0)
#define SWRITE(b, i) do { *(bf16x8*)((char*)V_lds + (b) * SHM_V + vst0) = St::tobf(sr_[i].vs0);          \
    *(bf16x8*)((char*)V_lds + (b) * SHM_V + vst1) = St::tobf(sr_[i].vs1); int kc = sc * 2;               \
    *(bf16x8*)((char*)K_lds + (b) * SHM_K + KSWZ_D(sr, kc)) = St::tobf(sr_[i].ks0);                       \
    *(bf16x8*)((char*)K_lds + (b) * SHM_K + KSWZ_D(32 + sr, kc)) = St::tobf(sr_[i].ks1); } while (0)
#define SWAIT() do { if constexpr (SDEPTH == 2) asm volatile("s_waitcnt vmcnt(4)" ::: "memory"); else asm volatile("s_waitcnt vmcnt(0)" ::: "memory"); } while (0)
#define RESC(a) do { if (__any((a) < 1.f)) { if (hi == 0) al_l[r32] = (a); asm volatile("s_waitcnt lgkmcnt(0)" ::: "memory"); \
    for (int d = 0; d < 4; ++d) for (int r = 0; r < 16; ++r) o[d][r] *= al_l[crow(r, hi)]; } } while (0)
  f32x16 pA0, pA1, pB0, pB1; float mnA, mnB, alA, alB; bf16x8 pa0, pa1, pa2, pa3; const int NT = seq / KVBLK;
  constexpr int SE = 0, SO = SDEPTH - 1;
  SLOAD(SE, 0); asm volatile("s_waitcnt vmcnt(0)" ::: "memory"); SWRITE(0, SE); __syncthreads();
  qkt(pA0, pA1, K_lds, qr, r32, hi); partialSM(pA0, pA1, m_reg, mnA, alA);
  SLOAD(SO, KVBLK); if constexpr (SDEPTH == 2) { if (2 < NT) SLOAD(SE, 2 * KVBLK); }
  SWAIT(); SWRITE(1, SO); __syncthreads();
  for (int j = 1; j + 1 < NT; j += 2) {
    SBAR_D(); qkt(pB0, pB1, (bf16*)((char*)K_lds + SHM_K), qr, r32, hi);
    finishSM(pA0, pA1, alA, l_reg, pa0, pa1, pa2, pa3); SBAR_D();
    SLOAD(SO, (j + SDEPTH) * KVBLK); SBAR_D();
    pv_d0(o, vb0, pa0, pa1, pa2, pa3); partialSM(pB0, pB1, m_reg, mnB, alB);
    __syncthreads(); SWAIT(); SWRITE(0, SE);
    RESC(alB); __syncthreads();
    SBAR_D(); qkt(pA0, pA1, K_lds, qr, r32, hi);
    finishSM(pB0, pB1, alB, l_reg, pa0, pa1, pa2, pa3); SBAR_D();
    if (SDEPTH == 1 || j + 3 < NT) SLOAD(SE, (j + 1 + SDEPTH) * KVBLK); SBAR_D();
    pv_d0(o, vb0 + (int)SHM_V, pa0, pa1, pa2, pa3); partialSM(pA0, pA1, m_reg, mnA, alA);
    __syncthreads(); SWAIT(); SWRITE(1, SO);
    RESC(alA); __syncthreads();
  }
  SBAR_D(); qkt(pB0, pB1, (bf16*)((char*)K_lds + SHM_K), qr, r32, hi);
  finishSM(pA0, pA1, alA, l_reg, pa0, pa1, pa2, pa3); SBAR_D();
  pv_d0(o, vb0, pa0, pa1, pa2, pa3); partialSM(pB0, pB1, m_reg, mnB, alB);
  __syncthreads(); RESC(alB);
  finishSM(pB0, pB1, alB, l_reg, pa0, pa1, pa2, pa3); SBAR_D();
  pv_d0(o, vb0 + (int)SHM_V, pa0, pa1, pa2, pa3);
  if (hi == 0) li_l[r32] = l_reg; asm volatile("s_waitcnt lgkmcnt(0)" ::: "memory");
  float rli[16];
#pragma unroll
  for (int r = 0; r < 16; ++r) rli[r] = __builtin_amdgcn_rcpf(li_l[crow(r, hi)]);
  bf16* Ow = Ob + (long)(wid * QBLK) * LDO;
#pragma unroll
  for (int r = 0; r < 16; ++r) { int orow = crow(r, hi);
    for (int d0 = 0; d0 < 4; ++d0) Ow[(long)orow * LDO + d0 * 32 + r32] = __float2bfloat16(o[d0][r] * rli[r]); }
#undef SLOAD
#undef SWRITE
#undef SWAIT
#undef RESC
}

}
__device__ __forceinline__ void phase_memattn(const Params& p, unsigned char* lds) {
    using attnd::bf16; unsigned char* ws = p.ws; const bf16* MQ = (const bf16*)(ws + WS_MQ); const bf16* MKV = (const bf16*)(ws + WS_MKV); bf16* Y = (bf16*)(ws + WS_Y);
    const int G = gridDim.x, bx = blockIdx.x; const int vcu = (G % 8 == 0) ? (bx % 8) * (G / 8) + bx / 8 : bx;
    for (int u = vcu; u < NBATCH * 4 * 16; u += G) {
        const int qb = u & 15, bh = u >> 4, b = bh >> 2, h = bh & 3; const size_t m0 = (size_t)b * SEQ + qb * 256;
        attnd::attn_dense_body<bf16>(MQ + m0 * 512 + h * 128, MKV + (size_t)b * NMEM * 1024 + h * 128, MKV + (size_t)b * NMEM * 1024 + 512 + h * 128, Y + m0 * 1536 + 1024 + h * 128, NMEM, (char*)lds);
        __syncthreads();
    }
}

namespace hg {
constexpr int ROWQ = 272, ROWT = 144;
constexpr int L_QR = 0, L_FR = 17408, L_VR = 34816, L_VT = 52224, L_KT = 70656, L_TOT = 89088, L_SSQ = 91136;
__device__ __forceinline__ void load_tile(unsigned char* dst, const bf16_t* src, int tid) {
    const int r = tid >> 3, c = tid & 7;
    const u32x4 a = *(const u32x4*)(src + (size_t)r * 2048 + c * 8), b = *(const u32x4*)(src + (size_t)r * 2048 + 64 + c * 8);
    *(u32x4*)(dst + r * ROWQ + c * 16) = a; *(u32x4*)(dst + r * ROWQ + 128 + c * 16) = b;
}
__device__ __forceinline__ u32x4 pack8(const float* v) { u32x4 w; w.x = pk2(v[0], v[1]); w.y = pk2(v[2], v[3]); w.z = pk2(v[4], v[5]); w.w = pk2(v[6], v[7]); return w; }
__device__ __forceinline__ void gate_scan(unsigned char* lds, int k, int seg, float lbv, float (&kk)[16], float (&cs)[16], float& offset, float& total) {
    float run = 0.f;
#pragma unroll
    for (int i = 0; i < 16; ++i) { const float fp = bf2f(*(const bf16_t*)(lds + L_FR + (16 * seg + i) * ROWQ + k * 2)); const float sg = sigmoidf_(fp);
        const float f = lbv + (1.f - lbv) * sg; kk[i] = (1.f - lbv) * (1.f - sg); run += __logf(f); cs[i] = run; }
    float* tot = (float*)(lds + L_TOT); tot[seg * 128 + k] = run;
    __syncthreads();
    const float t0 = tot[k], t1 = tot[128 + k], t2 = tot[256 + k], t3 = tot[384 + k];
    offset = (seg > 0 ? t0 : 0.f) + (seg > 1 ? t1 : 0.f) + (seg > 2 ? t2 : 0.f); total = (t0 + t1) + (t2 + t3);
}
__device__ __forceinline__ void write_vt(unsigned char* lds, int k, int seg) {
    float v[16];
#pragma unroll
    for (int i = 0; i < 16; ++i) v[i] = bf2f(*(const bf16_t*)(lds + L_VR + (16 * seg + i) * ROWQ + k * 2));
    *(u32x4*)(lds + L_VT + k * ROWT + seg * 32) = pack8(v); *(u32x4*)(lds + L_VT + k * ROWT + seg * 32 + 16) = pack8(v + 8);
}
}
__device__ __forceinline__ void phase_hgrn_A(const Params& p, unsigned char* lds) {
    using namespace hg; unsigned char* ws = p.ws; const bf16_t* HG = (const bf16_t*)(ws + WS_HG); const float* lower0 = (const float*)(ws + WS_SCAL);
    bf16_t* US = (bf16_t*)p.out; float* DEC = (float*)(ws + WS_DEC);
    const int tid = threadIdx.x, lane = tid & 63, w = tid >> 6, fr = lane & 15, fq = lane >> 4, k = tid & 127, seg = tid >> 7;
    for (int item = blockIdx.x; item < 4096; item += gridDim.x) {
        const int bh = item >> 6, c = item & 63, b = bh >> 2, h = bh & 3; const bf16_t* row0 = HG + ((size_t)b * SEQ + c * 64) * 2048 + h * 128;
        load_tile(lds + L_FR, row0 + 512, tid); load_tile(lds + L_VR, row0 + 1024, tid);
        __syncthreads();
        float kk[16], cs[16], offset, total; const float lbv = lower0[h * 128 + k];
        write_vt(lds, k, seg);
        gate_scan(lds, k, seg, lbv, kk, cs, offset, total);
        { float ke[16];
#pragma unroll
          for (int i = 0; i < 16; ++i) ke[i] = kk[i] * __expf(total - (offset + cs[i]));
          *(u32x4*)(lds + L_KT + k * ROWT + seg * 32) = pack8(ke); *(u32x4*)(lds + L_KT + k * ROWT + seg * 32 + 16) = pack8(ke + 8);
          if (seg == 0) DEC[(size_t)item * 128 + k] = __expf(total); }
        __syncthreads();
        const bf16x8 a0 = *(const bf16x8*)(lds + L_KT + (16 * w + fr) * ROWT + fq * 16), a1 = *(const bf16x8*)(lds + L_KT + (16 * w + fr) * ROWT + 64 + fq * 16);
        unsigned char* uT = lds + L_FR;
#pragma unroll
        for (int j = 0; j < 8; ++j) {
            const bf16x8 b0 = *(const bf16x8*)(lds + L_VT + (16 * j + fr) * ROWT + fq * 16), b1 = *(const bf16x8*)(lds + L_VT + (16 * j + fr) * ROWT + 64 + fq * 16);
            f32x4 acc = {0.f, 0.f, 0.f, 0.f};
            acc = __builtin_amdgcn_mfma_f32_16x16x32_bf16(a0, b0, acc, 0, 0, 0); acc = __builtin_amdgcn_mfma_f32_16x16x32_bf16(a1, b1, acc, 0, 0, 0);
            u32x2 o; o.x = pk2(acc[0], acc[1]); o.y = pk2(acc[2], acc[3]);
            *(u32x2*)(uT + (16 * j + fr) * ROWQ + (16 * w + 4 * fq) * 2) = o; }
        __syncthreads();
        bf16_t* dst = US + (size_t)item * 16384;
#pragma unroll
        for (int i = 0; i < 4; ++i) { const int ch = tid + 512 * i, v = ch >> 4, kc = ch & 15; *(u32x4*)(dst + v * 128 + kc * 8) = *(const u32x4*)(uT + v * ROWQ + kc * 16); }
        __syncthreads();
    }
}
__device__ __forceinline__ void phase_hgrn_B(const Params& p, unsigned char* lds) {
    unsigned char* ws = p.ws; bf16_t* US = (bf16_t*)p.out; const float* DEC = (const float*)(ws + WS_DEC);
    const size_t gt = (size_t)blockIdx.x * 512 + threadIdx.x, ngt = (size_t)gridDim.x * 512;
    for (size_t e = gt; e < (size_t)64 * 128 * 16; e += ngt) {
        const int kc = (int)(e & 15), v = (int)((e >> 4) & 127), bh = (int)(e >> 11);
        bf16_t* pu = US + (size_t)bh * 64 * 16384 + v * 128 + kc * 8; const float* pd = DEC + (size_t)bh * 64 * 128 + kc * 8;
        float S[8];
#pragma unroll
        for (int i = 0; i < 8; ++i) S[i] = 0.f;
#pragma unroll 4
        for (int c = 0; c < 64; ++c) {
            const u32x4 uw = *(const u32x4*)(pu + (size_t)c * 16384); const f32x4 d0 = *(const f32x4*)(pd + c * 128), d1 = *(const f32x4*)(pd + c * 128 + 4);
            float u[8]; pg8::unpack8(uw, u);
            *(u32x4*)(pu + (size_t)c * 16384) = hg::pack8(S);
            S[0] = d0[0] * S[0] + u[0]; S[1] = d0[1] * S[1] + u[1]; S[2] = d0[2] * S[2] + u[2]; S[3] = d0[3] * S[3] + u[3];
            S[4] = d1[0] * S[4] + u[4]; S[5] = d1[1] * S[5] + u[5]; S[6] = d1[2] * S[6] + u[6]; S[7] = d1[3] * S[7] + u[7];
        }
    }
}
__device__ __forceinline__ void phase_hgrn_C(const Params& p, unsigned char* lds) {
    using namespace hg; unsigned char* ws = p.ws; const bf16_t* HG = (const bf16_t*)(ws + WS_HG); const float* lower0 = (const float*)(ws + WS_SCAL);
    const bf16_t* US = (const bf16_t*)p.out; bf16_t* Y = (bf16_t*)(ws + WS_Y); const float* gain = (const float*)p.in[6];
    const int tid = threadIdx.x, lane = tid & 63, w = tid >> 6, fr = lane & 15, fq = lane >> 4, k = tid & 127, seg = tid >> 7;
    for (int item = blockIdx.x; item < 4096; item += gridDim.x) {
        const int bh = item >> 6, c = item & 63, b = bh >> 2, h = bh & 3; const size_t m0 = (size_t)b * SEQ + c * 64; const bf16_t* row0 = HG + m0 * 2048 + h * 128;
        bf16x8 bS[4];
        { const bf16_t* sp = US + (size_t)item * 16384 + (16 * w + fr) * 128 + fq * 8;
#pragma unroll
          for (int ks = 0; ks < 4; ++ks) bS[ks] = *(const bf16x8*)(sp + ks * 32); }
        load_tile(lds + L_QR, row0, tid); load_tile(lds + L_FR, row0 + 512, tid); load_tile(lds + L_VR, row0 + 1024, tid);
        __syncthreads();
        float kk[16], cs[16], offset, total; const float lbv = lower0[h * 128 + k];
        write_vt(lds, k, seg);
        gate_scan(lds, k, seg, lbv, kk, cs, offset, total);
#pragma unroll
        for (int i = 0; i < 16; ++i) { const float cum = offset + cs[i]; bf16_t* pq = (bf16_t*)(lds + L_QR + (16 * seg + i) * ROWQ + k * 2); bf16_t* pf = (bf16_t*)(lds + L_FR + (16 * seg + i) * ROWQ + k * 2);
            *pq = f2bf(bf2f(*pq) * __expf(cum)); *pf = f2bf(kk[i] * __expf(-cum)); }
        __syncthreads();
        { const int si = w >> 1; bf16x8 a[4];
#pragma unroll
          for (int ks = 0; ks < 4; ++ks) a[ks] = *(const bf16x8*)(lds + L_FR + (16 * si + fr) * ROWQ + ks * 64 + fq * 16);
#pragma unroll
          for (int jj = 0; jj < 2; ++jj) { const int tj = 2 * (w & 1) + jj; f32x4 acc = {0.f, 0.f, 0.f, 0.f};
#pragma unroll
              for (int ks = 0; ks < 4; ++ks) { const bf16x8 bq = *(const bf16x8*)(lds + L_QR + (16 * tj + fr) * ROWQ + ks * 64 + fq * 16); acc = __builtin_amdgcn_mfma_f32_16x16x32_bf16(a[ks], bq, acc, 0, 0, 0); }
              const int t = 16 * tj + fr, s0 = 16 * si + 4 * fq;
              u32x2 o; o.x = pk2(s0 <= t ? acc[0] : 0.f, s0 + 1 <= t ? acc[1] : 0.f); o.y = pk2(s0 + 2 <= t ? acc[2] : 0.f, s0 + 3 <= t ? acc[3] : 0.f);
              *(u32x2*)(lds + L_KT + t * ROWT + s0 * 2) = o; } }
        __syncthreads();
        f32x4 acc[4];
        { const bf16x8 bV0 = *(const bf16x8*)(lds + L_VT + (16 * w + fr) * ROWT + fq * 16), bV1 = *(const bf16x8*)(lds + L_VT + (16 * w + fr) * ROWT + 64 + fq * 16);
#pragma unroll
          for (int tj = 0; tj < 4; ++tj) { f32x4 ac = {0.f, 0.f, 0.f, 0.f};
#pragma unroll
              for (int ks = 0; ks < 4; ++ks) { const bf16x8 aq = *(const bf16x8*)(lds + L_QR + (16 * tj + fr) * ROWQ + ks * 64 + fq * 16); ac = __builtin_amdgcn_mfma_f32_16x16x32_bf16(aq, bS[ks], ac, 0, 0, 0); }
              const bf16x8 ap0 = *(const bf16x8*)(lds + L_KT + (16 * tj + fr) * ROWT + fq * 16), ap1 = *(const bf16x8*)(lds + L_KT + (16 * tj + fr) * ROWT + 64 + fq * 16);
              ac = __builtin_amdgcn_mfma_f32_16x16x32_bf16(ap0, bV0, ac, 0, 0, 0); ac = __builtin_amdgcn_mfma_f32_16x16x32_bf16(ap1, bV1, ac, 0, 0, 0);
              acc[tj] = ac; } }
        float* ssq = (float*)(lds + L_SSQ);
#pragma unroll
        for (int tj = 0; tj < 4; ++tj)
#pragma unroll
            for (int r = 0; r < 4; ++r) { float sq = acc[tj][r] * acc[tj][r]; sq += __shfl_xor(sq, 1); sq += __shfl_xor(sq, 2); sq += __shfl_xor(sq, 4); sq += __shfl_xor(sq, 8);
                if (fr == 0) ssq[w * 64 + 16 * tj + 4 * fq + r] = sq; }
        __syncthreads();
        const float gn = gain[h * 128 + 16 * w + fr];
#pragma unroll
        for (int tj = 0; tj < 4; ++tj)
#pragma unroll
            for (int r = 0; r < 4; ++r) { const int t = 16 * tj + 4 * fq + r; float tot = 0.f;
#pragma unroll
                for (int ww = 0; ww < 8; ++ww) tot += ssq[ww * 64 + t];
                const float gate = bf2f(row0[(size_t)t * 2048 + 1536 + 16 * w + fr]);
                Y[(m0 + t) * 1536 + h * 128 + 16 * w + fr] = f2bf(acc[tj][r] * rsqrtf(tot * (1.f / 128.f) + RMS_EPS) * gn * gate); }
        __syncthreads();
    }
}

#define XB_TMO      128
#define XB_XCNT(j)  (256  + 64 * (j))
#define XB_XSUB(j)  (1280 + 64 * (j))
#define XB_XGEN(j)  (2304 + 64 * (j))
#define XB_TOP      3328
#define XB_TOPGEN   3392
#define XCD_BAR_WORDS 3456
#define XB_SPIN_CAP (1u << 18)

__device__ __forceinline__ unsigned xb_ld(unsigned* p)              { return __hip_atomic_load(p, __ATOMIC_RELAXED, __HIP_MEMORY_SCOPE_AGENT); }
__device__ __forceinline__ unsigned xb_add(unsigned* p, unsigned v) { return __hip_atomic_fetch_add(p, v, __ATOMIC_RELAXED, __HIP_MEMORY_SCOPE_AGENT); }
__device__ __forceinline__ unsigned xb_xcc_id() { return (unsigned)__builtin_amdgcn_s_getreg((3 << 11) | 20) & 0xFu; }
#define XB_SPIN(cond, bar) do { unsigned _sp = 0; while (cond) { __builtin_amdgcn_s_sleep(1); \
    if ((++_sp & 255u) == 0u) { if (xb_ld(&(bar)[XB_TMO])) break; if (_sp > XB_SPIN_CAP) { atomicAdd(&(bar)[XB_TMO], 1u); break; } } } } while (0)

struct XcdBarrier {
    unsigned* bar; unsigned x;
    volatile __attribute__((address_space(3))) unsigned* st;
};

__device__ __forceinline__ XcdBarrier xcd_barrier_post(unsigned* bar, volatile __attribute__((address_space(3))) unsigned* st) {
    XcdBarrier b; b.bar = bar; b.x = xb_xcc_id(); b.st = st;
    if (threadIdx.x == 0) (void)xb_add(&bar[XB_XCNT(b.x)], 1u);
    return b;
}
__device__ __forceinline__ void xcd_barrier_complete(unsigned* bar, unsigned x, unsigned& nloc, unsigned& nx) {
    const unsigned G = gridDim.x * gridDim.y * gridDim.z;
    unsigned sum, cnt, mine, sp = 0u;
    for (;;) {
        sum = 0u; cnt = 0u; mine = 0u;
#pragma unroll
        for (unsigned j = 0; j < 16; ++j) { const unsigned c = xb_ld(&bar[XB_XCNT(j)]); sum += c; cnt += (c > 0u) ? 1u : 0u; mine = (j == x) ? c : mine; }
        if (sum == G) break;
        __builtin_amdgcn_s_sleep(1);
        if ((++sp & 255u) == 0u) { if (xb_ld(&bar[XB_TMO])) break; if (sp > XB_SPIN_CAP) { atomicAdd(&bar[XB_TMO], 1u); break; } }
    }
    nloc = mine > 0u ? mine : 1u; nx = cnt > 0u ? cnt : 1u;
}

__device__ __forceinline__ void xcd_barrier(const XcdBarrier& b) {
    asm volatile("s_waitcnt vmcnt(0)" ::: "memory");
    __syncthreads();
    if (threadIdx.x == 0) {
        unsigned* bar = b.bar;
        __builtin_amdgcn_s_waitcnt(0);
        unsigned nloc = b.st[0], nx = b.st[1];
        if (nloc == 0u) { xcd_barrier_complete(bar, b.x, nloc, nx); b.st[0] = nloc; b.st[1] = nx; }
        const unsigned old = xb_add(&bar[XB_XSUB(b.x)], 1u);
        const unsigned gen = old / nloc;
        if (old + 1u == (gen + 1u) * nloc) {
            __builtin_amdgcn_fence(__ATOMIC_RELEASE, "agent");
            asm volatile("s_waitcnt vmcnt(0)" ::: "memory");
            const unsigned og = xb_add(&bar[XB_TOP], 1u);
            const unsigned tg = og / nx;
            if (og + 1u == (tg + 1u) * nx) xb_add(&bar[XB_TOPGEN], 1u);
            else XB_SPIN(xb_ld(&bar[XB_TOPGEN]) == tg, bar);
            __builtin_amdgcn_fence(__ATOMIC_ACQUIRE, "agent");
            xb_add(&bar[XB_XGEN(b.x)], 1u);
            asm volatile("s_waitcnt vmcnt(0)" ::: "memory");
        } else {
            XB_SPIN(xb_ld(&bar[XB_XGEN(b.x)]) == gen, bar);
            __builtin_amdgcn_fence(__ATOMIC_ACQUIRE, "agent");
            asm volatile("s_waitcnt vmcnt(0)" ::: "memory");
        }
    }
    __syncthreads();
}


template <bool COOP> __device__ __forceinline__ void cg_or_nothing() { if (COOP) cg::this_grid().sync(); }
template <bool COOP>
__global__ void __launch_bounds__(512, 2) k_fwd(Params p) {
    extern __shared__ __attribute__((aligned(16))) unsigned char lds[];
    const int lo = p.ph_lo, hi = p.ph_hi;
    volatile __attribute__((address_space(3))) unsigned* bst = (volatile __attribute__((address_space(3))) unsigned*)LASP(lds + LDS_BAR);
    if (threadIdx.x < 2) bst[threadIdx.x] = 0u;
    __syncthreads();
    XcdBarrier bar; bar.bar = (unsigned*)(p.ws + WS_BAR); bar.x = 0; bar.st = bst;
    if (COOP) bar = xcd_barrier_post((unsigned*)(p.ws + WS_BAR), bst);
#define RUN_PHASE(k, call) do { if (((PHASE_MASK >> (k)) & 1) && lo <= (k) && (k) < hi) { call; if (COOP && (k) + 1 < hi) { if ((k) == 0) cg::this_grid().sync(); else xcd_barrier(bar); } } } while (0)
    RUN_PHASE(0, phase_prologue(p, lds));
    RUN_PHASE(1, ((USE_PG8 & 1) ? phase_proj_pg8(p, lds) : (phase_proj(p, lds), cg_or_nothing<COOP>(), phase_rope(p, lds))));
    RUN_PHASE(2, (((USE_OPT & 2) ? phase_hgrn_A(p, lds) : phase_hgrn_naive(p, lds)), __syncthreads(), (USE_OPT & 1) ? phase_diffattn(p, lds) : phase_attn_naive<true>(p, lds), __syncthreads(), (USE_OPT & 4) ? phase_memattn(p, lds) : phase_attn_naive<false>(p, lds)));
    RUN_PHASE(3, (((USE_OPT & 2) ? phase_hgrn_B(p, lds) : (void)0), __syncthreads(), (USE_OPT & 1) ? phase_diffcombine(p, lds) : (void)0));
    RUN_PHASE(4, ((USE_OPT & 2) ? phase_hgrn_C(p, lds) : (void)0));
    RUN_PHASE(5, ((USE_PG8 & 2) ? phase_merge_pg8(p, lds) : phase_merge(p, lds)));
    RUN_PHASE(6, ((USE_PG8 & 4) ? phase_wout_pg8(p, lds) : phase_wout(p, lds)));
    RUN_PHASE(7, ((USE_OPT & 8) ? phase_ln1_route2(p, lds) : phase_ln1_route(p, lds)));
    RUN_PHASE(8, phase_dispatch(p, lds));
    RUN_PHASE(9, ((USE_PG8 & 8) ? phase_exp_gu_pg8(p, lds) : phase_exp_gu(p, lds)));
    RUN_PHASE(10, ((USE_PG8 & 16) ? phase_exp_dn_pg8(p, lds) : phase_exp_dn(p, lds)));
    RUN_PHASE(11, phase_final(p, lds));
#undef RUN_PHASE
}

extern "C" void kernel_launch(void* const* d_in, const int* in_sizes, int n_in, void* d_out, int out_size, void* d_ws, size_t ws_size, hipStream_t stream) {
    static int grid = 0;
    if (grid == 0) {
        if (n_in != 26 || in_sizes[0] != NTOK * DM || out_size != NTOK * DM || ws_size < WS_END) {
            fprintf(stderr, "kernel_launch: unexpected shapes: n_in %d in0 %d out %d ws %zu (need >= %zu)\n", n_in, n_in > 0 ? in_sizes[0] : -1, out_size, ws_size, (size_t)WS_END); grid = -1; return; }
        int dev = 0, cus = 0, per_cu = 0;
        hipGetDevice(&dev); hipDeviceGetAttribute(&cus, hipDeviceAttributeMultiprocessorCount, dev);
        if (MK_ONE_LAUNCH) {
            hipFuncSetAttribute((const void*)k_fwd<true>, hipFuncAttributeMaxDynamicSharedMemorySize, LDS_BYTES);
            hipOccupancyMaxActiveBlocksPerMultiprocessor(&per_cu, (const void*)k_fwd<true>, 512, LDS_BYTES);
            if (per_cu < 1) { fprintf(stderr, "kernel_launch: occupancy query says %d blocks/CU\n", per_cu); per_cu = 1; }
            grid = cus * 1;
        } else {
            hipFuncSetAttribute((const void*)k_fwd<false>, hipFuncAttributeMaxDynamicSharedMemorySize, LDS_BYTES);
            grid = cus;
        }
        (void)hipGetLastError();
    }
    if (grid < 0) return;
    Params p{};
    for (int i = 0; i < 26; ++i) p.in[i] = d_in[i];
    p.out = (float*)d_out; p.ws = (unsigned char*)d_ws;
    if (MK_ONE_LAUNCH) {
        (void)hipMemsetAsync((char*)d_ws + WS_BAR, 0, 16384, stream);
        p.ph_lo = 0; p.ph_hi = NPHASE;
        void* args[] = {&p};
        hipError_t e = hipLaunchCooperativeKernel((const void*)k_fwd<true>, dim3(grid), dim3(512), args, LDS_BYTES, stream);
        if (e != hipSuccess) fprintf(stderr, "cooperative launch failed: %s (grid %d)\n", hipGetErrorString(e), grid);
    } else {
        for (int ph = 0; ph < NPHASE; ++ph) { p.ph_lo = ph; p.ph_hi = ph + 1; hipLaunchKernelGGL(k_fwd<false>, dim3(grid), dim3(512), LDS_BYTES, stream, p); }
    }
}
```

```cpp
#include <hip/hip_runtime.h>
#include <hip/hip_cooperative_groups.h>
#include <cstdio>
#include <cstdint>
namespace cg = cooperative_groups;

#ifndef PHASE_MASK
#define PHASE_MASK 0xffff
#endif
#ifndef USE_PG8
#define USE_PG8 0x1f
#endif
#ifndef USE_OPT
#define USE_OPT 0x1f
#endif
#ifndef MK_ONE_LAUNCH
#define MK_ONE_LAUNCH 1
#endif

typedef unsigned short bf16_t;
typedef short bf16x8 __attribute__((ext_vector_type(8)));
typedef float f32x4 __attribute__((ext_vector_type(4)));
typedef unsigned u32x4 __attribute__((ext_vector_type(4)));
typedef unsigned u32x2 __attribute__((ext_vector_type(2)));

constexpr int NTOK = 65536, DM = 1024, SEQ = 4096, NBATCH = 16, NMEM = 256, NEXP = 32;
constexpr int NSLOT = 2 * NTOK + NEXP * 256;
constexpr float ALPHA = 1.189207115002721f;
constexpr float LN_EPS = 1e-5f, RMS_EPS = 1e-6f;
constexpr float LOG2E = 1.4426950408889634f;
constexpr float QSCALE_DF = 0.125f * LOG2E;
constexpr float QSCALE_MEM = 0.08838834764831845f * LOG2E;
constexpr float LAM_INIT = 0.2f;
constexpr int NPHASE = 12;

constexpr size_t MiB = (size_t)1 << 20;
constexpr size_t WS_CTL = 0;
constexpr size_t WS_SCAL = 1 * MiB;
constexpr size_t WS_ROPE = 2 * MiB;
constexpr size_t WS_RECI = 6 * MiB;
constexpr size_t WS_RECW = 7 * MiB;
constexpr size_t WS_WT_IN = 8 * MiB;
constexpr size_t WS_WT_G = 16 * MiB;
constexpr size_t WS_WT_MKV = 22 * MiB;
constexpr size_t WS_WT_B = 24 * MiB;
constexpr size_t WS_WT_OUT = 27 * MiB;
constexpr size_t WS_WT_R = 29 * MiB;
constexpr size_t WS_WT_GU = 30 * MiB;
constexpr size_t WS_WT_DN = 94 * MiB;
constexpr size_t WS_MEMB = 126 * MiB;
constexpr size_t WS_MKV = 134 * MiB;
constexpr size_t WS_DEC = 142 * MiB;
constexpr size_t WS_LOGITS = 144 * MiB;
constexpr size_t WS_HG = 176 * MiB;
constexpr size_t WS_DQK = 432 * MiB;
constexpr size_t WS_DV = 560 * MiB;
constexpr size_t WS_MQ = 624 * MiB;
constexpr size_t WS_XB = 688 * MiB;
constexpr size_t WS_Y = 816 * MiB;
constexpr size_t WS_END = 1008 * MiB;
constexpr size_t WS_MERGED = WS_HG;
constexpr size_t WS_X1B = WS_DV;
constexpr size_t WS_XS = WS_HG;
constexpr size_t WS_H = 448 * MiB;
constexpr size_t WS_YB = 584 * MiB;
constexpr int LDS_BYTES = 147456, LDS_BAR = 147456 - 64;
constexpr size_t WS_BAR = 65536;

struct Params { const void* in[26]; float* out; unsigned char* ws; int ph_lo, ph_hi; };

__device__ __forceinline__ float bf2f(bf16_t v) { return __uint_as_float(((unsigned)v) << 16); }
__device__ __forceinline__ bf16_t f2bf(float f) { unsigned u = __float_as_uint(f); u += 0x7fffu + ((u >> 16) & 1u); return (bf16_t)(u >> 16); }
__device__ __forceinline__ unsigned pk2(float lo, float hi) { return (unsigned)f2bf(lo) | ((unsigned)f2bf(hi) << 16); }
__device__ __forceinline__ float sigmoidf_(float x) { return __builtin_amdgcn_rcpf(1.f + __expf(-x)); }
__device__ __forceinline__ float siluf_(float x) { return x * __builtin_amdgcn_rcpf(1.f + __expf(-x)); }
__device__ __forceinline__ float wave_sum(float v) {
#pragma unroll
    for (int o = 1; o < 64; o <<= 1) v += __shfl_xor(v, o);
    return v;
}
__device__ __forceinline__ float wave_max(float v) {
#pragma unroll
    for (int o = 1; o < 64; o <<= 1) v = fmaxf(v, __shfl_xor(v, o));
    return v;
}
#define LDS_WAIT() asm volatile("s_waitcnt lgkmcnt(0)" ::: "memory")

__device__ __forceinline__ void tr_item(const float* W, int K, int N, bf16_t* WT, int dst_row0, float* scr, int k0, int n0, int lane) {
#pragma unroll 8
    for (int i = 0; i < 32; ++i) { const int kk = 2 * i + (lane >> 5); scr[kk * 33 + (lane & 31)] = W[(size_t)(k0 + kk) * N + n0 + (lane & 31)]; }
    LDS_WAIT();
    const int c = lane & 7;
#pragma unroll
    for (int j = 0; j < 4; ++j) { const int n = (lane >> 3) + 8 * j; const float* s = scr + (8 * c) * 33 + n;
        u32x4 o; o.x = pk2(s[0 * 33], s[1 * 33]); o.y = pk2(s[2 * 33], s[3 * 33]); o.z = pk2(s[4 * 33], s[5 * 33]); o.w = pk2(s[6 * 33], s[7 * 33]);
        *(u32x4*)(WT + (size_t)(dst_row0 + n) * K + k0 + 8 * c) = o; }
    LDS_WAIT();
}
__device__ __forceinline__ void tr_job(const float* W, int K, int N, int ne, bf16_t* WT, int erow, int blk, int blkstride, int base, float* scr, int gw, int ngw, int lane) {
    const int nkb = K / 64, nnb = N / 32, per = nkb * nnb, total = per * ne;
    for (int it = gw; it < total; it += ngw) {
        const int e = it / per, r = it % per, kb = r / nnb, nb = r % nnb, n0 = nb * 32;
        tr_item(W + (size_t)e * K * N, K, N, WT, base + e * erow + (n0 / blk) * blkstride + (n0 % blk), scr, kb * 64, n0, lane);
    }
}
__device__ __forceinline__ void sincos_acc(float ang, float& c, float& s) {
    const double a = (double)ang;
    const double q = rint(a * 0.63661977236758134308);
    const double r = fma(-q, 1.57079632679489661923, a) - q * 6.12323399573676603587e-17;
    const double r2 = r * r;
    double sp = 1.0 / 6227020800.0; sp = fma(sp, r2, -1.0 / 39916800.0); sp = fma(sp, r2, 1.0 / 362880.0); sp = fma(sp, r2, -1.0 / 5040.0);
    sp = fma(sp, r2, 1.0 / 120.0); sp = fma(sp, r2, -1.0 / 6.0); sp = fma(sp, r2, 1.0); const double sr = sp * r;
    double cp = 1.0 / 479001600.0; cp = fma(cp, r2, -1.0 / 3628800.0); cp = fma(cp, r2, 1.0 / 40320.0); cp = fma(cp, r2, -1.0 / 720.0);
    cp = fma(cp, r2, 1.0 / 24.0); cp = fma(cp, r2, -0.5); const double cr = fma(cp, r2, 1.0);
    const int qi = ((int)q) & 3;
    const double cc = (qi == 0) ? cr : (qi == 1) ? -sr : (qi == 2) ? -cr : sr;
    const double ss = (qi == 0) ? sr : (qi == 1) ? cr : (qi == 2) ? -sr : -cr;
    c = (float)cc; s = (float)ss;
}
__device__ __forceinline__ void phase_prologue(const Params& p, unsigned char* lds) {
    const int tid = threadIdx.x, lane = tid & 63, wave = tid >> 6;
    const int gw = blockIdx.x * 8 + wave, ngw = gridDim.x * 8;
    const size_t gt = (size_t)blockIdx.x * 512 + tid, ngt = (size_t)gridDim.x * 512;
    unsigned char* ws = p.ws;
    float* scr = (float*)lds + wave * (64 * 33);
    tr_job((const float*)p.in[3], 1024, 4096, 1, (bf16_t*)(ws + WS_WT_IN), 0, 4096, 0, 0, scr, gw, ngw, lane);
    tr_job((const float*)p.in[4], 1024, 3072, 1, (bf16_t*)(ws + WS_WT_G), 0, 3072, 0, 0, scr, gw, ngw, lane);
    tr_job((const float*)p.in[12], 1024, 1024, 1, (bf16_t*)(ws + WS_WT_MKV), 0, 1024, 0, 0, scr, gw, ngw, lane);
    tr_job((const float*)p.in[13], 512, 1024, 1, (bf16_t*)(ws + WS_WT_B), 0, 1024, 0, 0, scr, gw, ngw, lane);
    tr_job((const float*)p.in[14], 512, 1024, 1, (bf16_t*)(ws + WS_WT_B), 0, 1024, 0, 1024, scr, gw, ngw, lane);
    tr_job((const float*)p.in[15], 512, 1024, 1, (bf16_t*)(ws + WS_WT_B), 0, 1024, 0, 2048, scr, gw, ngw, lane);
    tr_job((const float*)p.in[16], 1024, 1024, 1, (bf16_t*)(ws + WS_WT_OUT), 0, 1024, 0, 0, scr, gw, ngw, lane);
    tr_job((const float*)p.in[21], 1024, 512, 32, (bf16_t*)(ws + WS_WT_GU), 1024, 128, 256, 0, scr, gw, ngw, lane);
    tr_job((const float*)p.in[22], 1024, 512, 32, (bf16_t*)(ws + WS_WT_GU), 1024, 128, 256, 128, scr, gw, ngw, lane);
    tr_job((const float*)p.in[23], 512, 1024, 32, (bf16_t*)(ws + WS_WT_DN), 1024, 1024, 0, 0, scr, gw, ngw, lane);
    { const float* wg = (const float*)p.in[19]; const float* we = (const float*)p.in[20]; bf16_t* wr = (bf16_t*)(ws + WS_WT_R);
      for (size_t i = gt; i < 48 * 1024; i += ngt) { const int r = (int)(i >> 10), k = (int)(i & 1023);
          const float v = r < 4 ? wg[k * 4 + r] : (r < 36 ? we[k * 32 + (r - 4)] : 0.f); const bf16_t hb = f2bf(v); wr[i] = hb; wr[48 * 1024 + i] = f2bf(v - bf2f(hb)); } }
    { const float* x = (const float*)p.in[0]; bf16_t* xb = (bf16_t*)(ws + WS_XB);
      for (size_t i = gt; i < (size_t)NTOK * DM / 8; i += ngt) { const f32x4 a = *(const f32x4*)(x + i * 8), b = *(const f32x4*)(x + i * 8 + 4);
          u32x4 o; o.x = pk2(a.x, a.y); o.y = pk2(a.z, a.w); o.z = pk2(b.x, b.y); o.w = pk2(b.z, b.w); *(u32x4*)(xb + i * 8) = o; }
      const float* mm = (const float*)p.in[1]; bf16_t* mb = (bf16_t*)(ws + WS_MEMB);
      for (size_t i = gt; i < (size_t)NBATCH * NMEM * DM / 8; i += ngt) { const f32x4 a = *(const f32x4*)(mm + i * 8), b = *(const f32x4*)(mm + i * 8 + 4);
          u32x4 o; o.x = pk2(a.x, a.y); o.y = pk2(a.z, a.w); o.z = pk2(b.x, b.y); o.w = pk2(b.z, b.w); *(u32x4*)(mb + i * 8) = o; } }
    { const int* pos = (const int*)p.in[2]; float* rope = (float*)(ws + WS_ROPE);
      for (size_t i = gt; i < (size_t)NTOK * 8; i += ngt) { const int tk = (int)(i >> 3), fi = (int)(i & 7);
          const float invf = fi == 0 ? 1.0f : fi == 1 ? 0.1939227432012558f : fi == 2 ? 0.03760603070259094f : fi == 3 ? 0.007292664609849453f : fi == 4 ? 0.0014142135623842478f
                           : fi == 5 ? 0.00027424818836152554f : fi == 6 ? 5.3182957344688475e-05f : 1.0313385246263351e-05f;
          const float ang = (float)pos[tk] * invf; float c, s; sincos_acc(ang, c, s); rope[i * 2] = c; rope[i * 2 + 1] = s; } }
    if (blockIdx.x == 0) {
        float* sc = (float*)(ws + WS_SCAL); const float* lbs = (const float*)p.in[5];
        { const float a = lbs[tid], b = lbs[512 + tid]; sc[tid] = 1.f / (1.f + expf(b - a)); }
        if (wave == 0) {
            const float* q1 = (const float*)p.in[7]; const float* k1 = (const float*)p.in[8]; const float* q2 = (const float*)p.in[9]; const float* k2 = (const float*)p.in[10];
            const float s1 = wave_sum(q1[lane] * k1[lane]), s2 = wave_sum(q2[lane] * k2[lane]);
            if (lane == 0) sc[512] = expf(s1) - expf(s2) + LAM_INIT;
        }
        if (tid < 64) ((int*)(ws + WS_CTL))[tid] = 0;
    }
}

struct SgCtx { int t, wr, wc, fr, fq; unsigned char* sA; unsigned char* sB; };
__device__ __forceinline__ SgCtx sg_ctx(unsigned char* lds) {
    SgCtx c; const int tid = threadIdx.x; c.t = tid & 255; const int team = tid >> 8; const int wid = c.t >> 6, lane = c.t & 63;
    c.wr = wid >> 1; c.wc = wid & 1; c.fr = lane & 15; c.fq = lane >> 4; c.sA = lds + team * 16384; c.sB = c.sA + 8192; return c;
}
__device__ __forceinline__ void sg_zero(f32x4 (&acc)[4][2]) {
#pragma unroll
    for (int m = 0; m < 4; ++m)
#pragma unroll
        for (int n = 0; n < 2; ++n) acc[m][n] = (f32x4){0.f, 0.f, 0.f, 0.f};
}
__device__ __forceinline__ void sg_tile(f32x4 (&acc)[4][2], const bf16_t* a0, const bf16_t* a1, const bf16_t* b0, int K, const SgCtx& c) {
    const int bo = c.t * 16;
#pragma unroll 1
    for (int kt = 0; kt < K; kt += 32) {
        const bf16x8 va0 = *(const bf16x8*)(a0 + kt), va1 = *(const bf16x8*)(a1 + kt), vb0 = *(const bf16x8*)(b0 + kt);
        *(bf16x8*)(c.sA + bo) = va0; *(bf16x8*)(c.sA + bo + 4096) = va1; *(bf16x8*)(c.sB + bo) = vb0;
        __syncthreads();
        bf16x8 At[4], Bt[2];
#pragma unroll
        for (int m = 0; m < 4; ++m) At[m] = *(const bf16x8*)(c.sA + (c.wr * 64 + m * 16 + c.fr) * 64 + c.fq * 16);
#pragma unroll
        for (int n = 0; n < 2; ++n) Bt[n] = *(const bf16x8*)(c.sB + (c.wc * 32 + n * 16 + c.fr) * 64 + c.fq * 16);
#pragma unroll
        for (int m = 0; m < 4; ++m)
#pragma unroll
            for (int n = 0; n < 2; ++n) acc[m][n] = __builtin_amdgcn_mfma_f32_16x16x32_bf16(At[m], Bt[n], acc[m][n], 0, 0, 0);
        __syncthreads();
    }
}
#define SG_R0(c) ((c).t >> 2)
#define SG_C0(c) (((c).t & 3) * 8)
template <class F> __device__ __forceinline__ void sg_store_bf16(const f32x4 (&acc)[4][2], bf16_t* dst, size_t ld, const SgCtx& c, F f) {
    bf16_t* base = dst + (size_t)(c.wr * 64 + c.fq * 4) * ld + c.wc * 32 + c.fr;
#pragma unroll
    for (int m = 0; m < 4; ++m)
#pragma unroll
        for (int j = 0; j < 4; ++j) { bf16_t* pr = base + (size_t)(m * 16 + j) * ld;
#pragma unroll
            for (int n = 0; n < 2; ++n) pr[n * 16] = f2bf(f(acc[m][n][j], c.wc * 32 + n * 16));
            asm volatile("" ::: "memory"); }
}
struct FIdent { __device__ __forceinline__ float operator()(float v, int) const { return v; } };
struct FSilu { __device__ __forceinline__ float operator()(float v, int) const { return siluf_(v); } };
struct FQScale { __device__ __forceinline__ float operator()(float v, int d0) const { return d0 >= 16 ? v * QSCALE_DF : v; } };

__device__ __forceinline__ void phase_proj(const Params& p, unsigned char* lds) {
    const SgCtx c = sg_ctx(lds); const int team = threadIdx.x >> 8; unsigned char* ws = p.ws;
    const bf16_t* XB = (const bf16_t*)(ws + WS_XB); const bf16_t* WT = (const bf16_t*)(ws + WS_WT_IN);
    bf16_t* HG = (bf16_t*)(ws + WS_HG); bf16_t* DQK = (bf16_t*)(ws + WS_DQK); bf16_t* DV = (bf16_t*)(ws + WS_DV); bf16_t* MQ = (bf16_t*)(ws + WS_MQ);
    const int r0 = SG_R0(c), c0 = SG_C0(c);
    { const int ntiles = 512 * 64;
      for (int tb = 2 * blockIdx.x; tb < ntiles; tb += 2 * gridDim.x) {
        const int tile = tb + team; const int tm = tile >> 6, tn = tile & 63;
        f32x4 acc[4][2]; sg_zero(acc);
        sg_tile(acc, XB + (size_t)(tm * 128 + r0) * 1024 + c0, XB + (size_t)(tm * 128 + r0 + 64) * 1024 + c0, WT + (size_t)(tn * 64 + r0) * 1024 + c0, 1024, c);
        const size_t mrow = (size_t)tm * 128; const int n0 = tn * 64;
        if (n0 < 2048) { const int g = n0 >> 9; bf16_t* d = HG + mrow * 2048 + n0; if (g == 0 || g == 3) sg_store_bf16(acc, d, 2048, c, FSilu()); else sg_store_bf16(acc, d, 2048, c, FIdent()); }
        else if (n0 < 3072) { bf16_t* d = DQK + mrow * 1024 + (n0 - 2048); if (n0 < 2560) sg_store_bf16(acc, d, 1024, c, FQScale()); else sg_store_bf16(acc, d, 1024, c, FIdent()); }
        else if (n0 < 3584) sg_store_bf16(acc, DV + mrow * 512 + (n0 - 3072), 512, c, FIdent());
        else sg_store_bf16(acc, MQ + mrow * 512 + (n0 - 3584), 512, c, FIdent());
      } }
    { const bf16_t* MB = (const bf16_t*)(ws + WS_MEMB); const bf16_t* WK = (const bf16_t*)(ws + WS_WT_MKV); bf16_t* MKV = (bf16_t*)(ws + WS_MKV);
      const int ntiles = 32 * 16;
      for (int tb = 2 * blockIdx.x; tb < ntiles; tb += 2 * gridDim.x) {
        const int tile = tb + team; const int tm = tile >> 4, tn = tile & 15;
        f32x4 acc[4][2]; sg_zero(acc);
        sg_tile(acc, MB + (size_t)(tm * 128 + r0) * 1024 + c0, MB + (size_t)(tm * 128 + r0 + 64) * 1024 + c0, WK + (size_t)(tn * 64 + r0) * 1024 + c0, 1024, c);
        sg_store_bf16(acc, MKV + (size_t)tm * 128 * 1024 + tn * 64, 1024, c, FIdent());
      } }
}
__device__ __forceinline__ void phase_rope(const Params& p, unsigned char* lds) {
    unsigned char* ws = p.ws; bf16_t* DQK = (bf16_t*)(ws + WS_DQK); const float* rope = (const float*)(ws + WS_ROPE);
    const size_t gt = (size_t)blockIdx.x * 512 + threadIdx.x, ngt = (size_t)gridDim.x * 512;
    for (size_t i = gt; i < (size_t)NTOK * 128; i += ngt) {
        const size_t m = i >> 7; const int rem = (int)(i & 127), gh = rem >> 3, fi = rem & 7;
        bf16_t* q = DQK + m * 1024 + gh * 64;
        const float t1 = bf2f(q[fi]), t2 = bf2f(q[8 + fi]); const float cs = rope[(m * 8 + fi) * 2], sn = rope[(m * 8 + fi) * 2 + 1];
        float o1 = t1 * cs - t2 * sn, o2 = t2 * cs + t1 * sn;
        if (gh < 8) { o1 *= QSCALE_DF; o2 *= QSCALE_DF; }
        q[fi] = f2bf(o1); q[8 + fi] = f2bf(o2);
    }
}
__device__ __forceinline__ void phase_hgrn_naive(const Params& p, unsigned char* lds) {
    unsigned char* ws = p.ws; const bf16_t* HG = (const bf16_t*)(ws + WS_HG); bf16_t* Y = (bf16_t*)(ws + WS_Y);
    const float* lower0 = (const float*)(ws + WS_SCAL); const float* gain = (const float*)p.in[6];
    float* fs = (float*)lds; float* ks = fs + 128; float* qs = ks + 128; float* part = qs + 128; float* red = part + 512;
    const int tid = threadIdx.x, v = tid & 127, kq = tid >> 7, lane = tid & 63, wave = tid >> 6;
    for (int bh = blockIdx.x; bh < 64; bh += gridDim.x) {
        const int b = bh >> 2, h = bh & 3;
        float S[32];
#pragma unroll
        for (int i = 0; i < 32; ++i) S[i] = 0.f;
        const float lbv = lower0[h * 128 + v], gn = gain[h * 128 + v];
        for (int t = 0; t < SEQ; ++t) {
            const size_t m = (size_t)b * SEQ + t; const bf16_t* row = HG + m * 2048 + h * 128;
            if (tid < 128) { const float fp = bf2f(row[512 + v]); const float f = lbv + (1.f - lbv) * sigmoidf_(fp); fs[v] = f; ks[v] = 1.f - f; qs[v] = bf2f(row[v]); }
            const float vv = bf2f(row[1024 + v]);
            __syncthreads();
            float o = 0.f;
#pragma unroll
            for (int i = 0; i < 32; ++i) { const int k = kq * 32 + i; S[i] = fs[k] * S[i] + ks[k] * vv; o += qs[k] * S[i]; }
            part[kq * 128 + v] = o;
            __syncthreads();
            float ot = 0.f;
            if (tid < 128) { ot = part[v] + part[128 + v] + part[256 + v] + part[384 + v]; const float sq = wave_sum(ot * ot); if (lane == 0) red[wave] = sq; }
            __syncthreads();
            if (tid < 128) { const float ms = (red[0] + red[1]) * (1.f / 128.f); const float y = ot * rsqrtf(ms + RMS_EPS) * gn * bf2f(row[1536 + v]); Y[m * 1536 + h * 128 + v] = f2bf(y); }
        }
        __syncthreads();
    }
}
template <bool DIFF>
__device__ __forceinline__ void phase_attn_naive(const Params& p, unsigned char* lds) {
    constexpr int DQ = DIFF ? 64 : 128, NMAP = DIFF ? 2 : 1;
    unsigned char* ws = p.ws; const int tid = threadIdx.x, lane = tid & 63, wave = tid >> 6;
    float* wbuf = (float*)lds + wave * 4096; float* qbuf = (float*)(lds + 131072) + wave * 128;
    const bf16_t* DQK = (const bf16_t*)(ws + WS_DQK); const bf16_t* DV = (const bf16_t*)(ws + WS_DV); const bf16_t* MQ = (const bf16_t*)(ws + WS_MQ); const bf16_t* MKV = (const bf16_t*)(ws + WS_MKV);
    bf16_t* Y = (bf16_t*)(ws + WS_Y); const float lam = ((const float*)(ws + WS_SCAL))[512]; const float* sub_gain = (const float*)p.in[11];
    const int gw = blockIdx.x * 8 + wave, ngw = gridDim.x * 8; const int nrows = NTOK * 4;
    for (int r = gw; r < nrows; r += ngw) {
        int b, h, nk; size_t m; const bf16_t *Q, *K, *V; int kp, vp;
        if (DIFF) { const int bh = r >> 12, i = r & 4095; b = bh >> 2; h = bh & 3; m = (size_t)b * SEQ + i; nk = i + 1;
            Q = DQK + m * 1024 + h * 64; K = DQK + (size_t)b * SEQ * 1024 + 512 + h * 64; kp = 1024; V = DV + (size_t)b * SEQ * 512 + h * 128; vp = 512; }
        else { m = (size_t)(r >> 2); h = r & 3; b = (int)(m >> 12); nk = NMEM;
            Q = MQ + m * 512 + h * 128; K = MKV + (size_t)b * NMEM * 1024 + h * 128; kp = 1024; V = MKV + (size_t)b * NMEM * 1024 + 512 + h * 128; vp = 1024; }
        if (DIFF) { qbuf[lane] = bf2f(Q[lane]); qbuf[64 + lane] = bf2f(Q[256 + lane]); }
        else { qbuf[lane] = bf2f(Q[lane]) * QSCALE_MEM; qbuf[64 + lane] = bf2f(Q[64 + lane]) * QSCALE_MEM; }
        LDS_WAIT();
        float mx[NMAP], ls[NMAP];
#pragma unroll
        for (int a = 0; a < NMAP; ++a) { mx[a] = -1e30f; ls[a] = 0.f; }
        for (int j = lane; j < nk; j += 64) {
#pragma unroll
            for (int a = 0; a < NMAP; ++a) {
                const bf16_t* kr = K + (size_t)j * kp + a * 256; float s = 0.f;
#pragma unroll 2
                for (int cc = 0; cc < DQ / 8; ++cc) { const bf16x8 kv = *(const bf16x8*)(kr + cc * 8);
#pragma unroll
                    for (int e = 0; e < 8; ++e) s += qbuf[a * 64 + cc * 8 + e] * bf2f((bf16_t)kv[e]); }
                if (s > mx[a]) { ls[a] = ls[a] * exp2f(mx[a] - s) + 1.f; mx[a] = s; } else ls[a] += exp2f(s - mx[a]);
            }
        }
        float M[NMAP], Linv[NMAP];
#pragma unroll
        for (int a = 0; a < NMAP; ++a) { M[a] = wave_max(mx[a]); const float l = wave_sum(ls[a] * exp2f(mx[a] - M[a])); Linv[a] = 1.f / l; }
        for (int j = lane; j < nk; j += 64) {
            float w = 0.f;
#pragma unroll
            for (int a = 0; a < NMAP; ++a) {
                const bf16_t* kr = K + (size_t)j * kp + a * 256; float s = 0.f;
#pragma unroll 2
                for (int cc = 0; cc < DQ / 8; ++cc) { const bf16x8 kv = *(const bf16x8*)(kr + cc * 8);
#pragma unroll
                    for (int e = 0; e < 8; ++e) s += qbuf[a * 64 + cc * 8 + e] * bf2f((bf16_t)kv[e]); }
                const float pj = exp2f(s - M[a]) * Linv[a]; w = (a == 0) ? pj : w - lam * pj;
            }
            wbuf[j] = w;
        }
        LDS_WAIT();
        float a0 = 0.f, a1 = 0.f; const bf16_t* vb = V + 2 * lane;
        for (int j = 0; j < nk; ++j) { const float w = wbuf[j]; const unsigned u = *(const unsigned*)(vb + (size_t)j * vp); a0 += w * __uint_as_float(u << 16); a1 += w * __uint_as_float(u & 0xffff0000u); }
        if (DIFF) { const float ms = wave_sum(a0 * a0 + a1 * a1) * (1.f / 128.f); const float rs = rsqrtf(ms + RMS_EPS) * (1.f - LAM_INIT);
            *(unsigned*)(Y + m * 1536 + 512 + h * 128 + 2 * lane) = pk2(a0 * rs * sub_gain[2 * lane], a1 * rs * sub_gain[2 * lane + 1]); }
        else *(unsigned*)(Y + m * 1536 + 1024 + h * 128 + 2 * lane) = pk2(a0, a1);
        LDS_WAIT();
    }
}
__device__ __forceinline__ void phase_merge(const Params& p, unsigned char* lds) {
    const SgCtx c = sg_ctx(lds); const int team = threadIdx.x >> 8; unsigned char* ws = p.ws;
    const bf16_t* XB = (const bf16_t*)(ws + WS_XB); const bf16_t* WG = (const bf16_t*)(ws + WS_WT_G); const bf16_t* Y = (const bf16_t*)(ws + WS_Y); const bf16_t* WB = (const bf16_t*)(ws + WS_WT_B);
    bf16_t* MG = (bf16_t*)(ws + WS_MERGED); const int r0 = SG_R0(c), c0 = SG_C0(c);
    const int ntiles = 512 * 16;
    for (int tb = 2 * blockIdx.x; tb < ntiles; tb += 2 * gridDim.x) {
        const int tile = tb + team; const int tm = tile >> 4, tn = tile & 15;
        f32x4 sum[4][2]; sg_zero(sum);
#pragma unroll 1
        for (int br = 0; br < 3; ++br) {
            f32x4 ag[4][2]; sg_zero(ag);
            sg_tile(ag, XB + (size_t)(tm * 128 + r0) * 1024 + c0, XB + (size_t)(tm * 128 + r0 + 64) * 1024 + c0, WG + (size_t)(br * 1024 + tn * 64 + r0) * 1024 + c0, 1024, c);
            f32x4 ay[4][2]; sg_zero(ay);
            sg_tile(ay, Y + (size_t)(tm * 128 + r0) * 1536 + br * 512 + c0, Y + (size_t)(tm * 128 + r0 + 64) * 1536 + br * 512 + c0, WB + (size_t)(br * 1024 + tn * 64 + r0) * 512 + c0, 512, c);
#pragma unroll
            for (int m = 0; m < 4; ++m)
#pragma unroll
                for (int n = 0; n < 2; ++n)
#pragma unroll
                    for (int j = 0; j < 4; ++j) sum[m][n][j] += sigmoidf_(ag[m][n][j]) * ay[m][n][j];
        }
        sg_store_bf16(sum, MG + (size_t)tm * 128 * 1024 + tn * 64, 1024, c, FIdent());
    }
}
__device__ __forceinline__ void phase_wout(const Params& p, unsigned char* lds) {
    const SgCtx c = sg_ctx(lds); const int team = threadIdx.x >> 8; unsigned char* ws = p.ws;
    const bf16_t* MG = (const bf16_t*)(ws + WS_MERGED); const bf16_t* WO = (const bf16_t*)(ws + WS_WT_OUT); const float* x = (const float*)p.in[0]; float* pre = p.out;
    const int r0 = SG_R0(c), c0 = SG_C0(c); const int ntiles = 512 * 16;
    for (int tb = 2 * blockIdx.x; tb < ntiles; tb += 2 * gridDim.x) {
        const int tile = tb + team; const int tm = tile >> 4, tn = tile & 15;
        f32x4 acc[4][2]; sg_zero(acc);
        sg_tile(acc, MG + (size_t)(tm * 128 + r0) * 1024 + c0, MG + (size_t)(tm * 128 + r0 + 64) * 1024 + c0, WO + (size_t)(tn * 64 + r0) * 1024 + c0, 1024, c);
        { const size_t off = ((size_t)tm * 128 + c.wr * 64 + c.fq * 4) * 1024 + tn * 64 + c.wc * 32 + c.fr;
#pragma unroll
          for (int m = 0; m < 4; ++m)
#pragma unroll
              for (int j = 0; j < 4; ++j) { const size_t o2 = off + (size_t)(m * 16 + j) * 1024;
#pragma unroll
                  for (int n = 0; n < 2; ++n) pre[o2 + n * 16] = ALPHA * x[o2 + n * 16] + acc[m][n][j];
                  asm volatile("" ::: "memory"); } }
    }
}
__device__ __forceinline__ void phase_ln1_route(const Params& p, unsigned char* lds) {
    unsigned char* ws = p.ws; const int tid = threadIdx.x, lane = tid & 63, wave = tid >> 6;
    float* x1f = p.out; bf16_t* x1b = (bf16_t*)(ws + WS_X1B); const float* g1 = (const float*)p.in[17]; const float* b1 = (const float*)p.in[18];
    const float* wg = (const float*)p.in[19]; const float* we = (const float*)p.in[20];
    int* cnt = (int*)(ws + WS_CTL); int* reci = (int*)(ws + WS_RECI); float* recw = (float*)(ws + WS_RECW);
    const int gw = blockIdx.x * 8 + wave, ngw = gridDim.x * 8;
    for (int t = gw; t < NTOK; t += ngw) {
        float* row = x1f + (size_t)t * 1024; f32x4 v[4]; float s = 0.f;
#pragma unroll
        for (int j = 0; j < 4; ++j) { v[j] = *(const f32x4*)(row + 256 * j + 4 * lane); s += (v[j].x + v[j].y) + (v[j].z + v[j].w); }
        const float mean = wave_sum(s) * (1.f / 1024.f); float s2 = 0.f;
#pragma unroll
        for (int j = 0; j < 4; ++j) { v[j] = v[j] - mean; s2 += (v[j].x * v[j].x + v[j].y * v[j].y) + (v[j].z * v[j].z + v[j].w * v[j].w); }
        const float rstd = rsqrtf(wave_sum(s2) * (1.f / 1024.f) + LN_EPS);
#pragma unroll
        for (int j = 0; j < 4; ++j) { const f32x4 gg = *(const f32x4*)(g1 + 256 * j + 4 * lane), bb = *(const f32x4*)(b1 + 256 * j + 4 * lane);
            v[j] = v[j] * rstd * gg + bb; *(f32x4*)(row + 256 * j + 4 * lane) = v[j];
            u32x2 o; o.x = pk2(v[j].x, v[j].y); o.y = pk2(v[j].z, v[j].w); *(u32x2*)(x1b + (size_t)t * 1024 + 256 * j + 4 * lane) = o; }
        float lg[36];
#pragma unroll
        for (int i = 0; i < 36; ++i) lg[i] = 0.f;
#pragma unroll
        for (int j = 0; j < 4; ++j)
#pragma unroll
            for (int e = 0; e < 4; ++e) { const int k = 256 * j + 4 * lane + e; const float xv = v[j][e];
                const f32x4 g4 = *(const f32x4*)(wg + k * 4);
#pragma unroll
                for (int q = 0; q < 4; ++q) lg[q] += xv * g4[q];
#pragma unroll
                for (int q8 = 0; q8 < 8; ++q8) { const f32x4 e4 = *(const f32x4*)(we + k * 32 + q8 * 4);
#pragma unroll
                    for (int q = 0; q < 4; ++q) lg[4 + q8 * 4 + q] += xv * e4[q]; } }
#pragma unroll
        for (int i = 0; i < 36; ++i) lg[i] = wave_sum(lg[i]);
        int gi = 0; float gm = lg[0];
#pragma unroll
        for (int q = 1; q < 4; ++q) if (lg[q] > gm) { gm = lg[q]; gi = q; }
        float gs = 0.f;
#pragma unroll
        for (int q = 0; q < 4; ++q) gs += expf(lg[q] - gm);
        const float group_w = 1.f / gs;
        float ig[8];
#pragma unroll
        for (int i = 0; i < 8; ++i) ig[i] = gi == 0 ? lg[4 + i] : gi == 1 ? lg[12 + i] : gi == 2 ? lg[20 + i] : lg[28 + i];
        int i1 = 0; float l1 = ig[0];
#pragma unroll
        for (int i = 1; i < 8; ++i) if (ig[i] > l1) { l1 = ig[i]; i1 = i; }
        int i2 = -1; float l2 = -3.0e38f;
#pragma unroll
        for (int i = 0; i < 8; ++i) if (i != i1 && ig[i] > l2) { l2 = ig[i]; i2 = i; }
        const float e2 = expf(l2 - l1); const float w1 = group_w / (1.f + e2), w2 = group_w * e2 / (1.f + e2);
        if (lane == 0) { const int ea = gi * 8 + i1, eb = gi * 8 + i2; const int pa = atomicAdd(cnt + ea, 1), pb = atomicAdd(cnt + eb, 1);
            reci[t * 4 + 0] = ea; reci[t * 4 + 1] = eb; reci[t * 4 + 2] = pa; reci[t * 4 + 3] = pb; recw[t * 2] = w1; recw[t * 2 + 1] = w2; }
    }
}
__device__ __forceinline__ void phase_ln1_route2(const Params& p, unsigned char* lds) {
    unsigned char* ws = p.ws; const int tid = threadIdx.x, lane = tid & 63, wave = tid >> 6, fr = lane & 15, fq = lane >> 4;
    float* x1f = p.out; bf16_t* x1b = (bf16_t*)(ws + WS_X1B); const float* g1 = (const float*)p.in[17]; const float* b1 = (const float*)p.in[18];
    const bf16_t* WRH = (const bf16_t*)(ws + WS_WT_R); const bf16_t* WRL = WRH + 48 * 1024;
    int* cnt = (int*)(ws + WS_CTL); int* reci = (int*)(ws + WS_RECI); float* recw = (float*)(ws + WS_RECW);
    float* lgs = (float*)lds + wave * (16 * 48);
    const int gw = blockIdx.x * 8 + wave, ngw = gridDim.x * 8;
    f32x4 gg[4], bb[4];
#pragma unroll
    for (int j = 0; j < 4; ++j) { gg[j] = *(const f32x4*)(g1 + 256 * j + 4 * lane); bb[j] = *(const f32x4*)(b1 + 256 * j + 4 * lane); }
    for (int g = gw; g < NTOK / 16; g += ngw) {
#pragma unroll 2
        for (int rr = 0; rr < 16; ++rr) {
            const int t = g * 16 + rr; float* row = x1f + (size_t)t * 1024; f32x4 v[4]; float s = 0.f;
#pragma unroll
            for (int j = 0; j < 4; ++j) { v[j] = *(const f32x4*)(row + 256 * j + 4 * lane); s += (v[j].x + v[j].y) + (v[j].z + v[j].w); }
            const float mean = wave_sum(s) * (1.f / 1024.f); float s2 = 0.f;
#pragma unroll
            for (int j = 0; j < 4; ++j) { v[j] = v[j] - mean; s2 += (v[j].x * v[j].x + v[j].y * v[j].y) + (v[j].z * v[j].z + v[j].w * v[j].w); }
            const float rstd = rsqrtf(wave_sum(s2) * (1.f / 1024.f) + LN_EPS);
#pragma unroll
            for (int j = 0; j < 4; ++j) { v[j] = v[j] * rstd * gg[j] + bb[j]; *(f32x4*)(row + 256 * j + 4 * lane) = v[j];
                u32x2 o; o.x = pk2(v[j].x, v[j].y); o.y = pk2(v[j].z, v[j].w); *(u32x2*)(x1b + (size_t)t * 1024 + 256 * j + 4 * lane) = o; }
        }
        asm volatile("s_waitcnt vmcnt(0)" ::: "memory");
        f32x4 acc[3];
#pragma unroll
        for (int j = 0; j < 3; ++j) acc[j] = (f32x4){0.f, 0.f, 0.f, 0.f};
        const float* arow = x1f + (size_t)(g * 16 + fr) * 1024 + fq * 8; const bf16_t* bh = WRH + fr * 1024 + fq * 8; const bf16_t* bl = WRL + fr * 1024 + fq * 8;
#pragma unroll 4
        for (int ks = 0; ks < 32; ++ks) {
            const f32x4 xa = *(const f32x4*)(arow + ks * 32), xb = *(const f32x4*)(arow + ks * 32 + 4);
            const float xs[8] = {xa.x, xa.y, xa.z, xa.w, xb.x, xb.y, xb.z, xb.w}; bf16x8 ah, al;
#pragma unroll
            for (int e = 0; e < 8; ++e) { const bf16_t hb = f2bf(xs[e]); ah[e] = (short)hb; al[e] = (short)f2bf(xs[e] - bf2f(hb)); }
#pragma unroll
            for (int j = 0; j < 3; ++j) { const bf16x8 wh = *(const bf16x8*)(bh + j * 16 * 1024 + ks * 32), wl = *(const bf16x8*)(bl + j * 16 * 1024 + ks * 32);
                acc[j] = __builtin_amdgcn_mfma_f32_16x16x32_bf16(ah, wh, acc[j], 0, 0, 0); acc[j] = __builtin_amdgcn_mfma_f32_16x16x32_bf16(al, wh, acc[j], 0, 0, 0);
                acc[j] = __builtin_amdgcn_mfma_f32_16x16x32_bf16(ah, wl, acc[j], 0, 0, 0); }
        }
#pragma unroll
        for (int j = 0; j < 3; ++j)
#pragma unroll
            for (int r = 0; r < 4; ++r) lgs[(4 * fq + r) * 48 + j * 16 + fr] = acc[j][r];
        LDS_WAIT();
        if (lane < 16) {
            const int t = g * 16 + lane; float lg[36];
#pragma unroll
            for (int i = 0; i < 36; ++i) lg[i] = lgs[lane * 48 + i];
            int gi = 0; float gm = lg[0];
#pragma unroll
            for (int q = 1; q < 4; ++q) if (lg[q] > gm) { gm = lg[q]; gi = q; }
            float gs = 0.f;
#pragma unroll
            for (int q = 0; q < 4; ++q) gs += expf(lg[q] - gm);
            const float group_w = 1.f / gs;
            float ig[8];
#pragma unroll
            for (int i = 0; i < 8; ++i) ig[i] = gi == 0 ? lg[4 + i] : gi == 1 ? lg[12 + i] : gi == 2 ? lg[20 + i] : lg[28 + i];
            int i1 = 0; float l1 = ig[0];
#pragma unroll
            for (int i = 1; i < 8; ++i) if (ig[i] > l1) { l1 = ig[i]; i1 = i; }
            int i2 = -1; float l2 = -3.0e38f;
#pragma unroll
            for (int i = 0; i < 8; ++i) if (i != i1 && ig[i] > l2) { l2 = ig[i]; i2 = i; }
            const float e2 = expf(l2 - l1); const float w1 = group_w / (1.f + e2), w2 = group_w * e2 / (1.f + e2);
            const int ea = gi * 8 + i1, eb = gi * 8 + i2; const int pa = atomicAdd(cnt + ea, 1), pb = atomicAdd(cnt + eb, 1);
            reci[t * 4 + 0] = ea; reci[t * 4 + 1] = eb; reci[t * 4 + 2] = pa; reci[t * 4 + 3] = pb; recw[t * 2] = w1; recw[t * 2 + 1] = w2;
        }
        LDS_WAIT();
    }
}
__device__ __forceinline__ int expert_layout(const int* cnt, int lane, int& tiles, int& endi) {
    tiles = (lane < 32) ? ((cnt[lane] + 255) >> 8) : 0; int x = tiles;
#pragma unroll
    for (int o = 1; o < 32; o <<= 1) { const int y = __shfl_up(x, o); if (lane >= o) x += y; }
    endi = x; return __shfl(x, 31);
}
__device__ __forceinline__ int expert_of_tile(int rt, int lane, int endi) { return __popcll(__ballot(lane < 32 && endi <= rt)); }
__device__ __forceinline__ void phase_dispatch(const Params& p, unsigned char* lds) {
    unsigned char* ws = p.ws; const int tid = threadIdx.x, lane = tid & 63, wave = tid >> 6;
    const int* cnt = (const int*)(ws + WS_CTL); int* reci = (int*)(ws + WS_RECI); const bf16_t* x1b = (const bf16_t*)(ws + WS_X1B); bf16_t* xs = (bf16_t*)(ws + WS_XS);
    int tiles, endi; expert_layout(cnt, lane, tiles, endi); const int base = endi - tiles;
    const int gw = blockIdx.x * 8 + wave, ngw = gridDim.x * 8;
    for (int t = gw; t < NTOK; t += ngw) {
        const int ea = reci[t * 4], eb = reci[t * 4 + 1], pa = reci[t * 4 + 2], pb = reci[t * 4 + 3];
        const int sa = __shfl(base, ea) * 256 + pa, sb = __shfl(base, eb) * 256 + pb;
        const u32x4 a = *(const u32x4*)(x1b + (size_t)t * 1024 + lane * 8), b = *(const u32x4*)(x1b + (size_t)t * 1024 + 512 + lane * 8);
        *(u32x4*)(xs + (size_t)sa * 1024 + lane * 8) = a; *(u32x4*)(xs + (size_t)sa * 1024 + 512 + lane * 8) = b;
        *(u32x4*)(xs + (size_t)sb * 1024 + lane * 8) = a; *(u32x4*)(xs + (size_t)sb * 1024 + 512 + lane * 8) = b;
        if (lane == 0) { reci[t * 4 + 2] = sa; reci[t * 4 + 3] = sb; }
    }
}
__device__ __forceinline__ void phase_exp_gu(const Params& p, unsigned char* lds) {
    const SgCtx c = sg_ctx(lds); const int team = threadIdx.x >> 8, lane = threadIdx.x & 63; unsigned char* ws = p.ws;
    const int* cnt = (const int*)(ws + WS_CTL); const bf16_t* XS = (const bf16_t*)(ws + WS_XS); const bf16_t* WGU = (const bf16_t*)(ws + WS_WT_GU); bf16_t* H = (bf16_t*)(ws + WS_H);
    int tiles, endi; const int nt256 = expert_layout(cnt, lane, tiles, endi);
    const int r0 = SG_R0(c), c0 = SG_C0(c); const int ntiles = nt256 * 2 * 8;
    for (int tb = 2 * blockIdx.x; tb < ntiles; tb += 2 * gridDim.x) {
        int tile = tb + team; const bool valid = tile < ntiles; if (!valid) tile = ntiles - 1;
        const int rt = tile >> 3, tn = tile & 7; const int e = expert_of_tile(rt >> 1, lane, endi);
        const bf16_t* a0 = XS + (size_t)(rt * 128 + r0) * 1024 + c0; const bf16_t* a1 = a0 + (size_t)64 * 1024;
        const bf16_t* bg = WGU + (size_t)(e * 1024 + (tn >> 1) * 256 + (tn & 1) * 64 + r0) * 1024 + c0;
        f32x4 ag[4][2]; sg_zero(ag); sg_tile(ag, a0, a1, bg, 1024, c);
        f32x4 au[4][2]; sg_zero(au); sg_tile(au, a0, a1, bg + (size_t)128 * 1024, 1024, c);
#pragma unroll
        for (int m = 0; m < 4; ++m)
#pragma unroll
            for (int n = 0; n < 2; ++n)
#pragma unroll
                for (int j = 0; j < 4; ++j) ag[m][n][j] = siluf_(ag[m][n][j]) * au[m][n][j];
        if (valid) sg_store_bf16(ag, H + (size_t)rt * 128 * 512 + tn * 64, 512, c, FIdent());
    }
}
__device__ __forceinline__ void phase_exp_dn(const Params& p, unsigned char* lds) {
    const SgCtx c = sg_ctx(lds); const int team = threadIdx.x >> 8, lane = threadIdx.x & 63; unsigned char* ws = p.ws;
    const int* cnt = (const int*)(ws + WS_CTL); const bf16_t* H = (const bf16_t*)(ws + WS_H); const bf16_t* WDN = (const bf16_t*)(ws + WS_WT_DN); bf16_t* YB = (bf16_t*)(ws + WS_YB);
    int tiles, endi; const int nt256 = expert_layout(cnt, lane, tiles, endi);
    const int r0 = SG_R0(c), c0 = SG_C0(c); const int ntiles = nt256 * 2 * 16;
    for (int tb = 2 * blockIdx.x; tb < ntiles; tb += 2 * gridDim.x) {
        int tile = tb + team; const bool valid = tile < ntiles; if (!valid) tile = ntiles - 1;
        const int rt = tile >> 4, tn = tile & 15; const int e = expert_of_tile(rt >> 1, lane, endi);
        const bf16_t* a0 = H + (size_t)(rt * 128 + r0) * 512 + c0; const bf16_t* b0 = WDN + (size_t)(e * 1024 + tn * 64 + r0) * 512 + c0;
        f32x4 acc[4][2]; sg_zero(acc); sg_tile(acc, a0, a0 + (size_t)64 * 512, b0, 512, c);
        if (valid) sg_store_bf16(acc, YB + (size_t)rt * 128 * 1024 + tn * 64, 1024, c, FIdent());
    }
}
__device__ __forceinline__ void phase_final(const Params& p, unsigned char* lds) {
    unsigned char* ws = p.ws; const int tid = threadIdx.x, lane = tid & 63, wave = tid >> 6;
    float* out = p.out; const bf16_t* YB = (const bf16_t*)(ws + WS_YB); const int* reci = (const int*)(ws + WS_RECI); const float* recw = (const float*)(ws + WS_RECW);
    const float* g2 = (const float*)p.in[24]; const float* b2 = (const float*)p.in[25];
    const int gw = blockIdx.x * 8 + wave, ngw = gridDim.x * 8;
    for (int t = gw; t < NTOK; t += ngw) {
        float* row = out + (size_t)t * 1024; const int sa = reci[t * 4 + 2], sb = reci[t * 4 + 3]; const float wa = recw[t * 2], wb = recw[t * 2 + 1];
        f32x4 v[4]; float s = 0.f;
#pragma unroll
        for (int j = 0; j < 4; ++j) { const f32x4 xv = *(const f32x4*)(row + 256 * j + 4 * lane);
            const u32x2 ya = *(const u32x2*)(YB + (size_t)sa * 1024 + 256 * j + 4 * lane), yb = *(const u32x2*)(YB + (size_t)sb * 1024 + 256 * j + 4 * lane);
            f32x4 fa, fb; fa.x = __uint_as_float(ya.x << 16); fa.y = __uint_as_float(ya.x & 0xffff0000u); fa.z = __uint_as_float(ya.y << 16); fa.w = __uint_as_float(ya.y & 0xffff0000u);
            fb.x = __uint_as_float(yb.x << 16); fb.y = __uint_as_float(yb.x & 0xffff0000u); fb.z = __uint_as_float(yb.y << 16); fb.w = __uint_as_float(yb.y & 0xffff0000u);
            v[j] = xv * ALPHA + fa * wa + fb * wb; s += (v[j].x + v[j].y) + (v[j].z + v[j].w); }
        const float mean = wave_sum(s) * (1.f / 1024.f); float s2 = 0.f;
#pragma unroll
        for (int j = 0; j < 4; ++j) { v[j] = v[j] - mean; s2 += (v[j].x * v[j].x + v[j].y * v[j].y) + (v[j].z * v[j].z + v[j].w * v[j].w); }
        const float rstd = rsqrtf(wave_sum(s2) * (1.f / 1024.f) + LN_EPS);
#pragma unroll
        for (int j = 0; j < 4; ++j) { const f32x4 gg = *(const f32x4*)(g2 + 256 * j + 4 * lane), bb = *(const f32x4*)(b2 + 256 * j + 4 * lane);
            *(f32x4*)(row + 256 * j + 4 * lane) = v[j] * rstd * gg + bb; }
    }
}

namespace pg8 {
#define PG8_LAS __attribute__((address_space(3)))
constexpr int BM = 256, BK = 64, HALF = 128, HTB = HALF * BK * 2, STAGE_BYTES = 8 * HTB, NXCD = 8, WGM = 8;
__host__ __device__ __forceinline__ int lds_byte(int r, int c) { const int st = (r >> 4) * 2 + (c >> 5), rr = r & 15, cc = c & 31, ob = rr * 64 + cc * 2; return st * 1024 + (ob ^ (((ob >> 9) & 1) << 5)); }
__host__ __device__ __forceinline__ void stage_rc(int b, int& R, int& C) { const int st = b / 1024, sb = b % 1024, swz = sb ^ (((sb >> 9) & 1) << 5); R = (st >> 1) * 16 + swz / 64; C = (st & 1) * 32 + (swz % 64) / 2; }
__host__ __device__ __forceinline__ int perm32(int rho) { const int n = rho >> 4, i = rho & 15; return 8 * (i >> 2) + 4 * n + (i & 3); }
struct Unit { int pm, pn, aux, nt, lda, ldb; const char* a; const char* b; };
typedef float f32x2_t __attribute__((ext_vector_type(2))); typedef __bf16 bf16x2_t __attribute__((ext_vector_type(2)));
__device__ __forceinline__ unsigned cvt_pk_bf16(float lo, float hi) { f32x2_t v = {lo, hi}; bf16x2_t b = __builtin_convertvector(v, bf16x2_t); return __builtin_bit_cast(unsigned, b); }
__device__ __forceinline__ bool static_tile(int i, int G, int c, int nM, int nN, int& pm, int& pn) {
    const int nwg = nM * nN; const long L = (long)i * G + c; if (L >= nwg) return false;
    int wgid = (int)L; { const int q = nwg / NXCD, r = nwg % NXCD, xcd = wgid % NXCD, off = wgid / NXCD; wgid = (xcd < r ? xcd * (q + 1) : r * (q + 1) + (xcd - r) * q) + off; }
    const int nig = WGM * nN, gid = wgid / nig, fm = gid * WGM, gsz = (nM - fm) < WGM ? (nM - fm) : WGM;
    pm = fm + ((wgid % nig) % gsz); pn = (wgid % nig) / gsz; return true;
}
template <class Epi, class Sched, bool ALIGN_EPI>
__device__ __forceinline__ void gemm_phase(PG8_LAS unsigned char* lds, const Sched& S, const Epi& E) {
    const int tid = threadIdx.x, wid = __builtin_amdgcn_readfirstlane(tid >> 6), lane = tid & 63, wr = wid >> 2, wc = wid & 3, fr = lane & 15, fq = lane >> 4;
    const size_t kstep = (size_t)(BK * 2);
    const unsigned ldsw = (unsigned)wid * 1024u;
    const int aoff = lds_byte(wr * 64 + fr, fq * 8), boff = lds_byte(wc * 32 + fr, fq * 8);
#define PG8_VOFF(LDA, LDB) do { int t_ = threadIdx.x; asm volatile("" : "+v"(t_)); _Pragma("unroll") for (int i_ = 0; i_ < 2; ++i_) { int R_, C_; stage_rc(t_ * 16 + i_ * 8192, R_, C_); \
        const int Rb_ = Epi::PERM ? ((R_ & ~31) + perm32(R_ & 31)) : R_; voffA[i_] = (unsigned)(R_ * (LDA) + C_) * 2u; voffB[i_] = (unsigned)(Rb_ * (LDB) + C_) * 2u; } } while (0)
#define PG8_SA(b, h) (((b) * 2 + (h)) * HTB)
#define PG8_SB(b, h) ((4 + (b) * 2 + (h)) * HTB)
#define PG8_STAGE(bufoff, gbase, voff) do { _Pragma("unroll") for (int _i = 0; _i < 2; ++_i) \
        __builtin_amdgcn_global_load_lds((const unsigned*)((const char*)(gbase) + (voff)[_i]), (PG8_LAS unsigned*)(lds + (bufoff) + ldsw + _i * 8192), 16, 0, 0); } while (0)
#define PG8_LDA(dst, b, h) do { _Pragma("unroll") for (int m = 0; m < 4; ++m) _Pragma("unroll") for (int k = 0; k < 2; ++k) dst[m][k] = *(const PG8_LAS bf16x8*)(lds + PG8_SA(b, h) + aoff + m * 2048 + k * 1024); } while (0)
#define PG8_LDB(dst, b, h) do { _Pragma("unroll") for (int n = 0; n < 2; ++n) _Pragma("unroll") for (int k = 0; k < 2; ++k) dst[n][k] = *(const PG8_LAS bf16x8*)(lds + PG8_SB(b, h) + boff + n * 2048 + k * 1024); } while (0)
#define PG8_MMA(ai, bj, At, Bt) do { __builtin_amdgcn_s_setprio(1); _Pragma("unroll") for (int m = 0; m < 4; ++m) _Pragma("unroll") for (int n = 0; n < 2; ++n) _Pragma("unroll") for (int k = 0; k < 2; ++k) \
        acc[ai][bj][m][n] = __builtin_amdgcn_mfma_f32_16x16x32_bf16(Bt[n][k], At[m][k], acc[ai][bj][m][n], 0, 0, 0); __builtin_amdgcn_s_setprio(0); } while (0)
#define PG8_WAIT_V(n) asm volatile("s_waitcnt vmcnt(" #n ")" ::: "memory")
#define PG8_WAIT_L(n) asm volatile("s_waitcnt lgkmcnt(" #n ")" ::: "memory")
#define PG8_BAR __builtin_amdgcn_s_barrier()
#define PG8_SCHED __builtin_amdgcn_sched_barrier(0)
#define PG8_H1(p, ld) ((p) + (size_t)HALF * (ld) * 2)
    Unit cur, nxt; int ui = 0;
    if (!S.next(0, cur)) return;
    f32x4 acc[2][2][4][2];
#pragma unroll
    for (int a = 0; a < 2; ++a)
#pragma unroll
        for (int b = 0; b < 2; ++b)
#pragma unroll
            for (int m = 0; m < 4; ++m)
#pragma unroll
                for (int n = 0; n < 2; ++n) acc[a][b][m][n] = (f32x4){0.f, 0.f, 0.f, 0.f};
    bf16x8 At[4][2], B0[2][2], B1[2][2];
    unsigned voffA[2], voffB[2];
    PG8_VOFF(cur.lda, cur.ldb);
    PG8_STAGE(PG8_SB(0, 0), cur.b, voffB); PG8_STAGE(PG8_SB(0, 1), PG8_H1(cur.b, cur.ldb), voffB); PG8_STAGE(PG8_SA(0, 0), cur.a, voffA); PG8_STAGE(PG8_SA(0, 1), PG8_H1(cur.a, cur.lda), voffA);
    if (wr == 1) PG8_BAR;
    PG8_WAIT_V(2); PG8_BAR;
    PG8_STAGE(PG8_SB(1, 0), cur.b + kstep, voffB); PG8_STAGE(PG8_SA(1, 0), cur.a + kstep, voffA); PG8_STAGE(PG8_SB(1, 1), PG8_H1(cur.b, cur.ldb) + kstep, voffB);
    PG8_WAIT_V(6); PG8_BAR;
    for (;;) {
        const bool has_next = S.next(ui + 1, nxt);
        if (!has_next) nxt = cur;
        const int nt = cur.nt;
        for (int t = 0; t < nt; t += 2) {
            const bool last = (t == nt - 2);
            PG8_LDB(B0, 0, 0); PG8_LDB(B1, 0, 1); PG8_SCHED; PG8_LDA(At, 0, 0); PG8_STAGE(PG8_SA(1, 1), PG8_H1(cur.a, cur.lda) + (size_t)(t + 1) * kstep, voffA);
            if (last) PG8_VOFF(nxt.lda, nxt.ldb);
            const char* a2 = last ? nxt.a : cur.a + (size_t)(t + 2) * kstep; const char* b2 = last ? nxt.b : cur.b + (size_t)(t + 2) * kstep;
            const int lda2 = last ? nxt.lda : cur.lda, ldb2 = last ? nxt.ldb : cur.ldb;
            PG8_WAIT_V(8); PG8_WAIT_L(0); PG8_BAR; PG8_MMA(0, 0, At, B0); PG8_MMA(0, 1, At, B1); PG8_BAR; PG8_SCHED;
            PG8_LDA(At, 0, 1); PG8_STAGE(PG8_SB(0, 0), b2, voffB); PG8_STAGE(PG8_SB(0, 1), PG8_H1(b2, ldb2), voffB); PG8_STAGE(PG8_SA(0, 0), a2, voffA);
            PG8_WAIT_V(8); PG8_WAIT_L(0); PG8_BAR; PG8_MMA(1, 0, At, B0); PG8_MMA(1, 1, At, B1); PG8_BAR; PG8_SCHED;
            PG8_LDB(B0, 1, 0); PG8_LDB(B1, 1, 1); PG8_SCHED; PG8_LDA(At, 1, 0); PG8_STAGE(PG8_SA(0, 1), PG8_H1(a2, lda2), voffA);
            PG8_WAIT_V(8); PG8_WAIT_L(0); PG8_BAR; PG8_MMA(0, 0, At, B0); PG8_MMA(0, 1, At, B1); PG8_BAR; PG8_SCHED;
            PG8_LDA(At, 1, 1); PG8_STAGE(PG8_SB(1, 0), b2 + kstep, voffB); PG8_STAGE(PG8_SB(1, 1), PG8_H1(b2, ldb2) + kstep, voffB); PG8_STAGE(PG8_SA(1, 0), a2 + kstep, voffA);
            PG8_WAIT_V(8); PG8_WAIT_L(0); PG8_BAR; PG8_MMA(1, 0, At, B0); PG8_MMA(1, 1, At, B1); PG8_BAR; PG8_SCHED;
        }
        if constexpr (ALIGN_EPI) { if (wr == 0) PG8_BAR; }
        E(acc, cur, wr, wc, fr, fq);
        if (!has_next) break;
#pragma unroll
        for (int a = 0; a < 2; ++a)
#pragma unroll
            for (int b = 0; b < 2; ++b)
#pragma unroll
                for (int m = 0; m < 4; ++m)
#pragma unroll
                    for (int n = 0; n < 2; ++n) acc[a][b][m][n] = (f32x4){0.f, 0.f, 0.f, 0.f};
        cur = nxt; ++ui;
        if constexpr (ALIGN_EPI) { if (wr == 1) PG8_BAR; }
    }
    PG8_WAIT_V(0);
    if constexpr (!ALIGN_EPI) { if (wr == 0) PG8_BAR; }
    PG8_BAR;
#undef PG8_VOFF
#undef PG8_H1
#undef PG8_SA
#undef PG8_SB
#undef PG8_STAGE
#undef PG8_LDA
#undef PG8_LDB
#undef PG8_MMA
#undef PG8_WAIT_V
#undef PG8_WAIT_L
#undef PG8_BAR
#undef PG8_SCHED
}
struct SchedPlain {
    const char* A; const char* B; int nM, nN, lda, ldb, nt, G, c;
    __device__ __forceinline__ bool next(int i, Unit& u) const {
        int pm, pn; if (!static_tile(i, G, c, nM, nN, pm, pn)) return false;
        u.pm = pm; u.pn = pn; u.aux = 0; u.nt = nt; u.lda = lda; u.ldb = ldb; u.a = A + (size_t)pm * BM * lda * 2; u.b = B + (size_t)pn * BM * ldb * 2; return true; }
};
struct SchedMerge {
    const char* XB; const char* WG; const char* Y; const char* WB; int G, c;
    __device__ __forceinline__ bool next(int i, Unit& u) const {
        const int ti = i / 6, sub = i - ti * 6, br = sub >> 1; int pm, pn; if (!static_tile(ti, G, c, 256, 4, pm, pn)) return false;
        u.pm = pm; u.pn = pn; u.aux = sub;
        if ((sub & 1) == 0) { u.nt = 16; u.lda = 1024; u.ldb = 1024; u.a = XB + (size_t)pm * BM * 1024 * 2; u.b = WG + (size_t)(br * 1024 + pn * BM) * 1024 * 2; }
        else { u.nt = 8; u.lda = 1536; u.ldb = 512; u.a = Y + ((size_t)pm * BM * 1536 + br * 512) * 2; u.b = WB + (size_t)(br * 1024 + pn * BM) * 512 * 2; }
        return true; }
};
struct SchedExp {
    const char* A; const char* B; int lda, ldb, nt, total, G, c; size_t bexp; const PG8_LAS int* tab;
    __device__ __forceinline__ bool next(int i, Unit& u) const {
        const long L = (long)i * G + c; if (L >= total) return false;
        int id = (int)L; { const int q = total / NXCD, r = total % NXCD, xcd = id % NXCD, off = id / NXCD; id = (xcd < r ? xcd * (q + 1) : r * (q + 1) + (xcd - r) * q) + off; }
        const int rt = id >> 2, pn = id & 3; const int e = __builtin_amdgcn_readfirstlane(tab[rt]);
        u.pm = rt; u.pn = pn; u.aux = e; u.nt = nt; u.lda = lda; u.ldb = ldb; u.a = A + (size_t)rt * BM * lda * 2; u.b = B + (size_t)e * bexp + (size_t)pn * BM * ldb * 2; return true; }
};
struct EpiBf16 {
    static constexpr bool PERM = true; bf16_t* O; int ldc;
    __device__ __forceinline__ void operator()(const f32x4 (&acc)[2][2][4][2], const Unit& u, int wr, int wc, int fr, int fq) const {
        bf16_t* base = O + (size_t)(u.pm * BM + wr * 64 + fr) * ldc + u.pn * BM + wc * 32 + 8 * fq;
#pragma unroll
        for (int ai = 0; ai < 2; ++ai)
#pragma unroll
            for (int m = 0; m < 4; ++m) { bf16_t* rowp = base + (size_t)(ai * HALF + m * 16) * ldc;
#pragma unroll
                for (int bj = 0; bj < 2; ++bj) { const f32x4 v0 = acc[ai][bj][m][0], v1 = acc[ai][bj][m][1];
                    u32x4 w; w.x = cvt_pk_bf16(v0[0], v0[1]); w.y = cvt_pk_bf16(v0[2], v0[3]); w.z = cvt_pk_bf16(v1[0], v1[1]); w.w = cvt_pk_bf16(v1[2], v1[3]);
                    *(u32x4*)(rowp + bj * HALF) = w; } }
    }
};
struct EpiProj {
    static constexpr bool PERM = true; bf16_t *HG, *DQK, *DV, *MQ; const float* rope;
    __device__ __forceinline__ void operator()(const f32x4 (&acc)[2][2][4][2], const Unit& u, int wr, int wc, int fr, int fq) const {
        const int pn = u.pn; bf16_t* dst; int ld, mode;
        if (pn < 8) { dst = HG + pn * 256; ld = 2048; mode = (pn < 2 || pn >= 6) ? 1 : 0; }
        else if (pn < 12) { dst = DQK + (pn - 8) * 256; ld = 1024; mode = pn < 10 ? 2 : 3; }
        else if (pn < 14) { dst = DV + (pn - 12) * 256; ld = 512; mode = 0; }
        else { dst = MQ + (pn - 14) * 256; ld = 512; mode = 0; }
        const int row0 = u.pm * BM + wr * 64 + fr; const bool rot = (mode >= 2) && ((wc & 1) == 0);
#pragma unroll
        for (int ai = 0; ai < 2; ++ai)
#pragma unroll
            for (int m = 0; m < 4; ++m) { const int row = row0 + ai * HALF + m * 16; bf16_t* rowp = dst + (size_t)row * ld + wc * 32 + 8 * fq;
                f32x4 r0 = {1.f, 0.f, 1.f, 0.f}, r1 = r0, r2 = r0, r3 = r0;
                if (rot) { const f32x4* rp = (const f32x4*)(rope + (size_t)row * 16); r0 = rp[0]; r1 = rp[1]; r2 = rp[2]; r3 = rp[3]; }
#pragma unroll
                for (int bj = 0; bj < 2; ++bj) { f32x4 v0 = acc[ai][bj][m][0], v1 = acc[ai][bj][m][1];
                    if (mode == 1) {
#pragma unroll
                        for (int e = 0; e < 4; ++e) { v0[e] = siluf_(v0[e]); v1[e] = siluf_(v1[e]); } }
                    if (rot) {
                        f32x4 p0, p1;
#pragma unroll
                        for (int e = 0; e < 4; ++e) { p0[e] = __shfl_xor(v0[e], 16); p1[e] = __shfl_xor(v1[e], 16); }
                        const float sg = (fq == 0) ? -1.f : 1.f;
                        if (fq < 2) {
                            v0[0] = v0[0] * r0[0] + sg * p0[0] * r0[1]; v0[1] = v0[1] * r0[2] + sg * p0[1] * r0[3]; v0[2] = v0[2] * r1[0] + sg * p0[2] * r1[1]; v0[3] = v0[3] * r1[2] + sg * p0[3] * r1[3];
                            v1[0] = v1[0] * r2[0] + sg * p1[0] * r2[1]; v1[1] = v1[1] * r2[2] + sg * p1[1] * r2[3]; v1[2] = v1[2] * r3[0] + sg * p1[2] * r3[1]; v1[3] = v1[3] * r3[2] + sg * p1[3] * r3[3]; } }
                    if (mode == 2) { v0 = v0 * QSCALE_DF; v1 = v1 * QSCALE_DF; }
                    u32x4 w; w.x = cvt_pk_bf16(v0[0], v0[1]); w.y = cvt_pk_bf16(v0[2], v0[3]); w.z = cvt_pk_bf16(v1[0], v1[1]); w.w = cvt_pk_bf16(v1[2], v1[3]);
                    *(u32x4*)(rowp + bj * HALF) = w; }
                asm volatile("" ::: "memory"); }
    }
};
__device__ __forceinline__ u32x4 ld16_sc1(const unsigned char* p) {
    const unsigned long long a = __hip_atomic_load((const unsigned long long*)p, __ATOMIC_RELAXED, __HIP_MEMORY_SCOPE_AGENT), b = __hip_atomic_load((const unsigned long long*)p + 1, __ATOMIC_RELAXED, __HIP_MEMORY_SCOPE_AGENT);
    u32x4 r; r.x = (unsigned)a; r.y = (unsigned)(a >> 32); r.z = (unsigned)b; r.w = (unsigned)(b >> 32); return r; }
__device__ __forceinline__ void unpack8(const u32x4 w, float (&o)[8]) {
    o[0] = __uint_as_float(w.x << 16); o[1] = __uint_as_float(w.x & 0xffff0000u); o[2] = __uint_as_float(w.y << 16); o[3] = __uint_as_float(w.y & 0xffff0000u);
    o[4] = __uint_as_float(w.z << 16); o[5] = __uint_as_float(w.z & 0xffff0000u); o[6] = __uint_as_float(w.w << 16); o[7] = __uint_as_float(w.w & 0xffff0000u); }
struct EpiMerge {
    static constexpr bool PERM = true; bf16_t* MG; unsigned char* scrG; unsigned char* scrS;
    static __device__ __forceinline__ void unpack8_(const u32x4 w, float (&o)[8]) {
        o[0] = __uint_as_float(w.x << 16); o[1] = __uint_as_float(w.x & 0xffff0000u); o[2] = __uint_as_float(w.y << 16); o[3] = __uint_as_float(w.y & 0xffff0000u);
        o[4] = __uint_as_float(w.z << 16); o[5] = __uint_as_float(w.z & 0xffff0000u); o[6] = __uint_as_float(w.w << 16); o[7] = __uint_as_float(w.w & 0xffff0000u); }
    __device__ __forceinline__ void operator()(const f32x4 (&acc)[2][2][4][2], const Unit& u, int wr, int wc, int fr, int fq) const {
        const int sub = u.aux, br = sub >> 1; const int wid = wr * 4 + wc, lane = fq * 16 + fr;
        unsigned lo = ((unsigned)wid * 16u * 64u + (unsigned)lane) * 16u; asm volatile("" : "+v"(lo));
        if ((sub & 1) == 0) {
#pragma unroll
            for (int ai = 0; ai < 2; ++ai)
#pragma unroll
                for (int bj = 0; bj < 2; ++bj)
#pragma unroll
                    for (int m = 0; m < 4; ++m) { const int g = (ai * 2 + bj) * 4 + m; const f32x4 v0 = acc[ai][bj][m][0], v1 = acc[ai][bj][m][1];
                        u32x4 w; w.x = cvt_pk_bf16(sigmoidf_(v0[0]), sigmoidf_(v0[1])); w.y = cvt_pk_bf16(sigmoidf_(v0[2]), sigmoidf_(v0[3]));
                        w.z = cvt_pk_bf16(sigmoidf_(v1[0]), sigmoidf_(v1[1])); w.w = cvt_pk_bf16(sigmoidf_(v1[2]), sigmoidf_(v1[3]));
                        *(u32x4*)(scrG + (lo + (unsigned)g * 1024u)) = w; asm volatile("" ::: "memory"); }
        } else {
            bf16_t* base = MG + (size_t)(u.pm * BM + wr * 64 + fr) * 1024 + u.pn * BM + wc * 32 + 8 * fq;
#pragma unroll
            for (int ai = 0; ai < 2; ++ai)
#pragma unroll
                for (int bj = 0; bj < 2; ++bj)
#pragma unroll
                    for (int m = 0; m < 4; ++m) { const int g = (ai * 2 + bj) * 4 + m; const f32x4 v0 = acc[ai][bj][m][0], v1 = acc[ai][bj][m][1];
                        float gt[8], o[8]; unpack8(*(const u32x4*)(scrG + (lo + (unsigned)g * 1024u)), gt);
                        o[0] = gt[0] * v0[0]; o[1] = gt[1] * v0[1]; o[2] = gt[2] * v0[2]; o[3] = gt[3] * v0[3]; o[4] = gt[4] * v1[0]; o[5] = gt[5] * v1[1]; o[6] = gt[6] * v1[2]; o[7] = gt[7] * v1[3];
                        if (br > 0) { float pv[8]; unpack8(*(const u32x4*)(scrS + (lo + (unsigned)g * 1024u)), pv);
#pragma unroll
                            for (int e = 0; e < 8; ++e) o[e] += pv[e]; }
                        u32x4 w; w.x = cvt_pk_bf16(o[0], o[1]); w.y = cvt_pk_bf16(o[2], o[3]); w.z = cvt_pk_bf16(o[4], o[5]); w.w = cvt_pk_bf16(o[6], o[7]);
                        if (br < 2) *(u32x4*)(scrS + (lo + (unsigned)g * 1024u)) = w; else *(u32x4*)(base + (size_t)(ai * HALF + m * 16) * 1024 + bj * HALF) = w;
                        asm volatile("" ::: "memory"); }
        }
    }
};
struct EpiWout {
    static constexpr bool PERM = false; const float* x; float* out;
    __device__ __forceinline__ void operator()(const f32x4 (&acc)[2][2][4][2], const Unit& u, int wr, int wc, int fr, int fq) const {
        const size_t off0 = (size_t)(u.pm * BM + wr * 64 + fr) * 1024 + u.pn * BM + wc * 32 + 4 * fq;
#pragma unroll
        for (int ai = 0; ai < 2; ++ai)
#pragma unroll
            for (int m = 0; m < 4; ++m) { const size_t off = off0 + (size_t)(ai * HALF + m * 16) * 1024;
#pragma unroll
                for (int bj = 0; bj < 2; ++bj)
#pragma unroll
                    for (int n = 0; n < 2; ++n) { const f32x4 xv = *(const f32x4*)(x + off + bj * HALF + n * 16); *(f32x4*)(out + off + bj * HALF + n * 16) = xv * ALPHA + acc[ai][bj][m][n]; }
                if (m & 1) asm volatile("" ::: "memory"); }
    }
};
struct EpiSwiglu {
    static constexpr bool PERM = true; bf16_t* H;
    __device__ __forceinline__ void operator()(const f32x4 (&acc)[2][2][4][2], const Unit& u, int wr, int wc, int fr, int fq) const {
        bf16_t* base = H + (size_t)(u.pm * BM + wr * 64 + fr) * 512 + u.pn * HALF + wc * 32 + 8 * fq;
#pragma unroll
        for (int ai = 0; ai < 2; ++ai)
#pragma unroll
            for (int m = 0; m < 4; ++m) { const f32x4 g0 = acc[ai][0][m][0], g1 = acc[ai][0][m][1], u0 = acc[ai][1][m][0], u1 = acc[ai][1][m][1];
                u32x4 w; w.x = cvt_pk_bf16(siluf_(g0[0]) * u0[0], siluf_(g0[1]) * u0[1]); w.y = cvt_pk_bf16(siluf_(g0[2]) * u0[2], siluf_(g0[3]) * u0[3]);
                w.z = cvt_pk_bf16(siluf_(g1[0]) * u1[0], siluf_(g1[1]) * u1[1]); w.w = cvt_pk_bf16(siluf_(g1[2]) * u1[2], siluf_(g1[3]) * u1[3]);
                *(u32x4*)(base + (size_t)(ai * HALF + m * 16) * 512) = w; }
    }
};
}

#define LASP(p) ((__attribute__((address_space(3))) unsigned char*)(p))
__device__ __forceinline__ void phase_proj_pg8(const Params& p, unsigned char* lds) {
    unsigned char* ws = p.ws;
    { pg8::SchedPlain S{(const char*)(ws + WS_XB), (const char*)(ws + WS_WT_IN), 256, 16, 1024, 1024, 16, (int)gridDim.x, (int)blockIdx.x};
      pg8::EpiProj E{(bf16_t*)(ws + WS_HG), (bf16_t*)(ws + WS_DQK), (bf16_t*)(ws + WS_DV), (bf16_t*)(ws + WS_MQ), (const float*)(ws + WS_ROPE)};
      pg8::gemm_phase<pg8::EpiProj, pg8::SchedPlain, true>(LASP(lds), S, E); }
    { pg8::SchedPlain S{(const char*)(ws + WS_MEMB), (const char*)(ws + WS_WT_MKV), 16, 4, 1024, 1024, 16, (int)gridDim.x, (int)blockIdx.x};
      pg8::EpiBf16 E{(bf16_t*)(ws + WS_MKV), 1024};
      pg8::gemm_phase<pg8::EpiBf16, pg8::SchedPlain, true>(LASP(lds), S, E); }
}
constexpr size_t WS_SCR = WS_DQK;
__device__ __forceinline__ void phase_merge_pg8(const Params& p, unsigned char* lds) {
    unsigned char* ws = p.ws;
    pg8::SchedMerge S{(const char*)(ws + WS_XB), (const char*)(ws + WS_WT_G), (const char*)(ws + WS_Y), (const char*)(ws + WS_WT_B), (int)gridDim.x, (int)blockIdx.x};
    pg8::EpiMerge E{(bf16_t*)(ws + WS_MERGED), ws + WS_SCR + (size_t)blockIdx.x * 262144, ws + WS_SCR + (size_t)blockIdx.x * 262144 + 131072};
    pg8::gemm_phase<pg8::EpiMerge, pg8::SchedMerge, true>(LASP(lds), S, E);
}
__device__ __forceinline__ void phase_wout_pg8(const Params& p, unsigned char* lds) {
    unsigned char* ws = p.ws;
    pg8::SchedPlain S{(const char*)(ws + WS_MERGED), (const char*)(ws + WS_WT_OUT), 256, 4, 1024, 1024, 16, (int)gridDim.x, (int)blockIdx.x};
    pg8::EpiWout E{(const float*)p.in[0], p.out};
    pg8::gemm_phase<pg8::EpiWout, pg8::SchedPlain, true>(LASP(lds), S, E);
}
constexpr int LDS_TAB = 131072;
__device__ __forceinline__ int exp_table(const Params& p, unsigned char* lds) {
    const int lane = threadIdx.x & 63; int tiles, endi; const int nt256 = expert_layout((const int*)(p.ws + WS_CTL), lane, tiles, endi);
    int* tab = (int*)(lds + LDS_TAB);
    for (int rt = threadIdx.x >> 6; rt < nt256; rt += 8) { const int e = expert_of_tile(rt, lane, endi); if (lane == 0) tab[rt] = e; }
    __syncthreads(); return nt256;
}
__device__ __forceinline__ void phase_exp_gu_pg8(const Params& p, unsigned char* lds) {
    unsigned char* ws = p.ws; const int nt256 = exp_table(p, lds);
    pg8::SchedExp S{(const char*)(ws + WS_XS), (const char*)(ws + WS_WT_GU), 1024, 1024, 16, nt256 * 4, (int)gridDim.x, (int)blockIdx.x, (size_t)1024 * 1024 * 2, (const __attribute__((address_space(3))) int*)LASP(lds + LDS_TAB)};
    pg8::EpiSwiglu E{(bf16_t*)(ws + WS_H)};
    pg8::gemm_phase<pg8::EpiSwiglu, pg8::SchedExp, true>(LASP(lds), S, E);
}
__device__ __forceinline__ void phase_exp_dn_pg8(const Params& p, unsigned char* lds) {
    unsigned char* ws = p.ws; const int nt256 = exp_table(p, lds);
    pg8::SchedExp S{(const char*)(ws + WS_H), (const char*)(ws + WS_WT_DN), 512, 512, 8, nt256 * 4, (int)gridDim.x, (int)blockIdx.x, (size_t)1024 * 512 * 2, (const __attribute__((address_space(3))) int*)LASP(lds + LDS_TAB)};
    pg8::EpiBf16 E{(bf16_t*)(ws + WS_YB), 1024};
    pg8::gemm_phase<pg8::EpiBf16, pg8::SchedExp, true>(LASP(lds), S, E);
}

#include <hip/hip_bf16.h>
namespace attn64 {
using bf16=__hip_bfloat16;
using bf16x8=__attribute__((ext_vector_type(8)))short;
using s16x4=__attribute__((ext_vector_type(4)))short;
using f32x16=__attribute__((ext_vector_type(16)))float;
using u32x4=__attribute__((ext_vector_type(4)))unsigned;
constexpr int SEQ=4096,D=64;
constexpr int NW=8,QBLK=32,QB=QBLK*NW,KVBLK=64,NQB=SEQ/QB;
constexpr int ATTN_UNIT_ROWS=QB;
__device__ __forceinline__ int crow(int r,int hi){return (r&3)+8*(r>>2)+4*hi;}
#define SBAR() __builtin_amdgcn_sched_barrier(0)
__device__ __forceinline__ void cmask(f32x16&p0,f32x16&p1,int jb,int qrel,int hi){
  const float NEG=-INFINITY; const int dq=qrel-64*jb-4*hi;
  #pragma unroll
  for(int r=0;r<16;++r){const int c=(r&3)+8*(r>>2); if(c>dq)p0[r]=NEG; if(c+32>dq)p1[r]=NEG;}
}

constexpr int NSLOT=3, SLOTB=8192;
constexpr int LDS_K=0, LDS_V=NSLOT*SLOTB, LDS_WS=2*NSLOT*SLOTB, LDS_OST=LDS_WS+NW*64*4, LDS_BYTES=LDS_OST+NW*4096;
constexpr float C2=0.125f*1.4426950408889634f;
__device__ __forceinline__ void glds16(const void*gsrc,unsigned lds_dst){unsigned keep;
  asm volatile("s_mov_b32 %0, m0\n\ts_mov_b32 m0, %2\n\ts_nop 0\n\tglobal_load_lds_dwordx4 %1, off\n\ts_mov_b32 m0, %0":"=&s"(keep):"v"(gsrc),"s"(lds_dst):"memory");}
__device__ __forceinline__ float max3f(float a,float b,float c){float r;asm("v_max3_f32 %0, %1, %2, %3":"=v"(r):"v"(a),"v"(b),"v"(c));return r;}
__device__ __forceinline__ float max2f(float a,float b){float r;asm("v_max_f32_e32 %0, %1, %2":"=v"(r):"v"(a),"v"(b));return r;}
__device__ __forceinline__ float fadd_s(float a,float b){float r;asm("v_add_f32_e32 %0, %1, %2":"=v"(r):"v"(a),"v"(b));return r;}
__device__ __forceinline__ float fsub_s(float a,float b){float r;asm("v_sub_f32_e32 %0, %1, %2":"=v"(r):"v"(a),"v"(b));return r;}
typedef float f32x2_t __attribute__((ext_vector_type(2))); typedef __bf16 bf16x2_t __attribute__((ext_vector_type(2)));
__device__ __forceinline__ unsigned cvtpk_s(float lo,float hi){f32x2_t v={lo,hi};bf16x2_t b=__builtin_convertvector(v,bf16x2_t);return __builtin_bit_cast(unsigned,b);}
#define WAIT_BAR(N) asm volatile("s_waitcnt vmcnt(" #N ") lgkmcnt(0)\n\ts_barrier":::"memory")

__device__ __forceinline__ void qkt(f32x16&p0,f32x16&p1,const char*Kslot,const bf16x8*qr,const f32x16&negm,int r32,int hi){
  const char*kb=Kslot+hi*1024+r32*16;
  #pragma unroll
  for(int d0=0;d0<4;++d0){
    const bf16x8 b0=*reinterpret_cast<const bf16x8*>(kb+d0*2048);
    const bf16x8 b1=*reinterpret_cast<const bf16x8*>(kb+d0*2048+512);
    if(d0==0){p0=__builtin_amdgcn_mfma_f32_32x32x16_bf16(b0,qr[0],negm,0,0,0);p1=__builtin_amdgcn_mfma_f32_32x32x16_bf16(b1,qr[0],negm,0,0,0);}
    else{p0=__builtin_amdgcn_mfma_f32_32x32x16_bf16(b0,qr[d0],p0,0,0,0);p1=__builtin_amdgcn_mfma_f32_32x32x16_bf16(b1,qr[d0],p1,0,0,0);}}
}
typedef __attribute__((address_space(3))) const char* lds_cptr;
typedef short v4i16_t __attribute__((ext_vector_type(4)));
__device__ __forceinline__ void kload8(bf16x8*kf,lds_cptr kp){
  kf[0]=*(const __attribute__((address_space(3))) bf16x8*)(kp);      kf[1]=*(const __attribute__((address_space(3))) bf16x8*)(kp+512);
  kf[2]=*(const __attribute__((address_space(3))) bf16x8*)(kp+2048); kf[3]=*(const __attribute__((address_space(3))) bf16x8*)(kp+2560);
  kf[4]=*(const __attribute__((address_space(3))) bf16x8*)(kp+4096); kf[5]=*(const __attribute__((address_space(3))) bf16x8*)(kp+4608);
  kf[6]=*(const __attribute__((address_space(3))) bf16x8*)(kp+6144); kf[7]=*(const __attribute__((address_space(3))) bf16x8*)(kp+6656);
}
__device__ __forceinline__ void kload2(bf16x8*kf,lds_cptr kp,int j){ kf[2*j]=*(const __attribute__((address_space(3))) bf16x8*)(kp+j*2048); kf[2*j+1]=*(const __attribute__((address_space(3))) bf16x8*)(kp+j*2048+512); }
__device__ __forceinline__ s16x4 vtr(lds_cptr p){ return __builtin_bit_cast(s16x4,__builtin_amdgcn_ds_read_tr16_b64_v4i16((__attribute__((address_space(3))) v4i16_t*)p)); }
__device__ __forceinline__ float rowmax(const f32x16&p0,const f32x16&p1){
  float a=max3f(p0[0],p0[1],p1[0]),b=max3f(p0[2],p0[3],p1[1]);a=max3f(a,p1[2],p1[3]);
  #pragma unroll
  for(int r=4;r<16;r+=4){a=max3f(a,p0[r],p0[r+1]);b=max3f(b,p0[r+2],p0[r+3]);a=max3f(a,p1[r],p1[r+1]);b=max3f(b,p1[r+2],p1[r+3]);}
  const float m=max2f(a,b);
  auto rr=__builtin_amdgcn_permlane32_swap(__float_as_uint(m),__float_as_uint(m),false,false);
  return max2f(__uint_as_float(rr[0]),__uint_as_float(rr[1]));
}
__device__ __forceinline__ void pv(f32x16*o,int vb,bf16x8 pa0,bf16x8 pa1,bf16x8 pa2,bf16x8 pa3){
  #pragma unroll
  for(int d0=0;d0<2;++d0){s16x4 lo[4],hi[4];
    #pragma unroll
    for(int ks=0;ks<4;++ks){
      asm volatile("ds_read_b64_tr_b16 %0,%1 offset:%c2":"=&v"(lo[ks]):"v"(vb),"i"(d0*4096+ks*1024):"memory");
      asm volatile("ds_read_b64_tr_b16 %0,%1 offset:%c2":"=&v"(hi[ks]):"v"(vb),"i"(d0*4096+ks*1024+512):"memory");}
    asm volatile("s_waitcnt lgkmcnt(0)":::"memory");SBAR();
    #define PK(k) (bf16x8){lo[k][0],lo[k][1],lo[k][2],lo[k][3],hi[k][0],hi[k][1],hi[k][2],hi[k][3]}
    o[d0]=__builtin_amdgcn_mfma_f32_32x32x16_bf16(pa0,PK(0),o[d0],0,0,0);
    o[d0]=__builtin_amdgcn_mfma_f32_32x32x16_bf16(pa1,PK(1),o[d0],0,0,0);
    o[d0]=__builtin_amdgcn_mfma_f32_32x32x16_bf16(pa2,PK(2),o[d0],0,0,0);
    o[d0]=__builtin_amdgcn_mfma_f32_32x32x16_bf16(pa3,PK(3),o[d0],0,0,0);
    #undef PK
  }
}

#ifndef ATTN_STORE16
#define ATTN_STORE16(p,v) (*(u32x4*)(p)=(v))
#endif
template<int THRL,int PQ,int PK,int PV,int PO> __device__ __forceinline__ void attn_unit(int qb,const bf16*Qs,const bf16*__restrict__ Ks,const bf16*__restrict__ Vs,bf16*Os,char*shm){
  const int tid=threadIdx.x,lane=tid&63,r32=lane&31,hi=lane>>5; const int wid=__builtin_amdgcn_readfirstlane(tid>>6);
  const int q0=qb*QB;
  const bf16*Qw=Qs+(long)(q0+wid*QBLK)*PQ;
  const bf16*Kh=Ks,*Vh=Vs;
  const unsigned lds0=(unsigned)(uintptr_t)shm;
  float*wsf=(float*)(shm+LDS_WS)+wid*64;
  const bf16*ksrc=Kh+(long)lane*PK+wid*8;
  const bf16*vsrc=Vh+(long)(16*(wid&3)+(lane>>2))*PV+(wid>>2)*32+(lane&3)*8;
  const unsigned kdst=lds0+LDS_K+wid*1024, vdst=lds0+LDS_V+wid*1024;
  #define DMA_K(t,slot) glds16(ksrc+(long)(t)*KVBLK*PK,(unsigned)__builtin_amdgcn_readfirstlane(kdst+(slot)))
  #define DMA_V(t,slot) glds16(vsrc+(long)(t)*KVBLK*PV,(unsigned)__builtin_amdgcn_readfirstlane(vdst+(slot)))
  const int vb0=(int)(lds0+LDS_V)+((lane>>4)&1)*32+(lane&3)*8+(4*hi+((lane&15)>>2))*64;
  const char*Kbase=shm+LDS_K; bf16x8 kf[8];
  const lds_cptr shm3=(lds_cptr)shm; const lds_cptr kp0=shm3+LDS_K+hi*1024+r32*16; const lds_cptr vp0=shm3+LDS_V+((lane>>4)&1)*32+(lane&3)*8+(4*hi+((lane&15)>>2))*64;
  const int NT=(q0+QB)/KVBLK;
  DMA_K(0,0);DMA_V(0,0);DMA_K(1,SLOTB);
  bf16x8 qr[4];
  #pragma unroll
  for(int d0=0;d0<4;++d0)qr[d0]=*reinterpret_cast<const bf16x8*>(&Qw[(long)r32*PQ+d0*16+hi*8]);
  float mhat=0.f,l_reg=0.f;f32x16 o[2];f32x16 negm;{float z_=0.f;asm volatile("":"+v"(z_));
  _Pragma("unroll") for(int r=0;r<16;++r){o[0][r]=z_;o[1][r]=z_;negm[r]=z_;}}asm volatile("":"+v"(negm));
  const int qrel=wid*QBLK+r32;
  #define CMASK(P0,P1,t) do{int jb_=(t)-(NT-4); if(jb_>=0)cmask(P0,P1,jb_,qrel,hi);}while(0)
  bool resc=false;
  #define START(P0,P1) do{ const float rm=rowmax(P0,P1); resc=false; \
    { const float dl=rm; mhat=fadd_s(mhat,dl); \
      _Pragma("unroll") for(int r=0;r<16;++r){P0[r]=fsub_s(P0[r],dl);P1[r]=fsub_s(P1[r],dl);} \
      _Pragma("unroll") for(int r=0;r<16;++r)negm[r]=-mhat; asm volatile("":"+v"(negm)); } \
    _Pragma("unroll") for(int r=0;r<16;++r)P0[r]=__builtin_amdgcn_exp2f(P0[r]); }while(0)
  #define RESC() do{ if(resc){ asm volatile("s_waitcnt lgkmcnt(0)":::"memory"); \
      _Pragma("unroll") for(int d_=0;d_<2;++d_) _Pragma("unroll") for(int r=0;r<16;++r)o[d_][r]*=wsf[crow(r,hi)]; } }while(0)
  f32x16 pA0,pA1,pB0,pB1;
  int sl_prev=0,sl_cur=0,sl_next=SLOTB;
  #define ROT() do{sl_prev=sl_cur;sl_cur=sl_next;sl_next=(sl_next==(NSLOT-1)*SLOTB)?0:sl_next+SLOTB;}while(0)
  DMA_K(2,2*SLOTB);
  WAIT_BAR(3);
  qkt(pA0,pA1,Kbase,qr,negm,r32,hi);asm volatile("s_nop 15\n\ts_nop 7":"+v"(pA0),"+v"(pA1));CMASK(pA0,pA1,0);
  START(pA0,pA1);
  _Pragma("unroll") for(int r=0;r<16;++r)pA1[r]=__builtin_amdgcn_exp2f(pA1[r]);
  WAIT_BAR(0);
  DMA_K(3,0);DMA_V(1,SLOTB);
  ROT();
  kload8(kf,kp0+sl_cur);
  WAIT_BAR(2);
  s16x4 vlo[8],vhi[8]; u32x4 pw0,pw1,pw2,pw3;
  #define PKW(P,B) cvtpk_s(P[B],P[B+1])
  #define PAF(k) __builtin_bit_cast(bf16x8,pw##k)
  #define VFR(i) (bf16x8){vlo[i][0],vlo[i][1],vlo[i][2],vlo[i][3],vhi[i][0],vhi[i][1],vhi[i][2],vhi[i][3]}
  #define PIN(x) asm volatile("":"+v"(x))
  #define MX3(a,b,c) __builtin_fmaxf(__builtin_fmaxf((a),(b)),(c))
  #define GAPA(MF,A0,A1,A2,A3,W0,W1,PW) do{ MF; sacc+=A0; sacc+=A1; sacc+=A2; sacc+=A3; PIN(sacc); W0; W1; PIN(PW); SBAR(); }while(0)
  #define EX(v) __builtin_amdgcn_exp2f(v)
  #define GAPB(MF,X,B) do{ MF; X[B]=EX(X[B]); X[B+1]=EX(X[B+1]); X[B+2]=EX(X[B+2]); X[B+3]=EX(X[B+3]); PIN(X); SBAR(); }while(0)
  #define VRD(i) do{ vlo[i]=vtr(vp_+(((i)>>2)*4096+((i)&3)*1024)); vhi[i]=vtr(vp_+(((i)>>2)*4096+((i)&3)*1024+512)); }while(0)
  #define KRD(G,j) do{ if(G){ kload2(kf,kp0+sl_next,j); SBAR(); } }while(0)
  #define STEP(C0,C1,P0,P1,t,GK,GV,GL) do{ SBAR(); \
    const lds_cptr vp_=vp0+sl_prev; \
    VRD(0); SBAR(); float sacc=(P0[0]+P0[1]); \
    GAPA(C0=__builtin_amdgcn_mfma_f32_32x32x16_bf16(kf[0],qr[0],negm,0,0,0), P0[2],P0[3],P0[4],P0[5],     pw0[0]=PKW(P0,0), pw0[1]=PKW(P0,2), pw0); \
    VRD(4); SBAR(); GAPA(C1=__builtin_amdgcn_mfma_f32_32x32x16_bf16(kf[1],qr[0],negm,0,0,0), P0[6],P0[7],P0[8],P0[9],     pw0[2]=PKW(P0,4), pw0[3]=PKW(P0,6), pw0); \
    VRD(1); SBAR(); GAPA(C0=__builtin_amdgcn_mfma_f32_32x32x16_bf16(kf[2],qr[1],C0,0,0,0),   P0[10],P0[11],P0[12],P0[13], pw1[0]=PKW(P0,8), pw1[1]=PKW(P0,10), pw1); \
    VRD(5); SBAR(); GAPA(C1=__builtin_amdgcn_mfma_f32_32x32x16_bf16(kf[3],qr[1],C1,0,0,0),   P0[14],P0[15],P1[0],P1[1],   pw1[2]=PKW(P0,12),pw1[3]=PKW(P0,14), pw1); \
    VRD(2); SBAR(); GAPA(C0=__builtin_amdgcn_mfma_f32_32x32x16_bf16(kf[4],qr[2],C0,0,0,0),   P1[2],P1[3],P1[4],P1[5],     pw2[0]=PKW(P1,0), pw2[1]=PKW(P1,2), pw2); \
    VRD(6); SBAR(); GAPA(C1=__builtin_amdgcn_mfma_f32_32x32x16_bf16(kf[5],qr[2],C1,0,0,0),   P1[6],P1[7],P1[8],P1[9],     pw2[2]=PKW(P1,4), pw2[3]=PKW(P1,6), pw2); \
    VRD(3); SBAR(); GAPA(C0=__builtin_amdgcn_mfma_f32_32x32x16_bf16(kf[6],qr[3],C0,0,0,0),   P1[10],P1[11],P1[12],P1[13], pw3[0]=PKW(P1,8), pw3[1]=PKW(P1,10), pw3); \
    VRD(7); SBAR(); GAPA(C1=__builtin_amdgcn_mfma_f32_32x32x16_bf16(kf[7],qr[3],C1,0,0,0),   P1[14],P1[15],0.f,0.f,       pw3[2]=PKW(P1,12),pw3[3]=PKW(P1,14), pw3); \
    l_reg+=sacc; \
    if(GK){DMA_K((t)+3,sl_cur);} if(GV){DMA_V((t)+1,sl_next);} \
    CMASK(C0,C1,t); \
    { float a=MX3(C0[0],C0[1],C1[0]),b=MX3(C0[2],C0[3],C1[1]); a=MX3(a,C1[2],C1[3]); \
      _Pragma("unroll") for(int r=4;r<16;r+=4){a=MX3(a,C0[r],C0[r+1]);b=MX3(b,C0[r+2],C0[r+3]);a=MX3(a,C1[r],C1[r+1]);b=MX3(b,C1[r+2],C1[r+3]);} \
      float rm=__builtin_fmaxf(a,b); { auto rr=__builtin_amdgcn_permlane32_swap(__float_as_uint(rm),__float_as_uint(rm),false,false); rm=__builtin_fmaxf(__uint_as_float(rr[0]),__uint_as_float(rr[1])); } \
      resc=false; \
      if(__builtin_expect(__any(rm>(float)THRL),0)){ const float dl=__builtin_fmaxf(rm,0.f); mhat+=dl; \
        _Pragma("unroll") for(int r=0;r<16;++r){C0[r]-=dl;C1[r]-=dl;} \
        _Pragma("unroll") for(int r=0;r<16;++r)negm[r]=-mhat; asm volatile("":"+v"(negm)); \
        const float f=__builtin_amdgcn_exp2f(-dl); l_reg*=f; if(hi==0)wsf[r32]=f; resc=true; } } \
    SBAR(); \
    GAPB(o[0]=__builtin_amdgcn_mfma_f32_32x32x16_bf16(PAF(0),VFR(0),o[0],0,0,0), C0,0); \
    GAPB(o[1]=__builtin_amdgcn_mfma_f32_32x32x16_bf16(PAF(0),VFR(4),o[1],0,0,0), C0,4); \
    KRD(GL,0); GAPB(o[0]=__builtin_amdgcn_mfma_f32_32x32x16_bf16(PAF(1),VFR(1),o[0],0,0,0), C0,8); \
    KRD(GL,1); GAPB(o[1]=__builtin_amdgcn_mfma_f32_32x32x16_bf16(PAF(1),VFR(5),o[1],0,0,0), C0,12); \
    KRD(GL,2); GAPB(o[0]=__builtin_amdgcn_mfma_f32_32x32x16_bf16(PAF(2),VFR(2),o[0],0,0,0), C1,0); \
    KRD(GL,3); GAPB(o[1]=__builtin_amdgcn_mfma_f32_32x32x16_bf16(PAF(2),VFR(6),o[1],0,0,0), C1,4); \
    GAPB(o[0]=__builtin_amdgcn_mfma_f32_32x32x16_bf16(PAF(3),VFR(3),o[0],0,0,0), C1,8); \
    GAPB(o[1]=__builtin_amdgcn_mfma_f32_32x32x16_bf16(PAF(3),VFR(7),o[1],0,0,0), C1,12); \
    }while(0)
  int t=1;
  #undef CMASK
  #define CMASK(P0,P1,t) do{}while(0)
  for(;t+5<NT;t+=2){
    STEP(pB0,pB1,pA0,pA1,t,true,true,true);     WAIT_BAR(2); RESC(); ROT();
    STEP(pA0,pA1,pB0,pB1,t+1,true,true,true);   WAIT_BAR(2); RESC(); ROT();
  }
  #undef CMASK
  #define CMASK(P0,P1,t) do{int jb_=(t)-(NT-4); if(jb_>=0)cmask(P0,P1,jb_,qrel,hi);}while(0)
  #define ENDW(tt) do{ if((tt)+3<NT){WAIT_BAR(2);} else if((tt)+2<NT){WAIT_BAR(1);} else {WAIT_BAR(0);} }while(0)
  for(;t+1<NT;t+=2){
    STEP(pB0,pB1,pA0,pA1,t,(t+3<NT),(t+1<NT),(t+1<NT));       ENDW(t);   RESC(); ROT();
    STEP(pA0,pA1,pB0,pB1,t+1,(t+4<NT),(t+2<NT),(t+2<NT));     ENDW(t+1); RESC(); ROT();
  }
  STEP(pB0,pB1,pA0,pA1,NT-1,false,false,false); RESC();
  { float sacc=pB0[0]+pB0[1]; _Pragma("unroll") for(int r=2;r<16;++r)sacc+=pB0[r]; _Pragma("unroll") for(int r=0;r<16;++r)sacc+=pB1[r]; l_reg+=sacc;
    pw0=(u32x4){PKW(pB0,0),PKW(pB0,2),PKW(pB0,4),PKW(pB0,6)};pw1=(u32x4){PKW(pB0,8),PKW(pB0,10),PKW(pB0,12),PKW(pB0,14)};pw2=(u32x4){PKW(pB1,0),PKW(pB1,2),PKW(pB1,4),PKW(pB1,6)};pw3=(u32x4){PKW(pB1,8),PKW(pB1,10),PKW(pB1,12),PKW(pB1,14)};
    SBAR(); pv(o,vb0+sl_cur,PAF(0),PAF(1),PAF(2),PAF(3)); }
  #undef PKW
  #undef PAF
  #undef VFR
  #undef PIN
  #undef MX3
  #undef GAPA
  #undef GAPB
  #undef EX
  #undef VRD
  #undef KRD
  #undef STEP
  #undef ENDW
  {auto rr=__builtin_amdgcn_permlane32_swap(__float_as_uint(l_reg),__float_as_uint(l_reg),false,false);l_reg=__uint_as_float(rr[0])+__uint_as_float(rr[1]);}
  if(hi==0)wsf[32+r32]=l_reg;asm volatile("s_waitcnt lgkmcnt(0)":::"memory");
  float rli[16];
  #pragma unroll
  for(int r=0;r<16;++r)rli[r]=__builtin_amdgcn_rcpf(wsf[32+crow(r,hi)]);
  bf16*Ow=Os+(long)(q0+wid*QBLK)*PO;
  { bf16*stg=(bf16*)(shm+LDS_OST)+wid*2048;
    #pragma unroll
    for(int r=0;r<16;++r){const int orow=crow(r,hi);
      #pragma unroll
      for(int d0=0;d0<2;++d0)stg[orow*64+d0*32+r32]=__float2bfloat16(o[d0][r]*rli[r]);}
    asm volatile("s_waitcnt lgkmcnt(0)":::"memory");
    #pragma unroll
    for(int i=0;i<4;++i){const int row=i*8+(lane>>3),ch=lane&7; const u32x4 v=*(const u32x4*)(stg+row*64+ch*8); ATTN_STORE16(Ow+(long)row*PO+ch*8,v);} }
  asm volatile("s_waitcnt lgkmcnt(0)\n\ts_barrier":::"memory");
  #undef DMA_K
  #undef DMA_V
  #undef CMASK
  #undef START
  #undef RESC
  #undef ROT
}
constexpr int ATTN_LDS_BYTES=LDS_BYTES;
#undef SBAR
#undef WAIT_BAR
}

__device__ __forceinline__ void phase_diffattn(const Params& p, unsigned char* lds) {
    using attn64::bf16; unsigned char* ws = p.ws;
    const bf16* DQK = (const bf16*)(ws + WS_DQK); const bf16* DV = (const bf16*)(ws + WS_DV); bf16* O12 = (bf16*)p.out + (size_t)NTOK * 1024;
    const int G = gridDim.x, bx = blockIdx.x; const int vcu = (G % 8 == 0) ? (bx % 8) * (G / 8) + bx / 8 : bx;
    for (int vh = vcu; vh < 256; vh += G) {
        const int bh = vh >> 2, run = vh & 3, b = bh >> 2, h = bh & 3; const size_t row0 = (size_t)b * SEQ;
        const bf16* Qs = DQK + row0 * 1024 + (run >> 1) * 256 + h * 64; const bf16* Ks = DQK + row0 * 1024 + 512 + (run >> 1) * 256 + h * 64;
        const bf16* Vs = DV + row0 * 512 + h * 128 + (run & 1) * 64; bf16* Os = O12 + row0 * 1024 + h * 256 + run * 64;
        for (int qb = 15; qb >= 0; --qb) attn64::attn_unit<8, 1024, 1024, 512, 1024>(qb, Qs, Ks, Vs, Os, (char*)lds);
    }
}
__device__ __forceinline__ void phase_diffcombine(const Params& p, unsigned char* lds) {
    unsigned char* ws = p.ws; const bf16_t* O12 = (const bf16_t*)p.out + (size_t)NTOK * 1024; bf16_t* Y = (bf16_t*)(ws + WS_Y);
    const float lam = ((const float*)(ws + WS_SCAL))[512]; const float* sub_gain = (const float*)p.in[11];
    const int lane = threadIdx.x & 63, wave = threadIdx.x >> 6; const int gw = blockIdx.x * 8 + wave, ngw = gridDim.x * 8;
    const int h = lane >> 4, d0 = (lane & 15) * 8;
    float gn[8];
#pragma unroll
    for (int e = 0; e < 8; ++e) gn[e] = sub_gain[d0 + e] * (1.f - LAM_INIT);
    for (int t = gw; t < NTOK; t += ngw) {
        const u32x4 a = *(const u32x4*)(O12 + (size_t)t * 1024 + h * 256 + d0), b = *(const u32x4*)(O12 + (size_t)t * 1024 + h * 256 + 128 + d0);
        float o1[8], o2[8], o[8]; pg8::unpack8(a, o1); pg8::unpack8(b, o2); float sq = 0.f;
#pragma unroll
        for (int e = 0; e < 8; ++e) { o[e] = o1[e] - lam * o2[e]; sq += o[e] * o[e]; }
        sq += __shfl_xor(sq, 1); sq += __shfl_xor(sq, 2); sq += __shfl_xor(sq, 4); sq += __shfl_xor(sq, 8);
        const float rs = rsqrtf(sq * (1.f / 128.f) + RMS_EPS);
        u32x4 w; w.x = pk2(o[0] * rs * gn[0], o[1] * rs * gn[1]); w.y = pk2(o[2] * rs * gn[2], o[3] * rs * gn[3]); w.z = pk2(o[4] * rs * gn[4], o[5] * rs * gn[5]); w.w = pk2(o[6] * rs * gn[6], o[7] * rs * gn[7]);
        *(u32x4*)(Y + (size_t)t * 1536 + 512 + h * 128 + d0) = w;
    }
}

namespace attnd {
using bf16 = __hip_bfloat16;
constexpr int D = 128, NW = 8, QBLK = 32, KVBLK = 64;
constexpr float SCALE = 0.088388347648318440f;
constexpr float THR = 8.f;
constexpr int SDEPTH = 2;
constexpr int LDQ = 512, LDK = 1024, LDO = 1536;
constexpr size_t SHM_V = KVBLK * D * 2, SHM_K = KVBLK * D * 2, SHM_ATTN = 2 * SHM_V + 2 * SHM_K + NW * 64 * 4;
using bf16x8 = __attribute__((ext_vector_type(8))) short;
using s16x4  = __attribute__((ext_vector_type(4))) short;
using f32x16 = __attribute__((ext_vector_type(16))) float;
using f32x8  = __attribute__((ext_vector_type(8))) float;
using u32x4  = __attribute__((ext_vector_type(4))) unsigned;
#define KSWZ_D(row, colB) ((row) * 256 + ((colB) ^ (((row) & 7) << 4)))
#define SBAR_D() __builtin_amdgcn_sched_barrier(0)
__device__ __forceinline__ int crow(int r, int hi) { return (r & 3) + 8 * (r >> 2) + 4 * hi; }
__device__ __forceinline__ unsigned cvtpk(float lo, float hi) { return pg8::cvt_pk_bf16(lo, hi); }
template <typename TIn> struct Stage;
template <> struct Stage<bf16>  { using T = bf16x8;
  __device__ static __forceinline__ T ld8(const bf16* p) { return *reinterpret_cast<const bf16x8*>(p); }
  __device__ static __forceinline__ bf16x8 tobf(T x) { return x; } };
template <> struct Stage<float> { using T = f32x8;
  __device__ static __forceinline__ T ld8(const float* p) { return *reinterpret_cast<const f32x8*>(p); }
  __device__ static __forceinline__ bf16x8 tobf(T x) {
    u32x4 w = {cvtpk(x[0], x[1]), cvtpk(x[2], x[3]), cvtpk(x[4], x[5]), cvtpk(x[6], x[7])}; return *reinterpret_cast<bf16x8*>(&w); } };

__device__ __forceinline__ void partialSM(f32x16& p0, f32x16& p1, float& m_reg, float& mn, float& alpha) {
  constexpr float C = SCALE * 1.4426950408889634f;
  float pmax = p0[0]; for (int r = 1; r < 16; ++r) pmax = fmaxf(pmax, p0[r]); for (int r = 0; r < 16; ++r) pmax = fmaxf(pmax, p1[r]);
  { auto rr = __builtin_amdgcn_permlane32_swap(__float_as_uint(pmax), __float_as_uint(pmax), false, false);
    pmax = fmaxf(__uint_as_float(rr[0]), __uint_as_float(rr[1])); }
  if (__builtin_expect(__all(pmax - m_reg <= THR / SCALE), 1)) { mn = m_reg; alpha = 1.f; }
  else { mn = fmaxf(m_reg, pmax); alpha = __builtin_amdgcn_exp2f((m_reg - mn) * C); m_reg = mn; }
  float mnC = -mn * C;
  for (int r = 0; r < 16; ++r) p0[r] = fmaf(p0[r], C, mnC); for (int r = 0; r < 16; ++r) p1[r] = fmaf(p1[r], C, mnC);
  for (int r = 0; r < 16; ++r) p0[r] = __builtin_amdgcn_exp2f(p0[r]);
}
__device__ __forceinline__ void finishSM(f32x16& p0, f32x16& p1, float alpha, float& l_reg, bf16x8& pa0, bf16x8& pa1, bf16x8& pa2, bf16x8& pa3) {
  for (int r = 0; r < 16; ++r) p1[r] = __builtin_amdgcn_exp2f(p1[r]);
  float ps = 0; for (int r = 0; r < 16; ++r) ps += p0[r]; for (int r = 0; r < 16; ++r) ps += p1[r];
  { auto rr = __builtin_amdgcn_permlane32_swap(__float_as_uint(ps), __float_as_uint(ps), false, false);
    ps = __uint_as_float(rr[0]) + __uint_as_float(rr[1]); }
  l_reg = l_reg * alpha + ps;
#define PK4(P, BASE, OUT) do { unsigned a0 = cvtpk(P[BASE + 0], P[BASE + 1]), a1 = cvtpk(P[BASE + 2], P[BASE + 3]);   \
    unsigned b0 = cvtpk(P[BASE + 4], P[BASE + 5]), b1 = cvtpk(P[BASE + 6], P[BASE + 7]);                              \
    auto r0 = __builtin_amdgcn_permlane32_swap(a0, b0, false, false); auto r1 = __builtin_amdgcn_permlane32_swap(a1, b1, false, false); \
    u32x4 w = {r0[0], r1[0], r0[1], r1[1]}; OUT = *reinterpret_cast<bf16x8*>(&w); } while (0)
  PK4(p0, 0, pa0); PK4(p0, 8, pa1); PK4(p1, 0, pa2); PK4(p1, 8, pa3);
#undef PK4
}
__device__ __forceinline__ void qkt(f32x16& p0, f32x16& p1, const bf16* Ks, const bf16x8* qr, int r32, int hi) {
  p0 = f32x16{}; p1 = f32x16{};
  for (int d0 = 0; d0 < 8; ++d0) { int cb = (d0 * 16 + hi * 8) * 2;
    bf16x8 b0 = *reinterpret_cast<const bf16x8*>((const char*)Ks + KSWZ_D(r32, cb));
    bf16x8 b1 = *reinterpret_cast<const bf16x8*>((const char*)Ks + KSWZ_D(32 + r32, cb));
    p0 = __builtin_amdgcn_mfma_f32_32x32x16_bf16(b0, qr[d0], p0, 0, 0, 0);
    p1 = __builtin_amdgcn_mfma_f32_32x32x16_bf16(b1, qr[d0], p1, 0, 0, 0); }
}
__device__ __forceinline__ int v_st(int k, int c) { const int kk = (k & ~0xC) | ((k & 4) << 1) | ((k & 8) >> 1); return ((kk >> 3) * 4 + (c >> 5)) * 512 + ((kk & 7) * 32 + (c & 31)) * 2; }
__device__ __forceinline__ int v_rd_base(int lane) { return ((lane & 3) << 3) | (((lane >> 2) & 3) << 6) | (((lane >> 4) & 1) << 5) | (((lane >> 5) & 1) << 8); }
constexpr int v_rd_off(int d0, int ks, int half) { return d0 * 512 + ks * 4096 + half * 2048; }
template <int OFF> __device__ __forceinline__ s16x4 tr_read(int vb) {
  s16x4 r; asm volatile("ds_read_b64_tr_b16 %0, %1 offset:%2" : "=&v"(r) : "v"(vb), "i"(OFF) : "memory"); return r;
}
template <int D0> __device__ __forceinline__ void pv_one(f32x16& od, int vb, bf16x8 pa0, bf16x8 pa1, bf16x8 pa2, bf16x8 pa3) {
  const s16x4 l0 = tr_read<v_rd_off(D0, 0, 0)>(vb), h0 = tr_read<v_rd_off(D0, 0, 1)>(vb), l1 = tr_read<v_rd_off(D0, 1, 0)>(vb), h1 = tr_read<v_rd_off(D0, 1, 1)>(vb);
  const s16x4 l2 = tr_read<v_rd_off(D0, 2, 0)>(vb), h2 = tr_read<v_rd_off(D0, 2, 1)>(vb), l3 = tr_read<v_rd_off(D0, 3, 0)>(vb), h3 = tr_read<v_rd_off(D0, 3, 1)>(vb);
  asm volatile("s_waitcnt lgkmcnt(0)" ::: "memory"); SBAR_D();
#define PK(L, H) (bf16x8){L[0], L[1], L[2], L[3], H[0], H[1], H[2], H[3]}
  od = __builtin_amdgcn_mfma_f32_32x32x16_bf16(pa0, PK(l0, h0), od, 0, 0, 0);
  od = __builtin_amdgcn_mfma_f32_32x32x16_bf16(pa1, PK(l1, h1), od, 0, 0, 0);
  od = __builtin_amdgcn_mfma_f32_32x32x16_bf16(pa2, PK(l2, h2), od, 0, 0, 0);
  od = __builtin_amdgcn_mfma_f32_32x32x16_bf16(pa3, PK(l3, h3), od, 0, 0, 0);
#undef PK
}
__device__ __forceinline__ void pv_d0(f32x16* o, int vb, bf16x8 pa0, bf16x8 pa1, bf16x8 pa2, bf16x8 pa3) {
  pv_one<0>(o[0], vb, pa0, pa1, pa2, pa3); pv_one<1>(o[1], vb, pa0, pa1, pa2, pa3); pv_one<2>(o[2], vb, pa0, pa1, pa2, pa3); pv_one<3>(o[3], vb, pa0, pa1, pa2, pa3);
}

template <typename TQ>
__device__ __forceinline__ void attn_dense_body(const TQ* __restrict__ Qb, const bf16* __restrict__ Kh, const bf16* __restrict__ Vh,
                                                bf16* __restrict__ Ob, int seq, char* lds) {
  using St = Stage<bf16>; using SQ = Stage<TQ>;
  const int tid = threadIdx.x, wid = tid >> 6, lane = tid & 63, r32 = lane & 31, hi = lane >> 5;
  bf16* V_lds = (bf16*)lds; bf16* K_lds = (bf16*)(lds + 2 * SHM_V);
  float* ws = (float*)(lds + 2 * SHM_V + 2 * SHM_K) + wid * 64; float* li_l = ws; float* al_l = ws + 32;
  float m_reg = -1e30f, l_reg = 0; f32x16 o[4] = {}; bf16x8 qr[8];
  const TQ* Qw = Qb + (long)(wid * QBLK + r32) * LDQ + hi * 8;
#pragma unroll
  for (int d0 = 0; d0 < 8; ++d0) qr[d0] = SQ::tobf(SQ::ld8(Qw + d0 * 16));
  const int sr = tid >> 4, sc = (tid & 15) * 8, vst0 = v_st(sr, sc), vst1 = v_st(32 + sr, sc);
  const int vb0 = (int)(uintptr_t)V_lds + v_rd_base(lane);
  struct { typename St::T vs0, vs1, ks0, ks1; } sr_[SDEPTH];
#define SLOAD(i, k0) do { sr_[i].vs0 = St::ld8(&Vh[(long)((k0) + sr) * LDK + sc]); sr_[i].vs1 = St::ld8(&Vh[(long)((k0) + 32 + sr) * LDK + sc]); \
    sr_[i].ks0 = St::ld8(&Kh[(long)((k0) + sr) * LDK + sc]); sr_[i].ks1 = St::ld8(&Kh[(long)((k0) + 32 + sr) * LDK + sc]); } while (0)
#define SWRITE(b, i) do { *(bf16x8*)((char*)V_lds + (b) * SHM_V + vst0) = St::tobf(sr_[i].vs0);          \
    *(bf16x8*)((char*)V_lds + (b) * SHM_V + vst1) = St::tobf(sr_[i].vs1); int kc = sc * 2;               \
    *(bf16x8*)((char*)K_lds + (b) * SHM_K + KSWZ_D(sr, kc)) = St::tobf(sr_[i].ks0);                       \
    *(bf16x8*)((char*)K_lds + (b) * SHM_K + KSWZ_D(32 + sr, kc)) = St::tobf(sr_[i].ks1); } while (0)
#define SWAIT() do { if constexpr (SDEPTH == 2) asm volatile("s_waitcnt vmcnt(4)" ::: "memory"); else asm volatile("s_waitcnt vmcnt(0)" ::: "memory"); } while (0)
#define RESC(a) do { if (__any((a) < 1.f)) { if (hi == 0) al_l[r32] = (a); asm volatile("s_waitcnt lgkmcnt(0)" ::: "memory"); \
    for (int d = 0; d < 4; ++d) for (int r = 0; r < 16; ++r) o[d][r] *= al_l[crow(r, hi)]; } } while (0)
  f32x16 pA0, pA1, pB0, pB1; float mnA, mnB, alA, alB; bf16x8 pa0, pa1, pa2, pa3; const int NT = seq / KVBLK;
  constexpr int SE = 0, SO = SDEPTH - 1;
  SLOAD(SE, 0); asm volatile("s_waitcnt vmcnt(0)" ::: "memory"); SWRITE(0, SE); __syncthreads();
  qkt(pA0, pA1, K_lds, qr, r32, hi); partialSM(pA0, pA1, m_reg, mnA, alA);
  SLOAD(SO, KVBLK); if constexpr (SDEPTH == 2) { if (2 < NT) SLOAD(SE, 2 * KVBLK); }
  SWAIT(); SWRITE(1, SO); __syncthreads();
  for (int j = 1; j + 1 < NT; j += 2) {
    SBAR_D(); qkt(pB0, pB1, (bf16*)((char*)K_lds + SHM_K), qr, r32, hi);
    finishSM(pA0, pA1, alA, l_reg, pa0, pa1, pa2, pa3); SBAR_D();
    SLOAD(SO, (j + SDEPTH) * KVBLK); SBAR_D();
    pv_d0(o, vb0, pa0, pa1, pa2, pa3); partialSM(pB0, pB1, m_reg, mnB, alB);
    __syncthreads(); SWAIT(); SWRITE(0, SE);
    RESC(alB); __syncthreads();
    SBAR_D(); qkt(pA0, pA1, K_lds, qr, r32, hi);
    finishSM(pB0, pB1, alB, l_reg, pa0, pa1, pa2, pa3); SBAR_D();
    if (SDEPTH == 1 || j + 3 < NT) SLOAD(SE, (j + 1 + SDEPTH) * KVBLK); SBAR_D();
    pv_d0(o, vb0 + (int)SHM_V, pa0, pa1, pa2, pa3); partialSM(pA0, pA1, m_reg, mnA, alA);
    __syncthreads(); SWAIT(); SWRITE(1, SO);
    RESC(alA); __syncthreads();
  }
  SBAR_D(); qkt(pB0, pB1, (bf16*)((char*)K_lds + SHM_K), qr, r32, hi);
  finishSM(pA0, pA1, alA, l_reg, pa0, pa1, pa2, pa3); SBAR_D();
  pv_d0(o, vb0, pa0, pa1, pa2, pa3); partialSM(pB0, pB1, m_reg, mnB, alB);
  __syncthreads(); RESC(alB);
  finishSM(pB0, pB1, alB, l_reg, pa0, pa1, pa2, pa3); SBAR_D();
  pv_d0(o, vb0 + (int)SHM_V, pa0, pa1, pa2, pa3);
  if (hi == 0) li_l[r32] = l_reg; asm volatile("s_waitcnt lgkmcnt(0)" ::: "memory");
  float rli[16];
#pragma unroll
  for (int r = 0; r < 16; ++r) rli[r] = __builtin_amdgcn_rcpf(li_l[crow(r, hi)]);
  bf16* Ow = Ob + (long)(wid * QBLK) * LDO;
#pragma unroll
  for (int r = 0; r < 16; ++r) { int orow = crow(r, hi);
    for (int d0 = 0; d0 < 4; ++d0) Ow[(long)orow * LDO + d0 * 32 + r32] = __float2bfloat16(o[d0][r] * rli[r]); }
#undef SLOAD
#undef SWRITE
#undef SWAIT
#undef RESC
}

}
__device__ __forceinline__ void phase_memattn(const Params& p, unsigned char* lds) {
    using attnd::bf16; unsigned char* ws = p.ws; const bf16* MQ = (const bf16*)(ws + WS_MQ); const bf16* MKV = (const bf16*)(ws + WS_MKV); bf16* Y = (bf16*)(ws + WS_Y);
    const int G = gridDim.x, bx = blockIdx.x; const int vcu = (G % 8 == 0) ? (bx % 8) * (G / 8) + bx / 8 : bx;
    for (int u = vcu; u < NBATCH * 4 * 16; u += G) {
        const int qb = u & 15, bh = u >> 4, b = bh >> 2, h = bh & 3; const size_t m0 = (size_t)b * SEQ + qb * 256;
        attnd::attn_dense_body<bf16>(MQ + m0 * 512 + h * 128, MKV + (size_t)b * NMEM * 1024 + h * 128, MKV + (size_t)b * NMEM * 1024 + 512 + h * 128, Y + m0 * 1536 + 1024 + h * 128, NMEM, (char*)lds);
        __syncthreads();
    }
}

namespace attnc {
using attnd::bf16; using attnd::bf16x8; using attnd::s16x4; using attnd::f32x16; using attnd::u32x4; using attnd::crow; using attnd::cvtpk; using attnd::v_st; using attnd::v_rd_base; using attnd::pv_d0;
using attnd::finishSM;
constexpr int NW = 8, QBLK = 32, KVBLK = 64;
constexpr float THR2 = 8.f;
constexpr int LDQ = 1024, LDKK = 1024, LDV = 512, LDO = 1024;
constexpr size_t SHM_V = KVBLK * 128 * 2, SHM_K = KVBLK * 64 * 2, SHM_ATTN = 2 * SHM_V + 2 * SHM_K + NW * 64 * 4;
#define KSWZ_C(row, colB) ((row) * 128 + ((colB) ^ ((((row) >> 1) & 7) << 4)))
#define SBAR_C() __builtin_amdgcn_sched_barrier(0)
__device__ __forceinline__ void mask_tile(f32x16& p0, f32x16& p1, int dq) {
    const float NEG = -__builtin_inff();
#pragma unroll
    for (int r = 0; r < 16; ++r) { const int c = (r & 3) + 8 * (r >> 2); if (c > dq) p0[r] = NEG; if (c + 32 > dq) p1[r] = NEG; }
}
__device__ __forceinline__ void partialSM(f32x16& p0, f32x16& p1, float& m_reg, float& mn, float& alpha) {
    float pmax = p0[0]; for (int r = 1; r < 16; ++r) pmax = fmaxf(pmax, p0[r]); for (int r = 0; r < 16; ++r) pmax = fmaxf(pmax, p1[r]);
    { auto rr = __builtin_amdgcn_permlane32_swap(__float_as_uint(pmax), __float_as_uint(pmax), false, false);
      pmax = fmaxf(__uint_as_float(rr[0]), __uint_as_float(rr[1])); }
    if (__builtin_expect(__all(pmax - m_reg <= THR2), 1)) { mn = m_reg; alpha = 1.f; }
    else { mn = fmaxf(m_reg, pmax); alpha = __builtin_amdgcn_exp2f(m_reg - mn); m_reg = mn; }
    for (int r = 0; r < 16; ++r) p0[r] = p0[r] - mn; for (int r = 0; r < 16; ++r) p1[r] = p1[r] - mn;
    for (int r = 0; r < 16; ++r) p0[r] = __builtin_amdgcn_exp2f(p0[r]);
}
__device__ __forceinline__ void qkt(f32x16& p0, f32x16& p1, const bf16* Ks, const bf16x8* qr, int r32, int hi) {
    p0 = f32x16{}; p1 = f32x16{};
    for (int d0 = 0; d0 < 4; ++d0) { int cb = (d0 * 16 + hi * 8) * 2;
        bf16x8 b0 = *reinterpret_cast<const bf16x8*>((const char*)Ks + KSWZ_C(r32, cb));
        bf16x8 b1 = *reinterpret_cast<const bf16x8*>((const char*)Ks + KSWZ_C(32 + r32, cb));
        p0 = __builtin_amdgcn_mfma_f32_32x32x16_bf16(b0, qr[d0], p0, 0, 0, 0);
        p1 = __builtin_amdgcn_mfma_f32_32x32x16_bf16(b1, qr[d0], p1, 0, 0, 0); }
}
__device__ __forceinline__ void attn_causal_body(const bf16* __restrict__ Qb, const bf16* __restrict__ Kh, const bf16* __restrict__ Vh, bf16* __restrict__ Ob, int NT, char* lds) {
    const int tid = threadIdx.x, wid = tid >> 6, lane = tid & 63, r32 = lane & 31, hi = lane >> 5;
    bf16* V_lds = (bf16*)lds; bf16* K_lds = (bf16*)(lds + 2 * SHM_V);
    float* ws = (float*)(lds + 2 * SHM_V + 2 * SHM_K) + wid * 64; float* li_l = ws; float* al_l = ws + 32;
    float m_reg = -1e30f, l_reg = 0; f32x16 o[4] = {}; bf16x8 qr[4];
    const bf16* Qw = Qb + (long)(wid * QBLK + r32) * LDQ + hi * 8;
#pragma unroll
    for (int d0 = 0; d0 < 4; ++d0) qr[d0] = *reinterpret_cast<const bf16x8*>(Qw + d0 * 16);
    const int sr = tid >> 4, sc = (tid & 15) * 8, vst0 = v_st(sr, sc), vst1 = v_st(32 + sr, sc);
    const int kr = tid >> 3, kc = (tid & 7) * 8, kst = KSWZ_C(kr, kc * 2);
    const int vb0 = (int)(uintptr_t)V_lds + v_rd_base(lane);
    struct { bf16x8 vs0, vs1, ks0; } sr_[1];
    const int qrow = wid * QBLK + r32 - 4 * hi;
    const unsigned vo0 = (unsigned)(sr * LDV + sc) * 2u, ko0 = (unsigned)(kr * LDKK + kc) * 2u;
#define SLOAD(i, k0) do { const char* vt_ = (const char*)Vh + (size_t)(k0) * LDV * 2; const char* kt_ = (const char*)Kh + (size_t)(k0) * LDKK * 2; \
    sr_[i].vs0 = *reinterpret_cast<const bf16x8*>(vt_ + vo0); sr_[i].vs1 = *reinterpret_cast<const bf16x8*>(vt_ + 32 * LDV * 2 + vo0); \
    sr_[i].ks0 = *reinterpret_cast<const bf16x8*>(kt_ + ko0); } while (0)
#define SWRITE(b, i) do { *(bf16x8*)((char*)V_lds + (b) * SHM_V + vst0) = sr_[i].vs0; *(bf16x8*)((char*)V_lds + (b) * SHM_V + vst1) = sr_[i].vs1; \
    *(bf16x8*)((char*)K_lds + (b) * SHM_K + kst) = sr_[i].ks0; } while (0)
#define SWAIT() asm volatile("s_waitcnt vmcnt(0)" ::: "memory")
#define RESC(a) do { if (__any((a) < 1.f)) { if (hi == 0) al_l[r32] = (a); asm volatile("s_waitcnt lgkmcnt(0)" ::: "memory"); \
    for (int d = 0; d < 4; ++d) for (int r = 0; r < 16; ++r) o[d][r] *= al_l[crow(r, hi)]; } } while (0)
#define MASK(P0, P1, t) do { const int jb_ = (t) - (NT - 4); if (jb_ >= 0) mask_tile(P0, P1, qrow - 64 * jb_); } while (0)
    f32x16 pA0, pA1, pB0, pB1; float mnA, mnB, alA, alB; bf16x8 pa0, pa1, pa2, pa3;
    constexpr int SE = 0, SO = 0;
    SLOAD(SE, 0); asm volatile("s_waitcnt vmcnt(0)" ::: "memory"); SWRITE(0, SE); __syncthreads();
    qkt(pA0, pA1, K_lds, qr, r32, hi); MASK(pA0, pA1, 0); partialSM(pA0, pA1, m_reg, mnA, alA);
    SLOAD(SO, KVBLK);
    SWAIT(); SWRITE(1, SO); __syncthreads();
    for (int j = 1; j + 1 < NT; j += 2) {
        SBAR_C(); qkt(pB0, pB1, (bf16*)((char*)K_lds + SHM_K), qr, r32, hi);
        finishSM(pA0, pA1, alA, l_reg, pa0, pa1, pa2, pa3); SBAR_C();
        SLOAD(SO, (j + 1) * KVBLK); SBAR_C();
        pv_d0(o, vb0, pa0, pa1, pa2, pa3); MASK(pB0, pB1, j); partialSM(pB0, pB1, m_reg, mnB, alB);
        __syncthreads(); SWAIT(); SWRITE(0, SE);
        RESC(alB); __syncthreads();
        SBAR_C(); qkt(pA0, pA1, K_lds, qr, r32, hi);
        finishSM(pB0, pB1, alB, l_reg, pa0, pa1, pa2, pa3); SBAR_C();
        SLOAD(SE, (j + 2) * KVBLK); SBAR_C();
        pv_d0(o, vb0 + (int)SHM_V, pa0, pa1, pa2, pa3); MASK(pA0, pA1, j + 1); partialSM(pA0, pA1, m_reg, mnA, alA);
        __syncthreads(); SWAIT(); SWRITE(1, SO);
        RESC(alA); __syncthreads();
    }
    SBAR_C(); qkt(pB0, pB1, (bf16*)((char*)K_lds + SHM_K), qr, r32, hi);
    finishSM(pA0, pA1, alA, l_reg, pa0, pa1, pa2, pa3); SBAR_C();
    pv_d0(o, vb0, pa0, pa1, pa2, pa3); MASK(pB0, pB1, NT - 1); partialSM(pB0, pB1, m_reg, mnB, alB);
    __syncthreads(); RESC(alB);
    finishSM(pB0, pB1, alB, l_reg, pa0, pa1, pa2, pa3); SBAR_C();
    pv_d0(o, vb0 + (int)SHM_V, pa0, pa1, pa2, pa3);
    if (hi == 0) li_l[r32] = l_reg; asm volatile("s_waitcnt lgkmcnt(0)" ::: "memory");
    float rli[16];
#pragma unroll
    for (int r = 0; r < 16; ++r) rli[r] = __builtin_amdgcn_rcpf(li_l[crow(r, hi)]);
    char* Ow = (char*)(Ob + (long)(wid * QBLK) * LDO);
#pragma unroll
    for (int r = 0; r < 16; ++r) { const unsigned oo = (unsigned)(crow(r, hi) * LDO + r32) * 2u;
        for (int d0 = 0; d0 < 4; ++d0) *(bf16*)(Ow + oo + d0 * 64) = __float2bfloat16(o[d0][r] * rli[r]); }
#undef SLOAD
#undef SWRITE
#undef SWAIT
#undef RESC
#undef MASK
}
}
__device__ __forceinline__ void phase_diffattn2(const Params& p, unsigned char* lds) {
    using attnc::bf16; unsigned char* ws = p.ws;
    const bf16* DQK = (const bf16*)(ws + WS_DQK); const bf16* DV = (const bf16*)(ws + WS_DV); bf16* O12 = (bf16*)p.out + (size_t)NTOK * 1024;
    const int G = gridDim.x, bx = blockIdx.x; const int vcu = (G % 8 == 0) ? (bx % 8) * (G / 8) + bx / 8 : bx;
    for (int u = vcu; u < 256; u += G) {
        const int vh = u >> 1, half = u & 1, bh = vh >> 1, map = vh & 1, b = bh >> 2, h = bh & 3; const size_t row0 = (size_t)b * SEQ;
        const bf16* Qs = DQK + row0 * 1024 + map * 256 + h * 64; const bf16* Ks = DQK + row0 * 1024 + 512 + map * 256 + h * 64;
        const bf16* Vs = DV + row0 * 512 + h * 128; bf16* Os = O12 + row0 * 1024 + h * 256 + map * 128;
        for (int i = 0; i < 8; ++i) { const int pr = 7 - i; const int qb = half == 0 ? ((pr & 1) ? 4 * (pr >> 1) + 3 : 4 * (pr >> 1)) : ((pr & 1) ? 4 * (pr >> 1) + 2 : 4 * (pr >> 1) + 1);
            attnc::attn_causal_body(Qs + (size_t)qb * 256 * 1024, Ks, Vs, Os + (size_t)qb * 256 * 1024, 4 * (qb + 1), (char*)lds);
            __syncthreads(); }
    }
}

namespace hg {
constexpr int ROWQ = 272, ROWT = 144;
constexpr int L_QR = 0, L_FR = 17408, L_VR = 34816, L_VT = 52224, L_KT = 70656, L_TOT = 89088, L_SSQ = 91136;
__device__ __forceinline__ void load_tile(unsigned char* dst, const bf16_t* src, int tid) {
    const int r = tid >> 3, c = tid & 7;
    const u32x4 a = *(const u32x4*)(src + (size_t)r * 2048 + c * 8), b = *(const u32x4*)(src + (size_t)r * 2048 + 64 + c * 8);
    *(u32x4*)(dst + r * ROWQ + c * 16) = a; *(u32x4*)(dst + r * ROWQ + 128 + c * 16) = b;
}
__device__ __forceinline__ u32x4 pack8(const float* v) { u32x4 w; w.x = pk2(v[0], v[1]); w.y = pk2(v[2], v[3]); w.z = pk2(v[4], v[5]); w.w = pk2(v[6], v[7]); return w; }
__device__ __forceinline__ void gate_scan(unsigned char* lds, int k, int seg, float lbv, float (&kk)[16], float (&cs)[16], float& offset, float& total) {
    float run = 0.f;
#pragma unroll
    for (int i = 0; i < 16; ++i) { const float fp = bf2f(*(const bf16_t*)(lds + L_FR + (16 * seg + i) * ROWQ + k * 2)); const float sg = sigmoidf_(fp);
        const float f = lbv + (1.f - lbv) * sg; kk[i] = (1.f - lbv) * (1.f - sg); run += __logf(f); cs[i] = run; }
    float* tot = (float*)(lds + L_TOT); tot[seg * 128 + k] = run;
    __syncthreads();
    const float t0 = tot[k], t1 = tot[128 + k], t2 = tot[256 + k], t3 = tot[384 + k];
    offset = (seg > 0 ? t0 : 0.f) + (seg > 1 ? t1 : 0.f) + (seg > 2 ? t2 : 0.f); total = (t0 + t1) + (t2 + t3);
}
__device__ __forceinline__ void write_vt(unsigned char* lds, int k, int seg) {
    float v[16];
#pragma unroll
    for (int i = 0; i < 16; ++i) v[i] = bf2f(*(const bf16_t*)(lds + L_VR + (16 * seg + i) * ROWQ + k * 2));
    *(u32x4*)(lds + L_VT + k * ROWT + seg * 32) = pack8(v); *(u32x4*)(lds + L_VT + k * ROWT + seg * 32 + 16) = pack8(v + 8);
}
}
__device__ __forceinline__ void phase_hgrn_A(const Params& p, unsigned char* lds) {
    using namespace hg; unsigned char* ws = p.ws; const bf16_t* HG = (const bf16_t*)(ws + WS_HG); const float* lower0 = (const float*)(ws + WS_SCAL);
    bf16_t* US = (bf16_t*)p.out; float* DEC = (float*)(ws + WS_DEC);
    const int tid = threadIdx.x, lane = tid & 63, w = tid >> 6, fr = lane & 15, fq = lane >> 4, k = tid & 127, seg = tid >> 7;
    for (int item = blockIdx.x; item < 4096; item += gridDim.x) {
        const int bh = item >> 6, c = item & 63, b = bh >> 2, h = bh & 3; const bf16_t* row0 = HG + ((size_t)b * SEQ + c * 64) * 2048 + h * 128;
        load_tile(lds + L_FR, row0 + 512, tid); load_tile(lds + L_VR, row0 + 1024, tid);
        __syncthreads();
        float kk[16], cs[16], offset, total; const float lbv = lower0[h * 128 + k];
        write_vt(lds, k, seg);
        gate_scan(lds, k, seg, lbv, kk, cs, offset, total);
        { float ke[16];
#pragma unroll
          for (int i = 0; i < 16; ++i) ke[i] = kk[i] * __expf(total - (offset + cs[i]));
          *(u32x4*)(lds + L_KT + k * ROWT + seg * 32) = pack8(ke); *(u32x4*)(lds + L_KT + k * ROWT + seg * 32 + 16) = pack8(ke + 8);
          if (seg == 0) DEC[(size_t)item * 128 + k] = __expf(total); }
        __syncthreads();
        const bf16x8 a0 = *(const bf16x8*)(lds + L_KT + (16 * w + fr) * ROWT + fq * 16), a1 = *(const bf16x8*)(lds + L_KT + (16 * w + fr) * ROWT + 64 + fq * 16);
        unsigned char* uT = lds + L_FR;
#pragma unroll
        for (int j = 0; j < 8; ++j) {
            const bf16x8 b0 = *(const bf16x8*)(lds + L_VT + (16 * j + fr) * ROWT + fq * 16), b1 = *(const bf16x8*)(lds + L_VT + (16 * j + fr) * ROWT + 64 + fq * 16);
            f32x4 acc = {0.f, 0.f, 0.f, 0.f};
            acc = __builtin_amdgcn_mfma_f32_16x16x32_bf16(a0, b0, acc, 0, 0, 0); acc = __builtin_amdgcn_mfma_f32_16x16x32_bf16(a1, b1, acc, 0, 0, 0);
            u32x2 o; o.x = pk2(acc[0], acc[1]); o.y = pk2(acc[2], acc[3]);
            *(u32x2*)(uT + (16 * j + fr) * ROWQ + (16 * w + 4 * fq) * 2) = o; }
        __syncthreads();
        bf16_t* dst = US + (size_t)item * 16384;
#pragma unroll
        for (int i = 0; i < 4; ++i) { const int ch = tid + 512 * i, v = ch >> 4, kc = ch & 15; *(u32x4*)(dst + v * 128 + kc * 8) = *(const u32x4*)(uT + v * ROWQ + kc * 16); }
        __syncthreads();
    }
}
__device__ __forceinline__ void phase_hgrn_B(const Params& p, unsigned char* lds) {
    unsigned char* ws = p.ws; bf16_t* US = (bf16_t*)p.out; const float* DEC = (const float*)(ws + WS_DEC);
    const size_t gt = (size_t)blockIdx.x * 512 + threadIdx.x, ngt = (size_t)gridDim.x * 512;
    for (size_t e = gt; e < (size_t)64 * 128 * 16; e += ngt) {
        const int kc = (int)(e & 15), v = (int)((e >> 4) & 127), bh = (int)(e >> 11);
        bf16_t* pu = US + (size_t)bh * 64 * 16384 + v * 128 + kc * 8; const float* pd = DEC + (size_t)bh * 64 * 128 + kc * 8;
        float S[8];
#pragma unroll
        for (int i = 0; i < 8; ++i) S[i] = 0.f;
#pragma unroll 4
        for (int c = 0; c < 64; ++c) {
            const u32x4 uw = *(const u32x4*)(pu + (size_t)c * 16384); const f32x4 d0 = *(const f32x4*)(pd + c * 128), d1 = *(const f32x4*)(pd + c * 128 + 4);
            float u[8]; pg8::unpack8(uw, u);
            *(u32x4*)(pu + (size_t)c * 16384) = hg::pack8(S);
            S[0] = d0[0] * S[0] + u[0]; S[1] = d0[1] * S[1] + u[1]; S[2] = d0[2] * S[2] + u[2]; S[3] = d0[3] * S[3] + u[3];
            S[4] = d1[0] * S[4] + u[4]; S[5] = d1[1] * S[5] + u[5]; S[6] = d1[2] * S[6] + u[6]; S[7] = d1[3] * S[7] + u[7];
        }
    }
}
__device__ __forceinline__ void phase_hgrn_C(const Params& p, unsigned char* lds) {
    using namespace hg; unsigned char* ws = p.ws; const bf16_t* HG = (const bf16_t*)(ws + WS_HG); const float* lower0 = (const float*)(ws + WS_SCAL);
    const bf16_t* US = (const bf16_t*)p.out; bf16_t* Y = (bf16_t*)(ws + WS_Y); const float* gain = (const float*)p.in[6];
    const int tid = threadIdx.x, lane = tid & 63, w = tid >> 6, fr = lane & 15, fq = lane >> 4, k = tid & 127, seg = tid >> 7;
    for (int item = blockIdx.x; item < 4096; item += gridDim.x) {
        const int bh = item >> 6, c = item & 63, b = bh >> 2, h = bh & 3; const size_t m0 = (size_t)b * SEQ + c * 64; const bf16_t* row0 = HG + m0 * 2048 + h * 128;
        bf16x8 bS[4];
        { const bf16_t* sp = US + (size_t)item * 16384 + (16 * w + fr) * 128 + fq * 8;
#pragma unroll
          for (int ks = 0; ks < 4; ++ks) bS[ks] = *(const bf16x8*)(sp + ks * 32); }
        load_tile(lds + L_QR, row0, tid); load_tile(lds + L_FR, row0 + 512, tid); load_tile(lds + L_VR, row0 + 1024, tid);
        __syncthreads();
        float kk[16], cs[16], offset, total; const float lbv = lower0[h * 128 + k];
        write_vt(lds, k, seg);
        gate_scan(lds, k, seg, lbv, kk, cs, offset, total);
#pragma unroll
        for (int i = 0; i < 16; ++i) { const float cum = offset + cs[i]; bf16_t* pq = (bf16_t*)(lds + L_QR + (16 * seg + i) * ROWQ + k * 2); bf16_t* pf = (bf16_t*)(lds + L_FR + (16 * seg + i) * ROWQ + k * 2);
            *pq = f2bf(bf2f(*pq) * __expf(cum)); *pf = f2bf(kk[i] * __expf(-cum)); }
        __syncthreads();
        { const int si = w >> 1; bf16x8 a[4];
#pragma unroll
          for (int ks = 0; ks < 4; ++ks) a[ks] = *(const bf16x8*)(lds + L_FR + (16 * si + fr) * ROWQ + ks * 64 + fq * 16);
#pragma unroll
          for (int jj = 0; jj < 2; ++jj) { const int tj = 2 * (w & 1) + jj; f32x4 acc = {0.f, 0.f, 0.f, 0.f};
#pragma unroll
              for (int ks = 0; ks < 4; ++ks) { const bf16x8 bq = *(const bf16x8*)(lds + L_QR + (16 * tj + fr) * ROWQ + ks * 64 + fq * 16); acc = __builtin_amdgcn_mfma_f32_16x16x32_bf16(a[ks], bq, acc, 0, 0, 0); }
              const int t = 16 * tj + fr, s0 = 16 * si + 4 * fq;
              u32x2 o; o.x = pk2(s0 <= t ? acc[0] : 0.f, s0 + 1 <= t ? acc[1] : 0.f); o.y = pk2(s0 + 2 <= t ? acc[2] : 0.f, s0 + 3 <= t ? acc[3] : 0.f);
              *(u32x2*)(lds + L_KT + t * ROWT + s0 * 2) = o; } }
        __syncthreads();
        f32x4 acc[4];
        { const bf16x8 bV0 = *(const bf16x8*)(lds + L_VT + (16 * w + fr) * ROWT + fq * 16), bV1 = *(const bf16x8*)(lds + L_VT + (16 * w + fr) * ROWT + 64 + fq * 16);
#pragma unroll
          for (int tj = 0; tj < 4; ++tj) { f32x4 ac = {0.f, 0.f, 0.f, 0.f};
#pragma unroll
              for (int ks = 0; ks < 4; ++ks) { const bf16x8 aq = *(const bf16x8*)(lds + L_QR + (16 * tj + fr) * ROWQ + ks * 64 + fq * 16); ac = __builtin_amdgcn_mfma_f32_16x16x32_bf16(aq, bS[ks], ac, 0, 0, 0); }
              const bf16x8 ap0 = *(const bf16x8*)(lds + L_KT + (16 * tj + fr) * ROWT + fq * 16), ap1 = *(const bf16x8*)(lds + L_KT + (16 * tj + fr) * ROWT + 64 + fq * 16);
              ac = __builtin_amdgcn_mfma_f32_16x16x32_bf16(ap0, bV0, ac, 0, 0, 0); ac = __builtin_amdgcn_mfma_f32_16x16x32_bf16(ap1, bV1, ac, 0, 0, 0);
              acc[tj] = ac; } }
        float* ssq = (float*)(lds + L_SSQ);
#pragma unroll
        for (int tj = 0; tj < 4; ++tj)
#pragma unroll
            for (int r = 0; r < 4; ++r) { float sq = acc[tj][r] * acc[tj][r]; sq += __shfl_xor(sq, 1); sq += __shfl_xor(sq, 2); sq += __shfl_xor(sq, 4); sq += __shfl_xor(sq, 8);
                if (fr == 0) ssq[w * 64 + 16 * tj + 4 * fq + r] = sq; }
        __syncthreads();
        const float gn = gain[h * 128 + 16 * w + fr];
#pragma unroll
        for (int tj = 0; tj < 4; ++tj)
#pragma unroll
            for (int r = 0; r < 4; ++r) { const int t = 16 * tj + 4 * fq + r; float tot = 0.f;
#pragma unroll
                for (int ww = 0; ww < 8; ++ww) tot += ssq[ww * 64 + t];
                const float gate = bf2f(row0[(size_t)t * 2048 + 1536 + 16 * w + fr]);
                Y[(m0 + t) * 1536 + h * 128 + 16 * w + fr] = f2bf(acc[tj][r] * rsqrtf(tot * (1.f / 128.f) + RMS_EPS) * gn * gate); }
        __syncthreads();
    }
}

#define XB_TMO      128
#define XB_XCNT(j)  (256  + 64 * (j))
#define XB_XSUB(j)  (1280 + 64 * (j))
#define XB_XGEN(j)  (2304 + 64 * (j))
#define XB_TOP      3328
#define XB_TOPGEN   3392
#define XCD_BAR_WORDS 3456
#define XB_SPIN_CAP (1u << 18)

__device__ __forceinline__ unsigned xb_ld(unsigned* p)              { return __hip_atomic_load(p, __ATOMIC_RELAXED, __HIP_MEMORY_SCOPE_AGENT); }
__device__ __forceinline__ unsigned xb_add(unsigned* p, unsigned v) { return __hip_atomic_fetch_add(p, v, __ATOMIC_RELAXED, __HIP_MEMORY_SCOPE_AGENT); }
__device__ __forceinline__ unsigned xb_xcc_id() { return (unsigned)__builtin_amdgcn_s_getreg((3 << 11) | 20) & 0xFu; }
#define XB_SPIN(cond, bar) do { unsigned _sp = 0; while (cond) { __builtin_amdgcn_s_sleep(1); \
    if ((++_sp & 255u) == 0u) { if (xb_ld(&(bar)[XB_TMO])) break; if (_sp > XB_SPIN_CAP) { atomicAdd(&(bar)[XB_TMO], 1u); break; } } } } while (0)

struct XcdBarrier {
    unsigned* bar; unsigned x;
    volatile __attribute__((address_space(3))) unsigned* st;
};

__device__ __forceinline__ XcdBarrier xcd_barrier_post(unsigned* bar, volatile __attribute__((address_space(3))) unsigned* st) {
    XcdBarrier b; b.bar = bar; b.x = xb_xcc_id(); b.st = st;
    if (threadIdx.x == 0) (void)xb_add(&bar[XB_XCNT(b.x)], 1u);
    return b;
}
__device__ __forceinline__ void xcd_barrier_complete(unsigned* bar, unsigned x, unsigned& nloc, unsigned& nx) {
    const unsigned G = gridDim.x * gridDim.y * gridDim.z;
    unsigned sum, cnt, mine, sp = 0u;
    for (;;) {
        sum = 0u; cnt = 0u; mine = 0u;
#pragma unroll
        for (unsigned j = 0; j < 16; ++j) { const unsigned c = xb_ld(&bar[XB_XCNT(j)]); sum += c; cnt += (c > 0u) ? 1u : 0u; mine = (j == x) ? c : mine; }
        if (sum == G) break;
        __builtin_amdgcn_s_sleep(1);
        if ((++sp & 255u) == 0u) { if (xb_ld(&bar[XB_TMO])) break; if (sp > XB_SPIN_CAP) { atomicAdd(&bar[XB_TMO], 1u); break; } }
    }
    nloc = mine > 0u ? mine : 1u; nx = cnt > 0u ? cnt : 1u;
}

__device__ __forceinline__ void xcd_barrier(const XcdBarrier& b) {
    asm volatile("s_waitcnt vmcnt(0)" ::: "memory");
    __syncthreads();
    if (threadIdx.x == 0) {
        unsigned* bar = b.bar;
        __builtin_amdgcn_s_waitcnt(0);
        unsigned nloc = b.st[0], nx = b.st[1];
        if (nloc == 0u) { xcd_barrier_complete(bar, b.x, nloc, nx); b.st[0] = nloc; b.st[1] = nx; }
        const unsigned old = xb_add(&bar[XB_XSUB(b.x)], 1u);
        const unsigned gen = old / nloc;
        if (old + 1u == (gen + 1u) * nloc) {
            __builtin_amdgcn_fence(__ATOMIC_RELEASE, "agent");
            asm volatile("s_waitcnt vmcnt(0)" ::: "memory");
            const unsigned og = xb_add(&bar[XB_TOP], 1u);
            const unsigned tg = og / nx;
            if (og + 1u == (tg + 1u) * nx) xb_add(&bar[XB_TOPGEN], 1u);
            else XB_SPIN(xb_ld(&bar[XB_TOPGEN]) == tg, bar);
            __builtin_amdgcn_fence(__ATOMIC_ACQUIRE, "agent");
            xb_add(&bar[XB_XGEN(b.x)], 1u);
            asm volatile("s_waitcnt vmcnt(0)" ::: "memory");
        } else {
            XB_SPIN(xb_ld(&bar[XB_XGEN(b.x)]) == gen, bar);
            __builtin_amdgcn_fence(__ATOMIC_ACQUIRE, "agent");
            asm volatile("s_waitcnt vmcnt(0)" ::: "memory");
        }
    }
    __syncthreads();
}


template <bool COOP> __device__ __forceinline__ void cg_or_nothing() { if (COOP) cg::this_grid().sync(); }
template <bool COOP>
__global__ void __launch_bounds__(512, 2) k_fwd(Params p) {
    extern __shared__ __attribute__((aligned(16))) unsigned char lds[];
    const int lo = p.ph_lo, hi = p.ph_hi;
    volatile __attribute__((address_space(3))) unsigned* bst = (volatile __attribute__((address_space(3))) unsigned*)LASP(lds + LDS_BAR);
    if (threadIdx.x < 2) bst[threadIdx.x] = 0u;
    __syncthreads();
    XcdBarrier bar; bar.bar = (unsigned*)(p.ws + WS_BAR); bar.x = 0; bar.st = bst;
    if (COOP) bar = xcd_barrier_post((unsigned*)(p.ws + WS_BAR), bst);
#define RUN_PHASE(k, call) do { if (((PHASE_MASK >> (k)) & 1) && lo <= (k) && (k) < hi) { call; if (COOP && (k) + 1 < hi) { if ((k) == 0) cg::this_grid().sync(); else xcd_barrier(bar); } } } while (0)
    RUN_PHASE(0, phase_prologue(p, lds));
    RUN_PHASE(1, ((USE_PG8 & 1) ? phase_proj_pg8(p, lds) : (phase_proj(p, lds), cg_or_nothing<COOP>(), phase_rope(p, lds))));
    RUN_PHASE(2, (((USE_OPT & 2) ? phase_hgrn_A(p, lds) : phase_hgrn_naive(p, lds)), __syncthreads(), (USE_OPT & 16) ? phase_diffattn2(p, lds) : (USE_OPT & 1) ? phase_diffattn(p, lds) : phase_attn_naive<true>(p, lds), __syncthreads(), (USE_OPT & 4) ? phase_memattn(p, lds) : phase_attn_naive<false>(p, lds)));
    RUN_PHASE(3, (((USE_OPT & 2) ? phase_hgrn_B(p, lds) : (void)0), __syncthreads(), (USE_OPT & 1) ? phase_diffcombine(p, lds) : (void)0));
    RUN_PHASE(4, ((USE_OPT & 2) ? phase_hgrn_C(p, lds) : (void)0));
    RUN_PHASE(5, ((USE_PG8 & 2) ? phase_merge_pg8(p, lds) : phase_merge(p, lds)));
    RUN_PHASE(6, ((USE_PG8 & 4) ? phase_wout_pg8(p, lds) : phase_wout(p, lds)));
    RUN_PHASE(7, ((USE_OPT & 8) ? phase_ln1_route2(p, lds) : phase_ln1_route(p, lds)));
    RUN_PHASE(8, phase_dispatch(p, lds));
    RUN_PHASE(9, ((USE_PG8 & 8) ? phase_exp_gu_pg8(p, lds) : phase_exp_gu(p, lds)));
    RUN_PHASE(10, ((USE_PG8 & 16) ? phase_exp_dn_pg8(p, lds) : phase_exp_dn(p, lds)));
    RUN_PHASE(11, phase_final(p, lds));
#undef RUN_PHASE
}

extern "C" void kernel_launch(void* const* d_in, const int* in_sizes, int n_in, void* d_out, int out_size, void* d_ws, size_t ws_size, hipStream_t stream) {
    static int grid = 0;
    if (grid == 0) {
        if (n_in != 26 || in_sizes[0] != NTOK * DM || out_size != NTOK * DM || ws_size < WS_END) {
            fprintf(stderr, "kernel_launch: unexpected shapes: n_in %d in0 %d out %d ws %zu (need >= %zu)\n", n_in, n_in > 0 ? in_sizes[0] : -1, out_size, ws_size, (size_t)WS_END); grid = -1; return; }
        int dev = 0, cus = 0, per_cu = 0;
        hipGetDevice(&dev); hipDeviceGetAttribute(&cus, hipDeviceAttributeMultiprocessorCount, dev);
        if (MK_ONE_LAUNCH) {
            hipFuncSetAttribute((const void*)k_fwd<true>, hipFuncAttributeMaxDynamicSharedMemorySize, LDS_BYTES);
            hipOccupancyMaxActiveBlocksPerMultiprocessor(&per_cu, (const void*)k_fwd<true>, 512, LDS_BYTES);
            if (per_cu < 1) { fprintf(stderr, "kernel_launch: occupancy query says %d blocks/CU\n", per_cu); per_cu = 1; }
            grid = cus * 1;
        } else {
            hipFuncSetAttribute((const void*)k_fwd<false>, hipFuncAttributeMaxDynamicSharedMemorySize, LDS_BYTES);
            grid = cus;
        }
        (void)hipGetLastError();
    }
    if (grid < 0) return;
    Params p{};
    for (int i = 0; i < 26; ++i) p.in[i] = d_in[i];
    p.out = (float*)d_out; p.ws = (unsigned char*)d_ws;
    if (MK_ONE_LAUNCH) {
        (void)hipMemsetAsync((char*)d_ws + WS_BAR, 0, 16384, stream);
        p.ph_lo = 0; p.ph_hi = NPHASE;
        void* args[] = {&p};
        hipError_t e = hipLaunchCooperativeKernel((const void*)k_fwd<true>, dim3(grid), dim3(512), args, LDS_BYTES, stream);
        if (e != hipSuccess) fprintf(stderr, "cooperative launch failed: %s (grid %d)\n", hipGetErrorString(e), grid);
    } else {
        for (int ph = 0; ph < NPHASE; ++ph) { p.ph_lo = ph; p.ph_hi = ph + 1; hipLaunchKernelGGL(k_fwd<false>, dim3(grid), dim3(512), LDS_BYTES, stream, p); }
    }
}
```
